# Optimizing an MI355X kernel written in HIP

```python
import jax, jax.numpy as jnp
from jax import lax
import numpy as np

D_MODEL = 1024
BATCH = 4
SEQ = 4096
DEPTH = 1

PLE_DIM = 256
EPS = 1e-6
N_HEADS = 8
N_KV_HEADS = 2
HEAD_DIM = 64
ATTN_WIDTH = N_HEADS * HEAD_DIM
KV_WIDTH = N_KV_HEADS * HEAD_DIM
WINDOW = 128
BLOCK = WINDOW
ROPE_THETA = 10000.0
LRU_WIDTH = D_MODEL - ATTN_WIDTH
LRU_BLOCKS = 8
LRU_BLOCK_DIM = LRU_WIDTH // LRU_BLOCKS
CONV_WIDTH = 4
LRU_C = 8.0
MIX_WIDTH = ATTN_WIDTH + LRU_WIDTH
OFF_K = ATTN_WIDTH
OFF_V = OFF_K + KV_WIDTH
OFF_LX = OFF_V + KV_WIDTH
OFF_LG = OFF_LX + LRU_WIDTH
IN_PROJ_WIDTH = OFF_LG + LRU_WIDTH
N_GROUPS = 4
EXPERTS_PER_GROUP = 8
TOP_K = 2
EXPERT_FF = 512
NEG_INF = -1e30

kernel_name = "hymba_swa_rglru_hmoe_layer"


def rmsnorm(x, g):
    xf = x.astype(jnp.float32)
    y = xf * lax.rsqrt(jnp.mean(xf * xf, axis=-1, keepdims=True) + EPS)
    return (y * g.astype(jnp.float32)).astype(x.dtype)


def rope_tables(positions):
    inv_freq = ROPE_THETA ** (-jnp.arange(0, HEAD_DIM, 2, dtype=jnp.float32) / HEAD_DIM)
    ang = positions.astype(jnp.float32)[..., None] * inv_freq
    return jnp.cos(ang)[:, :, None, :], jnp.sin(ang)[:, :, None, :]


def apply_rope(t, cos, sin):
    tf = t.astype(jnp.float32)
    t1, t2 = tf[..., : HEAD_DIM // 2], tf[..., HEAD_DIM // 2:]
    out = jnp.concatenate([t1 * cos - t2 * sin, t2 * cos + t1 * sin], axis=-1)
    return out.astype(t.dtype)


def sliding_window_attention(q, k, v, sinks):
    B, S, H, Dh = q.shape
    nb = S // BLOCK
    grp = H // N_KV_HEADS
    qb = q.reshape(B, nb, BLOCK, N_KV_HEADS, grp, Dh)

    def with_prev_block(t):
        prev = jnp.pad(t, ((0, 0), (BLOCK, 0), (0, 0), (0, 0)))[:, :S]
        prev = prev.reshape(B, nb, BLOCK, N_KV_HEADS, Dh)
        cur = t.reshape(B, nb, BLOCK, N_KV_HEADS, Dh)
        return jnp.concatenate([prev, cur], axis=2)

    kb = with_prev_block(k)
    vb = with_prev_block(v)
    scale = HEAD_DIM ** -0.5
    scores = jnp.einsum('bnqkgd,bnskd->bnkgqs', qb, kb,
                        preferred_element_type=jnp.float32) * scale
    qi = jnp.arange(BLOCK)[:, None]
    kj = jnp.arange(2 * BLOCK)[None, :]
    rel = qi + BLOCK - kj
    band = (rel >= 0) & (rel < WINDOW)
    block_ok = (jnp.arange(nb)[:, None, None] > 0) | (kj >= BLOCK)[None]
    mask = band[None] & block_ok
    scores = jnp.where(mask[None, :, None, None], scores, NEG_INF)
    sink = sinks.astype(jnp.float32).reshape(N_KV_HEADS, grp)[None, None, :, :, None, None]
    sink = jnp.broadcast_to(sink, scores.shape[:-1] + (1,))
    probs = jax.nn.softmax(jnp.concatenate([scores, sink], axis=-1), axis=-1)[..., :-1]
    out = jnp.einsum('bnkgqs,bnskd->bnqkgd', probs.astype(vb.dtype), vb)
    return out.reshape(B, S, H * Dh)


def causal_depthwise_conv(x, w, b):
    y = lax.conv_general_dilated(
        x, w[:, None, :], window_strides=(1,), padding=((CONV_WIDTH - 1, 0),),
        dimension_numbers=('NWC', 'WIO', 'NWC'), feature_group_count=x.shape[-1])
    return y + b


def rg_lru(x, w_a, b_a, w_x, b_x, lam):
    B, S, C = x.shape
    xb = x.reshape(B, S, LRU_BLOCKS, LRU_BLOCK_DIM)
    gate_a = jnp.einsum('bshi,hij->bshj', xb, w_a).reshape(B, S, C) + b_a
    gate_x = jnp.einsum('bshi,hij->bshj', xb, w_x).reshape(B, S, C) + b_x
    r = jax.nn.sigmoid(gate_a.astype(jnp.float32))
    i = jax.nn.sigmoid(gate_x.astype(jnp.float32))
    log_a = -LRU_C * r * jax.nn.softplus(-lam.astype(jnp.float32))
    a = jnp.exp(log_a)
    mult = jnp.sqrt(-jnp.expm1(2.0 * log_a))
    bterm = mult * i * x.astype(jnp.float32)

    def combine(left, right):
        a1, b1 = left
        a2, b2 = right
        return a1 * a2, a2 * b1 + b2

    _, h = lax.associative_scan(combine, (a, bterm), axis=1)
    return h.astype(x.dtype)


def hierarchical_moe(h, w_rg, b_rg, w_re, b_re, w_gate, w_up, w_down):
    B, S, D = h.shape
    T = B * S
    t = h.reshape(T, D)
    g_prob = jax.nn.softmax((t @ w_rg).astype(jnp.float32) + b_rg.astype(jnp.float32), axis=-1)
    g_top_p, g_top = lax.top_k(g_prob, 1)
    e_logits = ((t @ w_re).astype(jnp.float32) + b_re.astype(jnp.float32)).reshape(
        T, N_GROUPS, EXPERTS_PER_GROUP)
    e_sel = jnp.take_along_axis(e_logits, g_top[:, :, None], axis=1)[:, 0]
    e_prob = jax.nn.softmax(e_sel, axis=-1)
    e_top_p, e_top = lax.top_k(e_prob, TOP_K)
    e_top_p = e_top_p / jnp.sum(e_top_p, axis=-1, keepdims=True)
    w_tok = g_top_p * e_top_p
    expert_w = jnp.sum(jax.nn.one_hot(e_top, EXPERTS_PER_GROUP, dtype=jnp.float32)
                       * w_tok[..., None], axis=1)
    combine = (jax.nn.one_hot(g_top[:, 0], N_GROUPS, dtype=jnp.float32)[:, :, None]
               * expert_w[:, None, :])
    out = jnp.zeros((T, D), dtype=h.dtype)
    for g in range(N_GROUPS):
        a = jnp.einsum('td,edf->tef', t, w_gate[g])
        u = jnp.einsum('td,edf->tef', t, w_up[g])
        hid = jax.nn.silu(a) * u * combine[:, g, :, None].astype(t.dtype)
        out = out + jnp.einsum('tef,efd->td', hid, w_down[g])
    return out.reshape(B, S, D)


def setup_inputs(seed: int = 0) -> dict:
    key = jax.random.key(seed)
    ks = jax.random.split(key, 32)
    f32 = jnp.float32

    def nrm(k, shape, scale):
        return jax.random.normal(k, shape, f32) * scale

    def gain(k, shape):
        return 1.0 + 0.01 * jax.random.normal(k, shape, f32)

    L, D, G, E, F = DEPTH, D_MODEL, N_GROUPS, EXPERTS_PER_GROUP, EXPERT_FF
    u = jax.random.uniform(ks[14], (L, LRU_WIDTH), f32, minval=0.9, maxval=0.999)
    s = u ** (1.0 / LRU_C)
    lru_lambda = jnp.log(s) - jnp.log1p(-s)
    positions = (jnp.arange(SEQ, dtype=jnp.int32)[None, :]
                 + jax.random.randint(ks[2], (BATCH, 1), 0, 1024, dtype=jnp.int32))
    return {
        "x": nrm(ks[0], (BATCH, SEQ, D), 1.0),
        "p": nrm(ks[1], (L, BATCH, SEQ, PLE_DIM), 1.0),
        "positions": positions,
        "g_mix": gain(ks[3], (L, D)),
        "w_in": nrm(ks[4], (L, D, IN_PROJ_WIDTH), D ** -0.5),
        "sinks": nrm(ks[5], (L, N_HEADS), 0.5),
        "conv_w": nrm(ks[6], (L, CONV_WIDTH, LRU_WIDTH), CONV_WIDTH ** -0.5),
        "conv_b": nrm(ks[7], (L, LRU_WIDTH), 0.01),
        "lru_wa": nrm(ks[8], (L, LRU_BLOCKS, LRU_BLOCK_DIM, LRU_BLOCK_DIM), LRU_BLOCK_DIM ** -0.5),
        "lru_ba": nrm(ks[9], (L, LRU_WIDTH), 0.01),
        "lru_wx": nrm(ks[10], (L, LRU_BLOCKS, LRU_BLOCK_DIM, LRU_BLOCK_DIM), LRU_BLOCK_DIM ** -0.5),
        "lru_bx": nrm(ks[11], (L, LRU_WIDTH), 0.01),
        "lru_lambda": lru_lambda,
        "g_attn_out": gain(ks[12], (L, ATTN_WIDTH)),
        "g_lru_out": gain(ks[13], (L, LRU_WIDTH)),
        "w_out": nrm(ks[15], (L, MIX_WIDTH, D), MIX_WIDTH ** -0.5),
        "g_ffn": gain(ks[16], (L, D)),
        "w_router_group": nrm(ks[17], (L, D, G), D ** -0.5),
        "b_router_group": nrm(ks[18], (L, G), 0.01),
        "w_router_expert": nrm(ks[19], (L, D, G * E), D ** -0.5),
        "b_router_expert": nrm(ks[20], (L, G * E), 0.01),
        "w_expert_gate": nrm(ks[21], (L, G, E, D, F), D ** -0.5),
        "w_expert_up": nrm(ks[22], (L, G, E, D, F), D ** -0.5),
        "w_expert_down": nrm(ks[23], (L, G, E, F, D), F ** -0.5),
        "g_ple": gain(ks[24], (L, D)),
        "w_ple_gate": nrm(ks[25], (L, D, D), D ** -0.5),
        "w_ple_proj": nrm(ks[26], (L, PLE_DIM, D), PLE_DIM ** -0.5),
        "g_final": gain(ks[27], (D,)),
    }


def reference(x, p, positions, g_mix, w_in, sinks, conv_w, conv_b, lru_wa, lru_ba,
              lru_wx, lru_bx, lru_lambda, g_attn_out, g_lru_out, w_out, g_ffn,
              w_router_group, b_router_group, w_router_expert, b_router_expert,
              w_expert_gate, w_expert_up, w_expert_down, g_ple, w_ple_gate, w_ple_proj,
              g_final):
    B, S, _ = x.shape
    cos, sin = rope_tables(positions)
    for i in range(DEPTH):
        h = rmsnorm(x, g_mix[i])
        proj = h @ w_in[i]
        q = proj[..., :OFF_K].reshape(B, S, N_HEADS, HEAD_DIM)
        k = proj[..., OFF_K:OFF_V].reshape(B, S, N_KV_HEADS, HEAD_DIM)
        v = proj[..., OFF_V:OFF_LX].reshape(B, S, N_KV_HEADS, HEAD_DIM)
        lx = proj[..., OFF_LX:OFF_LG]
        lg = proj[..., OFF_LG:]
        q = apply_rope(q, cos, sin)
        k = apply_rope(k, cos, sin)
        attn = sliding_window_attention(q, k, v, sinks[i])
        lx = causal_depthwise_conv(lx, conv_w[i], conv_b[i])
        lru = rg_lru(lx, lru_wa[i], lru_ba[i], lru_wx[i], lru_bx[i], lru_lambda[i])
        lru = lru * jax.nn.gelu(lg)
        mix = jnp.concatenate([rmsnorm(attn, g_attn_out[i]), rmsnorm(lru, g_lru_out[i])], axis=-1)
        x = x + mix @ w_out[i]
        h2 = rmsnorm(x, g_ffn[i])
        x = x + hierarchical_moe(h2, w_router_group[i], b_router_group[i],
                                 w_router_expert[i], b_router_expert[i],
                                 w_expert_gate[i], w_expert_up[i], w_expert_down[i])
        gate = jax.nn.sigmoid(rmsnorm(x, g_ple[i]) @ w_ple_gate[i])
        x = x + gate * (p[i] @ w_ple_proj[i])
    return rmsnorm(x, g_final)
```

```cpp
#include <hip/hip_runtime.h>
#include <cstdio>
#include <cstdint>

namespace {
constexpr int T = 16384, SEQ = 4096, D = 1024, NPROJ = 1792, PLE = 256;
constexpr int OFF_K = 512, OFF_V = 640, OFF_LX = 768, OFF_LG = 1280;
constexpr int NE = 32, FF = 512, NSLOT = 2 * T;
constexpr float EPS = 1e-6f;

__device__ __forceinline__ float wave_sum(float v) {
#pragma unroll
    for (int o = 1; o < 64; o <<= 1) v += __shfl_xor(v, o);
    return v;
}
__device__ __forceinline__ float sigmoidf_(float x) { return 1.f / (1.f + expf(-x)); }
__device__ __forceinline__ float gelu_tanh(float x) { return 0.5f * x * (1.f + tanhf(0.7978845608028654f * (x + 0.044715f * x * x * x))); }

__global__ void __launch_bounds__(256) k_rmsnorm(const float* x, const float* __restrict__ g, float* out, int ldx, int ldo, int rows, int cols) {
    const int lane = threadIdx.x & 63, row = blockIdx.x * 4 + (threadIdx.x >> 6);
    if (row >= rows) return;
    const float* xr = x + (size_t)row * ldx;
    float s = 0.f;
    for (int c = lane; c < cols; c += 64) { const float v = xr[c]; s += v * v; }
    s = wave_sum(s);
    const float r = rsqrtf(s / (float)cols + EPS);
    float* o = out + (size_t)row * ldo;
    for (int c = lane; c < cols; c += 64) o[c] = xr[c] * r * g[c];
}

struct GArgs {
    const float* A;
    const float* B; const float* B2;
    const int* rows;
    const int* counts;
    const int* aoff;
    long strideB;
    int lda, ldb, M, N, K, cap;
};
template <bool DUAL, class Epi>
__global__ void __launch_bounds__(256) k_gemm(GArgs g, Epi epi) {
    const int e = blockIdx.z;
    const int M = g.counts ? g.counts[e] : g.M;
    const int m0 = blockIdx.y * 64, n0 = blockIdx.x * 64;
    if (m0 >= M) return;
    __shared__ float As[16][68];
    __shared__ float Bs[16][64];
    __shared__ float Bs2[DUAL ? 16 : 1][64];
    const int tid = threadIdx.x, tx = tid & 15, ty = tid >> 4;
    const float* B = g.B + (size_t)e * g.strideB;
    const float* B2 = DUAL ? g.B2 + (size_t)e * g.strideB : nullptr;
    const int ar = tid >> 2, ak = (tid & 3) * 4;
    int arow = m0 + ar; bool aval = arow < M;
    long abase = 0;
    if (aval) { const int r = g.rows ? g.rows[(size_t)e * g.cap + arow] : (g.aoff ? g.aoff[e] + arow : arow); abase = (long)r * g.lda; }
    const int bk = tid >> 4, bn = (tid & 15) * 4;
    float acc[4][4] = {}, acc2[4][4] = {};
    for (int k0 = 0; k0 < g.K; k0 += 16) {
        float4 av = make_float4(0.f, 0.f, 0.f, 0.f);
        if (aval) av = *(const float4*)(g.A + abase + k0 + ak);
        As[ak + 0][ar] = av.x; As[ak + 1][ar] = av.y; As[ak + 2][ar] = av.z; As[ak + 3][ar] = av.w;
        *(float4*)&Bs[bk][bn] = *(const float4*)(B + (size_t)(k0 + bk) * g.ldb + n0 + bn);
        if (DUAL) *(float4*)&Bs2[bk][bn] = *(const float4*)(B2 + (size_t)(k0 + bk) * g.ldb + n0 + bn);
        __syncthreads();
#pragma unroll
        for (int kk = 0; kk < 16; ++kk) {
            float a[4], b[4], b2[4];
#pragma unroll
            for (int i = 0; i < 4; ++i) a[i] = As[kk][ty * 4 + i];
#pragma unroll
            for (int j = 0; j < 4; ++j) { b[j] = Bs[kk][tx * 4 + j]; if (DUAL) b2[j] = Bs2[kk][tx * 4 + j]; }
#pragma unroll
            for (int i = 0; i < 4; ++i)
#pragma unroll
                for (int j = 0; j < 4; ++j) { acc[i][j] += a[i] * b[j]; if (DUAL) acc2[i][j] += a[i] * b2[j]; }
        }
        __syncthreads();
    }
#pragma unroll
    for (int i = 0; i < 4; ++i) {
        const int m = m0 + ty * 4 + i; if (m >= M) continue;
#pragma unroll
        for (int j = 0; j < 4; ++j) epi(e, m, n0 + tx * 4 + j, acc[i][j], acc2[i][j]);
    }
}
struct EpiStore { float* C; int ldc; int pad; __device__ void operator()(int, int m, int n, float v, float) const { C[(size_t)m * ldc + n] = v; } };
struct EpiResid { const float* R; float* C; int ldc; int pad; __device__ void operator()(int, int m, int n, float v, float) const { C[(size_t)m * ldc + n] = R[(size_t)m * ldc + n] + v; } };
struct EpiMoe1 { float* hid; const int* off; const float* wl; int cap; int pad;
    __device__ void operator()(int e, int m, int n, float a, float u) const { const float w = wl[(size_t)e * cap + m]; hid[(size_t)(off[e] + m) * FF + n] = (a / (1.f + expf(-a))) * u * w; } };
struct EpiMoe2 { float* y; const int* off; __device__ void operator()(int e, int m, int n, float v, float) const { y[(size_t)(off[e] + m) * D + n] = v; } };
struct EpiPle { float* X; const float* pp; __device__ void operator()(int, int m, int n, float v, float) const { const size_t i = (size_t)m * D + n; X[i] = X[i] + sigmoidf_(v) * pp[i]; } };

__global__ void __launch_bounds__(256) k_rope(const float* __restrict__ proj, const int* __restrict__ pos, float* __restrict__ qr, float* __restrict__ kr) {
    const int idx = blockIdx.x * 256 + threadIdx.x;
    if (idx >= T * 10 * 32) return;
    const int i = idx & 31, hh = (idx >> 5) % 10, t = idx / 320;
    const float inv_freq = powf(10000.f, -(float)(2 * i) / 64.f);
    const float ang = (float)pos[t] * inv_freq;
    float sn, cs; sincosf(ang, &sn, &cs);
    const float* src = proj + (size_t)t * NPROJ + (hh < 8 ? hh * 64 : OFF_K + (hh - 8) * 64);
    float* dst = hh < 8 ? qr + (size_t)t * 512 + hh * 64 : kr + (size_t)t * 128 + (hh - 8) * 64;
    const float t1 = src[i], t2 = src[i + 32];
    dst[i] = t1 * cs - t2 * sn; dst[i + 32] = t2 * cs + t1 * sn;
}
__global__ void __launch_bounds__(256) k_attn(const float* __restrict__ qr, const float* __restrict__ kr, const float* __restrict__ proj, const float* __restrict__ sinks, float* __restrict__ attn) {
    const int lane = threadIdx.x & 63, gw = blockIdx.x * 4 + (threadIdx.x >> 6);
    const int t = gw >> 3, h = gw & 7, b = t / SEQ, s = t % SEQ, kvh = h >> 2;
    const float q = qr[(size_t)t * 512 + h * 64 + lane] * 0.125f;
    float m = sinks[h], l = 1.f, acc = 0.f;
    const int j0 = s - 127 < 0 ? 0 : s - 127;
    for (int j = j0; j <= s; ++j) {
        const size_t tj = (size_t)b * SEQ + j;
        const float sc = wave_sum(q * kr[tj * 128 + kvh * 64 + lane]);
        const float mn = fmaxf(m, sc), alpha = expf(m - mn), p = expf(sc - mn);
        l = l * alpha + p; acc = acc * alpha + p * proj[tj * NPROJ + OFF_V + kvh * 64 + lane]; m = mn;
    }
    attn[(size_t)t * 512 + h * 64 + lane] = acc / l;
}
__global__ void __launch_bounds__(512) k_lru_gates(const float* __restrict__ proj, const float* __restrict__ cw, const float* __restrict__ cb,
                                                   const float* __restrict__ wa, const float* __restrict__ ba, const float* __restrict__ wx, const float* __restrict__ bx,
                                                   const float* __restrict__ lam, float* __restrict__ av, float* __restrict__ bv) {
    __shared__ float sx[512];
    const int t = blockIdx.x, c = threadIdx.x, s = t % SEQ;
    float xc = cb[c];
#pragma unroll
    for (int j = 0; j < 4; ++j) { const int sj = s - 3 + j; if (sj >= 0) xc += cw[j * 512 + c] * proj[(size_t)(t - 3 + j) * NPROJ + OFF_LX + c]; }
    sx[c] = xc;
    __syncthreads();
    const int h = c >> 6, jj = c & 63;
    float ga = ba[c], gx = bx[c];
    for (int i = 0; i < 64; ++i) { const float xi = sx[h * 64 + i]; ga += xi * wa[(size_t)(h * 64 + i) * 64 + jj]; gx += xi * wx[(size_t)(h * 64 + i) * 64 + jj]; }
    const float r = sigmoidf_(ga), ig = sigmoidf_(gx);
    const float sp = log1pf(expf(-lam[c]));
    const float log_a = -8.f * r * sp;
    const float a = expf(log_a), mult = sqrtf(-expm1f(2.f * log_a));
    av[(size_t)t * 512 + c] = a; bv[(size_t)t * 512 + c] = mult * ig * xc;
}
__global__ void __launch_bounds__(64) k_lru_scan(const float* __restrict__ av, const float* __restrict__ bv, const float* __restrict__ proj, float* __restrict__ lru) {
    const int idx = blockIdx.x * 64 + threadIdx.x;
    const int b = idx >> 9, c = idx & 511;
    float h = 0.f;
    for (int s = 0; s < SEQ; s += 8) {
        float a[8], bb[8], lg[8];
#pragma unroll
        for (int u = 0; u < 8; ++u) { const size_t t = (size_t)b * SEQ + s + u; a[u] = av[t * 512 + c]; bb[u] = bv[t * 512 + c]; lg[u] = proj[t * NPROJ + OFF_LG + c]; }
#pragma unroll
        for (int u = 0; u < 8; ++u) { h = a[u] * h + bb[u]; lru[((size_t)b * SEQ + s + u) * 512 + c] = h * gelu_tanh(lg[u]); }
    }
}
__global__ void __launch_bounds__(256) k_router(const float* __restrict__ h2, const float* __restrict__ wrg, const float* __restrict__ brg, const float* __restrict__ wre, const float* __restrict__ bre,
                                                int* __restrict__ cnt, int* __restrict__ list, float* __restrict__ wl, int* __restrict__ tokE, int* __restrict__ tokPos) {
    const int lane = threadIdx.x & 63, t = blockIdx.x * 4 + (threadIdx.x >> 6);
    float acc[36];
#pragma unroll
    for (int j = 0; j < 36; ++j) acc[j] = 0.f;
    for (int k = lane; k < D; k += 64) {
        const float hv = h2[(size_t)t * D + k];
#pragma unroll
        for (int j = 0; j < 4; ++j) acc[j] += hv * wrg[k * 4 + j];
#pragma unroll
        for (int j = 0; j < 32; ++j) acc[4 + j] += hv * wre[k * 32 + j];
    }
#pragma unroll
    for (int j = 0; j < 36; ++j) acc[j] = wave_sum(acc[j]);
    if (lane == 0) {
        float gl[4], gm = -1e30f; int gt = 0;
#pragma unroll
        for (int j = 0; j < 4; ++j) { gl[j] = acc[j] + brg[j]; if (gl[j] > gm) { gm = gl[j]; gt = j; } }
        float gs = 0.f;
#pragma unroll
        for (int j = 0; j < 4; ++j) gs += expf(gl[j] - gm);
        const float gp = 1.f / gs;
        float el[8];
#pragma unroll
        for (int j = 0; j < 8; ++j) {
            float v = 0.f;
#pragma unroll
            for (int g2 = 0; g2 < 4; ++g2) v = (g2 == gt) ? acc[4 + g2 * 8 + j] : v;
            el[j] = v + bre[gt * 8 + j];
        }
        float m1 = -1e30f; int i1 = 0;
#pragma unroll
        for (int j = 0; j < 8; ++j) if (el[j] > m1) { m1 = el[j]; i1 = j; }
        float m2 = -1e30f; int i2 = 0;
#pragma unroll
        for (int j = 0; j < 8; ++j) if (j != i1 && el[j] > m2) { m2 = el[j]; i2 = j; }
        const float e2 = expf(m2 - m1), w1 = gp / (1.f + e2), w2 = gp * e2 / (1.f + e2);
        const int E1 = gt * 8 + i1, E2 = gt * 8 + i2;
        const int p1 = atomicAdd(&cnt[E1], 1), p2 = atomicAdd(&cnt[E2], 1);
        list[(size_t)E1 * T + p1] = t; wl[(size_t)E1 * T + p1] = w1;
        list[(size_t)E2 * T + p2] = t; wl[(size_t)E2 * T + p2] = w2;
        tokE[t * 2] = E1; tokPos[t * 2] = p1; tokE[t * 2 + 1] = E2; tokPos[t * 2 + 1] = p2;
    }
}
__global__ void k_offsets(const int* __restrict__ cnt, int* __restrict__ off) { if (threadIdx.x == 0) { int s = 0; for (int e = 0; e < NE; ++e) { off[e] = s; s += cnt[e]; } } }
__global__ void __launch_bounds__(256) k_combine(float* __restrict__ X, const float* __restrict__ y, const int* __restrict__ off, const int* __restrict__ tokE, const int* __restrict__ tokPos) {
    const int t = blockIdx.x;
    const size_t s1 = (size_t)off[tokE[t * 2]] + tokPos[t * 2], s2 = (size_t)off[tokE[t * 2 + 1]] + tokPos[t * 2 + 1];
    for (int n = threadIdx.x; n < D; n += 256) X[(size_t)t * D + n] += y[s1 * D + n] + y[s2 * D + n];
}
}

extern "C" void kernel_launch(void* const* d_in, const int* in_sizes, int n_in, void* d_out, int out_size, void* d_ws, size_t ws_size, hipStream_t stream) {
    const float* x = (const float*)d_in[0]; const float* p = (const float*)d_in[1]; const int* pos = (const int*)d_in[2];
    const float* g_mix = (const float*)d_in[3]; const float* w_in = (const float*)d_in[4]; const float* sinks = (const float*)d_in[5];
    const float* conv_w = (const float*)d_in[6]; const float* conv_b = (const float*)d_in[7]; const float* lru_wa = (const float*)d_in[8];
    const float* lru_ba = (const float*)d_in[9]; const float* lru_wx = (const float*)d_in[10]; const float* lru_bx = (const float*)d_in[11];
    const float* lru_lam = (const float*)d_in[12]; const float* g_attn = (const float*)d_in[13]; const float* g_lru = (const float*)d_in[14];
    const float* w_out = (const float*)d_in[15]; const float* g_ffn = (const float*)d_in[16]; const float* w_rg = (const float*)d_in[17];
    const float* b_rg = (const float*)d_in[18]; const float* w_re = (const float*)d_in[19]; const float* b_re = (const float*)d_in[20];
    const float* w_eg = (const float*)d_in[21]; const float* w_eu = (const float*)d_in[22]; const float* w_ed = (const float*)d_in[23];
    const float* g_ple = (const float*)d_in[24]; const float* w_pg = (const float*)d_in[25]; const float* w_pp = (const float*)d_in[26];
    const float* g_final = (const float*)d_in[27];
    float* X = (float*)d_out;
    const size_t MB = 1u << 20;
    const size_t R0 = 0, R1 = 64 * MB, R2 = 176 * MB, R3 = 240 * MB, WS_END = 248 * MB;
    if (ws_size < WS_END || n_in != 28 || out_size != T * D) { fprintf(stderr, "kernel_launch: ws %zu < %zu or n_in %d or out %d\n", ws_size, (size_t)WS_END, n_in, out_size); return; }
    char* ws = (char*)d_ws;
    float* hbuf = (float*)(ws + R0);
    float* proj = (float*)(ws + R1);
    float* attn = (float*)(ws + R2);
    float* lru = attn + (size_t)T * 512;
    int* cnt = (int*)(ws + R3); int* off = cnt + 64; int* tokE = off + 64; int* tokPos = tokE + 2 * T;
    int* list = tokPos + 2 * T; float* wl = (float*)(list + (size_t)NE * T);
    k_rmsnorm<<<T / 4, 256, 0, stream>>>(x, g_mix, hbuf, D, D, T, D);
    { GArgs g{hbuf, w_in, nullptr, nullptr, nullptr, nullptr, 0, D, NPROJ, T, NPROJ, D, 0}; k_gemm<false, EpiStore><<<dim3(NPROJ / 64, T / 64, 1), 256, 0, stream>>>(g, EpiStore{proj, NPROJ, 0}); }
    float* qr = hbuf; float* kr = hbuf + (size_t)T * 512;
    k_rope<<<T * 320 / 256, 256, 0, stream>>>(proj, pos, qr, kr);
    k_attn<<<T * 8 / 4, 256, 0, stream>>>(qr, kr, proj, sinks, attn);
    float* av = hbuf; float* bv = hbuf + (size_t)T * 512;
    k_lru_gates<<<T, 512, 0, stream>>>(proj, conv_w, conv_b, lru_wa, lru_ba, lru_wx, lru_bx, lru_lam, av, bv);
    k_lru_scan<<<2048 / 64, 64, 0, stream>>>(av, bv, proj, lru);
    k_rmsnorm<<<T / 4, 256, 0, stream>>>(attn, g_attn, hbuf, 512, D, T, 512);
    k_rmsnorm<<<T / 4, 256, 0, stream>>>(lru, g_lru, hbuf + 512, 512, D, T, 512);
    { GArgs g{hbuf, w_out, nullptr, nullptr, nullptr, nullptr, 0, D, D, T, D, D, 0}; k_gemm<false, EpiResid><<<dim3(D / 64, T / 64, 1), 256, 0, stream>>>(g, EpiResid{x, X, D, 0}); }
    k_rmsnorm<<<T / 4, 256, 0, stream>>>(X, g_ffn, hbuf, D, D, T, D);
    (void)hipMemsetAsync(cnt, 0, 64 * sizeof(int), stream);
    k_router<<<T / 4, 256, 0, stream>>>(hbuf, w_rg, b_rg, w_re, b_re, cnt, list, wl, tokE, tokPos);
    k_offsets<<<1, 64, 0, stream>>>(cnt, off);
    float* hid = attn;
    { GArgs g{hbuf, w_eg, w_eu, list, cnt, nullptr, (long)D * FF, D, FF, 0, FF, D, T}; k_gemm<true, EpiMoe1><<<dim3(FF / 64, T / 64, NE), 256, 0, stream>>>(g, EpiMoe1{hid, off, wl, T, 0}); }
    float* y = hbuf;
    { GArgs g{hid, w_ed, nullptr, nullptr, cnt, off, (long)FF * D, FF, D, 0, D, FF, 0}; k_gemm<false, EpiMoe2><<<dim3(D / 64, T / 64, NE), 256, 0, stream>>>(g, EpiMoe2{y, off}); }
    k_combine<<<T, 256, 0, stream>>>(X, y, off, tokE, tokPos);
    float* h3 = attn;
    float* pp = hbuf;
    k_rmsnorm<<<T / 4, 256, 0, stream>>>(X, g_ple, h3, D, D, T, D);
    { GArgs g{p, w_pp, nullptr, nullptr, nullptr, nullptr, 0, PLE, D, T, D, PLE, 0}; k_gemm<false, EpiStore><<<dim3(D / 64, T / 64, 1), 256, 0, stream>>>(g, EpiStore{pp, D, 0}); }
    { GArgs g{h3, w_pg, nullptr, nullptr, nullptr, nullptr, 0, D, D, T, D, D, 0}; k_gemm<false, EpiPle><<<dim3(D / 64, T / 64, 1), 256, 0, stream>>>(g, EpiPle{X, pp}); }
    k_rmsnorm<<<T / 4, 256, 0, stream>>>(X, g_final, X, D, D, T, D);
}
```

```cpp
#include <hip/hip_runtime.h>
#include <cstdio>
#include <cstdint>
#define GAS __attribute__((address_space(1)))
#define LAS __attribute__((address_space(3)))
typedef unsigned short bf16_t;
typedef short bf16x8 __attribute__((ext_vector_type(8)));
typedef float f32x4 __attribute__((ext_vector_type(4)));
typedef float f32x2 __attribute__((ext_vector_type(2)));
typedef unsigned u32x4 __attribute__((ext_vector_type(4)));
typedef unsigned u32x2 __attribute__((ext_vector_type(2)));
typedef GAS unsigned gu32;

namespace mk {
constexpr int T = 16384, SEQ = 4096, D = 1024, NPROJ = 1792, PLE = 256;
constexpr int OFF_K = 512, OFF_V = 640, OFF_LX = 768, OFF_LG = 1280;
constexpr int NE = 32, FF = 512;
constexpr float EPS = 1e-6f;
constexpr int NWAVES = 8, NTHR = 512;
constexpr int RING_BYTES = 131072, LDSCTL_OFF = RING_BYTES, MISC_OFF = LDSCTL_OFF + 320, XTRA_OFF = RING_BYTES + 1024, LDS_BYTES = 147456;

__device__ __forceinline__ unsigned f2bf(float f) { unsigned u = __builtin_bit_cast(unsigned, f); return (u + 0x7fffu + ((u >> 16) & 1u)) >> 16; }
typedef __bf16 bf16x2_t __attribute__((ext_vector_type(2)));
__device__ __forceinline__ unsigned pk2(float lo, float hi) { f32x2 f = {lo, hi}; return __builtin_bit_cast(unsigned, __builtin_convertvector(f, bf16x2_t)); }
__device__ __forceinline__ float bf2f(unsigned short b) { return __builtin_bit_cast(float, (unsigned)b << 16); }
__device__ __forceinline__ float bflo(unsigned w) { return __builtin_bit_cast(float, w << 16); }
__device__ __forceinline__ float bfhi(unsigned w) { return __builtin_bit_cast(float, w & 0xffff0000u); }
__device__ __forceinline__ float wsum(float v) {
#pragma unroll
    for (int o = 1; o < 64; o <<= 1) v += __shfl_xor(v, o);
    return v;
}

namespace pg8 {
constexpr int BM = 256, BK = 64, HALF = 128, HTB = HALF * BK * 2, STAGE_BYTES = 8 * HTB, NXCD = 8, WGM = 8;
__device__ __forceinline__ int lds_byte(int r, int c) { const int st = (r >> 4) * 2 + (c >> 5), rr = r & 15, cc = c & 31, ob = rr * 64 + cc * 2; return st * 1024 + (ob ^ (((ob >> 9) & 1) << 5)); }
__device__ __forceinline__ void stage_rc(int b, int& R, int& C) { const int st = b / 1024, sb = b % 1024, swz = sb ^ (((sb >> 9) & 1) << 5); R = (st >> 1) * 16 + swz / 64; C = (st & 1) * 32 + (swz % 64) / 2; }
__device__ __forceinline__ int perm32(int rho) { const int n = rho >> 4, i = rho & 15; return 8 * (i >> 2) + 4 * n + (i & 3); }

struct Unit { int pm, pn, e, nrow, li0; };

struct DenseOrder {
    const bf16_t* A; const bf16_t* Bt; int K, nM, nN, nwg, G, c;
    __device__ void init(const bf16_t* A_, const bf16_t* Bt_, int M, int N, int K_, int G_, int c_) { A = A_; Bt = Bt_; K = K_; nM = M / BM; nN = N / BM; nwg = nM * nN; G = G_; c = c_; }
    __device__ bool next(int i, Unit& u) const {
        const long L = (long)i * G + c; if (L >= nwg) return false;
        int wgid = (int)L; { const int q = nwg / NXCD, r = nwg % NXCD, xcd = wgid % NXCD, off = wgid / NXCD; wgid = (xcd < r ? xcd * (q + 1) : r * (q + 1) + (xcd - r) * q) + off; }
        const int nig = WGM * nN, gid = wgid / nig, fm = gid * WGM, gsz = (nM - fm) < WGM ? (nM - fm) : WGM;
        u.pm = fm + ((wgid % nig) % gsz); u.pn = (wgid % nig) / gsz; u.e = 0; u.nrow = BM; u.li0 = 0; return true;
    }
    __device__ const char* a_ptr(const Unit& u) const { return (const char*)A + (size_t)u.pm * BM * K * 2; }
    __device__ const char* b_ptr(const Unit& u) const { return (const char*)Bt + (size_t)u.pn * BM * K * 2; }
    __device__ unsigned a_row(const Unit&, int r) const { return (unsigned)r; }
};

#define PG8_WAIT_V(n) asm volatile("s_waitcnt vmcnt(" #n ")" ::: "memory")
#define PG8_WAIT_L(n) asm volatile("s_waitcnt lgkmcnt(" #n ")" ::: "memory")
#define PG8_BAR __builtin_amdgcn_s_barrier()
#define PG8_SCHED __builtin_amdgcn_sched_barrier(0)

template <class Epi, class Sched, bool ALIGN_EPI, bool GATHER>
__device__ __forceinline__ void gemm_phase(LAS unsigned char* lds, const int K, const Sched& S, const Epi& E) {
    const int tid = threadIdx.x, wid = __builtin_amdgcn_readfirstlane(tid >> 6), lane = tid & 63, wr = wid >> 2, wc = wid & 3, fr = lane & 15, fq = lane >> 4;
    const int nt = K / BK;
    int Rr[2], Cc[2]; unsigned voffA[2], voffB[2];
#pragma unroll
    for (int i = 0; i < 2; ++i) { stage_rc(tid * 16 + i * 8192, Rr[i], Cc[i]); const int Rb = Epi::PERM ? ((Rr[i] & ~31) + perm32(Rr[i] & 31)) : Rr[i];
        voffA[i] = (unsigned)(Rr[i] * K + Cc[i]) * 2u; voffB[i] = (unsigned)(Rb * K + Cc[i]) * 2u; }
    const size_t kstep = (size_t)(BK * 2);
    const size_t hstepB = (size_t)HALF * K * 2;
    const size_t hstepA = GATHER ? 0 : hstepB;
    const unsigned ldsw = (unsigned)wid * 1024u;
    const int aoff = lds_byte(wr * 64 + fr, fq * 8), boff = lds_byte(wc * 32 + fr, fq * 8);
#define PG8_SA(b, h) (((b) * 2 + (h)) * HTB)
#define PG8_SB(b, h) ((4 + (b) * 2 + (h)) * HTB)
#define PG8_ST2(bufoff, gbase, v0, v1) do { \
        __builtin_amdgcn_global_load_lds((const unsigned*)((const char*)(gbase) + (v0)), (LAS unsigned*)(lds + (bufoff) + ldsw), 16, 0, 0); \
        __builtin_amdgcn_global_load_lds((const unsigned*)((const char*)(gbase) + (v1)), (LAS unsigned*)(lds + (bufoff) + ldsw + 8192), 16, 0, 0); } while (0)
#define PG8_STB(bufoff, gbase) PG8_ST2(bufoff, gbase, voffB[0], voffB[1])
#define PG8_LDA(dst, b, h) do { _Pragma("unroll") for (int m = 0; m < 4; ++m) _Pragma("unroll") for (int k = 0; k < 2; ++k) dst[m][k] = *(const LAS bf16x8*)(lds + PG8_SA(b, h) + aoff + m * 2048 + k * 1024); } while (0)
#define PG8_LDB(dst, b, h) do { _Pragma("unroll") for (int n = 0; n < 2; ++n) _Pragma("unroll") for (int k = 0; k < 2; ++k) dst[n][k] = *(const LAS bf16x8*)(lds + PG8_SB(b, h) + boff + n * 2048 + k * 1024); } while (0)
#define PG8_MMA(ai, bj, At, Bt) do { __builtin_amdgcn_s_setprio(1); _Pragma("unroll") for (int m = 0; m < 4; ++m) _Pragma("unroll") for (int n = 0; n < 2; ++n) _Pragma("unroll") for (int k = 0; k < 2; ++k) \
        acc[ai][bj][m][n] = __builtin_amdgcn_mfma_f32_16x16x32_bf16(Bt[n][k], At[m][k], acc[ai][bj][m][n], 0, 0, 0); __builtin_amdgcn_s_setprio(0); } while (0)
    Unit cur, nxt; int ui = 0;
    if (!S.next(0, cur)) return;
    f32x4 acc[2][2][4][2];
#pragma unroll
    for (int a = 0; a < 2; ++a)
#pragma unroll
        for (int b = 0; b < 2; ++b)
#pragma unroll
            for (int m = 0; m < 4; ++m)
#pragma unroll
                for (int n = 0; n < 2; ++n) acc[a][b][m][n] = (f32x4){0.f, 0.f, 0.f, 0.f};
    bf16x8 At[4][2], B0[2][2], B1[2][2];
    const char* cA = S.a_ptr(cur); const char* cB = S.b_ptr(cur);
    unsigned c00 = voffA[0], c01 = voffA[1], c10 = voffA[0], c11 = voffA[1], n00 = voffA[0], n01 = voffA[1], n10 = voffA[0], n11 = voffA[1];
    if constexpr (GATHER) {
        c00 = (S.a_row(cur, Rr[0]) * (unsigned)K + (unsigned)Cc[0]) * 2u; c01 = (S.a_row(cur, Rr[1]) * (unsigned)K + (unsigned)Cc[1]) * 2u;
        c10 = (S.a_row(cur, HALF + Rr[0]) * (unsigned)K + (unsigned)Cc[0]) * 2u; c11 = (S.a_row(cur, HALF + Rr[1]) * (unsigned)K + (unsigned)Cc[1]) * 2u;
    }
    PG8_STB(PG8_SB(0, 0), cB); PG8_STB(PG8_SB(0, 1), cB + hstepB); PG8_ST2(PG8_SA(0, 0), cA, c00, c01); PG8_ST2(PG8_SA(0, 1), cA + hstepA, c10, c11);
    if (wr == 1) PG8_BAR;
    PG8_WAIT_V(2); PG8_BAR;
    PG8_STB(PG8_SB(1, 0), cB + kstep); PG8_ST2(PG8_SA(1, 0), cA + kstep, c00, c01); PG8_STB(PG8_SB(1, 1), cB + hstepB + kstep);
    PG8_WAIT_V(6); PG8_BAR;
    for (;;) {
        const bool has_next = S.next(ui + 1, nxt);
        const char* nA = has_next ? S.a_ptr(nxt) : cA; const char* nB = has_next ? S.b_ptr(nxt) : cB;
        if constexpr (GATHER) {
            if (has_next) {
                n00 = (S.a_row(nxt, Rr[0]) * (unsigned)K + (unsigned)Cc[0]) * 2u; n01 = (S.a_row(nxt, Rr[1]) * (unsigned)K + (unsigned)Cc[1]) * 2u;
                n10 = (S.a_row(nxt, HALF + Rr[0]) * (unsigned)K + (unsigned)Cc[0]) * 2u; n11 = (S.a_row(nxt, HALF + Rr[1]) * (unsigned)K + (unsigned)Cc[1]) * 2u;
            } else { n00 = c00; n01 = c01; n10 = c10; n11 = c11; }
        }
        for (int t = 0; t < nt; t += 2) {
            const bool last = (t == nt - 2);
            const char* a1 = cA + (size_t)(t + 1) * kstep;
            const char* a2 = last ? nA : cA + (size_t)(t + 2) * kstep; const char* b2 = last ? nB : cB + (size_t)(t + 2) * kstep;
            const char* a3 = a2 + kstep; const char* b3 = b2 + kstep;
            unsigned s00 = c00, s01 = c01, s10 = c10, s11 = c11;
            if constexpr (GATHER) { s00 = last ? n00 : c00; s01 = last ? n01 : c01; s10 = last ? n10 : c10; s11 = last ? n11 : c11; }
            if constexpr (Epi::MIDSCALE) { if (t == nt / 2) E.midscale(acc, cur, wr, fr); }
            PG8_LDB(B0, 0, 0); PG8_LDB(B1, 0, 1); PG8_SCHED; PG8_LDA(At, 0, 0); PG8_ST2(PG8_SA(1, 1), a1 + hstepA, c10, c11);
            PG8_WAIT_V(8); PG8_WAIT_L(0); PG8_BAR; PG8_MMA(0, 0, At, B0); PG8_MMA(0, 1, At, B1); PG8_BAR; PG8_SCHED;
            PG8_LDA(At, 0, 1); PG8_STB(PG8_SB(0, 0), b2); PG8_STB(PG8_SB(0, 1), b2 + hstepB); PG8_ST2(PG8_SA(0, 0), a2, s00, s01);
            PG8_WAIT_V(8); PG8_WAIT_L(0); PG8_BAR; PG8_MMA(1, 0, At, B0); PG8_MMA(1, 1, At, B1); PG8_BAR; PG8_SCHED;
            PG8_LDB(B0, 1, 0); PG8_LDB(B1, 1, 1); PG8_SCHED; PG8_LDA(At, 1, 0); PG8_ST2(PG8_SA(0, 1), a2 + hstepA, s10, s11);
            PG8_WAIT_V(8); PG8_WAIT_L(0); PG8_BAR; PG8_MMA(0, 0, At, B0); PG8_MMA(0, 1, At, B1); PG8_BAR; PG8_SCHED;
            PG8_LDA(At, 1, 1); PG8_STB(PG8_SB(1, 0), b3); PG8_STB(PG8_SB(1, 1), b3 + hstepB); PG8_ST2(PG8_SA(1, 0), a3, s00, s01);
            PG8_WAIT_V(8); PG8_WAIT_L(0); PG8_BAR; PG8_MMA(1, 0, At, B0); PG8_MMA(1, 1, At, B1); PG8_BAR; PG8_SCHED;
        }
        if constexpr (ALIGN_EPI) { if (wr == 0) PG8_BAR; }
        E(acc, cur, wr, wc, fr, fq);
        if (!has_next) break;
#pragma unroll
        for (int a = 0; a < 2; ++a)
#pragma unroll
            for (int b = 0; b < 2; ++b)
#pragma unroll
                for (int m = 0; m < 4; ++m)
#pragma unroll
                    for (int n = 0; n < 2; ++n) acc[a][b][m][n] = (f32x4){0.f, 0.f, 0.f, 0.f};
        cur = nxt; cA = nA; cB = nB; ++ui;
        if constexpr (GATHER) { c00 = n00; c01 = n01; c10 = n10; c11 = n11; }
        if constexpr (ALIGN_EPI) { if (wr == 1) PG8_BAR; }
    }
    PG8_WAIT_V(0);
    if constexpr (!ALIGN_EPI) { if (wr == 0) PG8_BAR; }
    PG8_BAR;
#undef PG8_SA
#undef PG8_SB
#undef PG8_ST2
#undef PG8_STB
#undef PG8_LDA
#undef PG8_LDB
#undef PG8_MMA
}

struct EpiScaleBf16 {
    static constexpr bool PERM = true, MIDSCALE = false;
    bf16_t* O; const float* rs; int ldc; int pad;
    __device__ __forceinline__ void midscale(f32x4 (&)[2][2][4][2], const Unit&, int, int) const {}
    __device__ __forceinline__ void operator()(const f32x4 (&acc)[2][2][4][2], const Unit& u, int wr, int wc, int fr, int fq) const {
        const int row0 = u.pm * BM + wr * 64 + fr, col0 = u.pn * BM + wc * 32 + 8 * fq;
#pragma unroll
        for (int ai = 0; ai < 2; ++ai)
#pragma unroll
            for (int m = 0; m < 4; ++m) { const int row = row0 + ai * HALF + m * 16; const float s = rs ? rs[row] : 1.f; bf16_t* rowp = O + (size_t)row * ldc + col0;
#pragma unroll
                for (int bj = 0; bj < 2; ++bj) { const f32x4 v0 = acc[ai][bj][m][0] * s, v1 = acc[ai][bj][m][1] * s;
                    u32x4 w; w.x = pk2(v0[0], v0[1]); w.y = pk2(v0[2], v0[3]); w.z = pk2(v1[0], v1[1]); w.w = pk2(v1[2], v1[3]);
                    *(u32x4*)(rowp + bj * HALF) = w; } }
    }
};
}

#define XB_TMO      128
#define XB_XCNT(j)  (256  + 64 * (j))
#define XB_XSUB(j)  (1280 + 64 * (j))
#define XB_XGEN(j)  (2304 + 64 * (j))
#define XB_TOP      3328
#define XB_TOPGEN   3392
#define XCD_BAR_WORDS 3456
#define XB_SPIN_CAP (1u << 18)
__device__ __forceinline__ unsigned xb_ld(unsigned* p)              { return __hip_atomic_load(p, __ATOMIC_RELAXED, __HIP_MEMORY_SCOPE_AGENT); }
__device__ __forceinline__ unsigned xb_add(unsigned* p, unsigned v) { return __hip_atomic_fetch_add(p, v, __ATOMIC_RELAXED, __HIP_MEMORY_SCOPE_AGENT); }
__device__ __forceinline__ unsigned xb_xcc_id() { return (unsigned)__builtin_amdgcn_s_getreg((3 << 11) | 20) & 0xFu; }
#define XB_SPIN(cond, bar) do { unsigned _sp = 0; while (cond) { __builtin_amdgcn_s_sleep(1); \
    if ((++_sp & 255u) == 0u) { if (xb_ld(&(bar)[XB_TMO])) break; if (_sp > XB_SPIN_CAP) { atomicAdd(&(bar)[XB_TMO], 1u); break; } } } } while (0)
struct XcdBarrier { unsigned* bar; unsigned x; volatile LAS unsigned* st; };
__device__ __forceinline__ XcdBarrier xcd_barrier_post(unsigned* bar, volatile LAS unsigned* st) {
    XcdBarrier b; b.bar = bar; b.x = xb_xcc_id(); b.st = st;
    if (threadIdx.x == 0) (void)xb_add(&bar[XB_XCNT(b.x)], 1u);
    return b;
}
__device__ __forceinline__ void xcd_barrier_complete(unsigned* bar, unsigned x, unsigned& nloc, unsigned& nx) {
    const unsigned G = gridDim.x * gridDim.y * gridDim.z;
    unsigned sum, cnt, mine, sp = 0u;
    for (;;) {
        sum = 0u; cnt = 0u; mine = 0u;
#pragma unroll
        for (unsigned j = 0; j < 16; ++j) { const unsigned c = xb_ld(&bar[XB_XCNT(j)]); sum += c; cnt += (c > 0u) ? 1u : 0u; mine = (j == x) ? c : mine; }
        if (sum == G) break;
        __builtin_amdgcn_s_sleep(1);
        if ((++sp & 255u) == 0u) { if (xb_ld(&bar[XB_TMO])) break; if (sp > XB_SPIN_CAP) { atomicAdd(&bar[XB_TMO], 1u); break; } }
    }
    nloc = mine > 0u ? mine : 1u; nx = cnt > 0u ? cnt : 1u;
}
__device__ __forceinline__ void xcd_barrier(const XcdBarrier& b) {
    asm volatile("s_waitcnt vmcnt(0)" ::: "memory");
    __syncthreads();
    if (threadIdx.x == 0) {
        unsigned* bar = b.bar;
        __builtin_amdgcn_s_waitcnt(0);
        unsigned nloc = b.st[0], nx = b.st[1];
        if (nloc == 0u) { xcd_barrier_complete(bar, b.x, nloc, nx); b.st[0] = nloc; b.st[1] = nx; }
        const unsigned old = xb_add(&bar[XB_XSUB(b.x)], 1u);
        const unsigned gen = old / nloc;
        if (old + 1u == (gen + 1u) * nloc) {
            __builtin_amdgcn_fence(__ATOMIC_RELEASE, "agent");
            asm volatile("s_waitcnt vmcnt(0)" ::: "memory");
            const unsigned og = xb_add(&bar[XB_TOP], 1u);
            const unsigned tg = og / nx;
            if (og + 1u == (tg + 1u) * nx) xb_add(&bar[XB_TOPGEN], 1u);
            else XB_SPIN(xb_ld(&bar[XB_TOPGEN]) == tg, bar);
            __builtin_amdgcn_fence(__ATOMIC_ACQUIRE, "agent");
            xb_add(&bar[XB_XGEN(b.x)], 1u);
            asm volatile("s_waitcnt vmcnt(0)" ::: "memory");
        } else {
            XB_SPIN(xb_ld(&bar[XB_XGEN(b.x)]) == gen, bar);
            __builtin_amdgcn_fence(__ATOMIC_ACQUIRE, "agent");
            asm volatile("s_waitcnt vmcnt(0)" ::: "memory");
        }
    }
    __syncthreads();
}


constexpr size_t MiB = 1u << 20;
constexpr size_t WS_CTL = 0, CTL_ZERO_BYTES = 64 * 1024;
constexpr int CW_BAR = 1024;
constexpr int CW_CNT = 8192;

__device__ __forceinline__ void p0_transpose_item(const float* W, int K, int N, const float* ks, bf16_t* WT, int rbase, int gshift, int gstride, LAS float* scr, int item, int lane) {
    const int nblk = N / 32, kb = item / nblk, nb = item % nblk, k0 = 64 * kb, n0 = 32 * nb;
#pragma unroll 8
    for (int i = 0; i < 32; ++i) { const int kk = 2 * i + (lane >> 5); const float s = ks ? ks[k0 + kk] : 1.f; scr[kk * 33 + (lane & 31)] = W[(size_t)(k0 + kk) * N + n0 + (lane & 31)] * s; }
    asm volatile("s_waitcnt lgkmcnt(0)" ::: "memory");
    const int c = lane & 7;
#pragma unroll
    for (int j = 0; j < 4; ++j) { const int nl = (lane >> 3) + 8 * j, n = n0 + nl; const LAS float* s = scr + (8 * c) * 33 + nl;
        const int row = rbase + (n >> gshift) * gstride + (n & ((1 << gshift) - 1));
        u32x4 o; o.x = pk2(s[0 * 33], s[1 * 33]); o.y = pk2(s[2 * 33], s[3 * 33]); o.z = pk2(s[4 * 33], s[5 * 33]); o.w = pk2(s[6 * 33], s[7 * 33]);
        *(u32x4*)(WT + (size_t)row * K + k0 + 8 * c) = o; }
    asm volatile("s_waitcnt lgkmcnt(0)" ::: "memory");
}

constexpr size_t MB_ = 1u << 20, KB_ = 1024;
namespace wsm {
constexpr size_t ctl = 0, r0 = 64 * KB_, rL = 128 * KB_, r2 = 192 * KB_, rP = 256 * KB_, tokE = 320 * KB_, tokPos = 448 * KB_,
    rope = 1 * MB_, ssqL = 5 * MB_, ssq1p = 7 * MB_, ssq3p = 8 * MB_, lt = 9 * MB_, lw = 11 * MB_, lr = 13 * MB_, wr_t = 15 * MB_,
    w_in_t = 16 * MB_, w_out_t = 20 * MB_, wgu_t = 22 * MB_, projb = 86 * MB_, x1b = 86 * MB_,
    wd_t = 142 * MB_, w_pg_t = 174 * MB_, w_pp_t = 176 * MB_,
    xb = 177 * MB_, mix = 177 * MB_, x2b = 177 * MB_, pb = 209 * MB_, hid = 209 * MB_, pp = 249 * MB_, y = 16 * MB_, END = 281 * MB_;
}
struct Args {
    const float* in[28]; float* out; unsigned char* ws;
    int ph_lo, ph_hi;
};
struct Frame {
    LAS unsigned char* lds; volatile LAS unsigned* MISC; gu32* ctl;
    int tid, lane, wave, vcu, G;
};
__device__ __forceinline__ float fexp2(float x) { return __builtin_amdgcn_exp2f(x); }
__device__ __forceinline__ float fexp(float x) { return __builtin_amdgcn_exp2f(x * 1.4426950408889634f); }
__device__ __forceinline__ float frcp(float x) { return __builtin_amdgcn_rcpf(x); }
__device__ __forceinline__ float fsigmoid(float x) { return frcp(1.f + fexp(-x)); }
__device__ __forceinline__ float fgelu_tanh(float x) {
    const float u = 0.7978845608028654f * (x + 0.044715f * x * x * x);
    return x * (1.f - frcp(1.f + fexp(2.f * u)));
}

__device__ __forceinline__ void p0_prologue(const Frame& F, const Args& a) {
    LAS float* scr = (LAS float*)(F.lds + F.wave * 16384);
    const int gw = F.vcu * NWAVES + F.wave, NGW = F.G * NWAVES, lane = F.lane;
    unsigned char* ws = a.ws;
    const float* w_in = a.in[4]; const float* g_mix = a.in[3]; const float* w_out = a.in[15]; const float* g_attn = a.in[13]; const float* g_lru = a.in[14];
    const float* g_ffn = a.in[16]; const float* w_eg = a.in[21]; const float* w_eu = a.in[22]; const float* w_ed = a.in[23];
    const float* g_ple = a.in[24]; const float* w_pg = a.in[25]; const float* w_pp = a.in[26];
    constexpr int I_IN = (D / 64) * (NPROJ / 32), I_OUT = (D / 64) * (D / 32), I_G = (D / 64) * (FF / 32), I_D = (FF / 64) * (D / 32), I_PG = I_OUT, I_PP = (PLE / 64) * (D / 32);
    constexpr int NITEMS = I_IN + I_OUT + NE * (2 * I_G + I_D) + I_PG + I_PP;
    for (int it = gw; it < NITEMS; it += NGW) {
        int r = it;
        if (r < I_IN) { p0_transpose_item(w_in, D, NPROJ, g_mix, (bf16_t*)(ws + wsm::w_in_t), 0, 30, 0, scr, r, lane); continue; } r -= I_IN;
        if (r < I_OUT) { const int kb = r / (D / 32); const float* ks = kb < 8 ? g_attn : g_lru - 512; p0_transpose_item(w_out, D, D, ks, (bf16_t*)(ws + wsm::w_out_t), 0, 30, 0, scr, r, lane); continue; } r -= I_OUT;
        if (r < NE * 2 * I_G) { const int e = r / (2 * I_G), q = r % (2 * I_G), up = q / I_G, item = q % I_G;
            p0_transpose_item((up ? w_eu : w_eg) + (size_t)e * D * FF, D, FF, g_ffn, (bf16_t*)(ws + wsm::wgu_t) + (size_t)e * 1024 * D, 128 * up, 7, 256, scr, item, lane); continue; } r -= NE * 2 * I_G;
        if (r < NE * I_D) { const int e = r / I_D, item = r % I_D; p0_transpose_item(w_ed + (size_t)e * FF * D, FF, D, nullptr, (bf16_t*)(ws + wsm::wd_t) + (size_t)e * D * FF, 0, 30, 0, scr, item, lane); continue; } r -= NE * I_D;
        if (r < I_PG) { p0_transpose_item(w_pg, D, D, g_ple, (bf16_t*)(ws + wsm::w_pg_t), 0, 30, 0, scr, r, lane); continue; } r -= I_PG;
        p0_transpose_item(w_pp, PLE, D, nullptr, (bf16_t*)(ws + wsm::w_pp_t), 0, 30, 0, scr, r, lane);
    }
    const float* x = a.in[0]; bf16_t* xb = (bf16_t*)(ws + wsm::xb); float* r0 = (float*)(ws + wsm::r0);
    for (int m = gw; m < T; m += NGW) {
        const f32x4* xr = (const f32x4*)(x + (size_t)m * D) + lane; f32x4 v[4]; float s = 0.f;
#pragma unroll
        for (int j = 0; j < 4; ++j) { v[j] = xr[64 * j]; s += (v[j].x * v[j].x + v[j].y * v[j].y) + (v[j].z * v[j].z + v[j].w * v[j].w); }
        s = wsum(s);
        u32x2* o8 = (u32x2*)(xb + (size_t)m * D) + lane;
#pragma unroll
        for (int j = 0; j < 4; ++j) { u32x2 w; w.x = pk2(v[j].x, v[j].y); w.y = pk2(v[j].z, v[j].w); o8[64 * j] = w; }
        if (lane == 0) r0[m] = rsqrtf(s * (1.f / D) + EPS);
    }
    const float* p = a.in[1]; bf16_t* pb = (bf16_t*)(ws + wsm::pb);
    for (int m = gw; m < T; m += NGW) { const f32x4 v = ((const f32x4*)(p + (size_t)m * PLE))[lane]; u32x2 w; w.x = pk2(v.x, v.y); w.y = pk2(v.z, v.w); ((u32x2*)(pb + (size_t)m * PLE))[lane] = w; }
    const int* pos = (const int*)a.in[2]; f32x2* rope = (f32x2*)(ws + wsm::rope);
    for (int idx = (F.vcu * NTHR + F.tid); idx < T * 32; idx += F.G * NTHR) { const int t = idx >> 5, i = idx & 31;
        const float inv_freq = powf(10000.f, -(float)(2 * i) / 64.f); const float ang = (float)pos[t] * inv_freq; float sn, cs; sincosf(ang, &sn, &cs); rope[idx] = (f32x2){cs, sn}; }
    const float* w_rg = a.in[17]; const float* w_re = a.in[19]; bf16_t* wr_t = (bf16_t*)(ws + wsm::wr_t);
    for (int idx = (F.vcu * NTHR + F.tid); idx < 48 * D; idx += F.G * NTHR) { const int j = idx >> 10, k = idx & 1023;
        float v = 0.f; if (j < 4) v = w_rg[k * 4 + j] * g_ffn[k]; else if (j < 36) v = w_re[k * 32 + (j - 4)] * g_ffn[k];
        wr_t[idx] = (bf16_t)(pk2(v, 0.f) & 0xffffu); }
}

constexpr int SEGL = 256;
constexpr int LRU_XS = 0, LRU_XS_PITCH = 144;
constexpr int LRU_XO = LRU_XS + SEGL * LRU_XS_PITCH;
constexpr int LRU_SA = LRU_XO + SEGL * 64;
constexpr int LRU_SB = LRU_SA + SEGL * 64;
constexpr int LRU_SUMA = LRU_SB + SEGL * 64;
constexpr int LRU_SUMH = LRU_SUMA + 2048;
constexpr int LRU_CARRY = LRU_SUMH + 2048;
constexpr int LRU_SSQ = LRU_CARRY + 128;
static_assert(LRU_SSQ + 1024 <= RING_BYTES, "lru lds");

__device__ __forceinline__ void lru_unit(const Frame& F, const Args& a, int b, int cg) {
    LAS unsigned char* lds = F.lds; const int tid = F.tid, lane = F.lane, wave = F.wave;
    unsigned char* ws = a.ws;
    const bf16_t* projb = (const bf16_t*)(ws + wsm::projb); bf16_t* mix = (bf16_t*)(ws + wsm::mix); float* ssqL = (float*)(ws + wsm::ssqL);
    const float* cw = a.in[6]; const float* cb = a.in[7]; const float* wa = a.in[8]; const float* ba = a.in[9]; const float* wx = a.in[10]; const float* bx = a.in[11]; const float* lam = a.in[12];
    const int hb = cg >> 2, jj0 = (cg & 3) * 16, c0 = cg * 16;
    const int q8 = tid & 7, cch = hb * 64 + q8 * 8;
    float cwr[4][8], cbr[8];
#pragma unroll
    for (int j = 0; j < 4; ++j)
#pragma unroll
        for (int e = 0; e < 8; ++e) cwr[j][e] = cw[j * 512 + cch + e];
#pragma unroll
    for (int e = 0; e < 8; ++e) cbr[e] = cb[cch + e];
    const int own = (q8 >> 1) == (cg & 3);
    bf16x8 wfa[2], wfx[2];
#pragma unroll
    for (int ks = 0; ks < 2; ++ks) { unsigned pa[4], px[4];
#pragma unroll
        for (int j = 0; j < 8; j += 2) { const int k = 32 * ks + 8 * (lane >> 4) + j; const size_t o0 = (size_t)(hb * 64 + k) * 64 + jj0 + (lane & 15), o1 = o0 + 64;
            pa[j >> 1] = pk2(wa[o0], wa[o1]); px[j >> 1] = pk2(wx[o0], wx[o1]); }
        wfa[ks] = __builtin_bit_cast(bf16x8, (u32x4){pa[0], pa[1], pa[2], pa[3]}); wfx[ks] = __builtin_bit_cast(bf16x8, (u32x4){px[0], px[1], px[2], px[3]}); }
    const int cl = lane & 15;
    const float bac = ba[c0 + cl], bxc = bx[c0 + cl];
    const float spc = log1pf(expf(-lam[c0 + cl])) * (-8.f * 1.4426950408889634f);
    LAS float* xo = (LAS float*)(lds + LRU_XO); LAS float* sa = (LAS float*)(lds + LRU_SA); LAS float* sb = (LAS float*)(lds + LRU_SB);
    LAS float* sumA = (LAS float*)(lds + LRU_SUMA); LAS float* sumH = (LAS float*)(lds + LRU_SUMH); LAS float* carry = (LAS float*)(lds + LRU_CARRY); LAS float* sq = (LAS float*)(lds + LRU_SSQ);
    if (tid < 32) carry[tid] = 0.f;
    __syncthreads();
    for (int seg = 0; seg < SEQ / SEGL; ++seg) {
        const int s0 = seg * SEGL; const size_t t0 = (size_t)b * SEQ + s0;
#pragma unroll
        for (int i = 0; i < 4; ++i) {
            const int tt = (tid >> 3) + 64 * i; float xv[8];
#pragma unroll
            for (int e = 0; e < 8; ++e) xv[e] = cbr[e];
#pragma unroll
            for (int j = 0; j < 4; ++j) { const int sj = s0 + tt - 3 + j;
                if (sj >= 0) { const u32x4 w = *(const u32x4*)(projb + ((size_t)b * SEQ + sj) * NPROJ + OFF_LX + cch);
                    xv[0] += cwr[j][0] * bflo(w.x); xv[1] += cwr[j][1] * bfhi(w.x); xv[2] += cwr[j][2] * bflo(w.y); xv[3] += cwr[j][3] * bfhi(w.y);
                    xv[4] += cwr[j][4] * bflo(w.z); xv[5] += cwr[j][5] * bfhi(w.z); xv[6] += cwr[j][6] * bflo(w.w); xv[7] += cwr[j][7] * bfhi(w.w); } }
            u32x4 o; o.x = pk2(xv[0], xv[1]); o.y = pk2(xv[2], xv[3]); o.z = pk2(xv[4], xv[5]); o.w = pk2(xv[6], xv[7]);
            *(LAS u32x4*)(lds + LRU_XS + tt * LRU_XS_PITCH + q8 * 16) = o;
            if (own) { LAS f32x4* d = (LAS f32x4*)(xo + tt * 16 + (q8 & 1) * 8); d[0] = (f32x4){xv[0], xv[1], xv[2], xv[3]}; d[1] = (f32x4){xv[4], xv[5], xv[6], xv[7]}; }
        }
        __syncthreads();
#pragma unroll
        for (int mi = 0; mi < 2; ++mi) {
            const int mt = wave * 2 + mi; f32x4 ga = {0.f, 0.f, 0.f, 0.f}, gx = {0.f, 0.f, 0.f, 0.f};
#pragma unroll
            for (int ks = 0; ks < 2; ++ks) { const bf16x8 af = *(const LAS bf16x8*)(lds + LRU_XS + (mt * 16 + (lane & 15)) * LRU_XS_PITCH + (32 * ks + 8 * (lane >> 4)) * 2);
                ga = __builtin_amdgcn_mfma_f32_16x16x32_bf16(af, wfa[ks], ga, 0, 0, 0); gx = __builtin_amdgcn_mfma_f32_16x16x32_bf16(af, wfx[ks], gx, 0, 0, 0); }
#pragma unroll
            for (int r = 0; r < 4; ++r) { const int tt = mt * 16 + (lane >> 4) * 4 + r;
                const float rg = fsigmoid(ga[r] + bac), ig = fsigmoid(gx[r] + bxc);
                const float av = fexp2(rg * spc), mult = sqrtf(fmaxf(1.f - av * av, 0.f));
                sa[tt * 16 + cl] = av; sb[tt * 16 + cl] = mult * ig * xo[tt * 16 + cl]; }
        }
        __syncthreads();
        const int sc = tid >> 4;
        float av8[8], bv8[8];
        { float A = 1.f, H = 0.f;
#pragma unroll
          for (int u = 0; u < 8; ++u) { av8[u] = sa[(sc * 8 + u) * 16 + cl]; bv8[u] = sb[(sc * 8 + u) * 16 + cl]; H = av8[u] * H + bv8[u]; A *= av8[u]; }
          sumA[sc * 16 + cl] = A; sumH[sc * 16 + cl] = H; }
        __syncthreads();
        float h = carry[(seg & 1) * 16 + cl];
        for (int s2 = 0; s2 < sc; ++s2) h = sumA[s2 * 16 + cl] * h + sumH[s2 * 16 + cl];
#pragma unroll
        for (int u = 0; u < 8; ++u) {
            h = av8[u] * h + bv8[u];
            const int tt = sc * 8 + u; const size_t t = t0 + tt;
            const float lg = bf2f(projb[t * NPROJ + OFF_LG + c0 + cl]);
            const float g = h * fgelu_tanh(lg);
            mix[t * D + 512 + c0 + cl] = (bf16_t)(pk2(g, 0.f) & 0xffffu);
            float s = g * g; s += __shfl_xor(s, 1); s += __shfl_xor(s, 2); s += __shfl_xor(s, 4); s += __shfl_xor(s, 8);
            if (cl == 0) sq[tt] = s;
        }
        if (sc == 31) carry[((seg + 1) & 1) * 16 + cl] = h;
        __syncthreads();
        if (tid < SEGL) ssqL[(size_t)cg * T + t0 + tid] = sq[tid];
    }
    __syncthreads();
}

typedef float f32x16 __attribute__((ext_vector_type(16)));
typedef short s16x4 __attribute__((ext_vector_type(4)));
constexpr int AT_KP = 144;
constexpr int AT_NK = 160;
constexpr int AT_K = 0, AT_V = 2 * AT_NK * AT_KP;
constexpr int AT_LINV = XTRA_OFF + 256;
static_assert(2 * AT_V <= RING_BYTES && AT_LINV + 2048 <= LDS_BYTES, "attn lds");
__device__ __forceinline__ int crow(int reg, int h) { return (reg & 3) + 8 * (reg >> 2) + 4 * h; }
typedef LAS s16x4* lds_s16x4_p;
__device__ __forceinline__ s16x4 tr_rd(unsigned addr) { return __builtin_amdgcn_ds_read_tr16_b64_v4i16((lds_s16x4_p)(size_t)addr); }

template <int QB>
__device__ __forceinline__ void attn_qblock(const bf16_t* projb, const f32x2* rope, size_t tq0, int h, unsigned kbase, unsigned vbase, float sink2, int kmin, int r, int hh, LAS float* linv, f32x16& o0, f32x16& o1) {
    const size_t tq = tq0 + 32 * QB + r;
    bf16x8 qf[4];
    { const bf16_t* src = projb + tq * NPROJ + h * 64 + 8 * hh; const f32x2* cs = rope + tq * 32 + 8 * hh;
      const float qs = 0.125f * 1.4426950408889634f;
#pragma unroll
      for (int kp = 0; kp < 2; ++kp) {
          const u32x4 w1 = *(const u32x4*)(src + 16 * kp), w2 = *(const u32x4*)(src + 16 * (kp + 2));
          float x1[8] = {bflo(w1.x), bfhi(w1.x), bflo(w1.y), bfhi(w1.y), bflo(w1.z), bfhi(w1.z), bflo(w1.w), bfhi(w1.w)};
          float x2[8] = {bflo(w2.x), bfhi(w2.x), bflo(w2.y), bfhi(w2.y), bflo(w2.z), bfhi(w2.z), bflo(w2.w), bfhi(w2.w)};
          float y1[8], y2[8];
#pragma unroll
          for (int e = 0; e < 8; ++e) { const f32x2 c2 = cs[16 * kp + e]; y1[e] = (x1[e] * c2.x - x2[e] * c2.y) * qs; y2[e] = (x2[e] * c2.x + x1[e] * c2.y) * qs; }
          qf[kp] = __builtin_bit_cast(bf16x8, (u32x4){pk2(y1[0], y1[1]), pk2(y1[2], y1[3]), pk2(y1[4], y1[5]), pk2(y1[6], y1[7])});
          qf[kp + 2] = __builtin_bit_cast(bf16x8, (u32x4){pk2(y2[0], y2[1]), pk2(y2[2], y2[3]), pk2(y2[4], y2[5]), pk2(y2[6], y2[7])});
      } }
    f32x16 S[5];
#pragma unroll
    for (int ti = 0; ti < 5; ++ti) {
        const float pen = (32 * (QB + ti) < kmin) ? -1e30f : 0.f;
        f32x16 acc;
#pragma unroll
        for (int i = 0; i < 16; ++i) acc[i] = pen;
#pragma unroll
        for (int ks = 0; ks < 4; ++ks) { const bf16x8 kf = *(const LAS bf16x8*)(size_t)(kbase + (unsigned)(32 * (QB + ti) * AT_KP + 32 * ks));
            acc = __builtin_amdgcn_mfma_f32_32x32x16_bf16(kf, qf[ks], acc, 0, 0, 0); }
        S[ti] = acc;
    }
    const int c4 = 4 * hh;
#pragma unroll
    for (int i = 0; i < 16; ++i) { const bool up = ((i & 3) + 8 * (i >> 2) + c4) > r; S[0][i] = up ? S[0][i] : -1e30f; S[4][i] = up ? -1e30f : S[4][i]; }
    float mx = sink2;
#pragma unroll
    for (int ti = 0; ti < 5; ++ti)
#pragma unroll
        for (int i = 0; i < 16; ++i) mx = fmaxf(mx, S[ti][i]);
    mx = fmaxf(mx, __shfl_xor(mx, 32));
    float l = 0.f; unsigned P[5][8];
#pragma unroll
    for (int ti = 0; ti < 5; ++ti)
#pragma unroll
        for (int i = 0; i < 16; i += 2) { const float p0 = fexp2(S[ti][i] - mx), p1 = fexp2(S[ti][i + 1] - mx); l += p0 + p1; P[ti][i >> 1] = pk2(p0, p1); }
    l += __shfl_xor(l, 32);
    l += fexp2(sink2 - mx);
    if (hh == 0) linv[(32 * QB + r) * 8 + h] = frcp(l);
#pragma unroll
    for (int i = 0; i < 16; ++i) { o0[i] = 0.f; o1[i] = 0.f; }
#pragma unroll
    for (int ti = 0; ti < 5; ++ti) {
#pragma unroll
        for (int s = 0; s < 2; ++s) {
            const bf16x8 pa = __builtin_bit_cast(bf16x8, (u32x4){P[ti][4 * s], P[ti][4 * s + 1], P[ti][4 * s + 2], P[ti][4 * s + 3]});
            const unsigned va = vbase + (unsigned)((32 * (QB + ti) + 16 * s) * AT_KP);
            const s16x4 lo0 = tr_rd(va), hi0 = tr_rd(va + 8 * AT_KP), lo1 = tr_rd(va + 64), hi1 = tr_rd(va + 8 * AT_KP + 64);
            const bf16x8 vb0 = __builtin_shufflevector(lo0, hi0, 0, 1, 2, 3, 4, 5, 6, 7), vb1 = __builtin_shufflevector(lo1, hi1, 0, 1, 2, 3, 4, 5, 6, 7);
            o0 = __builtin_amdgcn_mfma_f32_32x32x16_bf16(pa, vb0, o0, 0, 0, 0);
            o1 = __builtin_amdgcn_mfma_f32_32x32x16_bf16(pa, vb1, o1, 0, 0, 0);
        }
    }
}

__device__ __forceinline__ void attn_unit(const Frame& F, const Args& a, int b, int j) {
    LAS unsigned char* lds = F.lds; const int tid = F.tid, lane = F.lane, wave = F.wave;
    unsigned char* ws = a.ws;
    const bf16_t* projb = (const bf16_t*)(ws + wsm::projb); bf16_t* mix = (bf16_t*)(ws + wsm::mix); const f32x2* rope = (const f32x2*)(ws + wsm::rope);
    const float* sinks = a.in[5];
    const int key0 = 32 * j - 128;
#pragma unroll 1
    for (int task = tid; task < AT_NK * 2 * 4; task += NTHR) {
        const int c = task & 3, g = (task >> 2) & 1, kk = task >> 3; const int sp = key0 + kk;
        u32x4 o1 = {0u, 0u, 0u, 0u}, o2 = {0u, 0u, 0u, 0u};
        if (sp >= 0) { const size_t t = (size_t)b * SEQ + sp; const bf16_t* src = projb + t * NPROJ + OFF_K + g * 64 + 8 * c;
            const u32x4 w1 = *(const u32x4*)src, w2 = *(const u32x4*)(src + 32); const f32x2* cs = rope + t * 32 + 8 * c;
            float x1[8] = {bflo(w1.x), bfhi(w1.x), bflo(w1.y), bfhi(w1.y), bflo(w1.z), bfhi(w1.z), bflo(w1.w), bfhi(w1.w)};
            float x2[8] = {bflo(w2.x), bfhi(w2.x), bflo(w2.y), bfhi(w2.y), bflo(w2.z), bfhi(w2.z), bflo(w2.w), bfhi(w2.w)};
            float y1[8], y2[8];
#pragma unroll
            for (int e = 0; e < 8; ++e) { const f32x2 c2 = cs[e]; y1[e] = x1[e] * c2.x - x2[e] * c2.y; y2[e] = x2[e] * c2.x + x1[e] * c2.y; }
            o1 = (u32x4){pk2(y1[0], y1[1]), pk2(y1[2], y1[3]), pk2(y1[4], y1[5]), pk2(y1[6], y1[7])};
            o2 = (u32x4){pk2(y2[0], y2[1]), pk2(y2[2], y2[3]), pk2(y2[4], y2[5]), pk2(y2[6], y2[7])}; }
        LAS unsigned char* d = lds + AT_K + (g * AT_NK + kk) * AT_KP + 16 * c;
        *(LAS u32x4*)d = o1; *(LAS u32x4*)(d + 64) = o2;
    }
#pragma unroll 2
    for (int task = tid; task < AT_NK * 2 * 8; task += NTHR) {
        const int c = task & 7, g = (task >> 3) & 1, kk = task >> 4; const int sp = key0 + kk;
        u32x4 o = {0u, 0u, 0u, 0u};
        if (sp >= 0) o = *(const u32x4*)(projb + ((size_t)b * SEQ + sp) * NPROJ + OFF_V + g * 64 + 8 * c);
        *(LAS u32x4*)(lds + AT_V + (g * AT_NK + kk) * AT_KP + 16 * c) = o;
    }
    __syncthreads();
    const int h = wave, g = wave >> 2, r = lane & 31, hh = lane >> 5;
    const float sink2 = sinks[h] * 1.4426950408889634f;
    const int kmin = -key0;
    const unsigned kbase = (unsigned)(size_t)(lds + AT_K) + (unsigned)((g * AT_NK + r) * AT_KP + 16 * hh);
    const unsigned vbase = (unsigned)(size_t)(lds + AT_V) + (unsigned)((g * AT_NK + 4 * hh + ((lane & 15) >> 2)) * AT_KP + 32 * ((lane >> 4) & 1) + 8 * (lane & 3));
    const size_t tq0 = (size_t)b * SEQ + 32 * j;
    LAS float* linv = (LAS float*)(lds + AT_LINV);
    f32x16 oa0, oa1;
    attn_qblock<0>(projb, rope, tq0, h, kbase, vbase, sink2, kmin, r, hh, linv, oa0, oa1);
    __syncthreads();
    LAS float* ost = (LAS float*)lds;
#pragma unroll
    for (int i = 0; i < 16; ++i) { const int q = crow(i, hh); LAS float* d0 = ost + q * 512 + h * 64 + r; d0[0] = oa0[i]; d0[32] = oa1[i]; }
    __syncthreads();
    { const int tt = tid >> 4, pp = tid & 15; const LAS f32x4* row = (const LAS f32x4*)(ost + tt * 512);
      f32x4 v[8]; float s = 0.f;
#pragma unroll
      for (int i = 0; i < 8; ++i) { v[i] = row[pp + 16 * i] * linv[tt * 8 + i]; s += (v[i].x * v[i].x + v[i].y * v[i].y) + (v[i].z * v[i].z + v[i].w * v[i].w); }
      s += __shfl_xor(s, 1); s += __shfl_xor(s, 2); s += __shfl_xor(s, 4); s += __shfl_xor(s, 8);
      const float rr = rsqrtf(s * (1.f / 512.f) + EPS);
      bf16_t* dst = mix + (tq0 + tt) * D;
#pragma unroll
      for (int i = 0; i < 8; ++i) { u32x2 w; w.x = pk2(v[i].x * rr, v[i].y * rr); w.y = pk2(v[i].z * rr, v[i].w * rr); *(u32x2*)(dst + 4 * (pp + 16 * i)) = w; } }
    __syncthreads();
}

namespace pg8 {
struct EpiOutProj {
    static constexpr bool PERM = false, MIDSCALE = true;
    const float* x; float* X; bf16_t* x1b; const float* rL; float* ssq1p;
    __device__ __forceinline__ void midscale(f32x4 (&acc)[2][2][4][2], const Unit& u, int wr, int fr) const {
#pragma unroll
        for (int ai = 0; ai < 2; ++ai)
#pragma unroll
            for (int m = 0; m < 4; ++m) { const float s = 1.f / rL[u.pm * BM + ai * HALF + wr * 64 + m * 16 + fr];
#pragma unroll
                for (int bj = 0; bj < 2; ++bj)
#pragma unroll
                    for (int n = 0; n < 2; ++n) acc[ai][bj][m][n] = acc[ai][bj][m][n] * s; }
    }
    __device__ __forceinline__ void operator()(const f32x4 (&acc)[2][2][4][2], const Unit& u, int wr, int wc, int fr, int fq) const {
        const int col0 = u.pn * BM + wc * 32 + 4 * fq;
#pragma unroll
        for (int ai = 0; ai < 2; ++ai)
#pragma unroll
            for (int m = 0; m < 4; ++m) { const int row = u.pm * BM + ai * HALF + wr * 64 + m * 16 + fr; const float s = rL[row]; const size_t off = (size_t)row * D + col0; float q = 0.f;
#pragma unroll
                for (int bj = 0; bj < 2; ++bj)
#pragma unroll
                    for (int n = 0; n < 2; ++n) { const size_t o = off + bj * HALF + n * 16; const f32x4 v = *(const f32x4*)(x + o) + acc[ai][bj][m][n] * s;
                        *(f32x4*)(X + o) = v; u32x2 w; w.x = pk2(v[0], v[1]); w.y = pk2(v[2], v[3]); *(u32x2*)(x1b + o) = w;
                        q += (v[0] * v[0] + v[1] * v[1]) + (v[2] * v[2] + v[3] * v[3]); }
                q += __shfl_xor(q, 16); q += __shfl_xor(q, 32);
                if (fq == 0) ssq1p[(size_t)(u.pn * 4 + wc) * T + row] = q; }
    }
};
struct EpiMoe1 {
    static constexpr bool PERM = true, MIDSCALE = false;
    bf16_t* hid; const float* lw; const float* lr;
    __device__ __forceinline__ void midscale(f32x4 (&)[2][2][4][2], const Unit&, int, int) const {}
    __device__ __forceinline__ void operator()(const f32x4 (&acc)[2][2][4][2], const Unit& u, int wr, int wc, int fr, int fq) const {
        const int f0 = u.pn * HALF + wc * 32 + 8 * fq;
#pragma unroll
        for (int ai = 0; ai < 2; ++ai)
#pragma unroll
            for (int m = 0; m < 4; ++m) { const int rl = ai * HALF + wr * 64 + m * 16 + fr; const bool ok = rl < u.nrow; const size_t li = (size_t)u.e * T + u.li0 + rl;
                const float r2 = ok ? lr[li] : 0.f, w = ok ? lw[li] : 0.f; unsigned o[4];
#pragma unroll
                for (int n = 0; n < 2; ++n) { float hv[4];
#pragma unroll
                    for (int e = 0; e < 4; ++e) { const float gt = acc[ai][0][m][n][e] * r2, up = acc[ai][1][m][n][e] * r2; hv[e] = gt * frcp(1.f + fexp(-gt)) * up * w; }
                    o[2 * n] = pk2(hv[0], hv[1]); o[2 * n + 1] = pk2(hv[2], hv[3]); }
                *(u32x4*)(hid + (size_t)(u.pm * BM + rl) * FF + f0) = (u32x4){o[0], o[1], o[2], o[3]}; }
    }
};
struct EpiPle {
    static constexpr bool PERM = false, MIDSCALE = false;
    float* X; const bf16_t* pp; const float* rP; float* ssq3p;
    __device__ __forceinline__ void midscale(f32x4 (&)[2][2][4][2], const Unit&, int, int) const {}
    __device__ __forceinline__ void operator()(const f32x4 (&acc)[2][2][4][2], const Unit& u, int wr, int wc, int fr, int fq) const {
        const int col0 = u.pn * BM + wc * 32 + 4 * fq;
#pragma unroll
        for (int ai = 0; ai < 2; ++ai)
#pragma unroll
            for (int m = 0; m < 4; ++m) { const int row = u.pm * BM + ai * HALF + wr * 64 + m * 16 + fr; const float s = rP[row]; const size_t off = (size_t)row * D + col0; float q = 0.f;
#pragma unroll
                for (int bj = 0; bj < 2; ++bj)
#pragma unroll
                    for (int n = 0; n < 2; ++n) { const size_t o = off + bj * HALF + n * 16; const u32x2 pw = *(const u32x2*)(pp + o); const f32x4 a4 = acc[ai][bj][m][n] * s;
                        f32x4 v = *(const f32x4*)(X + o);
                        v[0] += fsigmoid(a4[0]) * bflo(pw.x); v[1] += fsigmoid(a4[1]) * bfhi(pw.x); v[2] += fsigmoid(a4[2]) * bflo(pw.y); v[3] += fsigmoid(a4[3]) * bfhi(pw.y);
                        *(f32x4*)(X + o) = v; q += (v[0] * v[0] + v[1] * v[1]) + (v[2] * v[2] + v[3] * v[3]); }
                q += __shfl_xor(q, 16); q += __shfl_xor(q, 32);
                if (fq == 0) ssq3p[(size_t)(u.pn * 4 + wc) * T + row] = q; }
    }
};
struct MoeOrder {
    const LAS int* tstart; const int* cnt; const int* lt; const char* A; const char* B; size_t strideB; int K, G, c, gather;
    __device__ bool next(int i, Unit& u) const {
        const int L = i * G + c, tile = L >> 2; if (tile >= tstart[NE]) return false;
        int e = 0;
#pragma unroll 1
        for (int k = 1; k < NE; ++k) e = (tstart[k] <= tile) ? k : e;
        u.e = e; u.pm = tile; u.pn = L & 3; u.li0 = (tile - tstart[e]) * BM; const int left = cnt[e] - u.li0; u.nrow = left < BM ? left : BM; return true;
    }
    __device__ const char* a_ptr(const Unit& u) const { return gather ? A : A + (size_t)u.pm * BM * K * 2; }
    __device__ const char* b_ptr(const Unit& u) const { return B + (size_t)u.e * strideB + (size_t)u.pn * BM * K * 2; }
    __device__ unsigned a_row(const Unit& u, int r) const { return r < u.nrow ? (unsigned)lt[(size_t)u.e * T + u.li0 + r] : 0u; }
};
}

__device__ __forceinline__ void moe_tstart(const Frame& F, LAS int* tstart, const int* cnt) {
    if (F.tid == 0) { int s = 0; for (int e = 0; e < NE; ++e) { tstart[e] = s; s += (cnt[e] + 255) >> 8; } tstart[NE] = s; }
    __syncthreads();
}

__global__ void __launch_bounds__(NTHR, 2) mk_fwd(Args args) {
    extern __shared__ __attribute__((aligned(16))) unsigned char lds_raw[];
    Frame F; F.lds = (LAS unsigned char*)lds_raw; F.MISC = (volatile LAS unsigned*)(F.lds + MISC_OFF);
    F.tid = threadIdx.x; F.lane = F.tid & 63; F.wave = __builtin_amdgcn_readfirstlane(F.tid >> 6);
    F.G = gridDim.x; { const int bx = blockIdx.x; F.vcu = (F.G % 8 == 0) ? (bx % 8) * (F.G / 8) + bx / 8 : bx; }
    unsigned char* ws = args.ws; F.ctl = (gu32*)(ws + wsm::ctl);
    for (int u = F.tid; u < (LDS_BYTES - LDSCTL_OFF) / 4; u += NTHR) ((LAS unsigned*)(F.lds + LDSCTL_OFF))[u] = 0u;
    __syncthreads();
    const int lo = args.ph_lo, hi = args.ph_hi;
    XcdBarrier bar = xcd_barrier_post((unsigned*)(F.ctl + CW_BAR), F.MISC + 8);
    int* cnt = (int*)(F.ctl + CW_CNT);
    LAS int* tstart = (LAS int*)(F.lds + XTRA_OFF);
    const int gw = F.vcu * NWAVES + F.wave, NGW = F.G * NWAVES, lane = F.lane;
#ifndef PHASE_MASK
#define PHASE_MASK 0x3ffu
#endif
#define IN(k) ((((PHASE_MASK) >> (k)) & 1u) && lo <= (k) && (k) < hi)
#define GRID_BAR(k) do { if (IN(k) && IN((k) + 1)) xcd_barrier(bar); } while (0)
    if (IN(0)) { p0_prologue(F, args); }
    GRID_BAR(0);
    if (IN(1)) {
        { pg8::DenseOrder S; S.init((const bf16_t*)(ws + wsm::xb), (const bf16_t*)(ws + wsm::w_in_t), T, NPROJ, D, F.G, (int)blockIdx.x);
          pg8::EpiScaleBf16 E{(bf16_t*)(ws + wsm::projb), (const float*)(ws + wsm::r0), NPROJ, 0};
          pg8::gemm_phase<pg8::EpiScaleBf16, pg8::DenseOrder, true, false>(F.lds, D, S, E); }
        { pg8::DenseOrder S; S.init((const bf16_t*)(ws + wsm::pb), (const bf16_t*)(ws + wsm::w_pp_t), T, D, PLE, F.G, (int)blockIdx.x);
          pg8::EpiScaleBf16 E{(bf16_t*)(ws + wsm::pp), nullptr, D, 0};
          pg8::gemm_phase<pg8::EpiScaleBf16, pg8::DenseOrder, true, false>(F.lds, PLE, S, E); }
    }
    GRID_BAR(1);
    if (IN(2)) {
        for (int it = blockIdx.x; it < 128 + 512; it += F.G) {
            if (it < 128) lru_unit(F, args, it >> 5, it & 31);
            else { const int u = it - 128; attn_unit(F, args, u >> 7, u & 127); }
        }
    }
    GRID_BAR(2);
    if (IN(3)) {
        pg8::DenseOrder S; S.init((const bf16_t*)(ws + wsm::mix), (const bf16_t*)(ws + wsm::w_out_t), T, D, D, F.G, (int)blockIdx.x);
        float* rL = (float*)(ws + wsm::rL); const float* ssqL = (const float*)(ws + wsm::ssqL);
        { pg8::Unit u; for (int i = 0; S.next(i, u); ++i) if (F.tid < 256) { const int row = u.pm * 256 + F.tid; float s = 0.f;
#pragma unroll 8
              for (int cg = 0; cg < 32; ++cg) s += ssqL[(size_t)cg * T + row];
              rL[row] = rsqrtf(s * (1.f / 512.f) + EPS); } }
        asm volatile("s_waitcnt vmcnt(0)" ::: "memory"); __syncthreads();
        pg8::EpiOutProj E{args.in[0], args.out, (bf16_t*)(ws + wsm::x1b), rL, (float*)(ws + wsm::ssq1p)};
        pg8::gemm_phase<pg8::EpiOutProj, pg8::DenseOrder, true, false>(F.lds, D, S, E);
    }
    GRID_BAR(3);
    if (IN(4)) {
        const bf16_t* x1b = (const bf16_t*)(ws + wsm::x1b); const bf16_t* wr_t = (const bf16_t*)(ws + wsm::wr_t); const float* ssq1p = (const float*)(ws + wsm::ssq1p);
        float* r2v = (float*)(ws + wsm::r2); int* lt = (int*)(ws + wsm::lt); float* lw = (float*)(ws + wsm::lw); float* lr = (float*)(ws + wsm::lr);
        int* tokE = (int*)(ws + wsm::tokE); int* tokPos = (int*)(ws + wsm::tokPos);
        const float* b_rg = args.in[18]; const float* b_re = args.in[20];
        LAS float* lg = (LAS float*)F.lds;
        for (int ch = F.vcu; ch < T / 64; ch += F.G) {
            const int tok0 = ch * 64, mt = F.wave & 3, kh = F.wave >> 2;
            f32x4 acc[3];
#pragma unroll
            for (int n = 0; n < 3; ++n) acc[n] = (f32x4){0.f, 0.f, 0.f, 0.f};
            const bf16_t* ap = x1b + (size_t)(tok0 + 16 * mt + (lane & 15)) * D + 512 * kh + 8 * (lane >> 4);
            const bf16_t* bp = wr_t + (size_t)(lane & 15) * D + 512 * kh + 8 * (lane >> 4);
#pragma unroll 4
            for (int ks = 0; ks < 16; ++ks) { const bf16x8 af = *(const bf16x8*)(ap + 32 * ks);
#pragma unroll
                for (int n = 0; n < 3; ++n) { const bf16x8 bf = *(const bf16x8*)(bp + (size_t)16 * n * D + 32 * ks); acc[n] = __builtin_amdgcn_mfma_f32_16x16x32_bf16(af, bf, acc[n], 0, 0, 0); } }
#pragma unroll
            for (int n = 0; n < 3; ++n)
#pragma unroll
                for (int r = 0; r < 4; ++r) lg[(kh * 64 + 16 * mt + (lane >> 4) * 4 + r) * 48 + 16 * n + (lane & 15)] = acc[n][r];
            __syncthreads();
            if (F.tid < 64) {
                const int t = tok0 + F.tid; float s = 0.f;
#pragma unroll
                for (int pq = 0; pq < 16; ++pq) s += ssq1p[(size_t)pq * T + t];
                const float r2 = rsqrtf(s * (1.f / D) + EPS); r2v[t] = r2;
                const LAS float* l0 = lg + F.tid * 48; const LAS float* l1 = lg + (64 + F.tid) * 48;
                float gm = -1e30f; int gt = 0; float gl[4];
#pragma unroll
                for (int jx = 0; jx < 4; ++jx) { gl[jx] = (l0[jx] + l1[jx]) * r2 + b_rg[jx]; if (gl[jx] > gm) { gm = gl[jx]; gt = jx; } }
                float gs = 0.f;
#pragma unroll
                for (int jx = 0; jx < 4; ++jx) gs += expf(gl[jx] - gm);
                const float gp = 1.f / gs;
                float m1 = -1e30f, m2 = -1e30f; int i1 = 0, i2 = 0;
#pragma unroll
                for (int jx = 0; jx < 8; ++jx) { const float v = (l0[4 + gt * 8 + jx] + l1[4 + gt * 8 + jx]) * r2 + b_re[gt * 8 + jx];
                    if (v > m1) { m2 = m1; i2 = i1; m1 = v; i1 = jx; } else if (v > m2) { m2 = v; i2 = jx; } }
                const float e2 = expf(m2 - m1), w1 = gp / (1.f + e2), w2 = gp * e2 / (1.f + e2);
                const int E1 = gt * 8 + i1, E2 = gt * 8 + i2;
                const int p1 = atomicAdd(&cnt[E1], 1), p2 = atomicAdd(&cnt[E2], 1);
                lt[(size_t)E1 * T + p1] = t; lw[(size_t)E1 * T + p1] = w1; lr[(size_t)E1 * T + p1] = r2;
                lt[(size_t)E2 * T + p2] = t; lw[(size_t)E2 * T + p2] = w2; lr[(size_t)E2 * T + p2] = r2;
                tokE[t * 2] = E1; tokPos[t * 2] = p1; tokE[t * 2 + 1] = E2; tokPos[t * 2 + 1] = p2;
            }
            __syncthreads();
        }
    }
    GRID_BAR(4);
    if (IN(5)) {
        moe_tstart(F, tstart, cnt);
        pg8::MoeOrder S{tstart, cnt, (const int*)(ws + wsm::lt), (const char*)(ws + wsm::x1b), (const char*)(ws + wsm::wgu_t), (size_t)1024 * D * 2, D, F.G, F.vcu, 1};
        pg8::EpiMoe1 E{(bf16_t*)(ws + wsm::hid), (const float*)(ws + wsm::lw), (const float*)(ws + wsm::lr)};
        pg8::gemm_phase<pg8::EpiMoe1, pg8::MoeOrder, true, true>(F.lds, D, S, E);
    }
    GRID_BAR(5);
    if (IN(6)) {
        moe_tstart(F, tstart, cnt);
        pg8::MoeOrder S{tstart, cnt, nullptr, (const char*)(ws + wsm::hid), (const char*)(ws + wsm::wd_t), (size_t)D * FF * 2, FF, F.G, F.vcu, 0};
        pg8::EpiScaleBf16 E{(bf16_t*)(ws + wsm::y), nullptr, D, 0};
        pg8::gemm_phase<pg8::EpiScaleBf16, pg8::MoeOrder, true, false>(F.lds, FF, S, E);
    }
    GRID_BAR(6);
    if (IN(7)) {
        moe_tstart(F, tstart, cnt);
        const bf16_t* y = (const bf16_t*)(ws + wsm::y); bf16_t* x2b = (bf16_t*)(ws + wsm::x2b); float* rP = (float*)(ws + wsm::rP);
        const int* tokE = (const int*)(ws + wsm::tokE); const int* tokPos = (const int*)(ws + wsm::tokPos); float* X = args.out;
        for (int t = gw; t < T; t += NGW) {
            const size_t s1 = (size_t)tstart[tokE[2 * t]] * 256 + tokPos[2 * t], s2 = (size_t)tstart[tokE[2 * t + 1]] * 256 + tokPos[2 * t + 1];
            f32x4* xr = (f32x4*)(X + (size_t)t * D) + lane; const u32x2* ya = (const u32x2*)(y + s1 * D) + lane; const u32x2* yb = (const u32x2*)(y + s2 * D) + lane;
            u32x2* ob = (u32x2*)(x2b + (size_t)t * D) + lane; float s = 0.f;
#pragma unroll
            for (int jx = 0; jx < 4; ++jx) { f32x4 v = xr[64 * jx]; const u32x2 a2 = ya[64 * jx], b2 = yb[64 * jx];
                v[0] += bflo(a2.x) + bflo(b2.x); v[1] += bfhi(a2.x) + bfhi(b2.x); v[2] += bflo(a2.y) + bflo(b2.y); v[3] += bfhi(a2.y) + bfhi(b2.y);
                xr[64 * jx] = v; u32x2 w; w.x = pk2(v[0], v[1]); w.y = pk2(v[2], v[3]); ob[64 * jx] = w; s += (v[0] * v[0] + v[1] * v[1]) + (v[2] * v[2] + v[3] * v[3]); }
            s = wsum(s);
            if (lane == 0) rP[t] = rsqrtf(s * (1.f / D) + EPS);
        }
    }
    GRID_BAR(7);
    if (IN(8)) {
        pg8::DenseOrder S; S.init((const bf16_t*)(ws + wsm::x2b), (const bf16_t*)(ws + wsm::w_pg_t), T, D, D, F.G, (int)blockIdx.x);
        pg8::EpiPle E{args.out, (const bf16_t*)(ws + wsm::pp), (const float*)(ws + wsm::rP), (float*)(ws + wsm::ssq3p)};
        pg8::gemm_phase<pg8::EpiPle, pg8::DenseOrder, true, false>(F.lds, D, S, E);
    }
    GRID_BAR(8);
    if (IN(9)) {
        const float* ssq3p = (const float*)(ws + wsm::ssq3p); const float* gfin = args.in[27]; float* X = args.out;
        f32x4 gv[4];
#pragma unroll
        for (int jx = 0; jx < 4; ++jx) gv[jx] = ((const f32x4*)gfin)[lane + 64 * jx];
        for (int t = gw; t < T; t += NGW) {
            float s = 0.f;
            if (lane < 16) s = ssq3p[(size_t)lane * T + t];
            s = wsum(s);
            const float r3 = rsqrtf(s * (1.f / D) + EPS);
            f32x4* xr = (f32x4*)(X + (size_t)t * D) + lane;
#pragma unroll
            for (int jx = 0; jx < 4; ++jx) xr[64 * jx] = xr[64 * jx] * r3 * gv[jx];
        }
    }
#undef IN
#undef GRID_BAR
}
}

#ifndef MK_ONE_LAUNCH
#define MK_ONE_LAUNCH 1
#endif
extern "C" void kernel_launch(void* const* d_in, const int* in_sizes, int n_in, void* d_out, int out_size, void* d_ws, size_t ws_size, hipStream_t stream) {
    using namespace mk;
    const size_t MB = 1u << 20, KB = 1024;
    const size_t WS_END = wsm::END;
    static int grid = 0;
    if (grid == 0) {
        if (ws_size < WS_END || n_in != 28 || out_size != T * D) { fprintf(stderr, "kernel_launch: ws %zu < %zu or n_in %d or out %d\n", ws_size, (size_t)WS_END, n_in, out_size); grid = -1; return; }
        int dev = 0, cus = 0;
        if (hipGetDevice(&dev) != hipSuccess || hipDeviceGetAttribute(&cus, hipDeviceAttributeMultiprocessorCount, dev) != hipSuccess) { grid = -1; return; }
        if (hipFuncSetAttribute((const void*)mk_fwd, hipFuncAttributeMaxDynamicSharedMemorySize, LDS_BYTES) != hipSuccess) { fprintf(stderr, "hipFuncSetAttribute failed\n"); grid = -1; return; }
        grid = cus;
    }
    if (grid < 0) return;
    Args a{};
    for (int i = 0; i < 28; ++i) a.in[i] = (const float*)d_in[i];
    a.out = (float*)d_out; a.ws = (unsigned char*)d_ws;
    (void)hipMemsetAsync((char*)d_ws + wsm::ctl, 0, CTL_ZERO_BYTES, stream);
#if MK_ONE_LAUNCH
    a.ph_lo = 0; a.ph_hi = 10; hipLaunchKernelGGL(mk_fwd, dim3(grid), dim3(NTHR), LDS_BYTES, stream, a);
#else
    for (int ph = 0; ph < 10; ++ph) { a.ph_lo = ph; a.ph_hi = ph + 1; hipLaunchKernelGGL(mk_fwd, dim3(grid), dim3(NTHR), LDS_BYTES, stream, a); }
#endif
}
```

```cpp
#define MK_TS_A 0
#define MK_TS_B 1
#define MK_DUP 6
#include <hip/hip_runtime.h>
#include <cstdio>
#include <cstdint>
#define GAS __attribute__((address_space(1)))
#define LAS __attribute__((address_space(3)))
typedef unsigned short bf16_t;
typedef short bf16x8 __attribute__((ext_vector_type(8)));
typedef float f32x4 __attribute__((ext_vector_type(4)));
typedef float f32x2 __attribute__((ext_vector_type(2)));
typedef unsigned u32x4 __attribute__((ext_vector_type(4)));
typedef unsigned u32x2 __attribute__((ext_vector_type(2)));
typedef GAS unsigned gu32;

namespace mk {
constexpr int T = 16384, SEQ = 4096, D = 1024, NPROJ = 1792, PLE = 256;
constexpr int OFF_K = 512, OFF_V = 640, OFF_LX = 768, OFF_LG = 1280;
constexpr int NE = 32, FF = 512;
constexpr float EPS = 1e-6f;
constexpr int NWAVES = 8, NTHR = 512;
constexpr int RING_BYTES = 131072, LDSCTL_OFF = RING_BYTES, MISC_OFF = LDSCTL_OFF + 320, XTRA_OFF = RING_BYTES + 1024, LDS_BYTES = 147456;

__device__ __forceinline__ unsigned f2bf(float f) { unsigned u = __builtin_bit_cast(unsigned, f); return (u + 0x7fffu + ((u >> 16) & 1u)) >> 16; }
typedef __bf16 bf16x2_t __attribute__((ext_vector_type(2)));
__device__ __forceinline__ unsigned pk2(float lo, float hi) { f32x2 f = {lo, hi}; return __builtin_bit_cast(unsigned, __builtin_convertvector(f, bf16x2_t)); }
__device__ __forceinline__ float bf2f(unsigned short b) { return __builtin_bit_cast(float, (unsigned)b << 16); }
__device__ __forceinline__ float bflo(unsigned w) { return __builtin_bit_cast(float, w << 16); }
__device__ __forceinline__ float bfhi(unsigned w) { return __builtin_bit_cast(float, w & 0xffff0000u); }
__device__ __forceinline__ float wsum(float v) {
#pragma unroll
    for (int o = 1; o < 64; o <<= 1) v += __shfl_xor(v, o);
    return v;
}

namespace pg8 {
constexpr int BM = 256, BK = 64, HALF = 128, HTB = HALF * BK * 2, STAGE_BYTES = 8 * HTB, NXCD = 8, WGM = 8;
__device__ __forceinline__ int lds_byte(int r, int c) { const int st = (r >> 4) * 2 + (c >> 5), rr = r & 15, cc = c & 31, ob = rr * 64 + cc * 2; return st * 1024 + (ob ^ (((ob >> 9) & 1) << 5)); }
__device__ __forceinline__ void stage_rc(int b, int& R, int& C) { const int st = b / 1024, sb = b % 1024, swz = sb ^ (((sb >> 9) & 1) << 5); R = (st >> 1) * 16 + swz / 64; C = (st & 1) * 32 + (swz % 64) / 2; }
__device__ __forceinline__ int perm32(int rho) { const int n = rho >> 4, i = rho & 15; return 8 * (i >> 2) + 4 * n + (i & 3); }

struct Unit { int pm, pn, e, nrow, li0, ord; };

struct DenseOrder {
    const bf16_t* A; const bf16_t* Bt; int K, PA, PB, nM, nN, nwg, G, c;
    __device__ void init(const bf16_t* A_, const bf16_t* Bt_, int M, int N, int K_, int G_, int c_) { A = A_; Bt = Bt_; K = K_; PA = K_; PB = K_; nM = M / BM; nN = N / BM; nwg = nM * nN; G = G_; c = c_; }
    __device__ bool next(int i, Unit& u) const {
        const long L = (long)i * G + c; if (L >= nwg) return false;
        int wgid = (int)L; { const int q = nwg / NXCD, r = nwg % NXCD, xcd = wgid % NXCD, off = wgid / NXCD; wgid = (xcd < r ? xcd * (q + 1) : r * (q + 1) + (xcd - r) * q) + off; }
        const int nig = WGM * nN, gid = wgid / nig, fm = gid * WGM, gsz = (nM - fm) < WGM ? (nM - fm) : WGM;
        u.pm = fm + ((wgid % nig) % gsz); u.pn = (wgid % nig) / gsz; u.e = 0; u.nrow = BM; u.li0 = 0; u.ord = i; return true;
    }
    __device__ const char* a_ptr(const Unit& u) const { return (const char*)A + (size_t)u.pm * BM * PA * 2; }
    __device__ const char* b_ptr(const Unit& u) const { return (const char*)Bt + (size_t)u.pn * BM * PB * 2; }
    __device__ unsigned a_row(const Unit&, int r) const { return (unsigned)r; }
};

#define PG8_WAIT_V(n) asm volatile("s_waitcnt vmcnt(" #n ")" ::: "memory")
#define PG8_WAIT_L(n) asm volatile("s_waitcnt lgkmcnt(" #n ")" ::: "memory")
#define PG8_BAR __builtin_amdgcn_s_barrier()
#define PG8_SCHED __builtin_amdgcn_sched_barrier(0)

template <class Epi, class Sched, bool ALIGN_EPI, bool GATHER>
__device__ __forceinline__ void gemm_phase(LAS unsigned char* lds, const int K, const Sched& S, const Epi& E) {
    const int tid = threadIdx.x, wid = __builtin_amdgcn_readfirstlane(tid >> 6), lane = tid & 63, wr = wid >> 2, wc = wid & 3, fr = lane & 15, fq = lane >> 4;
    const int nt = K / BK; const int PA = S.PA, PB = S.PB;
    int Rr[2], Cc[2]; unsigned voffA[2], voffB[2];
#pragma unroll
    for (int i = 0; i < 2; ++i) { stage_rc(tid * 16 + i * 8192, Rr[i], Cc[i]); const int Rb = Epi::PERM ? ((Rr[i] & ~31) + perm32(Rr[i] & 31)) : Rr[i];
        voffA[i] = (unsigned)(Rr[i] * PA + Cc[i]) * 2u; voffB[i] = (unsigned)(Rb * PB + Cc[i]) * 2u; }
    const size_t kstep = (size_t)(BK * 2);
    const size_t hstepB = (size_t)HALF * PB * 2;
    const size_t hstepA = GATHER ? 0 : (size_t)HALF * PA * 2;
    const unsigned ldsw = (unsigned)wid * 1024u;
    const int aoff = lds_byte(wr * 64 + fr, fq * 8), boff = lds_byte(wc * 32 + fr, fq * 8);
#define PG8_SA(b, h) (((b) * 2 + (h)) * HTB)
#define PG8_SB(b, h) ((4 + (b) * 2 + (h)) * HTB)
#define PG8_ST2(bufoff, gbase, v0, v1) do { \
        __builtin_amdgcn_global_load_lds((const unsigned*)((const char*)(gbase) + (v0)), (LAS unsigned*)(lds + (bufoff) + ldsw), 16, 0, 0); \
        __builtin_amdgcn_global_load_lds((const unsigned*)((const char*)(gbase) + (v1)), (LAS unsigned*)(lds + (bufoff) + ldsw + 8192), 16, 0, 0); } while (0)
#define PG8_STB(bufoff, gbase) PG8_ST2(bufoff, gbase, voffB[0], voffB[1])
#define PG8_LDA(dst, b, h) do { _Pragma("unroll") for (int m = 0; m < 4; ++m) _Pragma("unroll") for (int k = 0; k < 2; ++k) dst[m][k] = *(const LAS bf16x8*)(lds + PG8_SA(b, h) + aoff + m * 2048 + k * 1024); } while (0)
#define PG8_LDB(dst, b, h) do { _Pragma("unroll") for (int n = 0; n < 2; ++n) _Pragma("unroll") for (int k = 0; k < 2; ++k) dst[n][k] = *(const LAS bf16x8*)(lds + PG8_SB(b, h) + boff + n * 2048 + k * 1024); } while (0)
#define PG8_MMA(ai, bj, At, Bt) do { __builtin_amdgcn_s_setprio(1); _Pragma("unroll") for (int m = 0; m < 4; ++m) _Pragma("unroll") for (int n = 0; n < 2; ++n) _Pragma("unroll") for (int k = 0; k < 2; ++k) \
        acc[ai][bj][m][n] = __builtin_amdgcn_mfma_f32_16x16x32_bf16(Bt[n][k], At[m][k], acc[ai][bj][m][n], 0, 0, 0); __builtin_amdgcn_s_setprio(0); } while (0)
    Unit cur, nxt; int ui = 0;
    if (!S.next(0, cur)) return;
    f32x4 acc[2][2][4][2];
#pragma unroll
    for (int a = 0; a < 2; ++a)
#pragma unroll
        for (int b = 0; b < 2; ++b)
#pragma unroll
            for (int m = 0; m < 4; ++m)
#pragma unroll
                for (int n = 0; n < 2; ++n) acc[a][b][m][n] = (f32x4){0.f, 0.f, 0.f, 0.f};
    bf16x8 At[4][2], B0[2][2], B1[2][2];
    const char* cA = S.a_ptr(cur); const char* cB = S.b_ptr(cur);
    unsigned c00 = voffA[0], c01 = voffA[1], c10 = voffA[0], c11 = voffA[1];
    if constexpr (GATHER) {
        c00 = (S.a_row(cur, Rr[0]) * (unsigned)PA + (unsigned)Cc[0]) * 2u; c01 = (S.a_row(cur, Rr[1]) * (unsigned)PA + (unsigned)Cc[1]) * 2u;
        c10 = (S.a_row(cur, HALF + Rr[0]) * (unsigned)PA + (unsigned)Cc[0]) * 2u; c11 = (S.a_row(cur, HALF + Rr[1]) * (unsigned)PA + (unsigned)Cc[1]) * 2u;
    }
    PG8_STB(PG8_SB(0, 0), cB); PG8_STB(PG8_SB(0, 1), cB + hstepB); PG8_ST2(PG8_SA(0, 0), cA, c00, c01); PG8_ST2(PG8_SA(0, 1), cA + hstepA, c10, c11);
    if (wr == 1) PG8_BAR;
    PG8_WAIT_V(2); PG8_BAR;
    PG8_STB(PG8_SB(1, 0), cB + kstep); PG8_ST2(PG8_SA(1, 0), cA + kstep, c00, c01); PG8_STB(PG8_SB(1, 1), cB + hstepB + kstep);
    PG8_WAIT_V(6); PG8_BAR;
    for (;;) {
        const bool has_next = S.next(ui + 1, nxt);
        const char* nA = has_next ? S.a_ptr(nxt) : cA; const char* nB = has_next ? S.b_ptr(nxt) : cB;
        unsigned s00 = c00, s01 = c01, s10 = c10, s11 = c11;
        for (int t = 0; t < nt; t += 2) {
            const bool last = (t == nt - 2);
            const char* a1 = cA + (size_t)(t + 1) * kstep;
            const char* a2 = last ? nA : cA + (size_t)(t + 2) * kstep; const char* b2 = last ? nB : cB + (size_t)(t + 2) * kstep;
            const char* a3 = a2 + kstep; const char* b3 = b2 + kstep;
            if constexpr (GATHER) { if (last && has_next) {
                s00 = (S.a_row(nxt, Rr[0]) * (unsigned)PA + (unsigned)Cc[0]) * 2u; s01 = (S.a_row(nxt, Rr[1]) * (unsigned)PA + (unsigned)Cc[1]) * 2u;
                s10 = (S.a_row(nxt, HALF + Rr[0]) * (unsigned)PA + (unsigned)Cc[0]) * 2u; s11 = (S.a_row(nxt, HALF + Rr[1]) * (unsigned)PA + (unsigned)Cc[1]) * 2u; } }
            if constexpr (Epi::MIDSCALE) { if (t == nt / 2) E.midscale(acc, cur, wr, fr); }
            PG8_LDB(B0, 0, 0); PG8_LDB(B1, 0, 1); PG8_SCHED; PG8_LDA(At, 0, 0); PG8_ST2(PG8_SA(1, 1), a1 + hstepA, c10, c11);
            PG8_WAIT_V(8); PG8_WAIT_L(0); PG8_BAR; PG8_MMA(0, 0, At, B0); PG8_MMA(0, 1, At, B1); PG8_BAR; PG8_SCHED;
            PG8_LDA(At, 0, 1); PG8_STB(PG8_SB(0, 0), b2); PG8_STB(PG8_SB(0, 1), b2 + hstepB); PG8_ST2(PG8_SA(0, 0), a2, s00, s01);
            PG8_WAIT_V(8); PG8_WAIT_L(0); PG8_BAR; PG8_MMA(1, 0, At, B0); PG8_MMA(1, 1, At, B1); PG8_BAR; PG8_SCHED;
            PG8_LDB(B0, 1, 0); PG8_LDB(B1, 1, 1); PG8_SCHED; PG8_LDA(At, 1, 0); PG8_ST2(PG8_SA(0, 1), a2 + hstepA, s10, s11);
            PG8_WAIT_V(8); PG8_WAIT_L(0); PG8_BAR; PG8_MMA(0, 0, At, B0); PG8_MMA(0, 1, At, B1); PG8_BAR; PG8_SCHED;
            PG8_LDA(At, 1, 1); PG8_STB(PG8_SB(1, 0), b3); PG8_STB(PG8_SB(1, 1), b3 + hstepB); PG8_ST2(PG8_SA(1, 0), a3, s00, s01);
            PG8_WAIT_V(8); PG8_WAIT_L(0); PG8_BAR; PG8_MMA(1, 0, At, B0); PG8_MMA(1, 1, At, B1); PG8_BAR; PG8_SCHED;
        }
        if constexpr (ALIGN_EPI) { if (wr == 0) PG8_BAR; }
        E(acc, cur, wr, wc, fr, fq);
        if (!has_next) break;
#pragma unroll
        for (int a = 0; a < 2; ++a)
#pragma unroll
            for (int b = 0; b < 2; ++b)
#pragma unroll
                for (int m = 0; m < 4; ++m)
#pragma unroll
                    for (int n = 0; n < 2; ++n) acc[a][b][m][n] = (f32x4){0.f, 0.f, 0.f, 0.f};
        cur = nxt; cA = nA; cB = nB; ++ui;
        if constexpr (GATHER) { c00 = s00; c01 = s01; c10 = s10; c11 = s11; }
        if constexpr (ALIGN_EPI) { if (wr == 1) PG8_BAR; }
    }
    PG8_WAIT_V(0);
    if constexpr (!ALIGN_EPI) { if (wr == 0) PG8_BAR; }
    PG8_BAR;
#undef PG8_SA
#undef PG8_SB
#undef PG8_ST2
#undef PG8_STB
#undef PG8_LDA
#undef PG8_LDB
#undef PG8_MMA
}

struct EpiScaleBf16 {
    static constexpr bool PERM = true, MIDSCALE = false;
    bf16_t* O; const float* rs; int ldc; int pad;
    __device__ __forceinline__ void midscale(f32x4 (&)[2][2][4][2], const Unit&, int, int) const {}
    __device__ __forceinline__ void operator()(const f32x4 (&acc)[2][2][4][2], const Unit& u, int wr, int wc, int fr, int fq) const {
        const int row0 = u.pm * BM + wr * 64 + fr, col0 = u.pn * BM + wc * 32 + 8 * fq;
#pragma unroll
        for (int ai = 0; ai < 2; ++ai)
#pragma unroll
            for (int m = 0; m < 4; ++m) { const int row = row0 + ai * HALF + m * 16; const float s = rs ? rs[row] : 1.f; bf16_t* rowp = O + (size_t)row * ldc + col0;
#pragma unroll
                for (int bj = 0; bj < 2; ++bj) { const f32x4 v0 = acc[ai][bj][m][0] * s, v1 = acc[ai][bj][m][1] * s;
                    u32x4 w; w.x = pk2(v0[0], v0[1]); w.y = pk2(v0[2], v0[3]); w.z = pk2(v1[0], v1[1]); w.w = pk2(v1[2], v1[3]);
                    *(u32x4*)(rowp + bj * HALF) = w; } }
    }
};
}

#define XB_TMO      128
#define XB_XCNT(j)  (256  + 64 * (j))
#define XB_XSUB(j)  (1280 + 64 * (j))
#define XB_XGEN(j)  (2304 + 64 * (j))
#define XB_TOP      3328
#define XB_TOPGEN   3392
#define XCD_BAR_WORDS 3456
#define XB_SPIN_CAP (1u << 18)
__device__ __forceinline__ unsigned xb_ld(unsigned* p)              { return __hip_atomic_load(p, __ATOMIC_RELAXED, __HIP_MEMORY_SCOPE_AGENT); }
__device__ __forceinline__ unsigned xb_add(unsigned* p, unsigned v) { return __hip_atomic_fetch_add(p, v, __ATOMIC_RELAXED, __HIP_MEMORY_SCOPE_AGENT); }
__device__ __forceinline__ unsigned xb_xcc_id() { return (unsigned)__builtin_amdgcn_s_getreg((3 << 11) | 20) & 0xFu; }
#define XB_SPIN(cond, bar) do { unsigned _sp = 0; while (cond) { __builtin_amdgcn_s_sleep(1); \
    if ((++_sp & 255u) == 0u) { if (xb_ld(&(bar)[XB_TMO])) break; if (_sp > XB_SPIN_CAP) { atomicAdd(&(bar)[XB_TMO], 1u); break; } } } } while (0)
struct XcdBarrier { unsigned* bar; unsigned x; volatile LAS unsigned* st; };
__device__ __forceinline__ XcdBarrier xcd_barrier_post(unsigned* bar, volatile LAS unsigned* st) {
    XcdBarrier b; b.bar = bar; b.x = xb_xcc_id(); b.st = st;
    if (threadIdx.x == 0) (void)xb_add(&bar[XB_XCNT(b.x)], 1u);
    return b;
}
__device__ __forceinline__ void xcd_barrier_complete(unsigned* bar, unsigned x, unsigned& nloc, unsigned& nx) {
    const unsigned G = gridDim.x * gridDim.y * gridDim.z;
    unsigned sum, cnt, mine, sp = 0u;
    for (;;) {
        sum = 0u; cnt = 0u; mine = 0u;
#pragma unroll
        for (unsigned j = 0; j < 16; ++j) { const unsigned c = xb_ld(&bar[XB_XCNT(j)]); sum += c; cnt += (c > 0u) ? 1u : 0u; mine = (j == x) ? c : mine; }
        if (sum == G) break;
        __builtin_amdgcn_s_sleep(1);
        if ((++sp & 255u) == 0u) { if (xb_ld(&bar[XB_TMO])) break; if (sp > XB_SPIN_CAP) { atomicAdd(&bar[XB_TMO], 1u); break; } }
    }
    nloc = mine > 0u ? mine : 1u; nx = cnt > 0u ? cnt : 1u;
}
__device__ __forceinline__ void xcd_barrier(const XcdBarrier& b) {
    asm volatile("s_waitcnt vmcnt(0)" ::: "memory");
    __syncthreads();
    if (threadIdx.x == 0) {
        unsigned* bar = b.bar;
        __builtin_amdgcn_s_waitcnt(0);
        unsigned nloc = b.st[0], nx = b.st[1];
        if (nloc == 0u) { xcd_barrier_complete(bar, b.x, nloc, nx); b.st[0] = nloc; b.st[1] = nx; }
        const unsigned old = xb_add(&bar[XB_XSUB(b.x)], 1u);
        const unsigned gen = old / nloc;
        if (old + 1u == (gen + 1u) * nloc) {
            __builtin_amdgcn_fence(__ATOMIC_RELEASE, "agent");
            asm volatile("s_waitcnt vmcnt(0)" ::: "memory");
            const unsigned og = xb_add(&bar[XB_TOP], 1u);
            const unsigned tg = og / nx;
            if (og + 1u == (tg + 1u) * nx) xb_add(&bar[XB_TOPGEN], 1u);
            else XB_SPIN(xb_ld(&bar[XB_TOPGEN]) == tg, bar);
            __builtin_amdgcn_fence(__ATOMIC_ACQUIRE, "agent");
            xb_add(&bar[XB_XGEN(b.x)], 1u);
            asm volatile("s_waitcnt vmcnt(0)" ::: "memory");
        } else {
            XB_SPIN(xb_ld(&bar[XB_XGEN(b.x)]) == gen, bar);
            __builtin_amdgcn_fence(__ATOMIC_ACQUIRE, "agent");
            asm volatile("s_waitcnt vmcnt(0)" ::: "memory");
        }
    }
    __syncthreads();
}


constexpr size_t MiB = 1u << 20;
constexpr size_t WS_CTL = 0, CTL_ZERO_BYTES = 64 * 1024;
constexpr int CW_BAR = 1024;
constexpr int CW_CNT = 8192;

__device__ __forceinline__ void p0_transpose_item(const float* W, int K, int N, const float* ks, bf16_t* WT, int rbase, int gshift, int gstride, LAS float* scr, int item, int lane) {
    const int nblk = N / 32, kb = item / nblk, nb = item % nblk, k0 = 64 * kb, n0 = 32 * nb;
#pragma unroll 8
    for (int i = 0; i < 32; ++i) { const int kk = 2 * i + (lane >> 5); const float s = ks ? ks[k0 + kk] : 1.f; scr[kk * 33 + (lane & 31)] = W[(size_t)(k0 + kk) * N + n0 + (lane & 31)] * s; }
    asm volatile("s_waitcnt lgkmcnt(0)" ::: "memory");
    const int c = lane & 7;
#pragma unroll
    for (int j = 0; j < 4; ++j) { const int nl = (lane >> 3) + 8 * j, n = n0 + nl; const LAS float* s = scr + (8 * c) * 33 + nl;
        const int row = rbase + (n >> gshift) * gstride + (n & ((1 << gshift) - 1));
        u32x4 o; o.x = pk2(s[0 * 33], s[1 * 33]); o.y = pk2(s[2 * 33], s[3 * 33]); o.z = pk2(s[4 * 33], s[5 * 33]); o.w = pk2(s[6 * 33], s[7 * 33]);
        *(u32x4*)(WT + (size_t)row * K + k0 + 8 * c) = o; }
    asm volatile("s_waitcnt lgkmcnt(0)" ::: "memory");
}

constexpr size_t MB_ = 1u << 20, KB_ = 1024;
namespace wsm {
constexpr size_t ctl = 0, r0 = 64 * KB_, rL = 128 * KB_, r2 = 192 * KB_, rP = 256 * KB_, tokE = 320 * KB_, tokPos = 448 * KB_,
    rope = 1 * MB_, ssqL = 5 * MB_, ssq1p = 7 * MB_, ssq3p = 8 * MB_, lt = 9 * MB_, lw = 11 * MB_, lr = 13 * MB_, wr_t = 15 * MB_,
    w_in_t = 16 * MB_, w_out_t = 20 * MB_, wgu_t = 22 * MB_, projb = 86 * MB_, x1b = 110 * MB_,
    wd_t = 142 * MB_, w_pg_t = 174 * MB_, w_pp_t = 176 * MB_,
    xb = 177 * MB_, x2b = 177 * MB_, pb = 209 * MB_, mix = 209 * MB_, hid = 209 * MB_, x3b = 110 * MB_, pp = 249 * MB_, y = 16 * MB_, END = 281 * MB_;
}
struct Args {
    const float* in[28]; float* out; unsigned char* ws;
    int ph_lo, ph_hi, mode, pad;
};
typedef const __attribute__((address_space(4))) Args* KArgsP;
__device__ __forceinline__ KArgsP kargs() { KArgsP p = (KArgsP)__builtin_amdgcn_kernarg_segment_ptr(); asm volatile("" : "+s"(p)); return p; }
struct Frame {
    LAS unsigned char* lds; volatile LAS unsigned* MISC; gu32* ctl;
    int tid, lane, wave, vcu, G;
};
__device__ __forceinline__ float fexp2(float x) { return __builtin_amdgcn_exp2f(x); }
__device__ __forceinline__ float fexp(float x) { return __builtin_amdgcn_exp2f(x * 1.4426950408889634f); }
__device__ __forceinline__ float frcp(float x) { return __builtin_amdgcn_rcpf(x); }
__device__ __forceinline__ float fsigmoid(float x) { return frcp(1.f + fexp(-x)); }
__device__ __forceinline__ float fgelu_tanh(float x) {
    const float u = 0.7978845608028654f * (x + 0.044715f * x * x * x);
    return x * (1.f - frcp(1.f + fexp(2.f * u)));
}

__device__ __forceinline__ void p0_tr64(const float* W, int K, int N, const float* ks, bf16_t* WT, int rbase, int gshift, int gstride, LAS unsigned* t2, int item, int lane) {
    const int nblk = N / 64, kb = item / nblk, nb = item % nblk, k0 = 64 * kb, n0 = 64 * nb;
    const int n4 = lane & 15, kr = lane >> 4;
    f32x4 va[8], vb[8];
#pragma unroll
    for (int i = 0; i < 8; ++i) { const int k = k0 + 8 * i + 2 * kr; va[i] = *(const f32x4*)(W + (size_t)k * N + n0 + 4 * n4); vb[i] = *(const f32x4*)(W + (size_t)(k + 1) * N + n0 + 4 * n4); }
#pragma unroll
    for (int i = 0; i < 8; ++i) { const int k = k0 + 8 * i + 2 * kr, kp = 4 * i + kr; const float s0 = ks ? ks[k] : 1.f, s1 = ks ? ks[k + 1] : 1.f;
        LAS unsigned* d = t2 + (4 * n4) * 33 + kp;
        d[0] = pk2(va[i].x * s0, vb[i].x * s1); d[33] = pk2(va[i].y * s0, vb[i].y * s1); d[66] = pk2(va[i].z * s0, vb[i].z * s1); d[99] = pk2(va[i].w * s0, vb[i].w * s1); }
    asm volatile("s_waitcnt lgkmcnt(0)" ::: "memory");
    const int nl = lane >> 3, c = lane & 7;
#pragma unroll
    for (int j = 0; j < 8; ++j) { const int n = 8 * j + nl; const LAS unsigned* s = t2 + n * 33 + 4 * c; const int ng = n0 + n;
        const int row = rbase + (ng >> gshift) * gstride + (ng & ((1 << gshift) - 1));
        *(u32x4*)(WT + (size_t)row * K + k0 + 8 * c) = (u32x4){s[0], s[1], s[2], s[3]}; }
    asm volatile("s_waitcnt lgkmcnt(0)" ::: "memory");
}

__device__ __forceinline__ void p0_experts(const Frame& F, KArgsP a, int w, int nw) {
    LAS unsigned* t2 = (LAS unsigned*)(F.lds + F.wave * 8704); unsigned char* ws = a->ws; const int lane = F.lane;
    const float* g_ffn = a->in[16]; const float* w_eg = a->in[21]; const float* w_eu = a->in[22]; const float* w_ed = a->in[23];
    constexpr int I_G = (D / 64) * (FF / 64), I_D = (FF / 64) * (D / 64);
    for (int r = w; r < NE * (2 * I_G + I_D); r += nw) {
        if (r < NE * 2 * I_G) { const int e = r / (2 * I_G), q = r % (2 * I_G), up = q / I_G, item = q % I_G;
            p0_tr64((up ? w_eu : w_eg) + (size_t)e * D * FF, D, FF, g_ffn, (bf16_t*)(ws + wsm::wgu_t) + (size_t)e * 1024 * D, 128 * up, 7, 256, t2, item, lane); }
        else { const int r2 = r - NE * 2 * I_G, e = r2 / I_D, item = r2 % I_D; p0_tr64(w_ed + (size_t)e * FF * D, FF, D, nullptr, (bf16_t*)(ws + wsm::wd_t) + (size_t)e * D * FF, 0, 30, 0, t2, item, lane); }
    }
}
__device__ __forceinline__ void p0_prologue(const Frame& F, KArgsP a) {
    LAS unsigned* t2 = (LAS unsigned*)(F.lds + F.wave * 8704);
    const int gw = F.vcu * NWAVES + F.wave, NGW = F.G * NWAVES, lane = F.lane;
    unsigned char* ws = a->ws;
    const float* w_in = a->in[4]; const float* g_mix = a->in[3]; const float* w_out = a->in[15]; const float* g_attn = a->in[13]; const float* g_lru = a->in[14];
    const float* g_ffn = a->in[16];
    const float* g_ple = a->in[24]; const float* w_pg = a->in[25]; const float* w_pp = a->in[26];
    constexpr int I_IN = (D / 64) * (NPROJ / 64), I_OUT = (D / 64) * (D / 64), I_PG = I_OUT, I_PP = (PLE / 64) * (D / 64);
    constexpr int NITEMS = I_IN + I_OUT + I_PG + I_PP;
    for (int it = gw; it < NITEMS; it += NGW) {
        int r = it;
        if (r < I_IN) { p0_tr64(w_in, D, NPROJ, g_mix, (bf16_t*)(ws + wsm::w_in_t), 0, 30, 0, t2, r, lane); continue; } r -= I_IN;
        if (r < I_PP) { p0_tr64(w_pp, PLE, D, nullptr, (bf16_t*)(ws + wsm::w_pp_t), 0, 30, 0, t2, r, lane); continue; } r -= I_PP;
        if (r < I_OUT) { const int kb = r / (D / 64); const float* ks = kb < 8 ? g_attn : g_lru - 512; p0_tr64(w_out, D, D, ks, (bf16_t*)(ws + wsm::w_out_t), 0, 30, 0, t2, r, lane); continue; } r -= I_OUT;
        p0_tr64(w_pg, D, D, g_ple, (bf16_t*)(ws + wsm::w_pg_t), 0, 30, 0, t2, r, lane);
    }
    if (F.G < 256) p0_experts(F, a, gw, NGW);
    const float* x = a->in[0]; bf16_t* xb = (bf16_t*)(ws + wsm::xb); float* r0 = (float*)(ws + wsm::r0);
    for (int m = gw; m < T; m += 2 * NGW) {
        const int m2 = m + NGW;
        const f32x4* xr = (const f32x4*)(x + (size_t)m * D) + lane; const f32x4* xr2 = (const f32x4*)(x + (size_t)(m2 < T ? m2 : m) * D) + lane; f32x4 v[4], v2[4]; float s = 0.f, s2 = 0.f;
#pragma unroll
        for (int j = 0; j < 4; ++j) { v[j] = xr[64 * j]; v2[j] = xr2[64 * j]; }
#pragma unroll
        for (int j = 0; j < 4; ++j) { s += (v[j].x * v[j].x + v[j].y * v[j].y) + (v[j].z * v[j].z + v[j].w * v[j].w); s2 += (v2[j].x * v2[j].x + v2[j].y * v2[j].y) + (v2[j].z * v2[j].z + v2[j].w * v2[j].w); }
        s = wsum(s); s2 = wsum(s2);
        u32x2* o8 = (u32x2*)(xb + (size_t)m * D) + lane;
#pragma unroll
        for (int j = 0; j < 4; ++j) { u32x2 w; w.x = pk2(v[j].x, v[j].y); w.y = pk2(v[j].z, v[j].w); o8[64 * j] = w; }
        if (lane == 0) r0[m] = rsqrtf(s * (1.f / D) + EPS);
        if (m2 < T) { u32x2* o9 = (u32x2*)(xb + (size_t)m2 * D) + lane;
#pragma unroll
            for (int j = 0; j < 4; ++j) { u32x2 w; w.x = pk2(v2[j].x, v2[j].y); w.y = pk2(v2[j].z, v2[j].w); o9[64 * j] = w; }
            if (lane == 0) r0[m2] = rsqrtf(s2 * (1.f / D) + EPS); }
    }
    const float* p = a->in[1]; bf16_t* pb = (bf16_t*)(ws + wsm::pb);
    for (int m = gw; m < T; m += NGW) { const f32x4 v = ((const f32x4*)(p + (size_t)m * PLE))[lane]; u32x2 w; w.x = pk2(v.x, v.y); w.y = pk2(v.z, v.w); ((u32x2*)(pb + (size_t)m * PLE))[lane] = w; }
    const int* pos = (const int*)a->in[2]; f32x2* rope = (f32x2*)(ws + wsm::rope);
    for (int idx = (F.vcu * NTHR + F.tid); idx < T * 32; idx += F.G * NTHR) { const int t = idx >> 5, i = idx & 31;
        const float inv_freq = powf(10000.f, -(float)(2 * i) / 64.f); const float ang = (float)pos[t] * inv_freq; float sn, cs; sincosf(ang, &sn, &cs); rope[idx] = (f32x2){cs, sn}; }
    const float* w_rg = a->in[17]; const float* w_re = a->in[19]; bf16_t* wr_t = (bf16_t*)(ws + wsm::wr_t);
    for (int idx = (F.vcu * NTHR + F.tid); idx < 48 * D; idx += F.G * NTHR) { const int j = idx >> 10, k = idx & 1023;
        float v = 0.f; if (j < 4) v = w_rg[k * 4 + j] * g_ffn[k]; else if (j < 36) v = w_re[k * 32 + (j - 4)] * g_ffn[k];
        wr_t[idx] = (bf16_t)(pk2(v, 0.f) & 0xffffu); }
}

constexpr int LB = 512;
constexpr int LRU_XS = 0, LRU_XS_PITCH = 144;
constexpr int LRU_XO = LRU_XS + LB * LRU_XS_PITCH;
constexpr int LRU_WT = LRU_XO + LB * 64;
static_assert(LRU_WT + 2048 <= RING_BYTES, "lru lds");

__device__ __forceinline__ void lru_unit(const Frame& F, KArgsP a, int b, int cg) {
    LAS unsigned char* lds = F.lds; const int tid = F.tid, lane = F.lane, wave = F.wave;
    unsigned char* ws = a->ws;
    const bf16_t* projb = (const bf16_t*)(ws + wsm::projb); bf16_t* mix = (bf16_t*)(ws + wsm::mix); float* ssqL = (float*)(ws + wsm::ssqL);
    const float* cw = a->in[6]; const float* cb = a->in[7]; const float* wa = a->in[8]; const float* ba = a->in[9]; const float* wx = a->in[10]; const float* bx = a->in[11]; const float* lam = a->in[12];
    const int hb = cg >> 2, jj0 = (cg & 3) * 16, c0 = cg * 16;
    const int q8 = tid & 7, cch = hb * 64 + q8 * 8;
    float cwr[4][8], cbr[8];
#pragma unroll
    for (int j = 0; j < 4; ++j)
#pragma unroll
        for (int e = 0; e < 8; ++e) cwr[j][e] = cw[j * 512 + cch + e];
#pragma unroll
    for (int e = 0; e < 8; ++e) cbr[e] = cb[cch + e];
    const bool own = (q8 >> 1) == (cg & 3);
    bf16x8 wfa[2], wfx[2];
#pragma unroll
    for (int ks = 0; ks < 2; ++ks) { unsigned pa[4], px[4];
#pragma unroll
        for (int j = 0; j < 8; j += 2) { const int k = 32 * ks + 8 * (lane >> 4) + j; const size_t o0 = (size_t)(hb * 64 + k) * 64 + jj0 + (lane & 15), o1 = o0 + 64;
            pa[j >> 1] = pk2(wa[o0], wa[o1]); px[j >> 1] = pk2(wx[o0], wx[o1]); }
        wfa[ks] = __builtin_bit_cast(bf16x8, (u32x4){pa[0], pa[1], pa[2], pa[3]}); wfx[ks] = __builtin_bit_cast(bf16x8, (u32x4){px[0], px[1], px[2], px[3]}); }
    const int cl = lane & 15, kq = lane >> 4;
    const float bac = ba[c0 + cl], bxc = bx[c0 + cl];
    const float spc = log1pf(expf(-lam[c0 + cl])) * (-8.f * 1.4426950408889634f);
    LAS float* xo = (LAS float*)(lds + LRU_XO); LAS float* wt = (LAS float*)(lds + LRU_WT);
    float carry = 0.f;
    for (int it = 0; it < SEQ / LB; ++it) {
        const int s0 = it * LB; const size_t t0 = (size_t)b * SEQ + s0;
#pragma unroll 2
        for (int i = 0; i < 8; ++i) {
            const int tt = (tid >> 3) + 64 * i; float xv[8];
#pragma unroll
            for (int e = 0; e < 8; ++e) xv[e] = cbr[e];
#pragma unroll
            for (int j = 0; j < 4; ++j) { const int sj = s0 + tt - 3 + j;
                if (sj >= 0) { const u32x4 w = *(const u32x4*)(projb + ((size_t)b * SEQ + sj) * NPROJ + OFF_LX + cch);
                    xv[0] += cwr[j][0] * bflo(w.x); xv[1] += cwr[j][1] * bfhi(w.x); xv[2] += cwr[j][2] * bflo(w.y); xv[3] += cwr[j][3] * bfhi(w.y);
                    xv[4] += cwr[j][4] * bflo(w.z); xv[5] += cwr[j][5] * bfhi(w.z); xv[6] += cwr[j][6] * bflo(w.w); xv[7] += cwr[j][7] * bfhi(w.w); } }
            u32x4 o; o.x = pk2(xv[0], xv[1]); o.y = pk2(xv[2], xv[3]); o.z = pk2(xv[4], xv[5]); o.w = pk2(xv[6], xv[7]);
            *(LAS u32x4*)(lds + LRU_XS + tt * LRU_XS_PITCH + q8 * 16) = o;
            if (own) { LAS f32x4* d = (LAS f32x4*)(xo + tt * 16 + (q8 & 1) * 8); d[0] = (f32x4){xv[0], xv[1], xv[2], xv[3]}; d[1] = (f32x4){xv[4], xv[5], xv[6], xv[7]}; }
        }
        unsigned short lgr[4][4];
#pragma unroll
        for (int mt = 0; mt < 4; ++mt)
#pragma unroll
            for (int r = 0; r < 4; ++r) lgr[mt][r] = projb[(t0 + 64 * wave + 16 * mt + 4 * kq + r) * NPROJ + OFF_LG + c0 + cl];
        __syncthreads();
        float av[4][4], bv[4][4], Aex[4], Hex[4], At[4], Ht[4];
#pragma unroll
        for (int mt = 0; mt < 4; ++mt) {
            const int tb = 64 * wave + 16 * mt; f32x4 ga = {0.f, 0.f, 0.f, 0.f}, gx = {0.f, 0.f, 0.f, 0.f};
#pragma unroll
            for (int ks = 0; ks < 2; ++ks) { const bf16x8 af = *(const LAS bf16x8*)(lds + LRU_XS + (tb + (lane & 15)) * LRU_XS_PITCH + (32 * ks + 8 * kq) * 2);
                ga = __builtin_amdgcn_mfma_f32_16x16x32_bf16(af, wfa[ks], ga, 0, 0, 0); gx = __builtin_amdgcn_mfma_f32_16x16x32_bf16(af, wfx[ks], gx, 0, 0, 0); }
            float A4 = 1.f, H4 = 0.f;
#pragma unroll
            for (int r = 0; r < 4; ++r) { const int tt = tb + 4 * kq + r;
                const float rg = fsigmoid(ga[r] + bac), ig = fsigmoid(gx[r] + bxc);
                const float aa = fexp2(rg * spc), mult = sqrtf(fmaxf(1.f - aa * aa, 0.f));
                const float bb = mult * ig * xo[tt * 16 + cl];
                av[mt][r] = aa; bv[mt][r] = bb; H4 = aa * H4 + bb; A4 *= aa; }
            { float Ap = __shfl_up(A4, 16), Hp = __shfl_up(H4, 16); if (kq >= 1) { H4 = A4 * Hp + H4; A4 = Ap * A4; }
              Ap = __shfl_up(A4, 32); Hp = __shfl_up(H4, 32); if (kq >= 2) { H4 = A4 * Hp + H4; A4 = Ap * A4; } }
            { const float Ae = __shfl_up(A4, 16), He = __shfl_up(H4, 16); Aex[mt] = kq >= 1 ? Ae : 1.f; Hex[mt] = kq >= 1 ? He : 0.f; }
            At[mt] = __shfl(A4, 48 + cl); Ht[mt] = __shfl(H4, 48 + cl);
        }
        { float Aw = 1.f, Hw = 0.f;
#pragma unroll
          for (int mt = 0; mt < 4; ++mt) { Hw = At[mt] * Hw + Ht[mt]; Aw *= At[mt]; }
          if (kq == 0) { LAS float* d = wt + ((it & 1) * 8 + wave) * 32; d[cl] = Aw; d[16 + cl] = Hw; } }
        __syncthreads();
        float hin = carry, hall = carry;
#pragma unroll
        for (int w2 = 0; w2 < 8; ++w2) { const LAS float* s = wt + ((it & 1) * 8 + w2) * 32; const float A = s[cl], H = s[16 + cl]; hall = A * hall + H; hin = (w2 < wave) ? hall : hin; }
        carry = hall;
#pragma unroll
        for (int mt = 0; mt < 4; ++mt) {
            float h = Aex[mt] * hin + Hex[mt]; float sv = 0.f;
#pragma unroll
            for (int r = 0; r < 4; ++r) {
                h = av[mt][r] * h + bv[mt][r];
                const size_t t = t0 + 64 * wave + 16 * mt + 4 * kq + r;
                const float g = h * fgelu_tanh(bf2f(lgr[mt][r]));
                mix[t * D + 512 + c0 + cl] = (bf16_t)(pk2(g, 0.f) & 0xffffu);
                float s = g * g; s += __shfl_xor(s, 1); s += __shfl_xor(s, 2); s += __shfl_xor(s, 4); s += __shfl_xor(s, 8);
                sv = (cl == r) ? s : sv;
            }
            if (cl < 4) ssqL[(size_t)cg * T + t0 + 64 * wave + 16 * mt + 4 * kq + cl] = sv;
            hin = At[mt] * hin + Ht[mt];
        }
    }
    __syncthreads();
}

typedef float f32x16 __attribute__((ext_vector_type(16)));
typedef short s16x4 __attribute__((ext_vector_type(4)));
constexpr int AT_KP = 144;
constexpr int AT_NK = 160;
constexpr int AT_K = 0, AT_V = 2 * AT_NK * AT_KP;
constexpr int AT_LINV = XTRA_OFF + 256;
static_assert(2 * AT_V <= RING_BYTES && AT_LINV + 2048 <= LDS_BYTES, "attn lds");
__device__ __forceinline__ int crow(int reg, int h) { return (reg & 3) + 8 * (reg >> 2) + 4 * h; }
typedef LAS s16x4* lds_s16x4_p;
__device__ __forceinline__ s16x4 tr_rd(unsigned addr) { return __builtin_amdgcn_ds_read_tr16_b64_v4i16((lds_s16x4_p)(size_t)addr); }

template <int QB>
__device__ __forceinline__ void attn_qblock(const bf16_t* projb, const f32x2* rope, size_t tq0, int h, unsigned kbase, unsigned vbase, float sink2, int kmin, int r, int hh, LAS float* linv, f32x16& o0, f32x16& o1) {
    const size_t tq = tq0 + 32 * QB + r;
    bf16x8 qf[4];
    { const bf16_t* src = projb + tq * NPROJ + h * 64 + 8 * hh; const f32x2* cs = rope + tq * 32 + 8 * hh;
      const float qs = 0.125f * 1.4426950408889634f;
#pragma unroll
      for (int kp = 0; kp < 2; ++kp) {
          const u32x4 w1 = *(const u32x4*)(src + 16 * kp), w2 = *(const u32x4*)(src + 16 * (kp + 2));
          float x1[8] = {bflo(w1.x), bfhi(w1.x), bflo(w1.y), bfhi(w1.y), bflo(w1.z), bfhi(w1.z), bflo(w1.w), bfhi(w1.w)};
          float x2[8] = {bflo(w2.x), bfhi(w2.x), bflo(w2.y), bfhi(w2.y), bflo(w2.z), bfhi(w2.z), bflo(w2.w), bfhi(w2.w)};
          float y1[8], y2[8];
#pragma unroll
          for (int e = 0; e < 8; ++e) { const f32x2 c2 = cs[16 * kp + e]; y1[e] = (x1[e] * c2.x - x2[e] * c2.y) * qs; y2[e] = (x2[e] * c2.x + x1[e] * c2.y) * qs; }
          qf[kp] = __builtin_bit_cast(bf16x8, (u32x4){pk2(y1[0], y1[1]), pk2(y1[2], y1[3]), pk2(y1[4], y1[5]), pk2(y1[6], y1[7])});
          qf[kp + 2] = __builtin_bit_cast(bf16x8, (u32x4){pk2(y2[0], y2[1]), pk2(y2[2], y2[3]), pk2(y2[4], y2[5]), pk2(y2[6], y2[7])});
      } }
    f32x16 S[5];
#pragma unroll
    for (int ti = 0; ti < 5; ++ti) {
        const float pen = (32 * (QB + ti) < kmin) ? -1e30f : 0.f;
        f32x16 acc;
#pragma unroll
        for (int i = 0; i < 16; ++i) acc[i] = pen;
#pragma unroll
        for (int ks = 0; ks < 4; ++ks) { const bf16x8 kf = *(const LAS bf16x8*)(size_t)(kbase + (unsigned)(32 * (QB + ti) * AT_KP + 32 * ks));
            acc = __builtin_amdgcn_mfma_f32_32x32x16_bf16(kf, qf[ks], acc, 0, 0, 0); }
        S[ti] = acc;
    }
    const int c4 = 4 * hh;
#pragma unroll
    for (int i = 0; i < 16; ++i) { const bool up = ((i & 3) + 8 * (i >> 2) + c4) > r; S[0][i] = up ? S[0][i] : -1e30f; S[4][i] = up ? -1e30f : S[4][i]; }
    float mx = sink2;
#pragma unroll
    for (int ti = 0; ti < 5; ++ti)
#pragma unroll
        for (int i = 0; i < 16; ++i) mx = fmaxf(mx, S[ti][i]);
    mx = fmaxf(mx, __shfl_xor(mx, 32));
    float l = 0.f; unsigned P[5][8];
#pragma unroll
    for (int ti = 0; ti < 5; ++ti)
#pragma unroll
        for (int i = 0; i < 16; i += 2) { const float p0 = fexp2(S[ti][i] - mx), p1 = fexp2(S[ti][i + 1] - mx); l += p0 + p1; P[ti][i >> 1] = pk2(p0, p1); }
    l += __shfl_xor(l, 32);
    l += fexp2(sink2 - mx);
    if (hh == 0) linv[(32 * QB + r) * 8 + h] = frcp(l);
#pragma unroll
    for (int i = 0; i < 16; ++i) { o0[i] = 0.f; o1[i] = 0.f; }
#pragma unroll
    for (int ti = 0; ti < 5; ++ti) {
#pragma unroll
        for (int s = 0; s < 2; ++s) {
            const bf16x8 pa = __builtin_bit_cast(bf16x8, (u32x4){P[ti][4 * s], P[ti][4 * s + 1], P[ti][4 * s + 2], P[ti][4 * s + 3]});
            const unsigned va = vbase + (unsigned)((32 * (QB + ti) + 16 * s) * AT_KP);
            const s16x4 lo0 = tr_rd(va), hi0 = tr_rd(va + 8 * AT_KP), lo1 = tr_rd(va + 64), hi1 = tr_rd(va + 8 * AT_KP + 64);
            const bf16x8 vb0 = __builtin_shufflevector(lo0, hi0, 0, 1, 2, 3, 4, 5, 6, 7), vb1 = __builtin_shufflevector(lo1, hi1, 0, 1, 2, 3, 4, 5, 6, 7);
            o0 = __builtin_amdgcn_mfma_f32_32x32x16_bf16(pa, vb0, o0, 0, 0, 0);
            o1 = __builtin_amdgcn_mfma_f32_32x32x16_bf16(pa, vb1, o1, 0, 0, 0);
        }
    }
}

__device__ __forceinline__ void attn_unit(const Frame& F, KArgsP a, int b, int j) {
    LAS unsigned char* lds = F.lds; const int tid = F.tid, lane = F.lane, wave = F.wave;
    unsigned char* ws = a->ws;
    const bf16_t* projb = (const bf16_t*)(ws + wsm::projb); bf16_t* mix = (bf16_t*)(ws + wsm::mix); const f32x2* rope = (const f32x2*)(ws + wsm::rope);
    const float* sinks = a->in[5];
    const int key0 = 32 * j - 128;
#pragma unroll 1
    for (int task = tid; task < AT_NK * 2 * 4; task += NTHR) {
        const int c = task & 3, g = (task >> 2) & 1, kk = task >> 3; const int sp = key0 + kk;
        u32x4 o1 = {0u, 0u, 0u, 0u}, o2 = {0u, 0u, 0u, 0u};
        if (sp >= 0) { const size_t t = (size_t)b * SEQ + sp; const bf16_t* src = projb + t * NPROJ + OFF_K + g * 64 + 8 * c;
            const u32x4 w1 = *(const u32x4*)src, w2 = *(const u32x4*)(src + 32); const f32x2* cs = rope + t * 32 + 8 * c;
            float x1[8] = {bflo(w1.x), bfhi(w1.x), bflo(w1.y), bfhi(w1.y), bflo(w1.z), bfhi(w1.z), bflo(w1.w), bfhi(w1.w)};
            float x2[8] = {bflo(w2.x), bfhi(w2.x), bflo(w2.y), bfhi(w2.y), bflo(w2.z), bfhi(w2.z), bflo(w2.w), bfhi(w2.w)};
            float y1[8], y2[8];
#pragma unroll
            for (int e = 0; e < 8; ++e) { const f32x2 c2 = cs[e]; y1[e] = x1[e] * c2.x - x2[e] * c2.y; y2[e] = x2[e] * c2.x + x1[e] * c2.y; }
            o1 = (u32x4){pk2(y1[0], y1[1]), pk2(y1[2], y1[3]), pk2(y1[4], y1[5]), pk2(y1[6], y1[7])};
            o2 = (u32x4){pk2(y2[0], y2[1]), pk2(y2[2], y2[3]), pk2(y2[4], y2[5]), pk2(y2[6], y2[7])}; }
        LAS unsigned char* d = lds + AT_K + (g * AT_NK + kk) * AT_KP + 16 * c;
        *(LAS u32x4*)d = o1; *(LAS u32x4*)(d + 64) = o2;
    }
#pragma unroll 2
    for (int task = tid; task < AT_NK * 2 * 8; task += NTHR) {
        const int c = task & 7, g = (task >> 3) & 1, kk = task >> 4; const int sp = key0 + kk;
        u32x4 o = {0u, 0u, 0u, 0u};
        if (sp >= 0) o = *(const u32x4*)(projb + ((size_t)b * SEQ + sp) * NPROJ + OFF_V + g * 64 + 8 * c);
        *(LAS u32x4*)(lds + AT_V + (g * AT_NK + kk) * AT_KP + 16 * c) = o;
    }
    __syncthreads();
    const int h = wave, g = wave >> 2, r = lane & 31, hh = lane >> 5;
    const float sink2 = sinks[h] * 1.4426950408889634f;
    const int kmin = -key0;
    const unsigned kbase = (unsigned)(size_t)(lds + AT_K) + (unsigned)((g * AT_NK + r) * AT_KP + 16 * hh);
    const unsigned vbase = (unsigned)(size_t)(lds + AT_V) + (unsigned)((g * AT_NK + 4 * hh + ((lane & 15) >> 2)) * AT_KP + 32 * ((lane >> 4) & 1) + 8 * (lane & 3));
    const size_t tq0 = (size_t)b * SEQ + 32 * j;
    LAS float* linv = (LAS float*)(lds + AT_LINV);
    f32x16 oa0, oa1;
    attn_qblock<0>(projb, rope, tq0, h, kbase, vbase, sink2, kmin, r, hh, linv, oa0, oa1);
    __syncthreads();
    LAS float* ost = (LAS float*)lds;
#pragma unroll
    for (int i = 0; i < 16; ++i) { const int q = crow(i, hh); LAS float* d0 = ost + q * 512 + h * 64 + r; d0[0] = oa0[i]; d0[32] = oa1[i]; }
    __syncthreads();
    { const int tt = tid >> 4, pp = tid & 15; const LAS f32x4* row = (const LAS f32x4*)(ost + tt * 512);
      f32x4 v[8]; float s = 0.f;
#pragma unroll
      for (int i = 0; i < 8; ++i) { v[i] = row[pp + 16 * i] * linv[tt * 8 + i]; s += (v[i].x * v[i].x + v[i].y * v[i].y) + (v[i].z * v[i].z + v[i].w * v[i].w); }
      s += __shfl_xor(s, 1); s += __shfl_xor(s, 2); s += __shfl_xor(s, 4); s += __shfl_xor(s, 8);
      const float rr = rsqrtf(s * (1.f / 512.f) + EPS);
      bf16_t* dst = mix + (tq0 + tt) * D;
#pragma unroll
      for (int i = 0; i < 8; ++i) { u32x2 w; w.x = pk2(v[i].x * rr, v[i].y * rr); w.y = pk2(v[i].z * rr, v[i].w * rr); *(u32x2*)(dst + 4 * (pp + 16 * i)) = w; } }
    __syncthreads();
}

namespace pg8 {
struct EpiOutProj {
    static constexpr bool PERM = true, MIDSCALE = true;
    const bf16_t* xb; bf16_t* x1b; const float* rL; float* ssq1p;
    __device__ __forceinline__ void midscale(f32x4 (&acc)[2][2][4][2], const Unit& u, int wr, int fr) const {
#pragma unroll
        for (int ai = 0; ai < 2; ++ai)
#pragma unroll
            for (int m = 0; m < 4; ++m) { const float s = 1.f / rL[u.pm * BM + ai * HALF + wr * 64 + m * 16 + fr];
#pragma unroll
                for (int bj = 0; bj < 2; ++bj)
#pragma unroll
                    for (int n = 0; n < 2; ++n) acc[ai][bj][m][n] = acc[ai][bj][m][n] * s; }
    }
    __device__ __forceinline__ void operator()(const f32x4 (&acc)[2][2][4][2], const Unit& u, int wr, int wc, int fr, int fq) const {
        const int col0 = u.pn * BM + wc * 32 + 8 * fq;
#pragma unroll
        for (int ai = 0; ai < 2; ++ai)
#pragma unroll
            for (int m = 0; m < 4; ++m) { const int row = u.pm * BM + ai * HALF + wr * 64 + m * 16 + fr; const float s = rL[row]; const size_t off = (size_t)row * D + col0; float q = 0.f;
#pragma unroll
                for (int bj = 0; bj < 2; ++bj) { const size_t o = off + bj * HALF; const u32x4 xw = *(const u32x4*)(xb + o);
                    const f32x4 v0 = (f32x4){bflo(xw.x), bfhi(xw.x), bflo(xw.y), bfhi(xw.y)} + acc[ai][bj][m][0] * s, v1 = (f32x4){bflo(xw.z), bfhi(xw.z), bflo(xw.w), bfhi(xw.w)} + acc[ai][bj][m][1] * s;
                    *(u32x4*)(x1b + o) = (u32x4){pk2(v0[0], v0[1]), pk2(v0[2], v0[3]), pk2(v1[0], v1[1]), pk2(v1[2], v1[3])};
                    q += (v0[0] * v0[0] + v0[1] * v0[1]) + (v0[2] * v0[2] + v0[3] * v0[3]) + (v1[0] * v1[0] + v1[1] * v1[1]) + (v1[2] * v1[2] + v1[3] * v1[3]); }
                q += __shfl_xor(q, 16); q += __shfl_xor(q, 32);
                if (fq == 0) ssq1p[(size_t)(u.pn * 4 + wc) * T + row] = q; }
    }
};
struct EpiMoe1 {
    static constexpr bool PERM = true, MIDSCALE = false;
    bf16_t* hid; const float* lw; const float* lr;
    __device__ __forceinline__ void midscale(f32x4 (&)[2][2][4][2], const Unit&, int, int) const {}
    __device__ __forceinline__ void operator()(const f32x4 (&acc)[2][2][4][2], const Unit& u, int wr, int wc, int fr, int fq) const {
        const int f0 = u.pn * HALF + wc * 32 + 8 * fq;
#pragma unroll
        for (int ai = 0; ai < 2; ++ai)
#pragma unroll
            for (int m = 0; m < 4; ++m) { const int rl = ai * HALF + wr * 64 + m * 16 + fr; const bool ok = rl < u.nrow; const size_t li = (size_t)u.e * T + u.li0 + rl;
                const float r2 = ok ? lr[li] : 0.f, w = ok ? lw[li] : 0.f; unsigned o[4];
#pragma unroll
                for (int n = 0; n < 2; ++n) { float hv[4];
#pragma unroll
                    for (int e = 0; e < 4; ++e) { const float gt = acc[ai][0][m][n][e] * r2, up = acc[ai][1][m][n][e] * r2; hv[e] = gt * frcp(1.f + fexp(-gt)) * up * w; }
                    o[2 * n] = pk2(hv[0], hv[1]); o[2 * n + 1] = pk2(hv[2], hv[3]); }
                *(u32x4*)(hid + (size_t)(u.pm * BM + rl) * FF + f0) = (u32x4){o[0], o[1], o[2], o[3]}; }
    }
};
struct EpiPle {
    static constexpr bool PERM = true, MIDSCALE = false;
    const bf16_t* x2b; bf16_t* x3b; const bf16_t* pp; const float* rP; float* ssq3p;
    __device__ __forceinline__ void midscale(f32x4 (&)[2][2][4][2], const Unit&, int, int) const {}
    __device__ __forceinline__ void operator()(const f32x4 (&acc)[2][2][4][2], const Unit& u, int wr, int wc, int fr, int fq) const {
        const int col0 = u.pn * BM + wc * 32 + 8 * fq;
#pragma unroll
        for (int ai = 0; ai < 2; ++ai)
#pragma unroll
            for (int m = 0; m < 4; ++m) { const int row = u.pm * BM + ai * HALF + wr * 64 + m * 16 + fr; const float s = rP[row]; const size_t off = (size_t)row * D + col0; float q = 0.f;
#pragma unroll
                for (int bj = 0; bj < 2; ++bj) { const size_t o = off + bj * HALF; const u32x4 xw = *(const u32x4*)(x2b + o), pw = *(const u32x4*)(pp + o);
                    const f32x4 a0 = acc[ai][bj][m][0] * s, a1 = acc[ai][bj][m][1] * s;
                    float v[8] = {bflo(xw.x) + fsigmoid(a0[0]) * bflo(pw.x), bfhi(xw.x) + fsigmoid(a0[1]) * bfhi(pw.x), bflo(xw.y) + fsigmoid(a0[2]) * bflo(pw.y), bfhi(xw.y) + fsigmoid(a0[3]) * bfhi(pw.y),
                                  bflo(xw.z) + fsigmoid(a1[0]) * bflo(pw.z), bfhi(xw.z) + fsigmoid(a1[1]) * bfhi(pw.z), bflo(xw.w) + fsigmoid(a1[2]) * bflo(pw.w), bfhi(xw.w) + fsigmoid(a1[3]) * bfhi(pw.w)};
                    *(u32x4*)(x3b + o) = (u32x4){pk2(v[0], v[1]), pk2(v[2], v[3]), pk2(v[4], v[5]), pk2(v[6], v[7])};
                    q += (v[0] * v[0] + v[1] * v[1]) + (v[2] * v[2] + v[3] * v[3]) + (v[4] * v[4] + v[5] * v[5]) + (v[6] * v[6] + v[7] * v[7]); }
                q += __shfl_xor(q, 16); q += __shfl_xor(q, 32);
                if (fq == 0) ssq3p[(size_t)(u.pn * 4 + wc) * T + row] = q; }
    }
};
struct MoeOrder {
    const LAS int* tstart; const LAS int* cntl; const LAS int* rowtab; const int* lt; const char* A; const char* B; size_t strideB; int K, PA, PB, G, c, gather, maxu;
    __device__ bool next(int i, Unit& u) const {
        const int L = i * G + c, tile = L >> 2; if (tile >= __builtin_amdgcn_readfirstlane(tstart[NE]) || i >= maxu) return false;
        int e = 0;
#pragma unroll 1
        for (int k = 1; k < NE; ++k) e = (tstart[k] <= tile) ? k : e;
        e = __builtin_amdgcn_readfirstlane(e);
        u.e = e; u.pm = tile; u.pn = L & 3; u.li0 = __builtin_amdgcn_readfirstlane((tile - tstart[e]) * BM); const int left = __builtin_amdgcn_readfirstlane(cntl[e]) - u.li0; u.nrow = left < BM ? left : BM; u.ord = i; return true;
    }
    __device__ const char* a_ptr(const Unit& u) const { return gather ? A : A + (size_t)u.pm * BM * PA * 2; }
    __device__ const char* b_ptr(const Unit& u) const { return B + (size_t)u.e * strideB + (size_t)u.pn * BM * PB * 2; }
    __device__ unsigned a_row(const Unit& u, int r) const { return u.ord < 4 ? (unsigned)rowtab[u.ord * BM + r] : (r < u.nrow ? (unsigned)lt[(size_t)u.e * T + u.li0 + r] : 0u); }
};
}

constexpr int MOE_TSTART = XTRA_OFF, MOE_CNTL = XTRA_OFF + 256, MOE_ROWTAB = XTRA_OFF + 512;
static_assert(MOE_ROWTAB + 4096 <= LDS_BYTES, "moe lds");
__device__ __forceinline__ void moe_tstart(const Frame& F, const int* cnt) {
    LAS int* tstart = (LAS int*)(F.lds + MOE_TSTART); LAS int* cntl = (LAS int*)(F.lds + MOE_CNTL);
    if (F.tid < 64) { const int l = F.tid; const int c = l < NE ? cnt[l * 32] : 0; const int nt = (c + 255) >> 8; int inc = nt;
#pragma unroll
        for (int o = 1; o < 32; o <<= 1) { const int v = __shfl_up(inc, o); if ((l & 31) >= o) inc += v; }
        if (l < NE) { tstart[l] = inc - nt; cntl[l] = c; } if (l == NE - 1) tstart[NE] = inc; }
    __syncthreads();
}
__device__ __forceinline__ void moe_rowtab(const Frame& F, const pg8::MoeOrder& S) {
    LAS int* rowtab = (LAS int*)(F.lds + MOE_ROWTAB);
    for (int i = 0; i < 4; ++i) { pg8::Unit u; if (!S.next(i, u)) break; if (F.tid < 256) rowtab[i * 256 + F.tid] = F.tid < u.nrow ? S.lt[(size_t)u.e * T + u.li0 + F.tid] : 0; }
    asm volatile("s_waitcnt vmcnt(0) lgkmcnt(0)" ::: "memory"); __syncthreads();
}

__global__ void __launch_bounds__(NTHR, 2) mk_fwd(Args) {
    const KArgsP args0 = kargs();
    extern __shared__ __attribute__((aligned(16))) unsigned char lds_raw[];
    Frame F; F.lds = (LAS unsigned char*)lds_raw; F.MISC = (volatile LAS unsigned*)(F.lds + MISC_OFF);
    F.tid = threadIdx.x; F.lane = F.tid & 63; F.wave = __builtin_amdgcn_readfirstlane(F.tid >> 6);
    F.G = gridDim.x; { const int bx = blockIdx.x; F.vcu = (F.G % 8 == 0) ? (bx % 8) * (F.G / 8) + bx / 8 : bx; }
    unsigned char* ws = args0->ws; F.ctl = (gu32*)(ws + wsm::ctl);
    for (int u = F.tid; u < (LDS_BYTES - LDSCTL_OFF) / 4; u += NTHR) ((LAS unsigned*)(F.lds + LDSCTL_OFF))[u] = 0u;
    __syncthreads();
    const int lo = args0->ph_lo, hi = args0->ph_hi;
    XcdBarrier bar = xcd_barrier_post((unsigned*)(F.ctl + CW_BAR) + (args0->mode >> 8) * XCD_BAR_WORDS, F.MISC + 8);
    int* cnt = (int*)(F.ctl + CW_CNT);
    const LAS int* tstart = (const LAS int*)(F.lds + MOE_TSTART); const LAS int* cntl = (const LAS int*)(F.lds + MOE_CNTL); const LAS int* rowtab = (const LAS int*)(F.lds + MOE_ROWTAB);
    const int gw = F.vcu * NWAVES + F.wave, NGW = F.G * NWAVES, lane = F.lane;
#ifndef PHASE_MASK
#define PHASE_MASK 0x3ffu
#endif
#define IN(k) ((((PHASE_MASK) >> (k)) & 1u) && lo <= (k) && (k) < hi)
#ifdef MK_STAMPS
    unsigned long long* tsg = (unsigned long long*)(F.ctl + 12288);
#define STAMP(k) do { if (blockIdx.x == 0 && F.tid == 0) tsg[k] = __builtin_amdgcn_s_memrealtime(); } while (0)
#else
#define STAMP(k) do { } while (0)
#endif
#define GRID_BAR(k) do { if (IN(k) && IN((k) + 1)) xcd_barrier(bar); STAMP((k) + 1); } while (0)
#ifndef MK_DUP
#define MK_DUP -1
#endif
#define REP(k) for (int rep_ = 0; rep_ < ((MK_DUP == (k)) ? 2 : 1); ++rep_)
    STAMP(0);
    if (IN(0)) REP(0) { const KArgsP args = kargs(); p0_prologue(F, args); __syncthreads(); }
    GRID_BAR(0);
    if (IN(1)) REP(1) { const KArgsP args = kargs();
        { pg8::DenseOrder S; S.init((const bf16_t*)(ws + wsm::xb), (const bf16_t*)(ws + wsm::w_in_t), T, NPROJ, D, F.G, (int)blockIdx.x);
          pg8::EpiScaleBf16 E{(bf16_t*)(ws + wsm::projb), (const float*)(ws + wsm::r0), NPROJ, 0};
          pg8::gemm_phase<pg8::EpiScaleBf16, pg8::DenseOrder, true, false>(F.lds, D, S, E); }
        { pg8::DenseOrder S; S.init((const bf16_t*)(ws + wsm::pb), (const bf16_t*)(ws + wsm::w_pp_t), T, D, PLE, F.G, (int)blockIdx.x);
          pg8::EpiScaleBf16 E{(bf16_t*)(ws + wsm::pp), nullptr, D, 0};
          pg8::gemm_phase<pg8::EpiScaleBf16, pg8::DenseOrder, true, false>(F.lds, PLE, S, E); }
    }
    GRID_BAR(1);
    if (IN(2)) REP(2) { const KArgsP args = kargs();
        const int bx = blockIdx.x, G = F.G;
#pragma unroll 1
        for (int k = 0;; ++k) {
            int it;
            if (G >= 256) { if (bx < 128) { if (k > 0) break; it = bx; } else { const int u = bx - 128 + k * (G - 128); if (u >= 512) break; it = 128 + u; } }
            else { it = bx + k * G; if (it >= 640) break; }
            if (it < 128) lru_unit(F, args, it >> 5, it & 31);
            else { const int u = it - 128; attn_unit(F, args, u >> 7, u & 127); }
        }
        if (G >= 256 && bx >= 128) p0_experts(F, args, (bx - 128) * NWAVES + F.wave, (G - 128) * NWAVES);
    }
    GRID_BAR(2);
    if (IN(3)) REP(3) { const KArgsP args = kargs();
        pg8::DenseOrder S; S.init((const bf16_t*)(ws + wsm::mix), (const bf16_t*)(ws + wsm::w_out_t), T, D, D, F.G, (int)blockIdx.x);
        float* rL = (float*)(ws + wsm::rL); const float* ssqL = (const float*)(ws + wsm::ssqL);
        { pg8::Unit u; for (int i = 0; S.next(i, u); ++i) if (F.tid < 256) { const int row = u.pm * 256 + F.tid; float s = 0.f;
#pragma unroll 8
              for (int cg = 0; cg < 32; ++cg) s += ssqL[(size_t)cg * T + row];
              rL[row] = rsqrtf(s * (1.f / 512.f) + EPS); } }
        asm volatile("s_waitcnt vmcnt(0)" ::: "memory"); __syncthreads();
        pg8::EpiOutProj E{(const bf16_t*)(ws + wsm::xb), (bf16_t*)(ws + wsm::x1b), rL, (float*)(ws + wsm::ssq1p)};
        pg8::gemm_phase<pg8::EpiOutProj, pg8::DenseOrder, true, false>(F.lds, D, S, E);
    }
    GRID_BAR(3);
    if (IN(4)) { const KArgsP args = kargs();
        const bf16_t* x1b = (const bf16_t*)(ws + wsm::x1b); const bf16_t* wr_t = (const bf16_t*)(ws + wsm::wr_t); const float* ssq1p = (const float*)(ws + wsm::ssq1p);
        float* r2v = (float*)(ws + wsm::r2); int* lt = (int*)(ws + wsm::lt); float* lw = (float*)(ws + wsm::lw); float* lr = (float*)(ws + wsm::lr);
        int* tokE = (int*)(ws + wsm::tokE); int* tokPos = (int*)(ws + wsm::tokPos);
        const float* b_rg = args->in[18]; const float* b_re = args->in[20];
        LAS float* lg = (LAS float*)F.lds;
        for (int ch = F.vcu; ch < T / 64; ch += F.G) {
            const int tok0 = ch * 64, mt = F.wave & 3, kh = F.wave >> 2;
            f32x4 acc[3];
#pragma unroll
            for (int n = 0; n < 3; ++n) acc[n] = (f32x4){0.f, 0.f, 0.f, 0.f};
            const bf16_t* ap = x1b + (size_t)(tok0 + 16 * mt + (lane & 15)) * D + 512 * kh + 8 * (lane >> 4);
            const bf16_t* bp = wr_t + (size_t)(lane & 15) * D + 512 * kh + 8 * (lane >> 4);
#pragma unroll 4
            for (int ks = 0; ks < 16; ++ks) { const bf16x8 af = *(const bf16x8*)(ap + 32 * ks);
#pragma unroll
                for (int n = 0; n < 3; ++n) { const bf16x8 bf = *(const bf16x8*)(bp + (size_t)16 * n * D + 32 * ks); acc[n] = __builtin_amdgcn_mfma_f32_16x16x32_bf16(af, bf, acc[n], 0, 0, 0); } }
#pragma unroll
            for (int n = 0; n < 3; ++n)
#pragma unroll
                for (int r = 0; r < 4; ++r) lg[(kh * 64 + 16 * mt + (lane >> 4) * 4 + r) * 48 + 16 * n + (lane & 15)] = acc[n][r];
            __syncthreads();
            if (F.tid < 64) {
                const int t = tok0 + F.tid; float s = 0.f;
#pragma unroll
                for (int pq = 0; pq < 16; ++pq) s += ssq1p[(size_t)pq * T + t];
                const float r2 = rsqrtf(s * (1.f / D) + EPS); r2v[t] = r2;
                const LAS float* l0 = lg + F.tid * 48; const LAS float* l1 = lg + (64 + F.tid) * 48;
                float gm = -1e30f; int gt = 0; float gl[4];
#pragma unroll
                for (int jx = 0; jx < 4; ++jx) { gl[jx] = (l0[jx] + l1[jx]) * r2 + b_rg[jx]; if (gl[jx] > gm) { gm = gl[jx]; gt = jx; } }
                float gs = 0.f;
#pragma unroll
                for (int jx = 0; jx < 4; ++jx) gs += expf(gl[jx] - gm);
                const float gp = 1.f / gs;
                float m1 = -1e30f, m2 = -1e30f; int i1 = 0, i2 = 0;
#pragma unroll
                for (int jx = 0; jx < 8; ++jx) { const float v = (l0[4 + gt * 8 + jx] + l1[4 + gt * 8 + jx]) * r2 + b_re[gt * 8 + jx];
                    if (v > m1) { m2 = m1; i2 = i1; m1 = v; i1 = jx; } else if (v > m2) { m2 = v; i2 = jx; } }
                const float e2 = expf(m2 - m1), w1 = gp / (1.f + e2), w2 = gp * e2 / (1.f + e2);
                const int E1 = gt * 8 + i1, E2 = gt * 8 + i2;
                LAS int* hist = (LAS int*)(F.lds + 32768); LAS int* base = hist + 32;
                if (F.tid < 32) hist[F.tid] = 0;
                asm volatile("s_waitcnt lgkmcnt(0)" ::: "memory");
                const int q1 = __hip_atomic_fetch_add(hist + E1, 1, __ATOMIC_RELAXED, __HIP_MEMORY_SCOPE_WORKGROUP), q2 = __hip_atomic_fetch_add(hist + E2, 1, __ATOMIC_RELAXED, __HIP_MEMORY_SCOPE_WORKGROUP);
                asm volatile("s_waitcnt lgkmcnt(0)" ::: "memory");
                if (F.tid < 32) { const int hc = hist[F.tid]; base[F.tid] = hc > 0 ? atomicAdd(&cnt[F.tid * 32], hc) : 0; }
                asm volatile("s_waitcnt vmcnt(0) lgkmcnt(0)" ::: "memory");
                const int p1 = base[E1] + q1, p2 = base[E2] + q2;
                lt[(size_t)E1 * T + p1] = t; lw[(size_t)E1 * T + p1] = w1; lr[(size_t)E1 * T + p1] = r2;
                lt[(size_t)E2 * T + p2] = t; lw[(size_t)E2 * T + p2] = w2; lr[(size_t)E2 * T + p2] = r2;
                tokE[t * 2] = E1; tokPos[t * 2] = p1; tokE[t * 2 + 1] = E2; tokPos[t * 2 + 1] = p2;
            }
            __syncthreads();
        }
    }
    GRID_BAR(4);
    if (IN(5)) REP(5) { const KArgsP args = kargs();
        moe_tstart(F, cnt);
        pg8::MoeOrder S{tstart, cntl, rowtab, (const int*)(ws + wsm::lt), (const char*)(ws + wsm::x1b), (const char*)(ws + wsm::wgu_t), (size_t)1024 * D * 2, D, D, D, F.G, F.vcu, 1, (args->mode & 2) ? 1 : 64};
        moe_rowtab(F, S);
        pg8::EpiMoe1 E{(bf16_t*)(ws + wsm::hid), (const float*)(ws + wsm::lw), (const float*)(ws + wsm::lr)};
        pg8::gemm_phase<pg8::EpiMoe1, pg8::MoeOrder, true, true>(F.lds, D, S, E);
    }
    GRID_BAR(5);
    if (IN(6)) REP(6) { const KArgsP args = kargs();
        moe_tstart(F, cnt);
        pg8::MoeOrder S{tstart, cntl, rowtab, nullptr, (const char*)(ws + wsm::hid), (const char*)(ws + wsm::wd_t), (size_t)D * FF * 2, FF, FF, FF, F.G, (args->mode & 8) ? (int)blockIdx.x : F.vcu, 0, (args->mode & 16) ? 0 : ((args->mode & 2) ? 1 : ((args->mode & 4) ? 2 : 64))};
        if (args->mode & 1) { S.PA = 576; S.PB = 576; S.strideB = (size_t)D * 576 * 2; }
        pg8::EpiScaleBf16 E{(bf16_t*)(ws + wsm::y), nullptr, D, 0};
        pg8::gemm_phase<pg8::EpiScaleBf16, pg8::MoeOrder, true, false>(F.lds, FF, S, E);
    }
    GRID_BAR(6);
    if (IN(7)) { const KArgsP args = kargs();
        moe_tstart(F, cnt);
        const bf16_t* y = (const bf16_t*)(ws + wsm::y); const bf16_t* x1b = (const bf16_t*)(ws + wsm::x1b); bf16_t* x2b = (bf16_t*)(ws + wsm::x2b); float* rP = (float*)(ws + wsm::rP);
        const int* tokE = (const int*)(ws + wsm::tokE); const int* tokPos = (const int*)(ws + wsm::tokPos);
        for (int t = gw; t < T; t += NGW) {
            const size_t s1 = (size_t)tstart[tokE[2 * t]] * 256 + tokPos[2 * t], s2 = (size_t)tstart[tokE[2 * t + 1]] * 256 + tokPos[2 * t + 1];
            const u32x4* xr = (const u32x4*)(x1b + (size_t)t * D) + lane; const u32x4* ya = (const u32x4*)(y + s1 * D) + lane; const u32x4* yb = (const u32x4*)(y + s2 * D) + lane;
            u32x4* ob = (u32x4*)(x2b + (size_t)t * D) + lane; float s = 0.f;
#pragma unroll
            for (int jx = 0; jx < 2; ++jx) { const u32x4 xw = xr[64 * jx], a2 = ya[64 * jx], b2 = yb[64 * jx];
                float v[8] = {bflo(xw.x) + bflo(a2.x) + bflo(b2.x), bfhi(xw.x) + bfhi(a2.x) + bfhi(b2.x), bflo(xw.y) + bflo(a2.y) + bflo(b2.y), bfhi(xw.y) + bfhi(a2.y) + bfhi(b2.y),
                              bflo(xw.z) + bflo(a2.z) + bflo(b2.z), bfhi(xw.z) + bfhi(a2.z) + bfhi(b2.z), bflo(xw.w) + bflo(a2.w) + bflo(b2.w), bfhi(xw.w) + bfhi(a2.w) + bfhi(b2.w)};
                ob[64 * jx] = (u32x4){pk2(v[0], v[1]), pk2(v[2], v[3]), pk2(v[4], v[5]), pk2(v[6], v[7])};
                s += (v[0] * v[0] + v[1] * v[1]) + (v[2] * v[2] + v[3] * v[3]) + (v[4] * v[4] + v[5] * v[5]) + (v[6] * v[6] + v[7] * v[7]); }
            s = wsum(s);
            if (lane == 0) rP[t] = rsqrtf(s * (1.f / D) + EPS);
        }
    }
    GRID_BAR(7);
    if (IN(8)) REP(8) { const KArgsP args = kargs();
        pg8::DenseOrder S; S.init((const bf16_t*)(ws + wsm::x2b), (const bf16_t*)(ws + wsm::w_pg_t), T, D, D, F.G, (int)blockIdx.x);
        pg8::EpiPle E{(const bf16_t*)(ws + wsm::x2b), (bf16_t*)(ws + wsm::x3b), (const bf16_t*)(ws + wsm::pp), (const float*)(ws + wsm::rP), (float*)(ws + wsm::ssq3p)};
        pg8::gemm_phase<pg8::EpiPle, pg8::DenseOrder, true, false>(F.lds, D, S, E);
    }
    GRID_BAR(8);
    if (IN(9)) { const KArgsP args = kargs();
        const float* ssq3p = (const float*)(ws + wsm::ssq3p); const float* gfin = args->in[27]; float* X = args->out; const bf16_t* x3b = (const bf16_t*)(ws + wsm::x3b);
        f32x4 gv[4];
#pragma unroll
        for (int jx = 0; jx < 2; ++jx) { gv[2 * jx] = ((const f32x4*)gfin)[2 * (lane + 64 * jx)]; gv[2 * jx + 1] = ((const f32x4*)gfin)[2 * (lane + 64 * jx) + 1]; }
        for (int t = gw; t < T; t += NGW) {
            float s = 0.f;
            if (lane < 16) s = ssq3p[(size_t)lane * T + t];
            s = wsum(s);
            const float r3 = rsqrtf(s * (1.f / D) + EPS);
            const u32x4* xr = (const u32x4*)(x3b + (size_t)t * D) + lane; f32x4* orow = (f32x4*)(X + (size_t)t * D);
#pragma unroll
            for (int jx = 0; jx < 2; ++jx) { const u32x4 w = xr[64 * jx];
                orow[2 * (lane + 64 * jx)] = (f32x4){bflo(w.x), bfhi(w.x), bflo(w.y), bfhi(w.y)} * r3 * gv[2 * jx];
                orow[2 * (lane + 64 * jx) + 1] = (f32x4){bflo(w.z), bfhi(w.z), bflo(w.w), bfhi(w.w)} * r3 * gv[2 * jx + 1]; }
        }
    }
#ifdef MK_XBAR
    for (int i = 0; i < MK_XBAR; ++i) xcd_barrier(bar);
#endif
    STAMP(10);
#undef IN
#undef GRID_BAR
}
}

#ifndef MK_ONE_LAUNCH
#define MK_ONE_LAUNCH 1
#endif
#ifdef MK_STAMPS
__global__ void k_delay(const unsigned long long* ts, int k) {
    if (threadIdx.x == 0) { const unsigned long long d = (ts[k + 1] - ts[k]) * 8ull, t0 = __builtin_amdgcn_s_memrealtime(); while (__builtin_amdgcn_s_memrealtime() - t0 < d) __builtin_amdgcn_s_sleep(8); }
}
#endif
extern "C" void kernel_launch(void* const* d_in, const int* in_sizes, int n_in, void* d_out, int out_size, void* d_ws, size_t ws_size, hipStream_t stream) {
    using namespace mk;
    const size_t MB = 1u << 20, KB = 1024;
    const size_t WS_END = wsm::END;
    static int grid = 0;
    if (grid == 0) {
        if (ws_size < WS_END || n_in != 28 || out_size != T * D) { fprintf(stderr, "kernel_launch: ws %zu < %zu or n_in %d or out %d\n", ws_size, (size_t)WS_END, n_in, out_size); grid = -1; return; }
        int dev = 0, cus = 0;
        if (hipGetDevice(&dev) != hipSuccess || hipDeviceGetAttribute(&cus, hipDeviceAttributeMultiprocessorCount, dev) != hipSuccess) { grid = -1; return; }
        if (hipFuncSetAttribute((const void*)mk_fwd, hipFuncAttributeMaxDynamicSharedMemorySize, LDS_BYTES) != hipSuccess) { fprintf(stderr, "hipFuncSetAttribute failed\n"); grid = -1; return; }
        grid = cus;
    }
    if (grid < 0) return;
    Args a{};
    for (int i = 0; i < 28; ++i) a.in[i] = (const float*)d_in[i];
    a.out = (float*)d_out; a.ws = (unsigned char*)d_ws;
    (void)hipMemsetAsync((char*)d_ws + wsm::ctl, 0, CTL_ZERO_BYTES, stream);
#if MK_ONE_LAUNCH
#ifdef MK_CUT
    a.ph_lo = 0; a.ph_hi = MK_CUT; hipLaunchKernelGGL(mk_fwd, dim3(grid), dim3(NTHR), LDS_BYTES, stream, a);
    a.ph_lo = MK_CUT; a.ph_hi = 10; a.mode = 256; hipLaunchKernelGGL(mk_fwd, dim3(grid), dim3(NTHR), LDS_BYTES, stream, a);
#else
    a.ph_lo = 0; a.ph_hi = 10; hipLaunchKernelGGL(mk_fwd, dim3(grid), dim3(NTHR), LDS_BYTES, stream, a);
#endif
#ifdef MK_STAMPS
    if (MK_STAMPS >= 0) k_delay<<<1, 64, 0, stream>>>((const unsigned long long*)((char*)d_ws + wsm::ctl + 12288 * 4), MK_STAMPS);
#endif
#ifdef MK_EXTRA
    a.out = (float*)((char*)d_ws + 16 * MB); a.ph_lo = MK_EXTRA; a.ph_hi = MK_EXTRA + 1;
#ifdef MK_MODE
    a.mode = MK_MODE;
#endif
    hipLaunchKernelGGL(mk_fwd, dim3(grid), dim3(NTHR), LDS_BYTES, stream, a);
#endif
#else
    for (int ph = 0; ph < 10; ++ph) { a.ph_lo = ph; a.ph_hi = ph + 1; hipLaunchKernelGGL(mk_fwd, dim3(grid), dim3(NTHR), LDS_BYTES, stream, a); }
#endif
}
```

```cpp
#define MK_TS_A 0
#define MK_TS_B 1
#define MK_DUP 6
#include <hip/hip_runtime.h>
#include <cstdio>
#include <cstdint>
#define GAS __attribute__((address_space(1)))
#define LAS __attribute__((address_space(3)))
typedef unsigned short bf16_t;
typedef short bf16x8 __attribute__((ext_vector_type(8)));
typedef float f32x4 __attribute__((ext_vector_type(4)));
typedef float f32x2 __attribute__((ext_vector_type(2)));
typedef unsigned u32x4 __attribute__((ext_vector_type(4)));
typedef unsigned u32x2 __attribute__((ext_vector_type(2)));
typedef GAS unsigned gu32;

namespace mk {
constexpr int T = 16384, SEQ = 4096, D = 1024, NPROJ = 1792, PLE = 256;
constexpr int OFF_K = 512, OFF_V = 640, OFF_LX = 768, OFF_LG = 1280;
constexpr int NE = 32, FF = 512;
constexpr float EPS = 1e-6f;
constexpr int NWAVES = 8, NTHR = 512;
constexpr int RING_BYTES = 131072, LDSCTL_OFF = RING_BYTES, MISC_OFF = LDSCTL_OFF + 320, XTRA_OFF = RING_BYTES + 1024, LDS_BYTES = 147456;

__device__ __forceinline__ unsigned f2bf(float f) { unsigned u = __builtin_bit_cast(unsigned, f); return (u + 0x7fffu + ((u >> 16) & 1u)) >> 16; }
typedef __bf16 bf16x2_t __attribute__((ext_vector_type(2)));
__device__ __forceinline__ unsigned pk2(float lo, float hi) { f32x2 f = {lo, hi}; return __builtin_bit_cast(unsigned, __builtin_convertvector(f, bf16x2_t)); }
__device__ __forceinline__ float bf2f(unsigned short b) { return __builtin_bit_cast(float, (unsigned)b << 16); }
__device__ __forceinline__ float bflo(unsigned w) { return __builtin_bit_cast(float, w << 16); }
__device__ __forceinline__ float bfhi(unsigned w) { return __builtin_bit_cast(float, w & 0xffff0000u); }
__device__ __forceinline__ float wsum(float v) {
#pragma unroll
    for (int o = 1; o < 64; o <<= 1) v += __shfl_xor(v, o);
    return v;
}

namespace pg8 {
constexpr int BM = 256, BK = 64, HALF = 128, HTB = HALF * BK * 2, STAGE_BYTES = 8 * HTB, NXCD = 8, WGM = 8;
__device__ __forceinline__ int lds_byte(int r, int c) { const int st = (r >> 4) * 2 + (c >> 5), rr = r & 15, cc = c & 31, ob = rr * 64 + cc * 2; return st * 1024 + (ob ^ (((ob >> 9) & 1) << 5)); }
__device__ __forceinline__ void stage_rc(int b, int& R, int& C) { const int st = b / 1024, sb = b % 1024, swz = sb ^ (((sb >> 9) & 1) << 5); R = (st >> 1) * 16 + swz / 64; C = (st & 1) * 32 + (swz % 64) / 2; }
__device__ __forceinline__ int perm32(int rho) { const int n = rho >> 4, i = rho & 15; return 8 * (i >> 2) + 4 * n + (i & 3); }

struct Unit { int pm, pn, e, nrow, li0, ord; };

struct DenseOrder {
    const bf16_t* A; const bf16_t* Bt; int K, PA, PB, nM, nN, nwg, G, c;
    __device__ void init(const bf16_t* A_, const bf16_t* Bt_, int M, int N, int K_, int G_, int c_) { A = A_; Bt = Bt_; K = K_; PA = K_; PB = K_; nM = M / BM; nN = N / BM; nwg = nM * nN; G = G_; c = c_; }
    __device__ bool next(int i, Unit& u) const {
        const long L = (long)i * G + c; if (L >= nwg) return false;
        int wgid = (int)L; { const int q = nwg / NXCD, r = nwg % NXCD, xcd = wgid % NXCD, off = wgid / NXCD; wgid = (xcd < r ? xcd * (q + 1) : r * (q + 1) + (xcd - r) * q) + off; }
        const int nig = WGM * nN, gid = wgid / nig, fm = gid * WGM, gsz = (nM - fm) < WGM ? (nM - fm) : WGM;
        u.pm = fm + ((wgid % nig) % gsz); u.pn = (wgid % nig) / gsz; u.e = 0; u.nrow = BM; u.li0 = 0; u.ord = i; return true;
    }
    __device__ const char* a_ptr(const Unit& u) const { return (const char*)A + (size_t)u.pm * BM * PA * 2; }
    __device__ const char* b_ptr(const Unit& u) const { return (const char*)Bt + (size_t)u.pn * BM * PB * 2; }
    __device__ unsigned a_row(const Unit&, int r) const { return (unsigned)r; }
};

#define PG8_WAIT_V(n) asm volatile("s_waitcnt vmcnt(" #n ")" ::: "memory")
#define PG8_WAIT_L(n) asm volatile("s_waitcnt lgkmcnt(" #n ")" ::: "memory")
#define PG8_BAR __builtin_amdgcn_s_barrier()
#define PG8_SCHED __builtin_amdgcn_sched_barrier(0)

template <class Epi, class Sched, bool ALIGN_EPI, bool GATHER>
__device__ __forceinline__ void gemm_phase(LAS unsigned char* lds, const int K, const Sched& S, const Epi& E) {
    const int tid = threadIdx.x, wid = __builtin_amdgcn_readfirstlane(tid >> 6), lane = tid & 63, wr = wid >> 2, wc = wid & 3, fr = lane & 15, fq = lane >> 4;
    const int nt = K / BK; const int PA = S.PA, PB = S.PB;
    int Rr[2], Cc[2]; unsigned voffA[2], voffB[2];
#pragma unroll
    for (int i = 0; i < 2; ++i) { stage_rc(tid * 16 + i * 8192, Rr[i], Cc[i]); const int Rb = Epi::PERM ? ((Rr[i] & ~31) + perm32(Rr[i] & 31)) : Rr[i];
        voffA[i] = (unsigned)(Rr[i] * PA + Cc[i]) * 2u; voffB[i] = (unsigned)(Rb * PB + Cc[i]) * 2u; }
    const size_t kstep = (size_t)(BK * 2);
    const size_t hstepB = (size_t)HALF * PB * 2;
    const size_t hstepA = GATHER ? 0 : (size_t)HALF * PA * 2;
    const unsigned ldsw = (unsigned)wid * 1024u;
    const int aoff = lds_byte(wr * 64 + fr, fq * 8), boff = lds_byte(wc * 32 + fr, fq * 8);
#define PG8_SA(b, h) (((b) * 2 + (h)) * HTB)
#define PG8_SB(b, h) ((4 + (b) * 2 + (h)) * HTB)
#define PG8_ST2(bufoff, gbase, v0, v1) do { \
        __builtin_amdgcn_global_load_lds((const unsigned*)((const char*)(gbase) + (v0)), (LAS unsigned*)(lds + (bufoff) + ldsw), 16, 0, 0); \
        __builtin_amdgcn_global_load_lds((const unsigned*)((const char*)(gbase) + (v1)), (LAS unsigned*)(lds + (bufoff) + ldsw + 8192), 16, 0, 0); } while (0)
#define PG8_STB(bufoff, gbase) PG8_ST2(bufoff, gbase, voffB[0], voffB[1])
#define PG8_LDA(dst, b, h) do { _Pragma("unroll") for (int m = 0; m < 4; ++m) _Pragma("unroll") for (int k = 0; k < 2; ++k) dst[m][k] = *(const LAS bf16x8*)(lds + PG8_SA(b, h) + aoff + m * 2048 + k * 1024); } while (0)
#define PG8_LDB(dst, b, h) do { _Pragma("unroll") for (int n = 0; n < 2; ++n) _Pragma("unroll") for (int k = 0; k < 2; ++k) dst[n][k] = *(const LAS bf16x8*)(lds + PG8_SB(b, h) + boff + n * 2048 + k * 1024); } while (0)
#define PG8_MMA(ai, bj, At, Bt) do { __builtin_amdgcn_s_setprio(1); _Pragma("unroll") for (int m = 0; m < 4; ++m) _Pragma("unroll") for (int n = 0; n < 2; ++n) _Pragma("unroll") for (int k = 0; k < 2; ++k) \
        acc[ai][bj][m][n] = __builtin_amdgcn_mfma_f32_16x16x32_bf16(Bt[n][k], At[m][k], acc[ai][bj][m][n], 0, 0, 0); __builtin_amdgcn_s_setprio(0); } while (0)
    Unit cur, nxt; int ui = 0;
    if (!S.next(0, cur)) return;
    f32x4 acc[2][2][4][2];
#pragma unroll
    for (int a = 0; a < 2; ++a)
#pragma unroll
        for (int b = 0; b < 2; ++b)
#pragma unroll
            for (int m = 0; m < 4; ++m)
#pragma unroll
                for (int n = 0; n < 2; ++n) acc[a][b][m][n] = (f32x4){0.f, 0.f, 0.f, 0.f};
    bf16x8 At[4][2], B0[2][2], B1[2][2];
    const char* cA = S.a_ptr(cur); const char* cB = S.b_ptr(cur);
    unsigned c00 = voffA[0], c01 = voffA[1], c10 = voffA[0], c11 = voffA[1];
    if constexpr (GATHER) {
        c00 = (S.a_row(cur, Rr[0]) * (unsigned)PA + (unsigned)Cc[0]) * 2u; c01 = (S.a_row(cur, Rr[1]) * (unsigned)PA + (unsigned)Cc[1]) * 2u;
        c10 = (S.a_row(cur, HALF + Rr[0]) * (unsigned)PA + (unsigned)Cc[0]) * 2u; c11 = (S.a_row(cur, HALF + Rr[1]) * (unsigned)PA + (unsigned)Cc[1]) * 2u;
    }
    PG8_STB(PG8_SB(0, 0), cB); PG8_STB(PG8_SB(0, 1), cB + hstepB); PG8_ST2(PG8_SA(0, 0), cA, c00, c01); PG8_ST2(PG8_SA(0, 1), cA + hstepA, c10, c11);
    if (wr == 1) PG8_BAR;
    PG8_WAIT_V(2); PG8_BAR;
    PG8_STB(PG8_SB(1, 0), cB + kstep); PG8_ST2(PG8_SA(1, 0), cA + kstep, c00, c01); PG8_STB(PG8_SB(1, 1), cB + hstepB + kstep);
    PG8_WAIT_V(6); PG8_BAR;
    for (;;) {
        const bool has_next = S.next(ui + 1, nxt);
        const char* nA = has_next ? S.a_ptr(nxt) : cA; const char* nB = has_next ? S.b_ptr(nxt) : cB;
        unsigned s00 = c00, s01 = c01, s10 = c10, s11 = c11;
        for (int t = 0; t < nt; t += 2) {
            const bool last = (t == nt - 2);
            const char* a1 = cA + (size_t)(t + 1) * kstep;
            const char* a2 = last ? nA : cA + (size_t)(t + 2) * kstep; const char* b2 = last ? nB : cB + (size_t)(t + 2) * kstep;
            const char* a3 = a2 + kstep; const char* b3 = b2 + kstep;
            if constexpr (GATHER) { if (last && has_next) {
                int R0, C0, R1, C1; stage_rc(tid * 16, R0, C0); stage_rc(tid * 16 + 8192, R1, C1);
                s00 = (S.a_row(nxt, R0) * (unsigned)PA + (unsigned)C0) * 2u; s01 = (S.a_row(nxt, R1) * (unsigned)PA + (unsigned)C1) * 2u;
                s10 = (S.a_row(nxt, HALF + R0) * (unsigned)PA + (unsigned)C0) * 2u; s11 = (S.a_row(nxt, HALF + R1) * (unsigned)PA + (unsigned)C1) * 2u; } }
            if constexpr (Epi::MIDSCALE) { if (t == nt / 2) E.midscale(acc, cur, wr, fr); }
            PG8_LDB(B0, 0, 0); PG8_LDB(B1, 0, 1); PG8_SCHED; PG8_LDA(At, 0, 0); PG8_ST2(PG8_SA(1, 1), a1 + hstepA, c10, c11);
            PG8_WAIT_V(8); PG8_WAIT_L(0); PG8_BAR; PG8_MMA(0, 0, At, B0); PG8_MMA(0, 1, At, B1); PG8_BAR; PG8_SCHED;
            PG8_LDA(At, 0, 1); PG8_STB(PG8_SB(0, 0), b2); PG8_STB(PG8_SB(0, 1), b2 + hstepB); PG8_ST2(PG8_SA(0, 0), a2, s00, s01);
            PG8_WAIT_V(8); PG8_WAIT_L(0); PG8_BAR; PG8_MMA(1, 0, At, B0); PG8_MMA(1, 1, At, B1); PG8_BAR; PG8_SCHED;
            PG8_LDB(B0, 1, 0); PG8_LDB(B1, 1, 1); PG8_SCHED; PG8_LDA(At, 1, 0); PG8_ST2(PG8_SA(0, 1), a2 + hstepA, s10, s11);
            PG8_WAIT_V(8); PG8_WAIT_L(0); PG8_BAR; PG8_MMA(0, 0, At, B0); PG8_MMA(0, 1, At, B1); PG8_BAR; PG8_SCHED;
            PG8_LDA(At, 1, 1); PG8_STB(PG8_SB(1, 0), b3); PG8_STB(PG8_SB(1, 1), b3 + hstepB); PG8_ST2(PG8_SA(1, 0), a3, s00, s01);
            PG8_WAIT_V(8); PG8_WAIT_L(0); PG8_BAR; PG8_MMA(1, 0, At, B0); PG8_MMA(1, 1, At, B1); PG8_BAR; PG8_SCHED;
        }
        if constexpr (ALIGN_EPI) { if (wr == 0) PG8_BAR; }
        E(acc, cur, wr, wc, fr, fq);
        if (!has_next) break;
#pragma unroll
        for (int a = 0; a < 2; ++a)
#pragma unroll
            for (int b = 0; b < 2; ++b)
#pragma unroll
                for (int m = 0; m < 4; ++m)
#pragma unroll
                    for (int n = 0; n < 2; ++n) acc[a][b][m][n] = (f32x4){0.f, 0.f, 0.f, 0.f};
        cur = nxt; cA = nA; cB = nB; ++ui;
        if constexpr (GATHER) { c00 = s00; c01 = s01; c10 = s10; c11 = s11; }
        if constexpr (ALIGN_EPI) { if (wr == 1) PG8_BAR; }
    }
    PG8_WAIT_V(0);
    if constexpr (!ALIGN_EPI) { if (wr == 0) PG8_BAR; }
    PG8_BAR;
#undef PG8_SA
#undef PG8_SB
#undef PG8_ST2
#undef PG8_STB
#undef PG8_LDA
#undef PG8_LDB
#undef PG8_MMA
}

struct EpiScaleBf16 {
    static constexpr bool PERM = true, MIDSCALE = false;
    bf16_t* O; const float* rs; int ldc; int pad;
    __device__ __forceinline__ void midscale(f32x4 (&)[2][2][4][2], const Unit&, int, int) const {}
    __device__ __forceinline__ void operator()(const f32x4 (&acc)[2][2][4][2], const Unit& u, int wr, int wc, int fr, int fq) const {
        const int row0 = u.pm * BM + wr * 64 + fr, col0 = u.pn * BM + wc * 32 + 8 * fq;
#pragma unroll
        for (int ai = 0; ai < 2; ++ai)
#pragma unroll
            for (int m = 0; m < 4; ++m) { const int row = row0 + ai * HALF + m * 16; const float s = rs ? rs[row] : 1.f; bf16_t* rowp = O + (size_t)row * ldc + col0;
#pragma unroll
                for (int bj = 0; bj < 2; ++bj) { const f32x4 v0 = acc[ai][bj][m][0] * s, v1 = acc[ai][bj][m][1] * s;
                    u32x4 w; w.x = pk2(v0[0], v0[1]); w.y = pk2(v0[2], v0[3]); w.z = pk2(v1[0], v1[1]); w.w = pk2(v1[2], v1[3]);
                    *(u32x4*)(rowp + bj * HALF) = w; } }
    }
};
}

#define XB_TMO      128
#define XB_XCNT(j)  (256  + 64 * (j))
#define XB_XSUB(j)  (1280 + 64 * (j))
#define XB_XGEN(j)  (2304 + 64 * (j))
#define XB_TOP      3328
#define XB_TOPGEN   3392
#define XCD_BAR_WORDS 3456
#define XB_SPIN_CAP (1u << 18)
__device__ __forceinline__ unsigned xb_ld(unsigned* p)              { return __hip_atomic_load(p, __ATOMIC_RELAXED, __HIP_MEMORY_SCOPE_AGENT); }
__device__ __forceinline__ unsigned xb_add(unsigned* p, unsigned v) { return __hip_atomic_fetch_add(p, v, __ATOMIC_RELAXED, __HIP_MEMORY_SCOPE_AGENT); }
__device__ __forceinline__ unsigned xb_xcc_id() { return (unsigned)__builtin_amdgcn_s_getreg((3 << 11) | 20) & 0xFu; }
#define XB_SPIN(cond, bar) do { unsigned _sp = 0; while (cond) { __builtin_amdgcn_s_sleep(1); \
    if ((++_sp & 255u) == 0u) { if (xb_ld(&(bar)[XB_TMO])) break; if (_sp > XB_SPIN_CAP) { atomicAdd(&(bar)[XB_TMO], 1u); break; } } } } while (0)
struct XcdBarrier { unsigned* bar; unsigned x; volatile LAS unsigned* st; };
__device__ __forceinline__ XcdBarrier xcd_barrier_post(unsigned* bar, volatile LAS unsigned* st) {
    XcdBarrier b; b.bar = bar; b.x = xb_xcc_id(); b.st = st;
    if (threadIdx.x == 0) (void)xb_add(&bar[XB_XCNT(b.x)], 1u);
    return b;
}
__device__ __forceinline__ void xcd_barrier_complete(unsigned* bar, unsigned x, unsigned& nloc, unsigned& nx) {
    const unsigned G = gridDim.x * gridDim.y * gridDim.z;
    unsigned sum, cnt, mine, sp = 0u;
    for (;;) {
        sum = 0u; cnt = 0u; mine = 0u;
#pragma unroll
        for (unsigned j = 0; j < 16; ++j) { const unsigned c = xb_ld(&bar[XB_XCNT(j)]); sum += c; cnt += (c > 0u) ? 1u : 0u; mine = (j == x) ? c : mine; }
        if (sum == G) break;
        __builtin_amdgcn_s_sleep(1);
        if ((++sp & 255u) == 0u) { if (xb_ld(&bar[XB_TMO])) break; if (sp > XB_SPIN_CAP) { atomicAdd(&bar[XB_TMO], 1u); break; } }
    }
    nloc = mine > 0u ? mine : 1u; nx = cnt > 0u ? cnt : 1u;
}
__device__ __forceinline__ void xcd_barrier(const XcdBarrier& b) {
    asm volatile("s_waitcnt vmcnt(0)" ::: "memory");
    __syncthreads();
    if (threadIdx.x == 0) {
        unsigned* bar = b.bar;
        __builtin_amdgcn_s_waitcnt(0);
        unsigned nloc = b.st[0], nx = b.st[1];
        if (nloc == 0u) { xcd_barrier_complete(bar, b.x, nloc, nx); b.st[0] = nloc; b.st[1] = nx; }
        const unsigned old = xb_add(&bar[XB_XSUB(b.x)], 1u);
        const unsigned gen = old / nloc;
        if (old + 1u == (gen + 1u) * nloc) {
            __builtin_amdgcn_fence(__ATOMIC_RELEASE, "agent");
            asm volatile("s_waitcnt vmcnt(0)" ::: "memory");
            const unsigned og = xb_add(&bar[XB_TOP], 1u);
            const unsigned tg = og / nx;
            if (og + 1u == (tg + 1u) * nx) xb_add(&bar[XB_TOPGEN], 1u);
            else XB_SPIN(xb_ld(&bar[XB_TOPGEN]) == tg, bar);
            __builtin_amdgcn_fence(__ATOMIC_ACQUIRE, "agent");
            xb_add(&bar[XB_XGEN(b.x)], 1u);
            asm volatile("s_waitcnt vmcnt(0)" ::: "memory");
        } else {
            XB_SPIN(xb_ld(&bar[XB_XGEN(b.x)]) == gen, bar);
            __builtin_amdgcn_fence(__ATOMIC_ACQUIRE, "agent");
            asm volatile("s_waitcnt vmcnt(0)" ::: "memory");
        }
    }
    __syncthreads();
}


constexpr size_t MiB = 1u << 20;
constexpr size_t WS_CTL = 0, CTL_ZERO_BYTES = 64 * 1024;
constexpr int CW_BAR = 1024;
constexpr int CW_CNT = 8192;

__device__ __forceinline__ void p0_transpose_item(const float* W, int K, int N, const float* ks, bf16_t* WT, int rbase, int gshift, int gstride, LAS float* scr, int item, int lane) {
    const int nblk = N / 32, kb = item / nblk, nb = item % nblk, k0 = 64 * kb, n0 = 32 * nb;
#pragma unroll 8
    for (int i = 0; i < 32; ++i) { const int kk = 2 * i + (lane >> 5); const float s = ks ? ks[k0 + kk] : 1.f; scr[kk * 33 + (lane & 31)] = W[(size_t)(k0 + kk) * N + n0 + (lane & 31)] * s; }
    asm volatile("s_waitcnt lgkmcnt(0)" ::: "memory");
    const int c = lane & 7;
#pragma unroll
    for (int j = 0; j < 4; ++j) { const int nl = (lane >> 3) + 8 * j, n = n0 + nl; const LAS float* s = scr + (8 * c) * 33 + nl;
        const int row = rbase + (n >> gshift) * gstride + (n & ((1 << gshift) - 1));
        u32x4 o; o.x = pk2(s[0 * 33], s[1 * 33]); o.y = pk2(s[2 * 33], s[3 * 33]); o.z = pk2(s[4 * 33], s[5 * 33]); o.w = pk2(s[6 * 33], s[7 * 33]);
        *(u32x4*)(WT + (size_t)row * K + k0 + 8 * c) = o; }
    asm volatile("s_waitcnt lgkmcnt(0)" ::: "memory");
}

constexpr size_t MB_ = 1u << 20, KB_ = 1024;
namespace wsm {
constexpr size_t ctl = 0, r0 = 64 * KB_, rL = 128 * KB_, r2 = 192 * KB_, rP = 256 * KB_, tokE = 320 * KB_, tokPos = 448 * KB_,
    rope = 1 * MB_, wtot = 5 * MB_, ctot = 6 * MB_, ssq1p = 7 * MB_, ssq3p = 8 * MB_, lt = 9 * MB_, lw = 11 * MB_, lr = 13 * MB_, wr_t = 15 * MB_, wag_t = 15 * MB_ + 512 * KB_,
    w_in_t = 16 * MB_, w_out_t = 20 * MB_, wgu_t = 22 * MB_, projb = 86 * MB_, x1b = 110 * MB_,
    wd_t = 142 * MB_, w_pg_t = 174 * MB_, w_pp_t = 176 * MB_,
    xb = 177 * MB_, x2b = 177 * MB_, pb = 209 * MB_, mix = 209 * MB_, hid = 209 * MB_, x3b = 110 * MB_, pp = 249 * MB_, y = 16 * MB_, END = 281 * MB_;
}
struct Args {
    const float* in[28]; float* out; unsigned char* ws;
    int ph_lo, ph_hi, mode, pad;
};
typedef const __attribute__((address_space(4))) Args* KArgsP;
__device__ __forceinline__ KArgsP kargs() { KArgsP p = (KArgsP)__builtin_amdgcn_kernarg_segment_ptr(); asm volatile("" : "+s"(p)); return p; }
struct Frame {
    LAS unsigned char* lds; volatile LAS unsigned* MISC; gu32* ctl;
    int tid, lane, wave, vcu, G;
};
__device__ __forceinline__ float fexp2(float x) { return __builtin_amdgcn_exp2f(x); }
__device__ __forceinline__ float fexp(float x) { return __builtin_amdgcn_exp2f(x * 1.4426950408889634f); }
__device__ __forceinline__ float frcp(float x) { return __builtin_amdgcn_rcpf(x); }
__device__ __forceinline__ float fsigmoid(float x) { return frcp(1.f + fexp(-x)); }
__device__ __forceinline__ float fgelu_tanh(float x) {
    const float u = 0.7978845608028654f * (x + 0.044715f * x * x * x);
    return x * (1.f - frcp(1.f + fexp(2.f * u)));
}

__device__ __forceinline__ void p0_tr64(const float* W, int K, int N, const float* ks, bf16_t* WT, int rbase, int gshift, int gstride, LAS unsigned* t2, int item, int lane) {
    const int nblk = N / 64, kb = item / nblk, nb = item % nblk, k0 = 64 * kb, n0 = 64 * nb;
    const int n4 = lane & 15, kr = lane >> 4;
    f32x4 va[8], vb[8];
#pragma unroll
    for (int i = 0; i < 8; ++i) { const int k = k0 + 8 * i + 2 * kr; va[i] = *(const f32x4*)(W + (size_t)k * N + n0 + 4 * n4); vb[i] = *(const f32x4*)(W + (size_t)(k + 1) * N + n0 + 4 * n4); }
#pragma unroll
    for (int i = 0; i < 8; ++i) { const int k = k0 + 8 * i + 2 * kr, kp = 4 * i + kr; const float s0 = ks ? ks[k] : 1.f, s1 = ks ? ks[k + 1] : 1.f;
        LAS unsigned* d = t2 + (4 * n4) * 33 + kp;
        d[0] = pk2(va[i].x * s0, vb[i].x * s1); d[33] = pk2(va[i].y * s0, vb[i].y * s1); d[66] = pk2(va[i].z * s0, vb[i].z * s1); d[99] = pk2(va[i].w * s0, vb[i].w * s1); }
    asm volatile("s_waitcnt lgkmcnt(0)" ::: "memory");
    const int nl = lane >> 3, c = lane & 7;
#pragma unroll
    for (int j = 0; j < 8; ++j) { const int n = 8 * j + nl; const LAS unsigned* s = t2 + n * 33 + 4 * c; const int ng = n0 + n;
        const int row = rbase + (ng >> gshift) * gstride + (ng & ((1 << gshift) - 1));
        *(u32x4*)(WT + (size_t)row * K + k0 + 8 * c) = (u32x4){s[0], s[1], s[2], s[3]}; }
    asm volatile("s_waitcnt lgkmcnt(0)" ::: "memory");
}

__device__ __forceinline__ void p0_experts(const Frame& F, KArgsP a, int w, int nw) {
    LAS unsigned* t2 = (LAS unsigned*)(F.lds + F.wave * 8704); unsigned char* ws = a->ws; const int lane = F.lane;
    const float* g_ffn = a->in[16]; const float* w_eg = a->in[21]; const float* w_eu = a->in[22]; const float* w_ed = a->in[23];
    constexpr int I_G = (D / 64) * (FF / 64), I_D = (FF / 64) * (D / 64);
    for (int r = w; r < NE * (2 * I_G + I_D); r += nw) {
        if (r < NE * 2 * I_G) { const int e = r / (2 * I_G), q = r % (2 * I_G), up = q / I_G, item = q % I_G;
            p0_tr64((up ? w_eu : w_eg) + (size_t)e * D * FF, D, FF, g_ffn, (bf16_t*)(ws + wsm::wgu_t) + (size_t)e * 1024 * D, 128 * up, 7, 256, t2, item, lane); }
        else { const int r2 = r - NE * 2 * I_G, e = r2 / I_D, item = r2 % I_D; p0_tr64(w_ed + (size_t)e * FF * D, FF, D, nullptr, (bf16_t*)(ws + wsm::wd_t) + (size_t)e * D * FF, 0, 30, 0, t2, item, lane); }
    }
}
__device__ __forceinline__ void p0_prologue(const Frame& F, KArgsP a) {
    LAS unsigned* t2 = (LAS unsigned*)(F.lds + F.wave * 8704);
    const int gw = F.vcu * NWAVES + F.wave, NGW = F.G * NWAVES, lane = F.lane;
    unsigned char* ws = a->ws;
    const float* w_in = a->in[4]; const float* g_mix = a->in[3]; const float* w_out = a->in[15]; const float* g_attn = a->in[13]; const float* g_lru = a->in[14];
    const float* g_ffn = a->in[16];
    const float* g_ple = a->in[24]; const float* w_pg = a->in[25]; const float* w_pp = a->in[26];
    constexpr int I_IN = (D / 64) * (NPROJ / 64), I_OUT = (D / 64) * (D / 64), I_PG = I_OUT, I_PP = (PLE / 64) * (D / 64);
    constexpr int NITEMS = I_IN + I_OUT + I_PG + I_PP;
    for (int it = gw; it < NITEMS; it += NGW) {
        int r = it;
        if (r < I_IN) { p0_tr64(w_in, D, NPROJ, g_mix, (bf16_t*)(ws + wsm::w_in_t), 0, 30, 0, t2, r, lane); continue; } r -= I_IN;
        if (r < I_PP) { p0_tr64(w_pp, PLE, D, nullptr, (bf16_t*)(ws + wsm::w_pp_t), 0, 30, 0, t2, r, lane); continue; } r -= I_PP;
        if (r < I_OUT) { const int kb = r / (D / 64); const float* ks = kb < 8 ? g_attn : g_lru - 512; p0_tr64(w_out, D, D, ks, (bf16_t*)(ws + wsm::w_out_t), 0, 30, 0, t2, r, lane); continue; } r -= I_OUT;
        p0_tr64(w_pg, D, D, g_ple, (bf16_t*)(ws + wsm::w_pg_t), 0, 30, 0, t2, r, lane);
    }
    if (F.G < 256) p0_experts(F, a, gw, NGW);
    const float* x = a->in[0]; bf16_t* xb = (bf16_t*)(ws + wsm::xb); float* r0 = (float*)(ws + wsm::r0);
    for (int m = gw; m < T; m += 2 * NGW) {
        const int m2 = m + NGW;
        const f32x4* xr = (const f32x4*)(x + (size_t)m * D) + lane; const f32x4* xr2 = (const f32x4*)(x + (size_t)(m2 < T ? m2 : m) * D) + lane; f32x4 v[4], v2[4]; float s = 0.f, s2 = 0.f;
#pragma unroll
        for (int j = 0; j < 4; ++j) { v[j] = xr[64 * j]; v2[j] = xr2[64 * j]; }
#pragma unroll
        for (int j = 0; j < 4; ++j) { s += (v[j].x * v[j].x + v[j].y * v[j].y) + (v[j].z * v[j].z + v[j].w * v[j].w); s2 += (v2[j].x * v2[j].x + v2[j].y * v2[j].y) + (v2[j].z * v2[j].z + v2[j].w * v2[j].w); }
        s = wsum(s); s2 = wsum(s2);
        u32x2* o8 = (u32x2*)(xb + (size_t)m * D) + lane;
#pragma unroll
        for (int j = 0; j < 4; ++j) { u32x2 w; w.x = pk2(v[j].x, v[j].y); w.y = pk2(v[j].z, v[j].w); o8[64 * j] = w; }
        if (lane == 0) r0[m] = rsqrtf(s * (1.f / D) + EPS);
        if (m2 < T) { u32x2* o9 = (u32x2*)(xb + (size_t)m2 * D) + lane;
#pragma unroll
            for (int j = 0; j < 4; ++j) { u32x2 w; w.x = pk2(v2[j].x, v2[j].y); w.y = pk2(v2[j].z, v2[j].w); o9[64 * j] = w; }
            if (lane == 0) r0[m2] = rsqrtf(s2 * (1.f / D) + EPS); }
    }
    const float* p = a->in[1]; bf16_t* pb = (bf16_t*)(ws + wsm::pb);
    for (int m = gw; m < T; m += NGW) { const f32x4 v = ((const f32x4*)(p + (size_t)m * PLE))[lane]; u32x2 w; w.x = pk2(v.x, v.y); w.y = pk2(v.z, v.w); ((u32x2*)(pb + (size_t)m * PLE))[lane] = w; }
    const int* pos = (const int*)a->in[2]; f32x2* rope = (f32x2*)(ws + wsm::rope);
    for (int idx = (F.vcu * NTHR + F.tid); idx < T * 32; idx += F.G * NTHR) { const int t = idx >> 5, i = idx & 31;
        const float inv_freq = powf(10000.f, -(float)(2 * i) / 64.f); const float ang = (float)pos[t] * inv_freq; float sn, cs; sincosf(ang, &sn, &cs); rope[idx] = (f32x2){cs, sn}; }
    { const float* wa = a->in[8]; const float* wx = a->in[10]; bf16_t* wag_t = (bf16_t*)(ws + wsm::wag_t);
      for (int idx = (F.vcu * NTHR + F.tid); idx < 8 * 2 * 64 * 64; idx += F.G * NTHR) { const int i = idx & 63, j = (idx >> 6) & 63, gt = (idx >> 12) & 1, hb = idx >> 13;
          const float v = (gt ? wx : wa)[(size_t)(hb * 64 + i) * 64 + j]; wag_t[idx] = (bf16_t)(pk2(v, 0.f) & 0xffffu); } }
    const float* w_rg = a->in[17]; const float* w_re = a->in[19]; bf16_t* wr_t = (bf16_t*)(ws + wsm::wr_t);
    for (int idx = (F.vcu * NTHR + F.tid); idx < 48 * D; idx += F.G * NTHR) { const int j = idx >> 10, k = idx & 1023;
        float v = 0.f; if (j < 4) v = w_rg[k * 4 + j] * g_ffn[k]; else if (j < 36) v = w_re[k * 32 + (j - 4)] * g_ffn[k];
        wr_t[idx] = (bf16_t)(pk2(v, 0.f) & 0xffffu); }
}

constexpr int LB = 512;
constexpr int LRU_XS = 0, LRU_XS_PITCH = 144;
constexpr int LRU_WTL = LRU_XS + LB * LRU_XS_PITCH;
static_assert(LRU_WTL + 4096 <= RING_BYTES, "lru lds");

__device__ __forceinline__ void lruA_unit(const Frame& F, KArgsP a, int b, int hb, int chunk) {
    LAS unsigned char* lds = F.lds; const int tid = F.tid, lane = F.lane, wave = F.wave;
    unsigned char* ws = a->ws;
    const bf16_t* projb = (const bf16_t*)(ws + wsm::projb); bf16_t* hl = (bf16_t*)a->out; bf16_t* pl = hl + (size_t)T * 512;
    float* wtot = (float*)(ws + wsm::wtot); float* ctot = (float*)(ws + wsm::ctot); const bf16_t* wag_t = (const bf16_t*)(ws + wsm::wag_t);
    const float* cw = a->in[6]; const float* cb = a->in[7]; const float* ba = a->in[9]; const float* bx = a->in[11]; const float* lam = a->in[12];
    const int s0 = chunk * LB; const size_t t0 = (size_t)b * SEQ + s0;
    { const int q8 = tid & 7, cch = hb * 64 + q8 * 8;
      float cwr[4][8], cbr[8];
#pragma unroll
      for (int j = 0; j < 4; ++j)
#pragma unroll
          for (int e = 0; e < 8; ++e) cwr[j][e] = cw[j * 512 + cch + e];
#pragma unroll
      for (int e = 0; e < 8; ++e) cbr[e] = cb[cch + e];
#pragma unroll 2
      for (int i = 0; i < 8; ++i) {
          const int tt = (tid >> 3) + 64 * i; float xv[8];
#pragma unroll
          for (int e = 0; e < 8; ++e) xv[e] = cbr[e];
#pragma unroll
          for (int j = 0; j < 4; ++j) { const int sj = s0 + tt - 3 + j;
              if (sj >= 0) { const u32x4 w = *(const u32x4*)(projb + ((size_t)b * SEQ + sj) * NPROJ + OFF_LX + cch);
                  xv[0] += cwr[j][0] * bflo(w.x); xv[1] += cwr[j][1] * bfhi(w.x); xv[2] += cwr[j][2] * bflo(w.y); xv[3] += cwr[j][3] * bfhi(w.y);
                  xv[4] += cwr[j][4] * bflo(w.z); xv[5] += cwr[j][5] * bfhi(w.z); xv[6] += cwr[j][6] * bflo(w.w); xv[7] += cwr[j][7] * bfhi(w.w); } }
          u32x4 o; o.x = pk2(xv[0], xv[1]); o.y = pk2(xv[2], xv[3]); o.z = pk2(xv[4], xv[5]); o.w = pk2(xv[6], xv[7]);
          *(LAS u32x4*)(lds + LRU_XS + tt * LRU_XS_PITCH + q8 * 16) = o;
      } }
    __syncthreads();
    const int cl = lane & 15, kq = lane >> 4, tb0 = 64 * wave;
    bf16x8 af[4][2];
#pragma unroll
    for (int mt = 0; mt < 4; ++mt)
#pragma unroll
        for (int ks = 0; ks < 2; ++ks) af[mt][ks] = *(const LAS bf16x8*)(lds + LRU_XS + (tb0 + 16 * mt + cl) * LRU_XS_PITCH + (32 * ks + 8 * kq) * 2);
    LAS float* wtl = (LAS float*)(lds + LRU_WTL);
#pragma unroll 1
    for (int nt = 0; nt < 4; ++nt) {
        const int c = hb * 64 + nt * 16 + cl;
        bf16x8 wfa[2], wfx[2];
#pragma unroll
        for (int ks = 0; ks < 2; ++ks) { const bf16_t* s = wag_t + ((size_t)(hb * 2) * 64 + nt * 16 + cl) * 64 + 32 * ks + 8 * kq; wfa[ks] = *(const bf16x8*)s; wfx[ks] = *(const bf16x8*)(s + 64 * 64); }
        const float bac = ba[c], bxc = bx[c];
        const float spc = log1pf(expf(-lam[c])) * (-8.f * 1.4426950408889634f);
        float av[4][4], bv[4][4], Aex[4], Hex[4], At[4], Ht[4];
#pragma unroll
        for (int mt = 0; mt < 4; ++mt) {
            f32x4 ga = {0.f, 0.f, 0.f, 0.f}, gx = {0.f, 0.f, 0.f, 0.f};
#pragma unroll
            for (int ks = 0; ks < 2; ++ks) { ga = __builtin_amdgcn_mfma_f32_16x16x32_bf16(af[mt][ks], wfa[ks], ga, 0, 0, 0); gx = __builtin_amdgcn_mfma_f32_16x16x32_bf16(af[mt][ks], wfx[ks], gx, 0, 0, 0); }
            float A4 = 1.f, H4 = 0.f;
#pragma unroll
            for (int r = 0; r < 4; ++r) { const int tt = tb0 + 16 * mt + 4 * kq + r;
                const float xc = bf2f(*(const LAS unsigned short*)(lds + LRU_XS + tt * LRU_XS_PITCH + (16 * nt + cl) * 2));
                const float rg = fsigmoid(ga[r] + bac), ig = fsigmoid(gx[r] + bxc);
                const float aa = fexp2(rg * spc), mult = sqrtf(fmaxf(1.f - aa * aa, 0.f));
                const float bb = mult * ig * xc;
                av[mt][r] = aa; bv[mt][r] = bb; H4 = aa * H4 + bb; A4 *= aa; }
            { float Ap = __shfl_up(A4, 16), Hp = __shfl_up(H4, 16); if (kq >= 1) { H4 = A4 * Hp + H4; A4 = Ap * A4; }
              Ap = __shfl_up(A4, 32); Hp = __shfl_up(H4, 32); if (kq >= 2) { H4 = A4 * Hp + H4; A4 = Ap * A4; } }
            { const float Ae = __shfl_up(A4, 16), He = __shfl_up(H4, 16); Aex[mt] = kq >= 1 ? Ae : 1.f; Hex[mt] = kq >= 1 ? He : 0.f; }
            At[mt] = __shfl(A4, 48 + cl); Ht[mt] = __shfl(H4, 48 + cl);
        }
        float hin = 0.f, pin = 1.f;
#pragma unroll
        for (int mt = 0; mt < 4; ++mt) {
            float h = Aex[mt] * hin + Hex[mt], pr = Aex[mt] * pin;
#pragma unroll
            for (int r = 0; r < 4; ++r) { h = av[mt][r] * h + bv[mt][r]; pr *= av[mt][r];
                const size_t o = (t0 + tb0 + 16 * mt + 4 * kq + r) * 512 + c;
                hl[o] = (bf16_t)(pk2(h, 0.f) & 0xffffu); pl[o] = (bf16_t)(pk2(pr, 0.f) & 0xffffu); }
            hin = At[mt] * hin + Ht[mt]; pin = At[mt] * pin;
        }
        if (kq == 0) { float* d = wtot + ((size_t)(b * 64 + chunk * 8 + wave) * 2) * 512 + c; d[0] = pin; d[512] = hin; wtl[(wave * 2) * 64 + nt * 16 + cl] = pin; wtl[(wave * 2 + 1) * 64 + nt * 16 + cl] = hin; }
    }
    __syncthreads();
    if (tid < 64) { float A = 1.f, H = 0.f;
#pragma unroll
        for (int w2 = 0; w2 < 8; ++w2) { const float a2 = wtl[(w2 * 2) * 64 + tid], h2 = wtl[(w2 * 2 + 1) * 64 + tid]; H = a2 * H + h2; A *= a2; }
        float* d = ctot + ((size_t)(b * 8 + chunk) * 2) * 512 + hb * 64 + tid; d[0] = A; d[512] = H; }
    __syncthreads();
}

__device__ __forceinline__ void lru_finish(const Frame& F, KArgsP a, int b, int wc) {
    LAS float* cl_ = (LAS float*)F.lds; const int tid = F.tid, lane = F.lane, wave = F.wave;
    unsigned char* ws = a->ws;
    const bf16_t* projb = (const bf16_t*)(ws + wsm::projb); const bf16_t* hl = (const bf16_t*)a->out; const bf16_t* pl = hl + (size_t)T * 512; bf16_t* mix = (bf16_t*)(ws + wsm::mix);
    const float* wtot = (const float*)(ws + wsm::wtot); const float* ctot = (const float*)(ws + wsm::ctot);
    { const int c = wc >> 3, sub = wc & 7; float h = 0.f;
      for (int c2 = 0; c2 < c; ++c2) { const float* s = ctot + ((size_t)(b * 8 + c2) * 2) * 512 + tid; h = s[0] * h + s[512]; }
      for (int w2 = 0; w2 < sub; ++w2) { const float* s = wtot + ((size_t)(b * 64 + c * 8 + w2) * 2) * 512 + tid; h = s[0] * h + s[512]; }
      cl_[tid] = h; }
    __syncthreads();
    float cr[8];
#pragma unroll
    for (int e = 0; e < 8; ++e) cr[e] = cl_[8 * lane + e];
#pragma unroll 2
    for (int i = 0; i < 8; ++i) {
        const size_t t = (size_t)b * SEQ + 64 * wc + 8 * wave + i;
        const u32x4 hw = *(const u32x4*)(hl + t * 512 + 8 * lane), pw = *(const u32x4*)(pl + t * 512 + 8 * lane), gw4 = *(const u32x4*)(projb + t * NPROJ + OFF_LG + 8 * lane);
        const float hv[8] = {bflo(hw.x), bfhi(hw.x), bflo(hw.y), bfhi(hw.y), bflo(hw.z), bfhi(hw.z), bflo(hw.w), bfhi(hw.w)};
        const float pv[8] = {bflo(pw.x), bfhi(pw.x), bflo(pw.y), bfhi(pw.y), bflo(pw.z), bfhi(pw.z), bflo(pw.w), bfhi(pw.w)};
        const float lg[8] = {bflo(gw4.x), bfhi(gw4.x), bflo(gw4.y), bfhi(gw4.y), bflo(gw4.z), bfhi(gw4.z), bflo(gw4.w), bfhi(gw4.w)};
        float g[8]; float s = 0.f;
#pragma unroll
        for (int e = 0; e < 8; ++e) { g[e] = (hv[e] + pv[e] * cr[e]) * fgelu_tanh(lg[e]); s += g[e] * g[e]; }
        s = wsum(s);
        const float rr = rsqrtf(s * (1.f / 512.f) + EPS);
        *(u32x4*)(mix + t * D + 512 + 8 * lane) = (u32x4){pk2(g[0] * rr, g[1] * rr), pk2(g[2] * rr, g[3] * rr), pk2(g[4] * rr, g[5] * rr), pk2(g[6] * rr, g[7] * rr)};
    }
    __syncthreads();
}

typedef float f32x16 __attribute__((ext_vector_type(16)));
typedef short s16x4 __attribute__((ext_vector_type(4)));
constexpr int AT_KP = 144;
constexpr int AT_NK = 160;
constexpr int AT_K = 0, AT_V = 2 * AT_NK * AT_KP;
constexpr int AT_LINV = XTRA_OFF + 256;
static_assert(2 * AT_V <= RING_BYTES && AT_LINV + 2048 <= LDS_BYTES, "attn lds");
__device__ __forceinline__ int crow(int reg, int h) { return (reg & 3) + 8 * (reg >> 2) + 4 * h; }
typedef LAS s16x4* lds_s16x4_p;
__device__ __forceinline__ s16x4 tr_rd(unsigned addr) { return __builtin_amdgcn_ds_read_tr16_b64_v4i16((lds_s16x4_p)(size_t)addr); }

template <int QB>
__device__ __forceinline__ void attn_qblock(const bf16_t* projb, const f32x2* rope, size_t tq0, int h, unsigned kbase, unsigned vbase, float sink2, int kmin, int r, int hh, LAS float* linv, f32x16& o0, f32x16& o1) {
    const size_t tq = tq0 + 32 * QB + r;
    bf16x8 qf[4];
    { const bf16_t* src = projb + tq * NPROJ + h * 64 + 8 * hh; const f32x2* cs = rope + tq * 32 + 8 * hh;
      const float qs = 0.125f * 1.4426950408889634f;
#pragma unroll
      for (int kp = 0; kp < 2; ++kp) {
          const u32x4 w1 = *(const u32x4*)(src + 16 * kp), w2 = *(const u32x4*)(src + 16 * (kp + 2));
          float x1[8] = {bflo(w1.x), bfhi(w1.x), bflo(w1.y), bfhi(w1.y), bflo(w1.z), bfhi(w1.z), bflo(w1.w), bfhi(w1.w)};
          float x2[8] = {bflo(w2.x), bfhi(w2.x), bflo(w2.y), bfhi(w2.y), bflo(w2.z), bfhi(w2.z), bflo(w2.w), bfhi(w2.w)};
          float y1[8], y2[8];
#pragma unroll
          for (int e = 0; e < 8; ++e) { const f32x2 c2 = cs[16 * kp + e]; y1[e] = (x1[e] * c2.x - x2[e] * c2.y) * qs; y2[e] = (x2[e] * c2.x + x1[e] * c2.y) * qs; }
          qf[kp] = __builtin_bit_cast(bf16x8, (u32x4){pk2(y1[0], y1[1]), pk2(y1[2], y1[3]), pk2(y1[4], y1[5]), pk2(y1[6], y1[7])});
          qf[kp + 2] = __builtin_bit_cast(bf16x8, (u32x4){pk2(y2[0], y2[1]), pk2(y2[2], y2[3]), pk2(y2[4], y2[5]), pk2(y2[6], y2[7])});
      } }
    f32x16 S[5];
#pragma unroll
    for (int ti = 0; ti < 5; ++ti) {
        const float pen = (32 * (QB + ti) < kmin) ? -1e30f : 0.f;
        f32x16 acc;
#pragma unroll
        for (int i = 0; i < 16; ++i) acc[i] = pen;
#pragma unroll
        for (int ks = 0; ks < 4; ++ks) { const bf16x8 kf = *(const LAS bf16x8*)(size_t)(kbase + (unsigned)(32 * (QB + ti) * AT_KP + 32 * ks));
            acc = __builtin_amdgcn_mfma_f32_32x32x16_bf16(kf, qf[ks], acc, 0, 0, 0); }
        S[ti] = acc;
    }
    const int c4 = 4 * hh;
#pragma unroll
    for (int i = 0; i < 16; ++i) { const bool up = ((i & 3) + 8 * (i >> 2) + c4) > r; S[0][i] = up ? S[0][i] : -1e30f; S[4][i] = up ? -1e30f : S[4][i]; }
    float mx = sink2;
#pragma unroll
    for (int ti = 0; ti < 5; ++ti)
#pragma unroll
        for (int i = 0; i < 16; ++i) mx = fmaxf(mx, S[ti][i]);
    mx = fmaxf(mx, __shfl_xor(mx, 32));
    float l = 0.f; unsigned P[5][8];
#pragma unroll
    for (int ti = 0; ti < 5; ++ti)
#pragma unroll
        for (int i = 0; i < 16; i += 2) { const float p0 = fexp2(S[ti][i] - mx), p1 = fexp2(S[ti][i + 1] - mx); l += p0 + p1; P[ti][i >> 1] = pk2(p0, p1); }
    l += __shfl_xor(l, 32);
    l += fexp2(sink2 - mx);
    if (hh == 0) linv[(32 * QB + r) * 8 + h] = frcp(l);
#pragma unroll
    for (int i = 0; i < 16; ++i) { o0[i] = 0.f; o1[i] = 0.f; }
#pragma unroll
    for (int ti = 0; ti < 5; ++ti) {
#pragma unroll
        for (int s = 0; s < 2; ++s) {
            const bf16x8 pa = __builtin_bit_cast(bf16x8, (u32x4){P[ti][4 * s], P[ti][4 * s + 1], P[ti][4 * s + 2], P[ti][4 * s + 3]});
            const unsigned va = vbase + (unsigned)((32 * (QB + ti) + 16 * s) * AT_KP);
            const s16x4 lo0 = tr_rd(va), hi0 = tr_rd(va + 8 * AT_KP), lo1 = tr_rd(va + 64), hi1 = tr_rd(va + 8 * AT_KP + 64);
            const bf16x8 vb0 = __builtin_shufflevector(lo0, hi0, 0, 1, 2, 3, 4, 5, 6, 7), vb1 = __builtin_shufflevector(lo1, hi1, 0, 1, 2, 3, 4, 5, 6, 7);
            o0 = __builtin_amdgcn_mfma_f32_32x32x16_bf16(pa, vb0, o0, 0, 0, 0);
            o1 = __builtin_amdgcn_mfma_f32_32x32x16_bf16(pa, vb1, o1, 0, 0, 0);
        }
    }
}

__device__ __forceinline__ void attn_unit(const Frame& F, KArgsP a, int b, int j) {
    LAS unsigned char* lds = F.lds; const int tid = F.tid, lane = F.lane, wave = F.wave;
    unsigned char* ws = a->ws;
    const bf16_t* projb = (const bf16_t*)(ws + wsm::projb); bf16_t* mix = (bf16_t*)(ws + wsm::mix); const f32x2* rope = (const f32x2*)(ws + wsm::rope);
    const float* sinks = a->in[5];
    const int key0 = 32 * j - 128;
#pragma unroll 1
    for (int task = tid; task < AT_NK * 2 * 4; task += NTHR) {
        const int c = task & 3, g = (task >> 2) & 1, kk = task >> 3; const int sp = key0 + kk;
        u32x4 o1 = {0u, 0u, 0u, 0u}, o2 = {0u, 0u, 0u, 0u};
        if (sp >= 0) { const size_t t = (size_t)b * SEQ + sp; const bf16_t* src = projb + t * NPROJ + OFF_K + g * 64 + 8 * c;
            const u32x4 w1 = *(const u32x4*)src, w2 = *(const u32x4*)(src + 32); const f32x2* cs = rope + t * 32 + 8 * c;
            float x1[8] = {bflo(w1.x), bfhi(w1.x), bflo(w1.y), bfhi(w1.y), bflo(w1.z), bfhi(w1.z), bflo(w1.w), bfhi(w1.w)};
            float x2[8] = {bflo(w2.x), bfhi(w2.x), bflo(w2.y), bfhi(w2.y), bflo(w2.z), bfhi(w2.z), bflo(w2.w), bfhi(w2.w)};
            float y1[8], y2[8];
#pragma unroll
            for (int e = 0; e < 8; ++e) { const f32x2 c2 = cs[e]; y1[e] = x1[e] * c2.x - x2[e] * c2.y; y2[e] = x2[e] * c2.x + x1[e] * c2.y; }
            o1 = (u32x4){pk2(y1[0], y1[1]), pk2(y1[2], y1[3]), pk2(y1[4], y1[5]), pk2(y1[6], y1[7])};
            o2 = (u32x4){pk2(y2[0], y2[1]), pk2(y2[2], y2[3]), pk2(y2[4], y2[5]), pk2(y2[6], y2[7])}; }
        LAS unsigned char* d = lds + AT_K + (g * AT_NK + kk) * AT_KP + 16 * c;
        *(LAS u32x4*)d = o1; *(LAS u32x4*)(d + 64) = o2;
    }
#pragma unroll 2
    for (int task = tid; task < AT_NK * 2 * 8; task += NTHR) {
        const int c = task & 7, g = (task >> 3) & 1, kk = task >> 4; const int sp = key0 + kk;
        u32x4 o = {0u, 0u, 0u, 0u};
        if (sp >= 0) o = *(const u32x4*)(projb + ((size_t)b * SEQ + sp) * NPROJ + OFF_V + g * 64 + 8 * c);
        *(LAS u32x4*)(lds + AT_V + (g * AT_NK + kk) * AT_KP + 16 * c) = o;
    }
    __syncthreads();
    const int h = wave, g = wave >> 2, r = lane & 31, hh = lane >> 5;
    const float sink2 = sinks[h] * 1.4426950408889634f;
    const int kmin = -key0;
    const unsigned kbase = (unsigned)(size_t)(lds + AT_K) + (unsigned)((g * AT_NK + r) * AT_KP + 16 * hh);
    const unsigned vbase = (unsigned)(size_t)(lds + AT_V) + (unsigned)((g * AT_NK + 4 * hh + ((lane & 15) >> 2)) * AT_KP + 32 * ((lane >> 4) & 1) + 8 * (lane & 3));
    const size_t tq0 = (size_t)b * SEQ + 32 * j;
    LAS float* linv = (LAS float*)(lds + AT_LINV);
    f32x16 oa0, oa1;
    attn_qblock<0>(projb, rope, tq0, h, kbase, vbase, sink2, kmin, r, hh, linv, oa0, oa1);
    __syncthreads();
    LAS float* ost = (LAS float*)lds;
#pragma unroll
    for (int i = 0; i < 16; ++i) { const int q = crow(i, hh); LAS float* d0 = ost + q * 512 + h * 64 + r; d0[0] = oa0[i]; d0[32] = oa1[i]; }
    __syncthreads();
    { const int tt = tid >> 4, pp = tid & 15; const LAS f32x4* row = (const LAS f32x4*)(ost + tt * 512);
      f32x4 v[8]; float s = 0.f;
#pragma unroll
      for (int i = 0; i < 8; ++i) { v[i] = row[pp + 16 * i] * linv[tt * 8 + i]; s += (v[i].x * v[i].x + v[i].y * v[i].y) + (v[i].z * v[i].z + v[i].w * v[i].w); }
      s += __shfl_xor(s, 1); s += __shfl_xor(s, 2); s += __shfl_xor(s, 4); s += __shfl_xor(s, 8);
      const float rr = rsqrtf(s * (1.f / 512.f) + EPS);
      bf16_t* dst = mix + (tq0 + tt) * D;
#pragma unroll
      for (int i = 0; i < 8; ++i) { u32x2 w; w.x = pk2(v[i].x * rr, v[i].y * rr); w.y = pk2(v[i].z * rr, v[i].w * rr); *(u32x2*)(dst + 4 * (pp + 16 * i)) = w; } }
    __syncthreads();
}

namespace pg8 {
struct EpiOutProj {
    static constexpr bool PERM = true, MIDSCALE = false;
    const bf16_t* xb; bf16_t* x1b; float* ssq1p;
    __device__ __forceinline__ void midscale(f32x4 (&)[2][2][4][2], const Unit&, int, int) const {}
    __device__ __forceinline__ void operator()(const f32x4 (&acc)[2][2][4][2], const Unit& u, int wr, int wc, int fr, int fq) const {
        const int col0 = u.pn * BM + wc * 32 + 8 * fq;
#pragma unroll
        for (int ai = 0; ai < 2; ++ai)
#pragma unroll
            for (int m = 0; m < 4; ++m) { const int row = u.pm * BM + ai * HALF + wr * 64 + m * 16 + fr; const size_t off = (size_t)row * D + col0; float q = 0.f;
#pragma unroll
                for (int bj = 0; bj < 2; ++bj) { const size_t o = off + bj * HALF; const u32x4 xw = *(const u32x4*)(xb + o);
                    const f32x4 v0 = (f32x4){bflo(xw.x), bfhi(xw.x), bflo(xw.y), bfhi(xw.y)} + acc[ai][bj][m][0], v1 = (f32x4){bflo(xw.z), bfhi(xw.z), bflo(xw.w), bfhi(xw.w)} + acc[ai][bj][m][1];
                    *(u32x4*)(x1b + o) = (u32x4){pk2(v0[0], v0[1]), pk2(v0[2], v0[3]), pk2(v1[0], v1[1]), pk2(v1[2], v1[3])};
                    q += (v0[0] * v0[0] + v0[1] * v0[1]) + (v0[2] * v0[2] + v0[3] * v0[3]) + (v1[0] * v1[0] + v1[1] * v1[1]) + (v1[2] * v1[2] + v1[3] * v1[3]); }
                q += __shfl_xor(q, 16); q += __shfl_xor(q, 32);
                if (fq == 0) ssq1p[(size_t)(u.pn * 4 + wc) * T + row] = q; }
    }
};
struct EpiMoe1 {
    static constexpr bool PERM = true, MIDSCALE = false;
    bf16_t* hid; const float* lw; const float* lr;
    __device__ __forceinline__ void midscale(f32x4 (&)[2][2][4][2], const Unit&, int, int) const {}
    __device__ __forceinline__ void operator()(const f32x4 (&acc)[2][2][4][2], const Unit& u, int wr, int wc, int fr, int fq) const {
        const int f0 = u.pn * HALF + wc * 32 + 8 * fq;
#pragma unroll
        for (int ai = 0; ai < 2; ++ai)
#pragma unroll
            for (int m = 0; m < 4; ++m) { const int rl = ai * HALF + wr * 64 + m * 16 + fr; const bool ok = rl < u.nrow; const size_t li = (size_t)u.e * T + u.li0 + rl;
                const float r2 = ok ? lr[li] : 0.f, w = ok ? lw[li] : 0.f; unsigned o[4];
#pragma unroll
                for (int n = 0; n < 2; ++n) { float hv[4];
#pragma unroll
                    for (int e = 0; e < 4; ++e) { const float gt = acc[ai][0][m][n][e] * r2, up = acc[ai][1][m][n][e] * r2; hv[e] = gt * frcp(1.f + fexp(-gt)) * up * w; }
                    o[2 * n] = pk2(hv[0], hv[1]); o[2 * n + 1] = pk2(hv[2], hv[3]); }
                *(u32x4*)(hid + (size_t)(u.pm * BM + rl) * FF + f0) = (u32x4){o[0], o[1], o[2], o[3]}; }
    }
};
struct EpiPle {
    static constexpr bool PERM = true, MIDSCALE = false;
    const bf16_t* x2b; bf16_t* x3b; const bf16_t* pp; const float* rP; float* ssq3p;
    __device__ __forceinline__ void midscale(f32x4 (&)[2][2][4][2], const Unit&, int, int) const {}
    __device__ __forceinline__ void operator()(const f32x4 (&acc)[2][2][4][2], const Unit& u, int wr, int wc, int fr, int fq) const {
        const int col0 = u.pn * BM + wc * 32 + 8 * fq;
#pragma unroll
        for (int ai = 0; ai < 2; ++ai)
#pragma unroll
            for (int m = 0; m < 4; ++m) { const int row = u.pm * BM + ai * HALF + wr * 64 + m * 16 + fr; const float s = rP[row]; const size_t off = (size_t)row * D + col0; float q = 0.f;
#pragma unroll
                for (int bj = 0; bj < 2; ++bj) { const size_t o = off + bj * HALF; const u32x4 xw = *(const u32x4*)(x2b + o), pw = *(const u32x4*)(pp + o);
                    const f32x4 a0 = acc[ai][bj][m][0] * s, a1 = acc[ai][bj][m][1] * s;
                    float v[8] = {bflo(xw.x) + fsigmoid(a0[0]) * bflo(pw.x), bfhi(xw.x) + fsigmoid(a0[1]) * bfhi(pw.x), bflo(xw.y) + fsigmoid(a0[2]) * bflo(pw.y), bfhi(xw.y) + fsigmoid(a0[3]) * bfhi(pw.y),
                                  bflo(xw.z) + fsigmoid(a1[0]) * bflo(pw.z), bfhi(xw.z) + fsigmoid(a1[1]) * bfhi(pw.z), bflo(xw.w) + fsigmoid(a1[2]) * bflo(pw.w), bfhi(xw.w) + fsigmoid(a1[3]) * bfhi(pw.w)};
                    *(u32x4*)(x3b + o) = (u32x4){pk2(v[0], v[1]), pk2(v[2], v[3]), pk2(v[4], v[5]), pk2(v[6], v[7])};
                    q += (v[0] * v[0] + v[1] * v[1]) + (v[2] * v[2] + v[3] * v[3]) + (v[4] * v[4] + v[5] * v[5]) + (v[6] * v[6] + v[7] * v[7]); }
                q += __shfl_xor(q, 16); q += __shfl_xor(q, 32);
                if (fq == 0) ssq3p[(size_t)(u.pn * 4 + wc) * T + row] = q; }
    }
};
struct MoeOrder {
    const LAS int* tstart; const LAS int* cntl; const LAS int* rowtab; const int* lt; const char* A; const char* B; size_t strideB; int K, PA, PB, G, c, gather;
    __device__ bool next(int i, Unit& u) const {
        const int L = i * G + c, tile = L >> 2; if (tile >= __builtin_amdgcn_readfirstlane(tstart[NE])) return false;
        int e = 0;
#pragma unroll 1
        for (int k = 1; k < NE; ++k) e = (tstart[k] <= tile) ? k : e;
        e = __builtin_amdgcn_readfirstlane(e);
        u.e = e; u.pm = tile; u.pn = L & 3; u.li0 = __builtin_amdgcn_readfirstlane((tile - tstart[e]) * BM); const int left = __builtin_amdgcn_readfirstlane(cntl[e]) - u.li0; u.nrow = left < BM ? left : BM; u.ord = i; return true;
    }
    __device__ const char* a_ptr(const Unit& u) const { return gather ? A : A + (size_t)u.pm * BM * PA * 2; }
    __device__ const char* b_ptr(const Unit& u) const { return B + (size_t)u.e * strideB + (size_t)u.pn * BM * PB * 2; }
    __device__ unsigned a_row(const Unit& u, int r) const { return (unsigned)rowtab[(u.ord & 7) * BM + r]; }
};
}

constexpr int MOE_TSTART = XTRA_OFF, MOE_CNTL = XTRA_OFF + 256, MOE_ROWTAB = XTRA_OFF + 512;
static_assert(MOE_ROWTAB + 8192 <= LDS_BYTES, "moe lds");
__device__ __forceinline__ void moe_tstart(const Frame& F, const int* cnt) {
    LAS int* tstart = (LAS int*)(F.lds + MOE_TSTART); LAS int* cntl = (LAS int*)(F.lds + MOE_CNTL);
    if (F.tid < 64) { const int l = F.tid; const int c = l < NE ? cnt[l * 32] : 0; const int nt = (c + 255) >> 8; int inc = nt;
#pragma unroll
        for (int o = 1; o < 32; o <<= 1) { const int v = __shfl_up(inc, o); if ((l & 31) >= o) inc += v; }
        if (l < NE) { tstart[l] = inc - nt; cntl[l] = c; } if (l == NE - 1) tstart[NE] = inc; }
    __syncthreads();
}
__device__ __forceinline__ void moe_rowtab(const Frame& F, const pg8::MoeOrder& S) {
    LAS int* rowtab = (LAS int*)(F.lds + MOE_ROWTAB);
    for (int i = 0; i < 8; ++i) { pg8::Unit u; if (!S.next(i, u)) break; if (F.tid < 256) rowtab[i * 256 + F.tid] = F.tid < u.nrow ? S.lt[(size_t)u.e * T + u.li0 + F.tid] : 0; }
    asm volatile("s_waitcnt vmcnt(0) lgkmcnt(0)" ::: "memory"); __syncthreads();
}

__global__ void __launch_bounds__(NTHR, 2) mk_fwd(Args) {
    const KArgsP args0 = kargs();
    extern __shared__ __attribute__((aligned(16))) unsigned char lds_raw[];
    Frame F; F.lds = (LAS unsigned char*)lds_raw; F.MISC = (volatile LAS unsigned*)(F.lds + MISC_OFF);
    F.tid = threadIdx.x; F.lane = F.tid & 63; F.wave = __builtin_amdgcn_readfirstlane(F.tid >> 6);
    F.G = gridDim.x; { const int bx = blockIdx.x; F.vcu = (F.G % 8 == 0) ? (bx % 8) * (F.G / 8) + bx / 8 : bx; }
    unsigned char* ws = args0->ws; F.ctl = (gu32*)(ws + wsm::ctl);
    for (int u = F.tid; u < (LDS_BYTES - LDSCTL_OFF) / 4; u += NTHR) ((LAS unsigned*)(F.lds + LDSCTL_OFF))[u] = 0u;
    __syncthreads();
    const int lo = args0->ph_lo, hi = args0->ph_hi;
    XcdBarrier bar = xcd_barrier_post((unsigned*)(F.ctl + CW_BAR) + (args0->mode >> 8) * XCD_BAR_WORDS, F.MISC + 8);
    int* cnt = (int*)(F.ctl + CW_CNT);
    const LAS int* tstart = (const LAS int*)(F.lds + MOE_TSTART); const LAS int* cntl = (const LAS int*)(F.lds + MOE_CNTL); const LAS int* rowtab = (const LAS int*)(F.lds + MOE_ROWTAB);
    const int gw = F.vcu * NWAVES + F.wave, NGW = F.G * NWAVES, lane = F.lane;
#ifndef PHASE_MASK
#define PHASE_MASK 0x7ffu
#endif
#define IN(k) ((((PHASE_MASK) >> (k)) & 1u) && lo <= (k) && (k) < hi)
#ifdef MK_STAMPS
    unsigned long long* tsg = (unsigned long long*)(F.ctl + 12288);
#define STAMP(k) do { if (blockIdx.x == 0 && F.tid == 0) tsg[k] = __builtin_amdgcn_s_memrealtime(); } while (0)
#else
#define STAMP(k) do { } while (0)
#endif
#define GRID_BAR(k) do { if (IN(k) && IN((k) + 1)) xcd_barrier(bar); STAMP((k) + 1); } while (0)
    STAMP(0);
    if (IN(0)) { const KArgsP args = kargs(); p0_prologue(F, args); __syncthreads(); }
    GRID_BAR(0);
    if (IN(1)) { const KArgsP args = kargs();
        { pg8::DenseOrder S; S.init((const bf16_t*)(ws + wsm::xb), (const bf16_t*)(ws + wsm::w_in_t), T, NPROJ, D, F.G, (int)blockIdx.x);
          pg8::EpiScaleBf16 E{(bf16_t*)(ws + wsm::projb), (const float*)(ws + wsm::r0), NPROJ, 0};
          pg8::gemm_phase<pg8::EpiScaleBf16, pg8::DenseOrder, true, false>(F.lds, D, S, E); }
        { pg8::DenseOrder S; S.init((const bf16_t*)(ws + wsm::pb), (const bf16_t*)(ws + wsm::w_pp_t), T, D, PLE, F.G, (int)blockIdx.x);
          pg8::EpiScaleBf16 E{(bf16_t*)(ws + wsm::pp), nullptr, D, 0};
          pg8::gemm_phase<pg8::EpiScaleBf16, pg8::DenseOrder, true, false>(F.lds, PLE, S, E); }
    }
    GRID_BAR(1);
    if (IN(2)) { const KArgsP args = kargs();
        for (int it = blockIdx.x; it < 256 + 512; it += F.G) {
            if (it < 256) lruA_unit(F, args, it >> 6, (it >> 3) & 7, it & 7);
            else { const int u = it - 256; attn_unit(F, args, u >> 7, u & 127); }
        }
        if (F.G >= 256) p0_experts(F, args, gw, NGW);
    }
    GRID_BAR(2);
    if (IN(3)) { const KArgsP args = kargs();
        for (int it = blockIdx.x; it < T / 64; it += F.G) lru_finish(F, args, it >> 6, it & 63);
    }
    GRID_BAR(3);
    if (IN(4)) { const KArgsP args = kargs();
        pg8::DenseOrder S; S.init((const bf16_t*)(ws + wsm::mix), (const bf16_t*)(ws + wsm::w_out_t), T, D, D, F.G, (int)blockIdx.x);
        pg8::EpiOutProj E{(const bf16_t*)(ws + wsm::xb), (bf16_t*)(ws + wsm::x1b), (float*)(ws + wsm::ssq1p)};
        pg8::gemm_phase<pg8::EpiOutProj, pg8::DenseOrder, true, false>(F.lds, D, S, E);
    }
    GRID_BAR(4);
    if (IN(5)) { const KArgsP args = kargs();
        const bf16_t* x1b = (const bf16_t*)(ws + wsm::x1b); const bf16_t* wr_t = (const bf16_t*)(ws + wsm::wr_t); const float* ssq1p = (const float*)(ws + wsm::ssq1p);
        float* r2v = (float*)(ws + wsm::r2); int* lt = (int*)(ws + wsm::lt); float* lw = (float*)(ws + wsm::lw); float* lr = (float*)(ws + wsm::lr);
        int* tokE = (int*)(ws + wsm::tokE); int* tokPos = (int*)(ws + wsm::tokPos);
        const float* b_rg = args->in[18]; const float* b_re = args->in[20];
        LAS float* lg = (LAS float*)F.lds;
        for (int ch = F.vcu; ch < T / 64; ch += F.G) {
            const int tok0 = ch * 64, mt = F.wave & 3, kh = F.wave >> 2;
            f32x4 acc[3];
#pragma unroll
            for (int n = 0; n < 3; ++n) acc[n] = (f32x4){0.f, 0.f, 0.f, 0.f};
            const bf16_t* ap = x1b + (size_t)(tok0 + 16 * mt + (lane & 15)) * D + 512 * kh + 8 * (lane >> 4);
            const bf16_t* bp = wr_t + (size_t)(lane & 15) * D + 512 * kh + 8 * (lane >> 4);
#pragma unroll 4
            for (int ks = 0; ks < 16; ++ks) { const bf16x8 af = *(const bf16x8*)(ap + 32 * ks);
#pragma unroll
                for (int n = 0; n < 3; ++n) { const bf16x8 bf = *(const bf16x8*)(bp + (size_t)16 * n * D + 32 * ks); acc[n] = __builtin_amdgcn_mfma_f32_16x16x32_bf16(af, bf, acc[n], 0, 0, 0); } }
#pragma unroll
            for (int n = 0; n < 3; ++n)
#pragma unroll
                for (int r = 0; r < 4; ++r) lg[(kh * 64 + 16 * mt + (lane >> 4) * 4 + r) * 48 + 16 * n + (lane & 15)] = acc[n][r];
            __syncthreads();
            if (F.tid < 64) {
                const int t = tok0 + F.tid; float s = 0.f;
#pragma unroll
                for (int pq = 0; pq < 16; ++pq) s += ssq1p[(size_t)pq * T + t];
                const float r2 = rsqrtf(s * (1.f / D) + EPS); r2v[t] = r2;
                const LAS float* l0 = lg + F.tid * 48; const LAS float* l1 = lg + (64 + F.tid) * 48;
                float gm = -1e30f; int gt = 0; float gl[4];
#pragma unroll
                for (int jx = 0; jx < 4; ++jx) { gl[jx] = (l0[jx] + l1[jx]) * r2 + b_rg[jx]; if (gl[jx] > gm) { gm = gl[jx]; gt = jx; } }
                float gs = 0.f;
#pragma unroll
                for (int jx = 0; jx < 4; ++jx) gs += expf(gl[jx] - gm);
                const float gp = 1.f / gs;
                float m1 = -1e30f, m2 = -1e30f; int i1 = 0, i2 = 0;
#pragma unroll
                for (int jx = 0; jx < 8; ++jx) { const float v = (l0[4 + gt * 8 + jx] + l1[4 + gt * 8 + jx]) * r2 + b_re[gt * 8 + jx];
                    if (v > m1) { m2 = m1; i2 = i1; m1 = v; i1 = jx; } else if (v > m2) { m2 = v; i2 = jx; } }
                const float e2 = expf(m2 - m1), w1 = gp / (1.f + e2), w2 = gp * e2 / (1.f + e2);
                const int E1 = gt * 8 + i1, E2 = gt * 8 + i2;
                LAS int* hist = (LAS int*)(F.lds + 32768); LAS int* base = hist + 32;
                if (F.tid < 32) hist[F.tid] = 0;
                asm volatile("s_waitcnt lgkmcnt(0)" ::: "memory");
                const int q1 = __hip_atomic_fetch_add(hist + E1, 1, __ATOMIC_RELAXED, __HIP_MEMORY_SCOPE_WORKGROUP), q2 = __hip_atomic_fetch_add(hist + E2, 1, __ATOMIC_RELAXED, __HIP_MEMORY_SCOPE_WORKGROUP);
                asm volatile("s_waitcnt lgkmcnt(0)" ::: "memory");
                if (F.tid < 32) { const int hc = hist[F.tid]; base[F.tid] = hc > 0 ? atomicAdd(&cnt[F.tid * 32], hc) : 0; }
                asm volatile("s_waitcnt vmcnt(0) lgkmcnt(0)" ::: "memory");
                const int p1 = base[E1] + q1, p2 = base[E2] + q2;
                lt[(size_t)E1 * T + p1] = t; lw[(size_t)E1 * T + p1] = w1; lr[(size_t)E1 * T + p1] = r2;
                lt[(size_t)E2 * T + p2] = t; lw[(size_t)E2 * T + p2] = w2; lr[(size_t)E2 * T + p2] = r2;
                tokE[t * 2] = E1; tokPos[t * 2] = p1; tokE[t * 2 + 1] = E2; tokPos[t * 2 + 1] = p2;
            }
            __syncthreads();
        }
    }
    GRID_BAR(5);
    if (IN(6)) { const KArgsP args = kargs();
        moe_tstart(F, cnt);
        pg8::MoeOrder S{tstart, cntl, rowtab, (const int*)(ws + wsm::lt), (const char*)(ws + wsm::x1b), (const char*)(ws + wsm::wgu_t), (size_t)1024 * D * 2, D, D, D, F.G, F.vcu, 1};
        moe_rowtab(F, S);
        pg8::EpiMoe1 E{(bf16_t*)(ws + wsm::hid), (const float*)(ws + wsm::lw), (const float*)(ws + wsm::lr)};
        pg8::gemm_phase<pg8::EpiMoe1, pg8::MoeOrder, true, true>(F.lds, D, S, E);
    }
    GRID_BAR(6);
    if (IN(7)) { const KArgsP args = kargs();
        moe_tstart(F, cnt);
        pg8::MoeOrder S{tstart, cntl, rowtab, nullptr, (const char*)(ws + wsm::hid), (const char*)(ws + wsm::wd_t), (size_t)D * FF * 2, FF, FF, FF, F.G, F.vcu, 0};
        pg8::EpiScaleBf16 E{(bf16_t*)(ws + wsm::y), nullptr, D, 0};
        pg8::gemm_phase<pg8::EpiScaleBf16, pg8::MoeOrder, true, false>(F.lds, FF, S, E);
    }
    GRID_BAR(7);
    if (IN(8)) { const KArgsP args = kargs();
        moe_tstart(F, cnt);
        const bf16_t* y = (const bf16_t*)(ws + wsm::y); const bf16_t* x1b = (const bf16_t*)(ws + wsm::x1b); bf16_t* x2b = (bf16_t*)(ws + wsm::x2b); float* rP = (float*)(ws + wsm::rP);
        const int* tokE = (const int*)(ws + wsm::tokE); const int* tokPos = (const int*)(ws + wsm::tokPos);
        for (int t = gw; t < T; t += NGW) {
            const size_t s1 = (size_t)tstart[tokE[2 * t]] * 256 + tokPos[2 * t], s2 = (size_t)tstart[tokE[2 * t + 1]] * 256 + tokPos[2 * t + 1];
            const u32x4* xr = (const u32x4*)(x1b + (size_t)t * D) + lane; const u32x4* ya = (const u32x4*)(y + s1 * D) + lane; const u32x4* yb = (const u32x4*)(y + s2 * D) + lane;
            u32x4* ob = (u32x4*)(x2b + (size_t)t * D) + lane; float s = 0.f;
#pragma unroll
            for (int jx = 0; jx < 2; ++jx) { const u32x4 xw = xr[64 * jx], a2 = ya[64 * jx], b2 = yb[64 * jx];
                float v[8] = {bflo(xw.x) + bflo(a2.x) + bflo(b2.x), bfhi(xw.x) + bfhi(a2.x) + bfhi(b2.x), bflo(xw.y) + bflo(a2.y) + bflo(b2.y), bfhi(xw.y) + bfhi(a2.y) + bfhi(b2.y),
                              bflo(xw.z) + bflo(a2.z) + bflo(b2.z), bfhi(xw.z) + bfhi(a2.z) + bfhi(b2.z), bflo(xw.w) + bflo(a2.w) + bflo(b2.w), bfhi(xw.w) + bfhi(a2.w) + bfhi(b2.w)};
                ob[64 * jx] = (u32x4){pk2(v[0], v[1]), pk2(v[2], v[3]), pk2(v[4], v[5]), pk2(v[6], v[7])};
                s += (v[0] * v[0] + v[1] * v[1]) + (v[2] * v[2] + v[3] * v[3]) + (v[4] * v[4] + v[5] * v[5]) + (v[6] * v[6] + v[7] * v[7]); }
            s = wsum(s);
            if (lane == 0) rP[t] = rsqrtf(s * (1.f / D) + EPS);
        }
    }
    GRID_BAR(8);
    if (IN(9)) { const KArgsP args = kargs();
        pg8::DenseOrder S; S.init((const bf16_t*)(ws + wsm::x2b), (const bf16_t*)(ws + wsm::w_pg_t), T, D, D, F.G, (int)blockIdx.x);
        pg8::EpiPle E{(const bf16_t*)(ws + wsm::x2b), (bf16_t*)(ws + wsm::x3b), (const bf16_t*)(ws + wsm::pp), (const float*)(ws + wsm::rP), (float*)(ws + wsm::ssq3p)};
        pg8::gemm_phase<pg8::EpiPle, pg8::DenseOrder, true, false>(F.lds, D, S, E);
    }
    GRID_BAR(9);
    if (IN(10)) { const KArgsP args = kargs();
        const float* ssq3p = (const float*)(ws + wsm::ssq3p); const float* gfin = args->in[27]; float* X = args->out; const bf16_t* x3b = (const bf16_t*)(ws + wsm::x3b);
        f32x4 gv[4];
#pragma unroll
        for (int jx = 0; jx < 2; ++jx) { gv[2 * jx] = ((const f32x4*)gfin)[2 * (lane + 64 * jx)]; gv[2 * jx + 1] = ((const f32x4*)gfin)[2 * (lane + 64 * jx) + 1]; }
        for (int t = gw; t < T; t += NGW) {
            float s = 0.f;
            if (lane < 16) s = ssq3p[(size_t)lane * T + t];
            s = wsum(s);
            const float r3 = rsqrtf(s * (1.f / D) + EPS);
            const u32x4* xr = (const u32x4*)(x3b + (size_t)t * D) + lane; f32x4* orow = (f32x4*)(X + (size_t)t * D);
#pragma unroll
            for (int jx = 0; jx < 2; ++jx) { const u32x4 w = xr[64 * jx];
                orow[2 * (lane + 64 * jx)] = (f32x4){bflo(w.x), bfhi(w.x), bflo(w.y), bfhi(w.y)} * r3 * gv[2 * jx];
                orow[2 * (lane + 64 * jx) + 1] = (f32x4){bflo(w.z), bfhi(w.z), bflo(w.w), bfhi(w.w)} * r3 * gv[2 * jx + 1]; }
        }
    }
#ifdef MK_XBAR
    for (int i = 0; i < MK_XBAR; ++i) xcd_barrier(bar);
#endif
    STAMP(11);
#undef IN
#undef GRID_BAR
}
}

#ifndef MK_ONE_LAUNCH
#define MK_ONE_LAUNCH 1
#endif
#ifdef MK_STAMPS
__global__ void k_delay(const unsigned long long* ts, int k) {
    if (threadIdx.x == 0) { const unsigned long long d = (ts[k + 1] - ts[k]) * 8ull, t0 = __builtin_amdgcn_s_memrealtime(); while (__builtin_amdgcn_s_memrealtime() - t0 < d) __builtin_amdgcn_s_sleep(8); }
}
#endif
extern "C" void kernel_launch(void* const* d_in, const int* in_sizes, int n_in, void* d_out, int out_size, void* d_ws, size_t ws_size, hipStream_t stream) {
    using namespace mk;
    const size_t MB = 1u << 20, KB = 1024;
    const size_t WS_END = wsm::END;
    static int grid = 0;
    if (grid == 0) {
        if (ws_size < WS_END || n_in != 28 || out_size != T * D) { fprintf(stderr, "kernel_launch: ws %zu < %zu or n_in %d or out %d\n", ws_size, (size_t)WS_END, n_in, out_size); grid = -1; return; }
        int dev = 0, cus = 0;
        if (hipGetDevice(&dev) != hipSuccess || hipDeviceGetAttribute(&cus, hipDeviceAttributeMultiprocessorCount, dev) != hipSuccess) { grid = -1; return; }
        if (hipFuncSetAttribute((const void*)mk_fwd, hipFuncAttributeMaxDynamicSharedMemorySize, LDS_BYTES) != hipSuccess) { fprintf(stderr, "hipFuncSetAttribute failed\n"); grid = -1; return; }
        grid = cus;
    }
    if (grid < 0) return;
    Args a{};
    for (int i = 0; i < 28; ++i) a.in[i] = (const float*)d_in[i];
    a.out = (float*)d_out; a.ws = (unsigned char*)d_ws;
    (void)hipMemsetAsync((char*)d_ws + wsm::ctl, 0, CTL_ZERO_BYTES, stream);
#if MK_ONE_LAUNCH
#ifdef MK_CUT
    a.ph_lo = 0; a.ph_hi = MK_CUT; hipLaunchKernelGGL(mk_fwd, dim3(grid), dim3(NTHR), LDS_BYTES, stream, a);
    a.ph_lo = MK_CUT; a.ph_hi = 11; a.mode = 256; hipLaunchKernelGGL(mk_fwd, dim3(grid), dim3(NTHR), LDS_BYTES, stream, a);
#else
    a.ph_lo = 0; a.ph_hi = 11; hipLaunchKernelGGL(mk_fwd, dim3(grid), dim3(NTHR), LDS_BYTES, stream, a);
#endif
#ifdef MK_STAMPS
    if (MK_STAMPS >= 0) k_delay<<<1, 64, 0, stream>>>((const unsigned long long*)((char*)d_ws + wsm::ctl + 12288 * 4), MK_STAMPS);
#endif
#ifdef MK_EXTRA
    a.out = (float*)((char*)d_ws + 16 * MB); a.ph_lo = MK_EXTRA; a.ph_hi = MK_EXTRA + 1;
#ifdef MK_MODE
    a.mode = MK_MODE;
#endif
    hipLaunchKernelGGL(mk_fwd, dim3(grid), dim3(NTHR), LDS_BYTES, stream, a);
#endif
#else
    for (int ph = 0; ph < 11; ++ph) { a.ph_lo = ph; a.ph_hi = ph + 1; hipLaunchKernelGGL(mk_fwd, dim3(grid), dim3(NTHR), LDS_BYTES, stream, a); }
#endif
}
```

```cpp
#define MK_TS_A 0
#define MK_TS_B 1
#define MK_DUP 6
#include <hip/hip_runtime.h>
#include <cstdio>
#include <cstdint>
#define GAS __attribute__((address_space(1)))
#define LAS __attribute__((address_space(3)))
typedef unsigned short bf16_t;
typedef short bf16x8 __attribute__((ext_vector_type(8)));
typedef float f32x4 __attribute__((ext_vector_type(4)));
typedef float f32x2 __attribute__((ext_vector_type(2)));
typedef unsigned u32x4 __attribute__((ext_vector_type(4)));
typedef unsigned u32x2 __attribute__((ext_vector_type(2)));
typedef GAS unsigned gu32;

namespace mk {
constexpr int T = 16384, SEQ = 4096, D = 1024, NPROJ = 1792, PLE = 256;
constexpr int OFF_K = 512, OFF_V = 640, OFF_LX = 768, OFF_LG = 1280;
constexpr int NE = 32, FF = 512;
constexpr float EPS = 1e-6f;
constexpr int NWAVES = 8, NTHR = 512;
constexpr int RING_BYTES = 131072, LDSCTL_OFF = RING_BYTES, MISC_OFF = LDSCTL_OFF + 320, XTRA_OFF = RING_BYTES + 1024, LDS_BYTES = 147456;

__device__ __forceinline__ unsigned f2bf(float f) { unsigned u = __builtin_bit_cast(unsigned, f); return (u + 0x7fffu + ((u >> 16) & 1u)) >> 16; }
typedef __bf16 bf16x2_t __attribute__((ext_vector_type(2)));
__device__ __forceinline__ unsigned pk2(float lo, float hi) { f32x2 f = {lo, hi}; return __builtin_bit_cast(unsigned, __builtin_convertvector(f, bf16x2_t)); }
__device__ __forceinline__ float bf2f(unsigned short b) { return __builtin_bit_cast(float, (unsigned)b << 16); }
__device__ __forceinline__ float bflo(unsigned w) { return __builtin_bit_cast(float, w << 16); }
__device__ __forceinline__ float bfhi(unsigned w) { return __builtin_bit_cast(float, w & 0xffff0000u); }
__device__ __forceinline__ float wsum(float v) {
#pragma unroll
    for (int o = 1; o < 64; o <<= 1) v += __shfl_xor(v, o);
    return v;
}

namespace pg8 {
constexpr int BM = 256, BK = 64, HALF = 128, HTB = HALF * BK * 2, STAGE_BYTES = 8 * HTB, NXCD = 8, WGM = 8;
__device__ __forceinline__ int lds_byte(int r, int c) { const int st = (r >> 4) * 2 + (c >> 5), rr = r & 15, cc = c & 31, ob = rr * 64 + cc * 2; return st * 1024 + (ob ^ (((ob >> 9) & 1) << 5)); }
__device__ __forceinline__ void stage_rc(int b, int& R, int& C) { const int st = b / 1024, sb = b % 1024, swz = sb ^ (((sb >> 9) & 1) << 5); R = (st >> 1) * 16 + swz / 64; C = (st & 1) * 32 + (swz % 64) / 2; }
__device__ __forceinline__ int perm32(int rho) { const int n = rho >> 4, i = rho & 15; return 8 * (i >> 2) + 4 * n + (i & 3); }

struct Unit { int pm, pn, e, nrow, li0, ord; };

struct DenseOrder {
    const bf16_t* A; const bf16_t* Bt; int K, PA, PB, nM, nN, nwg, G, c;
    __device__ void init(const bf16_t* A_, const bf16_t* Bt_, int M, int N, int K_, int G_, int c_) { A = A_; Bt = Bt_; K = K_; PA = K_; PB = K_; nM = M / BM; nN = N / BM; nwg = nM * nN; G = G_; c = c_; }
    __device__ bool next(int i, Unit& u) const {
        const long L = (long)i * G + c; if (L >= nwg || c < 0) return false;
        int wgid = (int)L; { const int q = nwg / NXCD, r = nwg % NXCD, xcd = wgid % NXCD, off = wgid / NXCD; wgid = (xcd < r ? xcd * (q + 1) : r * (q + 1) + (xcd - r) * q) + off; }
        const int nig = WGM * nN, gid = wgid / nig, fm = gid * WGM, gsz = (nM - fm) < WGM ? (nM - fm) : WGM;
        u.pm = fm + ((wgid % nig) % gsz); u.pn = (wgid % nig) / gsz; u.e = 0; u.nrow = BM; u.li0 = 0; u.ord = i; return true;
    }
    __device__ const char* a_ptr(const Unit& u) const { return (const char*)A + (size_t)u.pm * BM * PA * 2; }
    __device__ const char* b_ptr(const Unit& u) const { return (const char*)Bt + (size_t)u.pn * BM * PB * 2; }
    __device__ unsigned a_row(const Unit&, int r) const { return (unsigned)r; }
};

#define PG8_WAIT_V(n) asm volatile("s_waitcnt vmcnt(" #n ")" ::: "memory")
#define PG8_WAIT_L(n) asm volatile("s_waitcnt lgkmcnt(" #n ")" ::: "memory")
#define PG8_BAR __builtin_amdgcn_s_barrier()
#define PG8_SCHED __builtin_amdgcn_sched_barrier(0)

template <class Epi, class Sched, bool ALIGN_EPI, bool GATHER>
__device__ __forceinline__ void gemm_phase(LAS unsigned char* lds, const int K, const Sched& S, const Epi& E) {
    const int tid = threadIdx.x, wid = __builtin_amdgcn_readfirstlane(tid >> 6), lane = tid & 63, wr = wid >> 2, wc = wid & 3, fr = lane & 15, fq = lane >> 4;
    const int nt = K / BK; const int PA = S.PA, PB = S.PB;
    int Rr[2], Cc[2]; unsigned voffA[2], voffB[2];
#pragma unroll
    for (int i = 0; i < 2; ++i) { stage_rc(tid * 16 + i * 8192, Rr[i], Cc[i]); const int Rb = Epi::PERM ? ((Rr[i] & ~31) + perm32(Rr[i] & 31)) : Rr[i];
        voffA[i] = (unsigned)(Rr[i] * PA + Cc[i]) * 2u; voffB[i] = (unsigned)(Rb * PB + Cc[i]) * 2u; }
    const size_t kstep = (size_t)(BK * 2);
    const size_t hstepB = (size_t)HALF * PB * 2;
    const size_t hstepA = GATHER ? 0 : (size_t)HALF * PA * 2;
    const unsigned ldsw = (unsigned)wid * 1024u;
    const int aoff = lds_byte(wr * 64 + fr, fq * 8), boff = lds_byte(wc * 32 + fr, fq * 8);
#define PG8_SA(b, h) (((b) * 2 + (h)) * HTB)
#define PG8_SB(b, h) ((4 + (b) * 2 + (h)) * HTB)
#define PG8_ST2(bufoff, gbase, v0, v1) do { \
        __builtin_amdgcn_global_load_lds((const unsigned*)((const char*)(gbase) + (v0)), (LAS unsigned*)(lds + (bufoff) + ldsw), 16, 0, 0); \
        __builtin_amdgcn_global_load_lds((const unsigned*)((const char*)(gbase) + (v1)), (LAS unsigned*)(lds + (bufoff) + ldsw + 8192), 16, 0, 0); } while (0)
#define PG8_STB(bufoff, gbase) PG8_ST2(bufoff, gbase, voffB[0], voffB[1])
#define PG8_LDA(dst, b, h) do { _Pragma("unroll") for (int m = 0; m < 4; ++m) _Pragma("unroll") for (int k = 0; k < 2; ++k) dst[m][k] = *(const LAS bf16x8*)(lds + PG8_SA(b, h) + aoff + m * 2048 + k * 1024); } while (0)
#define PG8_LDB(dst, b, h) do { _Pragma("unroll") for (int n = 0; n < 2; ++n) _Pragma("unroll") for (int k = 0; k < 2; ++k) dst[n][k] = *(const LAS bf16x8*)(lds + PG8_SB(b, h) + boff + n * 2048 + k * 1024); } while (0)
#define PG8_MMA(ai, bj, At, Bt) do { __builtin_amdgcn_s_setprio(1); _Pragma("unroll") for (int m = 0; m < 4; ++m) _Pragma("unroll") for (int n = 0; n < 2; ++n) _Pragma("unroll") for (int k = 0; k < 2; ++k) \
        acc[ai][bj][m][n] = __builtin_amdgcn_mfma_f32_16x16x32_bf16(Bt[n][k], At[m][k], acc[ai][bj][m][n], 0, 0, 0); __builtin_amdgcn_s_setprio(0); } while (0)
    Unit cur, nxt; int ui = 0;
    if (!S.next(0, cur)) return;
    f32x4 acc[2][2][4][2];
#pragma unroll
    for (int a = 0; a < 2; ++a)
#pragma unroll
        for (int b = 0; b < 2; ++b)
#pragma unroll
            for (int m = 0; m < 4; ++m)
#pragma unroll
                for (int n = 0; n < 2; ++n) acc[a][b][m][n] = (f32x4){0.f, 0.f, 0.f, 0.f};
    bf16x8 At[4][2], B0[2][2], B1[2][2];
    const char* cA = S.a_ptr(cur); const char* cB = S.b_ptr(cur);
    unsigned c00 = voffA[0], c01 = voffA[1], c10 = voffA[0], c11 = voffA[1];
    if constexpr (GATHER) {
        c00 = (S.a_row(cur, Rr[0]) * (unsigned)PA + (unsigned)Cc[0]) * 2u; c01 = (S.a_row(cur, Rr[1]) * (unsigned)PA + (unsigned)Cc[1]) * 2u;
        c10 = (S.a_row(cur, HALF + Rr[0]) * (unsigned)PA + (unsigned)Cc[0]) * 2u; c11 = (S.a_row(cur, HALF + Rr[1]) * (unsigned)PA + (unsigned)Cc[1]) * 2u;
    }
    PG8_STB(PG8_SB(0, 0), cB); PG8_STB(PG8_SB(0, 1), cB + hstepB); PG8_ST2(PG8_SA(0, 0), cA, c00, c01); PG8_ST2(PG8_SA(0, 1), cA + hstepA, c10, c11);
    if (wr == 1) PG8_BAR;
    PG8_WAIT_V(2); PG8_BAR;
    PG8_STB(PG8_SB(1, 0), cB + kstep); PG8_ST2(PG8_SA(1, 0), cA + kstep, c00, c01); PG8_STB(PG8_SB(1, 1), cB + hstepB + kstep);
    PG8_WAIT_V(6); PG8_BAR;
    for (;;) {
        const bool has_next = S.next(ui + 1, nxt);
        const char* nA = has_next ? S.a_ptr(nxt) : cA; const char* nB = has_next ? S.b_ptr(nxt) : cB;
        unsigned s00 = c00, s01 = c01, s10 = c10, s11 = c11;
        for (int t = 0; t < nt; t += 2) {
            const bool last = (t == nt - 2);
            const char* a1 = cA + (size_t)(t + 1) * kstep;
            const char* a2 = last ? nA : cA + (size_t)(t + 2) * kstep; const char* b2 = last ? nB : cB + (size_t)(t + 2) * kstep;
            const char* a3 = a2 + kstep; const char* b3 = b2 + kstep;
            if constexpr (GATHER) { if (last && has_next) {
                int R0, C0, R1, C1; stage_rc(tid * 16, R0, C0); stage_rc(tid * 16 + 8192, R1, C1);
                s00 = (S.a_row(nxt, R0) * (unsigned)PA + (unsigned)C0) * 2u; s01 = (S.a_row(nxt, R1) * (unsigned)PA + (unsigned)C1) * 2u;
                s10 = (S.a_row(nxt, HALF + R0) * (unsigned)PA + (unsigned)C0) * 2u; s11 = (S.a_row(nxt, HALF + R1) * (unsigned)PA + (unsigned)C1) * 2u; } }
            if constexpr (Epi::MIDSCALE) { if (t == nt / 2) E.midscale(acc, cur, wr, fr); }
            PG8_LDB(B0, 0, 0); PG8_LDB(B1, 0, 1); PG8_SCHED; PG8_LDA(At, 0, 0); PG8_ST2(PG8_SA(1, 1), a1 + hstepA, c10, c11);
            PG8_WAIT_V(8); PG8_WAIT_L(0); PG8_BAR; PG8_MMA(0, 0, At, B0); PG8_MMA(0, 1, At, B1); PG8_BAR; PG8_SCHED;
            PG8_LDA(At, 0, 1); PG8_STB(PG8_SB(0, 0), b2); PG8_STB(PG8_SB(0, 1), b2 + hstepB); PG8_ST2(PG8_SA(0, 0), a2, s00, s01);
            PG8_WAIT_V(8); PG8_WAIT_L(0); PG8_BAR; PG8_MMA(1, 0, At, B0); PG8_MMA(1, 1, At, B1); PG8_BAR; PG8_SCHED;
            PG8_LDB(B0, 1, 0); PG8_LDB(B1, 1, 1); PG8_SCHED; PG8_LDA(At, 1, 0); PG8_ST2(PG8_SA(0, 1), a2 + hstepA, s10, s11);
            PG8_WAIT_V(8); PG8_WAIT_L(0); PG8_BAR; PG8_MMA(0, 0, At, B0); PG8_MMA(0, 1, At, B1); PG8_BAR; PG8_SCHED;
            PG8_LDA(At, 1, 1); PG8_STB(PG8_SB(1, 0), b3); PG8_STB(PG8_SB(1, 1), b3 + hstepB); PG8_ST2(PG8_SA(1, 0), a3, s00, s01);
            PG8_WAIT_V(8); PG8_WAIT_L(0); PG8_BAR; PG8_MMA(1, 0, At, B0); PG8_MMA(1, 1, At, B1); PG8_BAR; PG8_SCHED;
        }
        if constexpr (ALIGN_EPI) { if (wr == 0) PG8_BAR; }
        E(acc, cur, wr, wc, fr, fq);
        if (!has_next) break;
#pragma unroll
        for (int a = 0; a < 2; ++a)
#pragma unroll
            for (int b = 0; b < 2; ++b)
#pragma unroll
                for (int m = 0; m < 4; ++m)
#pragma unroll
                    for (int n = 0; n < 2; ++n) acc[a][b][m][n] = (f32x4){0.f, 0.f, 0.f, 0.f};
        cur = nxt; cA = nA; cB = nB; ++ui;
        if constexpr (GATHER) { c00 = s00; c01 = s01; c10 = s10; c11 = s11; }
        if constexpr (ALIGN_EPI) { if (wr == 1) PG8_BAR; }
    }
    PG8_WAIT_V(0);
    if constexpr (!ALIGN_EPI) { if (wr == 0) PG8_BAR; }
    PG8_BAR;
#undef PG8_SA
#undef PG8_SB
#undef PG8_ST2
#undef PG8_STB
#undef PG8_LDA
#undef PG8_LDB
#undef PG8_MMA
}

struct EpiScaleBf16 {
    static constexpr bool PERM = true, MIDSCALE = false;
    bf16_t* O; const float* rs; int ldc; int pad;
    __device__ __forceinline__ void midscale(f32x4 (&)[2][2][4][2], const Unit&, int, int) const {}
    __device__ __forceinline__ void operator()(const f32x4 (&acc)[2][2][4][2], const Unit& u, int wr, int wc, int fr, int fq) const {
        const int row0 = u.pm * BM + wr * 64 + fr, col0 = u.pn * BM + wc * 32 + 8 * fq;
#pragma unroll
        for (int ai = 0; ai < 2; ++ai)
#pragma unroll
            for (int m = 0; m < 4; ++m) { const int row = row0 + ai * HALF + m * 16; const float s = rs ? rs[row] : 1.f; bf16_t* rowp = O + (size_t)row * ldc + col0;
#pragma unroll
                for (int bj = 0; bj < 2; ++bj) { const f32x4 v0 = acc[ai][bj][m][0] * s, v1 = acc[ai][bj][m][1] * s;
                    u32x4 w; w.x = pk2(v0[0], v0[1]); w.y = pk2(v0[2], v0[3]); w.z = pk2(v1[0], v1[1]); w.w = pk2(v1[2], v1[3]);
                    *(u32x4*)(rowp + bj * HALF) = w; } }
    }
};
}

#define XB_TMO      128
#define XB_XCNT(j)  (256  + 64 * (j))
#define XB_XSUB(j)  (1280 + 64 * (j))
#define XB_XGEN(j)  (2304 + 64 * (j))
#define XB_TOP      3328
#define XB_TOPGEN   3392
#define XCD_BAR_WORDS 3456
#define XB_SPIN_CAP (1u << 18)
__device__ __forceinline__ unsigned xb_ld(unsigned* p)              { return __hip_atomic_load(p, __ATOMIC_RELAXED, __HIP_MEMORY_SCOPE_AGENT); }
__device__ __forceinline__ unsigned xb_add(unsigned* p, unsigned v) { return __hip_atomic_fetch_add(p, v, __ATOMIC_RELAXED, __HIP_MEMORY_SCOPE_AGENT); }
__device__ __forceinline__ unsigned xb_xcc_id() { return (unsigned)__builtin_amdgcn_s_getreg((3 << 11) | 20) & 0xFu; }
#define XB_SPIN(cond, bar) do { unsigned _sp = 0; while (cond) { __builtin_amdgcn_s_sleep(1); \
    if ((++_sp & 255u) == 0u) { if (xb_ld(&(bar)[XB_TMO])) break; if (_sp > XB_SPIN_CAP) { atomicAdd(&(bar)[XB_TMO], 1u); break; } } } } while (0)
struct XcdBarrier { unsigned* bar; unsigned x; volatile LAS unsigned* st; };
__device__ __forceinline__ XcdBarrier xcd_barrier_post(unsigned* bar, volatile LAS unsigned* st) {
    XcdBarrier b; b.bar = bar; b.x = xb_xcc_id(); b.st = st;
    if (threadIdx.x == 0) (void)xb_add(&bar[XB_XCNT(b.x)], 1u);
    return b;
}
__device__ __forceinline__ void xcd_barrier_complete(unsigned* bar, unsigned x, unsigned& nloc, unsigned& nx) {
    const unsigned G = gridDim.x * gridDim.y * gridDim.z;
    unsigned sum, cnt, mine, sp = 0u;
    for (;;) {
        sum = 0u; cnt = 0u; mine = 0u;
#pragma unroll
        for (unsigned j = 0; j < 16; ++j) { const unsigned c = xb_ld(&bar[XB_XCNT(j)]); sum += c; cnt += (c > 0u) ? 1u : 0u; mine = (j == x) ? c : mine; }
        if (sum == G) break;
        __builtin_amdgcn_s_sleep(1);
        if ((++sp & 255u) == 0u) { if (xb_ld(&bar[XB_TMO])) break; if (sp > XB_SPIN_CAP) { atomicAdd(&bar[XB_TMO], 1u); break; } }
    }
    nloc = mine > 0u ? mine : 1u; nx = cnt > 0u ? cnt : 1u;
}
__device__ __forceinline__ void xcd_barrier(const XcdBarrier& b) {
    asm volatile("s_waitcnt vmcnt(0)" ::: "memory");
    __syncthreads();
    if (threadIdx.x == 0) {
        unsigned* bar = b.bar;
        __builtin_amdgcn_s_waitcnt(0);
        unsigned nloc = b.st[0], nx = b.st[1];
        if (nloc == 0u) { xcd_barrier_complete(bar, b.x, nloc, nx); b.st[0] = nloc; b.st[1] = nx; }
        const unsigned old = xb_add(&bar[XB_XSUB(b.x)], 1u);
        const unsigned gen = old / nloc;
        if (old + 1u == (gen + 1u) * nloc) {
            __builtin_amdgcn_fence(__ATOMIC_RELEASE, "agent");
            asm volatile("s_waitcnt vmcnt(0)" ::: "memory");
            const unsigned og = xb_add(&bar[XB_TOP], 1u);
            const unsigned tg = og / nx;
            if (og + 1u == (tg + 1u) * nx) xb_add(&bar[XB_TOPGEN], 1u);
            else XB_SPIN(xb_ld(&bar[XB_TOPGEN]) == tg, bar);
            __builtin_amdgcn_fence(__ATOMIC_ACQUIRE, "agent");
            xb_add(&bar[XB_XGEN(b.x)], 1u);
            asm volatile("s_waitcnt vmcnt(0)" ::: "memory");
        } else {
            XB_SPIN(xb_ld(&bar[XB_XGEN(b.x)]) == gen, bar);
            __builtin_amdgcn_fence(__ATOMIC_ACQUIRE, "agent");
            asm volatile("s_waitcnt vmcnt(0)" ::: "memory");
        }
    }
    __syncthreads();
}


constexpr size_t MiB = 1u << 20;
constexpr size_t WS_CTL = 0, CTL_ZERO_BYTES = 64 * 1024;
constexpr int CW_BAR = 1024;
constexpr int CW_CNT = 8192;
constexpr int CW_PANA = 9216, CW_PANB = 11264;

__device__ __forceinline__ void p0_transpose_item(const float* W, int K, int N, const float* ks, bf16_t* WT, int rbase, int gshift, int gstride, LAS float* scr, int item, int lane) {
    const int nblk = N / 32, kb = item / nblk, nb = item % nblk, k0 = 64 * kb, n0 = 32 * nb;
#pragma unroll 8
    for (int i = 0; i < 32; ++i) { const int kk = 2 * i + (lane >> 5); const float s = ks ? ks[k0 + kk] : 1.f; scr[kk * 33 + (lane & 31)] = W[(size_t)(k0 + kk) * N + n0 + (lane & 31)] * s; }
    asm volatile("s_waitcnt lgkmcnt(0)" ::: "memory");
    const int c = lane & 7;
#pragma unroll
    for (int j = 0; j < 4; ++j) { const int nl = (lane >> 3) + 8 * j, n = n0 + nl; const LAS float* s = scr + (8 * c) * 33 + nl;
        const int row = rbase + (n >> gshift) * gstride + (n & ((1 << gshift) - 1));
        u32x4 o; o.x = pk2(s[0 * 33], s[1 * 33]); o.y = pk2(s[2 * 33], s[3 * 33]); o.z = pk2(s[4 * 33], s[5 * 33]); o.w = pk2(s[6 * 33], s[7 * 33]);
        *(u32x4*)(WT + (size_t)row * K + k0 + 8 * c) = o; }
    asm volatile("s_waitcnt lgkmcnt(0)" ::: "memory");
}

constexpr size_t MB_ = 1u << 20, KB_ = 1024;
namespace wsm {
constexpr size_t ctl = 0, r0 = 64 * KB_, rL = 128 * KB_, r2 = 192 * KB_, rP = 256 * KB_, tokE = 320 * KB_, tokPos = 448 * KB_,
    rope = 1 * MB_, wtot = 5 * MB_, ctot = 6 * MB_, ssq1p = 7 * MB_, ssq3p = 8 * MB_, lt = 9 * MB_, lw = 11 * MB_, lr = 13 * MB_, wr_t = 15 * MB_, wag_t = 15 * MB_ + 512 * KB_,
    w_in_t = 16 * MB_, w_out_t = 20 * MB_, wgu_t = 22 * MB_, projb = 86 * MB_, x1b = 110 * MB_,
    wd_t = 142 * MB_, w_pg_t = 174 * MB_, w_pp_t = 176 * MB_,
    xb = 177 * MB_, x2b = 177 * MB_, pb = 209 * MB_, mix = 209 * MB_, hid = 209 * MB_, x3b = 110 * MB_, pp = 249 * MB_, y = 16 * MB_, END = 281 * MB_;
}
struct Args {
    const float* in[28]; float* out; unsigned char* ws;
    int ph_lo, ph_hi, mode, pad;
};
typedef const __attribute__((address_space(4))) Args* KArgsP;
__device__ __forceinline__ KArgsP kargs() { KArgsP p = (KArgsP)__builtin_amdgcn_kernarg_segment_ptr(); asm volatile("" : "+s"(p)); return p; }
struct Frame {
    LAS unsigned char* lds; volatile LAS unsigned* MISC; gu32* ctl;
    int tid, lane, wave, vcu, G;
};
__device__ __forceinline__ float fexp2(float x) { return __builtin_amdgcn_exp2f(x); }
__device__ __forceinline__ float fexp(float x) { return __builtin_amdgcn_exp2f(x * 1.4426950408889634f); }
__device__ __forceinline__ float frcp(float x) { return __builtin_amdgcn_rcpf(x); }
__device__ __forceinline__ float fsigmoid(float x) { return frcp(1.f + fexp(-x)); }
__device__ __forceinline__ float fgelu_tanh(float x) {
    const float u = 0.7978845608028654f * (x + 0.044715f * x * x * x);
    return x * (1.f - frcp(1.f + fexp(2.f * u)));
}

__device__ __forceinline__ void p0_tr64(const float* W, int K, int N, const float* ks, bf16_t* WT, int rbase, int gshift, int gstride, LAS unsigned* t2, int item, int lane) {
    const int nblk = N / 64, kb = item / nblk, nb = item % nblk, k0 = 64 * kb, n0 = 64 * nb;
    const int n4 = lane & 15, kr = lane >> 4;
    f32x4 va[8], vb[8];
#pragma unroll
    for (int i = 0; i < 8; ++i) { const int k = k0 + 8 * i + 2 * kr; va[i] = *(const f32x4*)(W + (size_t)k * N + n0 + 4 * n4); vb[i] = *(const f32x4*)(W + (size_t)(k + 1) * N + n0 + 4 * n4); }
#pragma unroll
    for (int i = 0; i < 8; ++i) { const int k = k0 + 8 * i + 2 * kr, kp = 4 * i + kr; const float s0 = ks ? ks[k] : 1.f, s1 = ks ? ks[k + 1] : 1.f;
        LAS unsigned* d = t2 + (4 * n4) * 33 + kp;
        d[0] = pk2(va[i].x * s0, vb[i].x * s1); d[33] = pk2(va[i].y * s0, vb[i].y * s1); d[66] = pk2(va[i].z * s0, vb[i].z * s1); d[99] = pk2(va[i].w * s0, vb[i].w * s1); }
    asm volatile("s_waitcnt lgkmcnt(0)" ::: "memory");
    const int nl = lane >> 3, c = lane & 7;
#pragma unroll
    for (int j = 0; j < 8; ++j) { const int n = 8 * j + nl; const LAS unsigned* s = t2 + n * 33 + 4 * c; const int ng = n0 + n;
        const int row = rbase + (ng >> gshift) * gstride + (ng & ((1 << gshift) - 1));
        *(u32x4*)(WT + (size_t)row * K + k0 + 8 * c) = (u32x4){s[0], s[1], s[2], s[3]}; }
    asm volatile("s_waitcnt lgkmcnt(0)" ::: "memory");
}

__device__ __forceinline__ void p0_experts(const Frame& F, KArgsP a, int w, int nw, int part) {
    LAS unsigned* t2 = (LAS unsigned*)(F.lds + F.wave * 8704); unsigned char* ws = a->ws; const int lane = F.lane;
    const float* g_ffn = a->in[16]; const float* w_eg = a->in[21]; const float* w_eu = a->in[22]; const float* w_ed = a->in[23];
    constexpr int I_G = (D / 64) * (FF / 64), I_D = (FF / 64) * (D / 64);
    if (part & 1) for (int r = w; r < NE * 2 * I_G; r += nw) { const int e = r / (2 * I_G), q = r % (2 * I_G), up = q / I_G, item = q % I_G;
        p0_tr64((up ? w_eu : w_eg) + (size_t)e * D * FF, D, FF, g_ffn, (bf16_t*)(ws + wsm::wgu_t) + (size_t)e * 1024 * D, 128 * up, 7, 256, t2, item, lane); }
    if (part & 2) for (int r = w; r < NE * I_D; r += nw) { const int e = r / I_D, item = r % I_D;
        p0_tr64(w_ed + (size_t)e * FF * D, FF, D, nullptr, (bf16_t*)(ws + wsm::wd_t) + (size_t)e * D * FF, 0, 30, 0, t2, item, lane); }
}
__device__ __forceinline__ void p0_prologue(const Frame& F, KArgsP a) {
    LAS unsigned* t2 = (LAS unsigned*)(F.lds + F.wave * 8704);
    const int gw = F.vcu * NWAVES + F.wave, NGW = F.G * NWAVES, lane = F.lane;
    unsigned char* ws = a->ws;
    const float* w_in = a->in[4]; const float* g_mix = a->in[3]; const float* w_out = a->in[15]; const float* g_attn = a->in[13]; const float* g_lru = a->in[14];
    const float* g_ffn = a->in[16];
    const float* g_ple = a->in[24]; const float* w_pg = a->in[25]; const float* w_pp = a->in[26];
    constexpr int I_IN = (D / 64) * (NPROJ / 64), I_OUT = (D / 64) * (D / 64), I_PG = I_OUT, I_PP = (PLE / 64) * (D / 64);
    constexpr int NITEMS = I_IN + I_OUT + I_PG + I_PP;
    for (int it = gw; it < NITEMS; it += NGW) {
        int r = it;
        if (r < I_IN) { p0_tr64(w_in, D, NPROJ, g_mix, (bf16_t*)(ws + wsm::w_in_t), 0, 30, 0, t2, r, lane); continue; } r -= I_IN;
        if (r < I_PP) { p0_tr64(w_pp, PLE, D, nullptr, (bf16_t*)(ws + wsm::w_pp_t), 0, 30, 0, t2, r, lane); continue; } r -= I_PP;
        if (r < I_OUT) { const int kb = r / (D / 64); const float* ks = kb < 8 ? g_attn : g_lru - 512; p0_tr64(w_out, D, D, ks, (bf16_t*)(ws + wsm::w_out_t), 0, 30, 0, t2, r, lane); continue; } r -= I_OUT;
        p0_tr64(w_pg, D, D, g_ple, (bf16_t*)(ws + wsm::w_pg_t), 0, 30, 0, t2, r, lane);
    }
    if (F.G < 256) p0_experts(F, a, gw, NGW, 3);
    const float* x = a->in[0]; bf16_t* xb = (bf16_t*)(ws + wsm::xb); float* r0 = (float*)(ws + wsm::r0);
    for (int m = gw; m < T; m += 2 * NGW) {
        const int m2 = m + NGW;
        const f32x4* xr = (const f32x4*)(x + (size_t)m * D) + lane; const f32x4* xr2 = (const f32x4*)(x + (size_t)(m2 < T ? m2 : m) * D) + lane; f32x4 v[4], v2[4]; float s = 0.f, s2 = 0.f;
#pragma unroll
        for (int j = 0; j < 4; ++j) { v[j] = xr[64 * j]; v2[j] = xr2[64 * j]; }
#pragma unroll
        for (int j = 0; j < 4; ++j) { s += (v[j].x * v[j].x + v[j].y * v[j].y) + (v[j].z * v[j].z + v[j].w * v[j].w); s2 += (v2[j].x * v2[j].x + v2[j].y * v2[j].y) + (v2[j].z * v2[j].z + v2[j].w * v2[j].w); }
        s = wsum(s); s2 = wsum(s2);
        u32x2* o8 = (u32x2*)(xb + (size_t)m * D) + lane;
#pragma unroll
        for (int j = 0; j < 4; ++j) { u32x2 w; w.x = pk2(v[j].x, v[j].y); w.y = pk2(v[j].z, v[j].w); o8[64 * j] = w; }
        if (lane == 0) r0[m] = rsqrtf(s * (1.f / D) + EPS);
        if (m2 < T) { u32x2* o9 = (u32x2*)(xb + (size_t)m2 * D) + lane;
#pragma unroll
            for (int j = 0; j < 4; ++j) { u32x2 w; w.x = pk2(v2[j].x, v2[j].y); w.y = pk2(v2[j].z, v2[j].w); o9[64 * j] = w; }
            if (lane == 0) r0[m2] = rsqrtf(s2 * (1.f / D) + EPS); }
    }
    const float* p = a->in[1]; bf16_t* pb = (bf16_t*)(ws + wsm::pb);
    for (int m = gw; m < T; m += NGW) { const f32x4 v = ((const f32x4*)(p + (size_t)m * PLE))[lane]; u32x2 w; w.x = pk2(v.x, v.y); w.y = pk2(v.z, v.w); ((u32x2*)(pb + (size_t)m * PLE))[lane] = w; }
    const int* pos = (const int*)a->in[2]; f32x2* rope = (f32x2*)(ws + wsm::rope);
    for (int idx = (F.vcu * NTHR + F.tid); idx < T * 32; idx += F.G * NTHR) { const int t = idx >> 5, i = idx & 31;
        const float inv_freq = powf(10000.f, -(float)(2 * i) / 64.f); const float ang = (float)pos[t] * inv_freq; float sn, cs; sincosf(ang, &sn, &cs); rope[idx] = (f32x2){cs, sn}; }
    { const float* wa = a->in[8]; const float* wx = a->in[10]; bf16_t* wag_t = (bf16_t*)(ws + wsm::wag_t);
      for (int idx = (F.vcu * NTHR + F.tid); idx < 8 * 2 * 64 * 64; idx += F.G * NTHR) { const int i = idx & 63, j = (idx >> 6) & 63, gt = (idx >> 12) & 1, hb = idx >> 13;
          const float v = (gt ? wx : wa)[(size_t)(hb * 64 + i) * 64 + j]; wag_t[idx] = (bf16_t)(pk2(v, 0.f) & 0xffffu); } }
    const float* w_rg = a->in[17]; const float* w_re = a->in[19]; bf16_t* wr_t = (bf16_t*)(ws + wsm::wr_t);
    for (int idx = (F.vcu * NTHR + F.tid); idx < 48 * D; idx += F.G * NTHR) { const int j = idx >> 10, k = idx & 1023;
        float v = 0.f; if (j < 4) v = w_rg[k * 4 + j] * g_ffn[k]; else if (j < 36) v = w_re[k * 32 + (j - 4)] * g_ffn[k];
        wr_t[idx] = (bf16_t)(pk2(v, 0.f) & 0xffffu); }
}

constexpr int LB = 512;
constexpr int LRU_XS = 0, LRU_XS_PITCH = 144;
constexpr int LRU_WTL = LRU_XS + LB * LRU_XS_PITCH;
static_assert(LRU_WTL + 4096 <= RING_BYTES, "lru lds");

__device__ __forceinline__ void lruA_unit(const Frame& F, KArgsP a, int b, int hb, int chunk) {
    LAS unsigned char* lds = F.lds; const int tid = F.tid, lane = F.lane, wave = F.wave;
    unsigned char* ws = a->ws;
    const bf16_t* projb = (const bf16_t*)(ws + wsm::projb); bf16_t* hl = (bf16_t*)a->out; bf16_t* pl = hl + (size_t)T * 512;
    float* wtot = (float*)(ws + wsm::wtot); float* ctot = (float*)(ws + wsm::ctot); const bf16_t* wag_t = (const bf16_t*)(ws + wsm::wag_t);
    const float* cw = a->in[6]; const float* cb = a->in[7]; const float* ba = a->in[9]; const float* bx = a->in[11]; const float* lam = a->in[12];
    const int s0 = chunk * LB; const size_t t0 = (size_t)b * SEQ + s0;
    { const int q8 = tid & 7, cch = hb * 64 + q8 * 8;
      float cwr[4][8], cbr[8];
#pragma unroll
      for (int j = 0; j < 4; ++j)
#pragma unroll
          for (int e = 0; e < 8; ++e) cwr[j][e] = cw[j * 512 + cch + e];
#pragma unroll
      for (int e = 0; e < 8; ++e) cbr[e] = cb[cch + e];
#pragma unroll 2
      for (int i = 0; i < 8; ++i) {
          const int tt = (tid >> 3) + 64 * i; float xv[8];
#pragma unroll
          for (int e = 0; e < 8; ++e) xv[e] = cbr[e];
#pragma unroll
          for (int j = 0; j < 4; ++j) { const int sj = s0 + tt - 3 + j;
              if (sj >= 0) { const u32x4 w = *(const u32x4*)(projb + ((size_t)b * SEQ + sj) * NPROJ + OFF_LX + cch);
                  xv[0] += cwr[j][0] * bflo(w.x); xv[1] += cwr[j][1] * bfhi(w.x); xv[2] += cwr[j][2] * bflo(w.y); xv[3] += cwr[j][3] * bfhi(w.y);
                  xv[4] += cwr[j][4] * bflo(w.z); xv[5] += cwr[j][5] * bfhi(w.z); xv[6] += cwr[j][6] * bflo(w.w); xv[7] += cwr[j][7] * bfhi(w.w); } }
          u32x4 o; o.x = pk2(xv[0], xv[1]); o.y = pk2(xv[2], xv[3]); o.z = pk2(xv[4], xv[5]); o.w = pk2(xv[6], xv[7]);
          *(LAS u32x4*)(lds + LRU_XS + tt * LRU_XS_PITCH + q8 * 16) = o;
      } }
    __syncthreads();
    const int cl = lane & 15, kq = lane >> 4, tb0 = 64 * wave;
    bf16x8 af[4][2];
#pragma unroll
    for (int mt = 0; mt < 4; ++mt)
#pragma unroll
        for (int ks = 0; ks < 2; ++ks) af[mt][ks] = *(const LAS bf16x8*)(lds + LRU_XS + (tb0 + 16 * mt + cl) * LRU_XS_PITCH + (32 * ks + 8 * kq) * 2);
    LAS float* wtl = (LAS float*)(lds + LRU_WTL);
#pragma unroll 1
    for (int nt = 0; nt < 4; ++nt) {
        const int c = hb * 64 + nt * 16 + cl;
        bf16x8 wfa[2], wfx[2];
#pragma unroll
        for (int ks = 0; ks < 2; ++ks) { const bf16_t* s = wag_t + ((size_t)(hb * 2) * 64 + nt * 16 + cl) * 64 + 32 * ks + 8 * kq; wfa[ks] = *(const bf16x8*)s; wfx[ks] = *(const bf16x8*)(s + 64 * 64); }
        const float bac = ba[c], bxc = bx[c];
        const float spc = log1pf(expf(-lam[c])) * (-8.f * 1.4426950408889634f);
        float av[4][4], bv[4][4], Aex[4], Hex[4], At[4], Ht[4];
#pragma unroll
        for (int mt = 0; mt < 4; ++mt) {
            f32x4 ga = {0.f, 0.f, 0.f, 0.f}, gx = {0.f, 0.f, 0.f, 0.f};
#pragma unroll
            for (int ks = 0; ks < 2; ++ks) { ga = __builtin_amdgcn_mfma_f32_16x16x32_bf16(af[mt][ks], wfa[ks], ga, 0, 0, 0); gx = __builtin_amdgcn_mfma_f32_16x16x32_bf16(af[mt][ks], wfx[ks], gx, 0, 0, 0); }
            float A4 = 1.f, H4 = 0.f;
#pragma unroll
            for (int r = 0; r < 4; ++r) { const int tt = tb0 + 16 * mt + 4 * kq + r;
                const float xc = bf2f(*(const LAS unsigned short*)(lds + LRU_XS + tt * LRU_XS_PITCH + (16 * nt + cl) * 2));
                const float rg = fsigmoid(ga[r] + bac), ig = fsigmoid(gx[r] + bxc);
                const float aa = fexp2(rg * spc), mult = sqrtf(fmaxf(1.f - aa * aa, 0.f));
                const float bb = mult * ig * xc;
                av[mt][r] = aa; bv[mt][r] = bb; H4 = aa * H4 + bb; A4 *= aa; }
            { float Ap = __shfl_up(A4, 16), Hp = __shfl_up(H4, 16); if (kq >= 1) { H4 = A4 * Hp + H4; A4 = Ap * A4; }
              Ap = __shfl_up(A4, 32); Hp = __shfl_up(H4, 32); if (kq >= 2) { H4 = A4 * Hp + H4; A4 = Ap * A4; } }
            { const float Ae = __shfl_up(A4, 16), He = __shfl_up(H4, 16); Aex[mt] = kq >= 1 ? Ae : 1.f; Hex[mt] = kq >= 1 ? He : 0.f; }
            At[mt] = __shfl(A4, 48 + cl); Ht[mt] = __shfl(H4, 48 + cl);
        }
        float hin = 0.f, pin = 1.f;
#pragma unroll
        for (int mt = 0; mt < 4; ++mt) {
            float h = Aex[mt] * hin + Hex[mt], pr = Aex[mt] * pin;
#pragma unroll
            for (int r = 0; r < 4; ++r) { h = av[mt][r] * h + bv[mt][r]; pr *= av[mt][r];
                const size_t o = (t0 + tb0 + 16 * mt + 4 * kq + r) * 512 + c;
                hl[o] = (bf16_t)(pk2(h, 0.f) & 0xffffu); pl[o] = (bf16_t)(pk2(pr, 0.f) & 0xffffu); }
            hin = At[mt] * hin + Ht[mt]; pin = At[mt] * pin;
        }
        if (kq == 0) { float* d = wtot + ((size_t)(b * 64 + chunk * 8 + wave) * 2) * 512 + c; d[0] = pin; d[512] = hin; wtl[(wave * 2) * 64 + nt * 16 + cl] = pin; wtl[(wave * 2 + 1) * 64 + nt * 16 + cl] = hin; }
    }
    __syncthreads();
    if (tid < 64) { float A = 1.f, H = 0.f;
#pragma unroll
        for (int w2 = 0; w2 < 8; ++w2) { const float a2 = wtl[(w2 * 2) * 64 + tid], h2 = wtl[(w2 * 2 + 1) * 64 + tid]; H = a2 * H + h2; A *= a2; }
        float* d = ctot + ((size_t)(b * 8 + chunk) * 2) * 512 + hb * 64 + tid; d[0] = A; d[512] = H; }
    __syncthreads();
}

__device__ __forceinline__ void lru_finish(const Frame& F, KArgsP a, int b, int wc) {
    LAS float* cl_ = (LAS float*)F.lds; const int tid = F.tid, lane = F.lane, wave = F.wave;
    unsigned char* ws = a->ws;
    const bf16_t* projb = (const bf16_t*)(ws + wsm::projb); const bf16_t* hl = (const bf16_t*)a->out; const bf16_t* pl = hl + (size_t)T * 512; bf16_t* mix = (bf16_t*)(ws + wsm::mix);
    const float* wtot = (const float*)(ws + wsm::wtot); const float* ctot = (const float*)(ws + wsm::ctot);
    { const int c = wc >> 3, sub = wc & 7; float h = 0.f;
      for (int c2 = 0; c2 < c; ++c2) { const float* s = ctot + ((size_t)(b * 8 + c2) * 2) * 512 + tid; h = s[0] * h + s[512]; }
      for (int w2 = 0; w2 < sub; ++w2) { const float* s = wtot + ((size_t)(b * 64 + c * 8 + w2) * 2) * 512 + tid; h = s[0] * h + s[512]; }
      cl_[tid] = h; }
    __syncthreads();
    float cr[8];
#pragma unroll
    for (int e = 0; e < 8; ++e) cr[e] = cl_[8 * lane + e];
#pragma unroll 2
    for (int i = 0; i < 8; ++i) {
        const size_t t = (size_t)b * SEQ + 64 * wc + 8 * wave + i;
        const u32x4 hw = *(const u32x4*)(hl + t * 512 + 8 * lane), pw = *(const u32x4*)(pl + t * 512 + 8 * lane), gw4 = *(const u32x4*)(projb + t * NPROJ + OFF_LG + 8 * lane);
        const float hv[8] = {bflo(hw.x), bfhi(hw.x), bflo(hw.y), bfhi(hw.y), bflo(hw.z), bfhi(hw.z), bflo(hw.w), bfhi(hw.w)};
        const float pv[8] = {bflo(pw.x), bfhi(pw.x), bflo(pw.y), bfhi(pw.y), bflo(pw.z), bfhi(pw.z), bflo(pw.w), bfhi(pw.w)};
        const float lg[8] = {bflo(gw4.x), bfhi(gw4.x), bflo(gw4.y), bfhi(gw4.y), bflo(gw4.z), bfhi(gw4.z), bflo(gw4.w), bfhi(gw4.w)};
        float g[8]; float s = 0.f;
#pragma unroll
        for (int e = 0; e < 8; ++e) { g[e] = (hv[e] + pv[e] * cr[e]) * fgelu_tanh(lg[e]); s += g[e] * g[e]; }
        s = wsum(s);
        const float rr = rsqrtf(s * (1.f / 512.f) + EPS);
        *(u32x4*)(mix + t * D + 512 + 8 * lane) = (u32x4){pk2(g[0] * rr, g[1] * rr), pk2(g[2] * rr, g[3] * rr), pk2(g[4] * rr, g[5] * rr), pk2(g[6] * rr, g[7] * rr)};
    }
    __syncthreads();
}

typedef float f32x16 __attribute__((ext_vector_type(16)));
typedef short s16x4 __attribute__((ext_vector_type(4)));
constexpr int AT_KP = 144;
constexpr int AT_NK = 160;
constexpr int AT_K = 0, AT_V = 2 * AT_NK * AT_KP;
constexpr int AT_LINV = XTRA_OFF + 256;
static_assert(2 * AT_V <= RING_BYTES && AT_LINV + 2048 <= LDS_BYTES, "attn lds");
__device__ __forceinline__ int crow(int reg, int h) { return (reg & 3) + 8 * (reg >> 2) + 4 * h; }
typedef LAS s16x4* lds_s16x4_p;
__device__ __forceinline__ s16x4 tr_rd(unsigned addr) { return __builtin_amdgcn_ds_read_tr16_b64_v4i16((lds_s16x4_p)(size_t)addr); }

template <int QB>
__device__ __forceinline__ void attn_qblock(const bf16_t* projb, const f32x2* rope, size_t tq0, int h, unsigned kbase, unsigned vbase, float sink2, int kmin, int r, int hh, LAS float* linv, f32x16& o0, f32x16& o1) {
    const size_t tq = tq0 + 32 * QB + r;
    bf16x8 qf[4];
    { const bf16_t* src = projb + tq * NPROJ + h * 64 + 8 * hh; const f32x2* cs = rope + tq * 32 + 8 * hh;
      const float qs = 0.125f * 1.4426950408889634f;
#pragma unroll
      for (int kp = 0; kp < 2; ++kp) {
          const u32x4 w1 = *(const u32x4*)(src + 16 * kp), w2 = *(const u32x4*)(src + 16 * (kp + 2));
          float x1[8] = {bflo(w1.x), bfhi(w1.x), bflo(w1.y), bfhi(w1.y), bflo(w1.z), bfhi(w1.z), bflo(w1.w), bfhi(w1.w)};
          float x2[8] = {bflo(w2.x), bfhi(w2.x), bflo(w2.y), bfhi(w2.y), bflo(w2.z), bfhi(w2.z), bflo(w2.w), bfhi(w2.w)};
          float y1[8], y2[8];
#pragma unroll
          for (int e = 0; e < 8; ++e) { const f32x2 c2 = cs[16 * kp + e]; y1[e] = (x1[e] * c2.x - x2[e] * c2.y) * qs; y2[e] = (x2[e] * c2.x + x1[e] * c2.y) * qs; }
          qf[kp] = __builtin_bit_cast(bf16x8, (u32x4){pk2(y1[0], y1[1]), pk2(y1[2], y1[3]), pk2(y1[4], y1[5]), pk2(y1[6], y1[7])});
          qf[kp + 2] = __builtin_bit_cast(bf16x8, (u32x4){pk2(y2[0], y2[1]), pk2(y2[2], y2[3]), pk2(y2[4], y2[5]), pk2(y2[6], y2[7])});
      } }
    f32x16 S[5];
#pragma unroll
    for (int ti = 0; ti < 5; ++ti) {
        const float pen = (32 * (QB + ti) < kmin) ? -1e30f : 0.f;
        f32x16 acc;
#pragma unroll
        for (int i = 0; i < 16; ++i) acc[i] = pen;
#pragma unroll
        for (int ks = 0; ks < 4; ++ks) { const bf16x8 kf = *(const LAS bf16x8*)(size_t)(kbase + (unsigned)(32 * (QB + ti) * AT_KP + 32 * ks));
            acc = __builtin_amdgcn_mfma_f32_32x32x16_bf16(kf, qf[ks], acc, 0, 0, 0); }
        S[ti] = acc;
    }
    const int c4 = 4 * hh;
#pragma unroll
    for (int i = 0; i < 16; ++i) { const bool up = ((i & 3) + 8 * (i >> 2) + c4) > r; S[0][i] = up ? S[0][i] : -1e30f; S[4][i] = up ? -1e30f : S[4][i]; }
    float mx = sink2;
#pragma unroll
    for (int ti = 0; ti < 5; ++ti)
#pragma unroll
        for (int i = 0; i < 16; ++i) mx = fmaxf(mx, S[ti][i]);
    mx = fmaxf(mx, __shfl_xor(mx, 32));
    float l = 0.f; unsigned P[5][8];
#pragma unroll
    for (int ti = 0; ti < 5; ++ti)
#pragma unroll
        for (int i = 0; i < 16; i += 2) { const float p0 = fexp2(S[ti][i] - mx), p1 = fexp2(S[ti][i + 1] - mx); l += p0 + p1; P[ti][i >> 1] = pk2(p0, p1); }
    l += __shfl_xor(l, 32);
    l += fexp2(sink2 - mx);
    if (hh == 0) linv[(32 * QB + r) * 8 + h] = frcp(l);
#pragma unroll
    for (int i = 0; i < 16; ++i) { o0[i] = 0.f; o1[i] = 0.f; }
#pragma unroll
    for (int ti = 0; ti < 5; ++ti) {
#pragma unroll
        for (int s = 0; s < 2; ++s) {
            const bf16x8 pa = __builtin_bit_cast(bf16x8, (u32x4){P[ti][4 * s], P[ti][4 * s + 1], P[ti][4 * s + 2], P[ti][4 * s + 3]});
            const unsigned va = vbase + (unsigned)((32 * (QB + ti) + 16 * s) * AT_KP);
            const s16x4 lo0 = tr_rd(va), hi0 = tr_rd(va + 8 * AT_KP), lo1 = tr_rd(va + 64), hi1 = tr_rd(va + 8 * AT_KP + 64);
            const bf16x8 vb0 = __builtin_shufflevector(lo0, hi0, 0, 1, 2, 3, 4, 5, 6, 7), vb1 = __builtin_shufflevector(lo1, hi1, 0, 1, 2, 3, 4, 5, 6, 7);
            o0 = __builtin_amdgcn_mfma_f32_32x32x16_bf16(pa, vb0, o0, 0, 0, 0);
            o1 = __builtin_amdgcn_mfma_f32_32x32x16_bf16(pa, vb1, o1, 0, 0, 0);
        }
    }
}

__device__ __forceinline__ void attn_unit(const Frame& F, KArgsP a, int b, int j) {
    LAS unsigned char* lds = F.lds; const int tid = F.tid, lane = F.lane, wave = F.wave;
    unsigned char* ws = a->ws;
    const bf16_t* projb = (const bf16_t*)(ws + wsm::projb); bf16_t* mix = (bf16_t*)(ws + wsm::mix); const f32x2* rope = (const f32x2*)(ws + wsm::rope);
    const float* sinks = a->in[5];
    const int key0 = 32 * j - 128;
#pragma unroll 1
    for (int task = tid; task < AT_NK * 2 * 4; task += NTHR) {
        const int c = task & 3, g = (task >> 2) & 1, kk = task >> 3; const int sp = key0 + kk;
        u32x4 o1 = {0u, 0u, 0u, 0u}, o2 = {0u, 0u, 0u, 0u};
        if (sp >= 0) { const size_t t = (size_t)b * SEQ + sp; const bf16_t* src = projb + t * NPROJ + OFF_K + g * 64 + 8 * c;
            const u32x4 w1 = *(const u32x4*)src, w2 = *(const u32x4*)(src + 32); const f32x2* cs = rope + t * 32 + 8 * c;
            float x1[8] = {bflo(w1.x), bfhi(w1.x), bflo(w1.y), bfhi(w1.y), bflo(w1.z), bfhi(w1.z), bflo(w1.w), bfhi(w1.w)};
            float x2[8] = {bflo(w2.x), bfhi(w2.x), bflo(w2.y), bfhi(w2.y), bflo(w2.z), bfhi(w2.z), bflo(w2.w), bfhi(w2.w)};
            float y1[8], y2[8];
#pragma unroll
            for (int e = 0; e < 8; ++e) { const f32x2 c2 = cs[e]; y1[e] = x1[e] * c2.x - x2[e] * c2.y; y2[e] = x2[e] * c2.x + x1[e] * c2.y; }
            o1 = (u32x4){pk2(y1[0], y1[1]), pk2(y1[2], y1[3]), pk2(y1[4], y1[5]), pk2(y1[6], y1[7])};
            o2 = (u32x4){pk2(y2[0], y2[1]), pk2(y2[2], y2[3]), pk2(y2[4], y2[5]), pk2(y2[6], y2[7])}; }
        LAS unsigned char* d = lds + AT_K + (g * AT_NK + kk) * AT_KP + 16 * c;
        *(LAS u32x4*)d = o1; *(LAS u32x4*)(d + 64) = o2;
    }
#pragma unroll 2
    for (int task = tid; task < AT_NK * 2 * 8; task += NTHR) {
        const int c = task & 7, g = (task >> 3) & 1, kk = task >> 4; const int sp = key0 + kk;
        u32x4 o = {0u, 0u, 0u, 0u};
        if (sp >= 0) o = *(const u32x4*)(projb + ((size_t)b * SEQ + sp) * NPROJ + OFF_V + g * 64 + 8 * c);
        *(LAS u32x4*)(lds + AT_V + (g * AT_NK + kk) * AT_KP + 16 * c) = o;
    }
    __syncthreads();
    const int h = wave, g = wave >> 2, r = lane & 31, hh = lane >> 5;
    const float sink2 = sinks[h] * 1.4426950408889634f;
    const int kmin = -key0;
    const unsigned kbase = (unsigned)(size_t)(lds + AT_K) + (unsigned)((g * AT_NK + r) * AT_KP + 16 * hh);
    const unsigned vbase = (unsigned)(size_t)(lds + AT_V) + (unsigned)((g * AT_NK + 4 * hh + ((lane & 15) >> 2)) * AT_KP + 32 * ((lane >> 4) & 1) + 8 * (lane & 3));
    const size_t tq0 = (size_t)b * SEQ + 32 * j;
    LAS float* linv = (LAS float*)(lds + AT_LINV);
    f32x16 oa0, oa1;
    attn_qblock<0>(projb, rope, tq0, h, kbase, vbase, sink2, kmin, r, hh, linv, oa0, oa1);
    __syncthreads();
    LAS float* ost = (LAS float*)lds;
#pragma unroll
    for (int i = 0; i < 16; ++i) { const int q = crow(i, hh); LAS float* d0 = ost + q * 512 + h * 64 + r; d0[0] = oa0[i]; d0[32] = oa1[i]; }
    __syncthreads();
    { const int tt = tid >> 4, pp = tid & 15; const LAS f32x4* row = (const LAS f32x4*)(ost + tt * 512);
      f32x4 v[8]; float s = 0.f;
#pragma unroll
      for (int i = 0; i < 8; ++i) { v[i] = row[pp + 16 * i] * linv[tt * 8 + i]; s += (v[i].x * v[i].x + v[i].y * v[i].y) + (v[i].z * v[i].z + v[i].w * v[i].w); }
      s += __shfl_xor(s, 1); s += __shfl_xor(s, 2); s += __shfl_xor(s, 4); s += __shfl_xor(s, 8);
      const float rr = rsqrtf(s * (1.f / 512.f) + EPS);
      bf16_t* dst = mix + (tq0 + tt) * D;
#pragma unroll
      for (int i = 0; i < 8; ++i) { u32x2 w; w.x = pk2(v[i].x * rr, v[i].y * rr); w.y = pk2(v[i].z * rr, v[i].w * rr); *(u32x2*)(dst + 4 * (pp + 16 * i)) = w; } }
    __syncthreads();
}

namespace pg8 {
struct EpiOutProj {
    static constexpr bool PERM = true, MIDSCALE = false;
    const bf16_t* xb; bf16_t* x1b; float* ssq1p;
    __device__ __forceinline__ void midscale(f32x4 (&)[2][2][4][2], const Unit&, int, int) const {}
    __device__ __forceinline__ void operator()(const f32x4 (&acc)[2][2][4][2], const Unit& u, int wr, int wc, int fr, int fq) const {
        const int col0 = u.pn * BM + wc * 32 + 8 * fq;
#pragma unroll
        for (int ai = 0; ai < 2; ++ai)
#pragma unroll
            for (int m = 0; m < 4; ++m) { const int row = u.pm * BM + ai * HALF + wr * 64 + m * 16 + fr; const size_t off = (size_t)row * D + col0; float q = 0.f;
#pragma unroll
                for (int bj = 0; bj < 2; ++bj) { const size_t o = off + bj * HALF; const u32x4 xw = *(const u32x4*)(xb + o);
                    const f32x4 v0 = (f32x4){bflo(xw.x), bfhi(xw.x), bflo(xw.y), bfhi(xw.y)} + acc[ai][bj][m][0], v1 = (f32x4){bflo(xw.z), bfhi(xw.z), bflo(xw.w), bfhi(xw.w)} + acc[ai][bj][m][1];
                    *(u32x4*)(x1b + o) = (u32x4){pk2(v0[0], v0[1]), pk2(v0[2], v0[3]), pk2(v1[0], v1[1]), pk2(v1[2], v1[3])};
                    q += (v0[0] * v0[0] + v0[1] * v0[1]) + (v0[2] * v0[2] + v0[3] * v0[3]) + (v1[0] * v1[0] + v1[1] * v1[1]) + (v1[2] * v1[2] + v1[3] * v1[3]); }
                q += __shfl_xor(q, 16); q += __shfl_xor(q, 32);
                if (fq == 0) ssq1p[(size_t)(u.pn * 4 + wc) * T + row] = q; }
    }
};
struct EpiMoe1 {
    static constexpr bool PERM = true, MIDSCALE = false;
    bf16_t* hid; const float* lw; const float* lr;
    __device__ __forceinline__ void midscale(f32x4 (&)[2][2][4][2], const Unit&, int, int) const {}
    __device__ __forceinline__ void operator()(const f32x4 (&acc)[2][2][4][2], const Unit& u, int wr, int wc, int fr, int fq) const {
        const int f0 = u.pn * HALF + wc * 32 + 8 * fq;
#pragma unroll
        for (int ai = 0; ai < 2; ++ai)
#pragma unroll
            for (int m = 0; m < 4; ++m) { const int rl = ai * HALF + wr * 64 + m * 16 + fr; const bool ok = rl < u.nrow; const size_t li = (size_t)u.e * T + u.li0 + rl;
                const float r2 = ok ? lr[li] : 0.f, w = ok ? lw[li] : 0.f; unsigned o[4];
#pragma unroll
                for (int n = 0; n < 2; ++n) { float hv[4];
#pragma unroll
                    for (int e = 0; e < 4; ++e) { const float gt = acc[ai][0][m][n][e] * r2, up = acc[ai][1][m][n][e] * r2; hv[e] = gt * frcp(1.f + fexp(-gt)) * up * w; }
                    o[2 * n] = pk2(hv[0], hv[1]); o[2 * n + 1] = pk2(hv[2], hv[3]); }
                *(u32x4*)(hid + (size_t)(u.pm * BM + rl) * FF + f0) = (u32x4){o[0], o[1], o[2], o[3]}; }
    }
};
struct EpiPle {
    static constexpr bool PERM = true, MIDSCALE = false;
    const bf16_t* x2b; bf16_t* x3b; const bf16_t* pp; const float* rP; float* ssq3p;
    __device__ __forceinline__ void midscale(f32x4 (&)[2][2][4][2], const Unit&, int, int) const {}
    __device__ __forceinline__ void operator()(const f32x4 (&acc)[2][2][4][2], const Unit& u, int wr, int wc, int fr, int fq) const {
        const int col0 = u.pn * BM + wc * 32 + 8 * fq;
#pragma unroll
        for (int ai = 0; ai < 2; ++ai)
#pragma unroll
            for (int m = 0; m < 4; ++m) { const int row = u.pm * BM + ai * HALF + wr * 64 + m * 16 + fr; const float s = rP[row]; const size_t off = (size_t)row * D + col0; float q = 0.f;
#pragma unroll
                for (int bj = 0; bj < 2; ++bj) { const size_t o = off + bj * HALF; const u32x4 xw = *(const u32x4*)(x2b + o), pw = *(const u32x4*)(pp + o);
                    const f32x4 a0 = acc[ai][bj][m][0] * s, a1 = acc[ai][bj][m][1] * s;
                    float v[8] = {bflo(xw.x) + fsigmoid(a0[0]) * bflo(pw.x), bfhi(xw.x) + fsigmoid(a0[1]) * bfhi(pw.x), bflo(xw.y) + fsigmoid(a0[2]) * bflo(pw.y), bfhi(xw.y) + fsigmoid(a0[3]) * bfhi(pw.y),
                                  bflo(xw.z) + fsigmoid(a1[0]) * bflo(pw.z), bfhi(xw.z) + fsigmoid(a1[1]) * bfhi(pw.z), bflo(xw.w) + fsigmoid(a1[2]) * bflo(pw.w), bfhi(xw.w) + fsigmoid(a1[3]) * bfhi(pw.w)};
                    *(u32x4*)(x3b + o) = (u32x4){pk2(v[0], v[1]), pk2(v[2], v[3]), pk2(v[4], v[5]), pk2(v[6], v[7])};
                    q += (v[0] * v[0] + v[1] * v[1]) + (v[2] * v[2] + v[3] * v[3]) + (v[4] * v[4] + v[5] * v[5]) + (v[6] * v[6] + v[7] * v[7]); }
                q += __shfl_xor(q, 16); q += __shfl_xor(q, 32);
                if (fq == 0) ssq3p[(size_t)(u.pn * 4 + wc) * T + row] = q; }
    }
};
struct MoeOrder {
    const LAS int* tstart; const LAS int* cntl; const LAS int* rowtab; const int* lt; const char* A; const char* B; size_t strideB; int K, PA, PB, G, c, gather;
    __device__ bool next(int i, Unit& u) const {
        const int L = i * G + c, tile = L >> 2; if (tile >= __builtin_amdgcn_readfirstlane(tstart[NE])) return false;
        int e = 0;
#pragma unroll 1
        for (int k = 1; k < NE; ++k) e = (tstart[k] <= tile) ? k : e;
        e = __builtin_amdgcn_readfirstlane(e);
        u.e = e; u.pm = tile; u.pn = L & 3; u.li0 = __builtin_amdgcn_readfirstlane((tile - tstart[e]) * BM); const int left = __builtin_amdgcn_readfirstlane(cntl[e]) - u.li0; u.nrow = left < BM ? left : BM; u.ord = i; return true;
    }
    __device__ const char* a_ptr(const Unit& u) const { return gather ? A : A + (size_t)u.pm * BM * PA * 2; }
    __device__ const char* b_ptr(const Unit& u) const { return B + (size_t)u.e * strideB + (size_t)u.pn * BM * PB * 2; }
    __device__ unsigned a_row(const Unit& u, int r) const { return (unsigned)rowtab[(u.ord & 7) * BM + r]; }
};
}

constexpr int MOE_TSTART = XTRA_OFF, MOE_CNTL = XTRA_OFF + 256, MOE_ROWTAB = XTRA_OFF + 512;
static_assert(MOE_ROWTAB + 8192 <= LDS_BYTES, "moe lds");
__device__ __forceinline__ void moe_tstart(const Frame& F, const int* cnt) {
    LAS int* tstart = (LAS int*)(F.lds + MOE_TSTART); LAS int* cntl = (LAS int*)(F.lds + MOE_CNTL);
    if (F.tid < 64) { const int l = F.tid; const int c = l < NE ? cnt[l * 32] : 0; const int nt = (c + 255) >> 8; int inc = nt;
#pragma unroll
        for (int o = 1; o < 32; o <<= 1) { const int v = __shfl_up(inc, o); if ((l & 31) >= o) inc += v; }
        if (l < NE) { tstart[l] = inc - nt; cntl[l] = c; } if (l == NE - 1) tstart[NE] = inc; }
    __syncthreads();
}
__device__ __forceinline__ void moe_rowtab(const Frame& F, const pg8::MoeOrder& S) {
    LAS int* rowtab = (LAS int*)(F.lds + MOE_ROWTAB);
    for (int i = 0; i < 8; ++i) { pg8::Unit u; if (!S.next(i, u)) break; if (F.tid < 256) rowtab[i * 256 + F.tid] = F.tid < u.nrow ? S.lt[(size_t)u.e * T + u.li0 + F.tid] : 0; }
    asm volatile("s_waitcnt vmcnt(0) lgkmcnt(0)" ::: "memory"); __syncthreads();
}

__device__ __forceinline__ void router_chunk(const Frame& F, KArgsP args, int* cnt, int ch) {
    unsigned char* ws = args->ws; const int lane = F.lane;
    const bf16_t* x1b = (const bf16_t*)(ws + wsm::x1b); const bf16_t* wr_t = (const bf16_t*)(ws + wsm::wr_t); const float* ssq1p = (const float*)(ws + wsm::ssq1p);
    float* r2v = (float*)(ws + wsm::r2); int* lt = (int*)(ws + wsm::lt); float* lw = (float*)(ws + wsm::lw); float* lr = (float*)(ws + wsm::lr);
    int* tokE = (int*)(ws + wsm::tokE); int* tokPos = (int*)(ws + wsm::tokPos);
    const float* b_rg = args->in[18]; const float* b_re = args->in[20];
    LAS float* lg = (LAS float*)F.lds;
    {
            const int tok0 = ch * 64, mt = F.wave & 3, kh = F.wave >> 2;
            f32x4 acc[3];
#pragma unroll
            for (int n = 0; n < 3; ++n) acc[n] = (f32x4){0.f, 0.f, 0.f, 0.f};
            const bf16_t* ap = x1b + (size_t)(tok0 + 16 * mt + (lane & 15)) * D + 512 * kh + 8 * (lane >> 4);
            const bf16_t* bp = wr_t + (size_t)(lane & 15) * D + 512 * kh + 8 * (lane >> 4);
#pragma unroll 4
            for (int ks = 0; ks < 16; ++ks) { const bf16x8 af = *(const bf16x8*)(ap + 32 * ks);
#pragma unroll
                for (int n = 0; n < 3; ++n) { const bf16x8 bf = *(const bf16x8*)(bp + (size_t)16 * n * D + 32 * ks); acc[n] = __builtin_amdgcn_mfma_f32_16x16x32_bf16(af, bf, acc[n], 0, 0, 0); } }
#pragma unroll
            for (int n = 0; n < 3; ++n)
#pragma unroll
                for (int r = 0; r < 4; ++r) lg[(kh * 64 + 16 * mt + (lane >> 4) * 4 + r) * 48 + 16 * n + (lane & 15)] = acc[n][r];
            __syncthreads();
            if (F.tid < 64) {
                const int t = tok0 + F.tid; float s = 0.f;
#pragma unroll
                for (int pq = 0; pq < 16; ++pq) s += ssq1p[(size_t)pq * T + t];
                const float r2 = rsqrtf(s * (1.f / D) + EPS); r2v[t] = r2;
                const LAS float* l0 = lg + F.tid * 48; const LAS float* l1 = lg + (64 + F.tid) * 48;
                float gm = -1e30f; int gt = 0; float gl[4];
#pragma unroll
                for (int jx = 0; jx < 4; ++jx) { gl[jx] = (l0[jx] + l1[jx]) * r2 + b_rg[jx]; if (gl[jx] > gm) { gm = gl[jx]; gt = jx; } }
                float gs = 0.f;
#pragma unroll
                for (int jx = 0; jx < 4; ++jx) gs += expf(gl[jx] - gm);
                const float gp = 1.f / gs;
                float m1 = -1e30f, m2 = -1e30f; int i1 = 0, i2 = 0;
#pragma unroll
                for (int jx = 0; jx < 8; ++jx) { const float v = (l0[4 + gt * 8 + jx] + l1[4 + gt * 8 + jx]) * r2 + b_re[gt * 8 + jx];
                    if (v > m1) { m2 = m1; i2 = i1; m1 = v; i1 = jx; } else if (v > m2) { m2 = v; i2 = jx; } }
                const float e2 = expf(m2 - m1), w1 = gp / (1.f + e2), w2 = gp * e2 / (1.f + e2);
                const int E1 = gt * 8 + i1, E2 = gt * 8 + i2;
                LAS int* hist = (LAS int*)(F.lds + 32768); LAS int* base = hist + 32;
                if (F.tid < 32) hist[F.tid] = 0;
                asm volatile("s_waitcnt lgkmcnt(0)" ::: "memory");
                const int q1 = __hip_atomic_fetch_add(hist + E1, 1, __ATOMIC_RELAXED, __HIP_MEMORY_SCOPE_WORKGROUP), q2 = __hip_atomic_fetch_add(hist + E2, 1, __ATOMIC_RELAXED, __HIP_MEMORY_SCOPE_WORKGROUP);
                asm volatile("s_waitcnt lgkmcnt(0)" ::: "memory");
                if (F.tid < 32) { const int hc = hist[F.tid]; base[F.tid] = hc > 0 ? atomicAdd(&cnt[F.tid * 32], hc) : 0; }
                asm volatile("s_waitcnt vmcnt(0) lgkmcnt(0)" ::: "memory");
                const int p1 = base[E1] + q1, p2 = base[E2] + q2;
                lt[(size_t)E1 * T + p1] = t; lw[(size_t)E1 * T + p1] = w1; lr[(size_t)E1 * T + p1] = r2;
                lt[(size_t)E2 * T + p2] = t; lw[(size_t)E2 * T + p2] = w2; lr[(size_t)E2 * T + p2] = r2;
                tokE[t * 2] = E1; tokPos[t * 2] = p1; tokE[t * 2 + 1] = E2; tokPos[t * 2 + 1] = p2;
            }
            __syncthreads();
    }
}

__device__ __forceinline__ void final_rows(const Frame& F, KArgsP args, int row0, int nrow) {
    unsigned char* ws = args->ws; const int lane = F.lane;
    const float* ssq3p = (const float*)(ws + wsm::ssq3p); const float* gfin = args->in[27]; float* X = args->out; const bf16_t* x3b = (const bf16_t*)(ws + wsm::x3b);
    f32x4 gv[4];
#pragma unroll
    for (int jx = 0; jx < 2; ++jx) { gv[2 * jx] = ((const f32x4*)gfin)[2 * (lane + 64 * jx)]; gv[2 * jx + 1] = ((const f32x4*)gfin)[2 * (lane + 64 * jx) + 1]; }
    for (int t = row0 + F.wave; t < row0 + nrow; t += NWAVES) {
        float s = 0.f;
        if (lane < 16) s = ssq3p[(size_t)lane * T + t];
        s = wsum(s);
        const float r3 = rsqrtf(s * (1.f / D) + EPS);
        const u32x4* xr = (const u32x4*)(x3b + (size_t)t * D) + lane; f32x4* orow = (f32x4*)(X + (size_t)t * D);
#pragma unroll
        for (int jx = 0; jx < 2; ++jx) { const u32x4 w = xr[64 * jx];
            orow[2 * (lane + 64 * jx)] = (f32x4){bflo(w.x), bfhi(w.x), bflo(w.y), bfhi(w.y)} * r3 * gv[2 * jx];
            orow[2 * (lane + 64 * jx) + 1] = (f32x4){bflo(w.z), bfhi(w.z), bflo(w.w), bfhi(w.w)} * r3 * gv[2 * jx + 1]; }
    }
}
__device__ __forceinline__ void panel_sync(const Frame& F, gu32* cw) {
    asm volatile("s_waitcnt vmcnt(0)" ::: "memory");
    __syncthreads();
    if (F.tid == 0) {
        __builtin_amdgcn_fence(__ATOMIC_RELEASE, "agent"); asm volatile("s_waitcnt vmcnt(0)" ::: "memory");
        (void)__hip_atomic_fetch_add(cw, 1u, __ATOMIC_RELAXED, __HIP_MEMORY_SCOPE_AGENT);
        unsigned sp = 0; while (__hip_atomic_load(cw, __ATOMIC_RELAXED, __HIP_MEMORY_SCOPE_AGENT) < 4u) { __builtin_amdgcn_s_sleep(2); if (++sp > (1u << 22)) break; }
        __builtin_amdgcn_fence(__ATOMIC_ACQUIRE, "agent"); asm volatile("s_waitcnt vmcnt(0)" ::: "memory");
    }
    __syncthreads();
}

__global__ void __launch_bounds__(NTHR, 2) mk_fwd(Args) {
    const KArgsP args0 = kargs();
    extern __shared__ __attribute__((aligned(16))) unsigned char lds_raw[];
    Frame F; F.lds = (LAS unsigned char*)lds_raw; F.MISC = (volatile LAS unsigned*)(F.lds + MISC_OFF);
    F.tid = threadIdx.x; F.lane = F.tid & 63; F.wave = __builtin_amdgcn_readfirstlane(F.tid >> 6);
    F.G = gridDim.x; { const int bx = blockIdx.x; F.vcu = (F.G % 8 == 0) ? (bx % 8) * (F.G / 8) + bx / 8 : bx; }
    unsigned char* ws = args0->ws; F.ctl = (gu32*)(ws + wsm::ctl);
    for (int u = F.tid; u < (LDS_BYTES - LDSCTL_OFF) / 4; u += NTHR) ((LAS unsigned*)(F.lds + LDSCTL_OFF))[u] = 0u;
    __syncthreads();
    const int lo = args0->ph_lo, hi = args0->ph_hi;
    XcdBarrier bar = xcd_barrier_post((unsigned*)(F.ctl + CW_BAR) + (args0->mode >> 8) * XCD_BAR_WORDS, F.MISC + 8);
    int* cnt = (int*)(F.ctl + CW_CNT);
    const LAS int* tstart = (const LAS int*)(F.lds + MOE_TSTART); const LAS int* cntl = (const LAS int*)(F.lds + MOE_CNTL); const LAS int* rowtab = (const LAS int*)(F.lds + MOE_ROWTAB);
    const int gw = F.vcu * NWAVES + F.wave, NGW = F.G * NWAVES, lane = F.lane;
#ifndef PHASE_MASK
#define PHASE_MASK 0x7ffu
#endif
#define IN(k) ((((PHASE_MASK) >> (k)) & 1u) && lo <= (k) && (k) < hi)
#ifdef MK_STAMPS
    unsigned long long* tsg = (unsigned long long*)(F.ctl + 14336);
#define STAMP(k) do { if (blockIdx.x == 0 && F.tid == 0) tsg[k] = __builtin_amdgcn_s_memrealtime(); } while (0)
#else
#define STAMP(k) do { } while (0)
#endif
#define GRID_BAR(k) do { if (IN(k) && IN((k) + 1)) xcd_barrier(bar); STAMP((k) + 1); } while (0)
    STAMP(0);
    const bool fused = false;
    if (IN(0)) { const KArgsP args = kargs(); p0_prologue(F, args); __syncthreads(); }
    GRID_BAR(0);
    if (IN(1)) { const KArgsP args = kargs();
        { pg8::DenseOrder S; S.init((const bf16_t*)(ws + wsm::xb), (const bf16_t*)(ws + wsm::w_in_t), T, NPROJ, D, F.G, (int)blockIdx.x);
          pg8::EpiScaleBf16 E{(bf16_t*)(ws + wsm::projb), (const float*)(ws + wsm::r0), NPROJ, 0};
          pg8::gemm_phase<pg8::EpiScaleBf16, pg8::DenseOrder, true, false>(F.lds, D, S, E); }
        { pg8::DenseOrder S; S.init((const bf16_t*)(ws + wsm::pb), (const bf16_t*)(ws + wsm::w_pp_t), T, D, PLE, F.G, (int)blockIdx.x);
          pg8::EpiScaleBf16 E{(bf16_t*)(ws + wsm::pp), nullptr, D, 0};
          pg8::gemm_phase<pg8::EpiScaleBf16, pg8::DenseOrder, true, false>(F.lds, PLE, S, E); }
    }
    GRID_BAR(1);
    if (IN(2)) { const KArgsP args = kargs();
        const bool conv_first = (F.G >= 256) && (blockIdx.x & 1);
        if (conv_first) p0_experts(F, args, gw, NGW, 1);
        STAMP(12);
        for (int it = blockIdx.x; it < 256 + 512; it += F.G) {
            if (it < 256) { lruA_unit(F, args, it >> 6, (it >> 3) & 7, it & 7); STAMP(13); }
            else { const int u = it - 256; attn_unit(F, args, u >> 7, u & 127); }
        }
        STAMP(14);
        if (F.G >= 256 && !conv_first) p0_experts(F, args, gw, NGW, 1);
        STAMP(15);
    }
    GRID_BAR(2);
    if (IN(3)) { const KArgsP args = kargs();
        for (int it = blockIdx.x; it < T / 64; it += F.G) lru_finish(F, args, it >> 6, it & 63);
    }
    GRID_BAR(3);
    if (IN(4)) { const KArgsP args = kargs();
        pg8::DenseOrder S; S.init((const bf16_t*)(ws + wsm::mix), (const bf16_t*)(ws + wsm::w_out_t), T, D, D, F.G, (int)blockIdx.x);
        pg8::EpiOutProj E{(const bf16_t*)(ws + wsm::xb), (bf16_t*)(ws + wsm::x1b), (float*)(ws + wsm::ssq1p)};
        pg8::gemm_phase<pg8::EpiOutProj, pg8::DenseOrder, true, false>(F.lds, D, S, E);
        if (fused) { pg8::Unit u; S.next(0, u); panel_sync(F, F.ctl + CW_PANA + 32 * u.pm); router_chunk(F, args, cnt, 4 * u.pm + u.pn); }
    }
    if (!fused) GRID_BAR(4);
    if (IN(5) && !fused) { const KArgsP args = kargs();
        for (int ch = F.vcu; ch < T / 64; ch += F.G) router_chunk(F, args, cnt, ch);
    }
    GRID_BAR(5);
    if (IN(6)) { const KArgsP args = kargs();
        moe_tstart(F, cnt);
        pg8::MoeOrder S{tstart, cntl, rowtab, (const int*)(ws + wsm::lt), (const char*)(ws + wsm::x1b), (const char*)(ws + wsm::wgu_t), (size_t)1024 * D * 2, D, D, D, F.G, F.vcu, 1};
        moe_rowtab(F, S);
        pg8::EpiMoe1 E{(bf16_t*)(ws + wsm::hid), (const float*)(ws + wsm::lw), (const float*)(ws + wsm::lr)};
        pg8::gemm_phase<pg8::EpiMoe1, pg8::MoeOrder, true, true>(F.lds, D, S, E);
        if (F.G >= 256) { pg8::Unit u; const int nfull = (4 * __builtin_amdgcn_readfirstlane(tstart[NE])) / F.G;
            if (!S.next(nfull, u)) { const int nspare = F.G - (4 * __builtin_amdgcn_readfirstlane(tstart[NE]) - nfull * F.G); const int sid = F.vcu - (F.G - nspare);
                p0_experts(F, args, sid * NWAVES + F.wave, nspare * NWAVES, 2); } }
    }
    GRID_BAR(6);
    if (IN(7)) { const KArgsP args = kargs();
        moe_tstart(F, cnt);
        pg8::MoeOrder S{tstart, cntl, rowtab, nullptr, (const char*)(ws + wsm::hid), (const char*)(ws + wsm::wd_t), (size_t)D * FF * 2, FF, FF, FF, F.G, F.vcu, 0};
        pg8::EpiScaleBf16 E{(bf16_t*)(ws + wsm::y), nullptr, D, 0};
        pg8::gemm_phase<pg8::EpiScaleBf16, pg8::MoeOrder, true, false>(F.lds, FF, S, E);
    }
    GRID_BAR(7);
    if (IN(8)) { const KArgsP args = kargs();
        moe_tstart(F, cnt);
        const bf16_t* y = (const bf16_t*)(ws + wsm::y); const bf16_t* x1b = (const bf16_t*)(ws + wsm::x1b); bf16_t* x2b = (bf16_t*)(ws + wsm::x2b); float* rP = (float*)(ws + wsm::rP);
        const int* tokE = (const int*)(ws + wsm::tokE); const int* tokPos = (const int*)(ws + wsm::tokPos);
        for (int t = gw; t < T; t += NGW) {
            const size_t s1 = (size_t)tstart[tokE[2 * t]] * 256 + tokPos[2 * t], s2 = (size_t)tstart[tokE[2 * t + 1]] * 256 + tokPos[2 * t + 1];
            const u32x4* xr = (const u32x4*)(x1b + (size_t)t * D) + lane; const u32x4* ya = (const u32x4*)(y + s1 * D) + lane; const u32x4* yb = (const u32x4*)(y + s2 * D) + lane;
            u32x4* ob = (u32x4*)(x2b + (size_t)t * D) + lane; float s = 0.f;
#pragma unroll
            for (int jx = 0; jx < 2; ++jx) { const u32x4 xw = xr[64 * jx], a2 = ya[64 * jx], b2 = yb[64 * jx];
                float v[8] = {bflo(xw.x) + bflo(a2.x) + bflo(b2.x), bfhi(xw.x) + bfhi(a2.x) + bfhi(b2.x), bflo(xw.y) + bflo(a2.y) + bflo(b2.y), bfhi(xw.y) + bfhi(a2.y) + bfhi(b2.y),
                              bflo(xw.z) + bflo(a2.z) + bflo(b2.z), bfhi(xw.z) + bfhi(a2.z) + bfhi(b2.z), bflo(xw.w) + bflo(a2.w) + bflo(b2.w), bfhi(xw.w) + bfhi(a2.w) + bfhi(b2.w)};
                ob[64 * jx] = (u32x4){pk2(v[0], v[1]), pk2(v[2], v[3]), pk2(v[4], v[5]), pk2(v[6], v[7])};
                s += (v[0] * v[0] + v[1] * v[1]) + (v[2] * v[2] + v[3] * v[3]) + (v[4] * v[4] + v[5] * v[5]) + (v[6] * v[6] + v[7] * v[7]); }
            s = wsum(s);
            if (lane == 0) rP[t] = rsqrtf(s * (1.f / D) + EPS);
        }
    }
    GRID_BAR(8);
    if (IN(9)) { const KArgsP args = kargs();
        pg8::DenseOrder S; S.init((const bf16_t*)(ws + wsm::x2b), (const bf16_t*)(ws + wsm::w_pg_t), T, D, D, F.G, (int)blockIdx.x);
        pg8::EpiPle E{(const bf16_t*)(ws + wsm::x2b), (bf16_t*)(ws + wsm::x3b), (const bf16_t*)(ws + wsm::pp), (const float*)(ws + wsm::rP), (float*)(ws + wsm::ssq3p)};
        pg8::gemm_phase<pg8::EpiPle, pg8::DenseOrder, true, false>(F.lds, D, S, E);
        if (fused) { pg8::Unit u; S.next(0, u); panel_sync(F, F.ctl + CW_PANB + 32 * u.pm); final_rows(F, args, 256 * u.pm + 64 * u.pn, 64); }
    }
    if (!fused) GRID_BAR(9);
    if (IN(10) && !fused) { const KArgsP args = kargs();
        for (int r0 = F.vcu * 64; r0 < T; r0 += F.G * 64) final_rows(F, args, r0, 64);
    }
#ifdef MK_XBAR
    for (int i = 0; i < MK_XBAR; ++i) xcd_barrier(bar);
#endif
    STAMP(11);
#undef IN
#undef GRID_BAR
}
}

#ifndef MK_ONE_LAUNCH
#define MK_ONE_LAUNCH 1
#endif
#ifdef MK_STAMPS
__global__ void k_delay(const unsigned long long* ts, int k) {
    if (threadIdx.x == 0) { const unsigned long long d = (ts[k + 1] - ts[k]) * 8ull, t0 = __builtin_amdgcn_s_memrealtime(); while (__builtin_amdgcn_s_memrealtime() - t0 < d) __builtin_amdgcn_s_sleep(8); }
}
#endif
extern "C" void kernel_launch(void* const* d_in, const int* in_sizes, int n_in, void* d_out, int out_size, void* d_ws, size_t ws_size, hipStream_t stream) {
    using namespace mk;
    const size_t MB = 1u << 20, KB = 1024;
    const size_t WS_END = wsm::END;
    static int grid = 0;
    if (grid == 0) {
        if (ws_size < WS_END || n_in != 28 || out_size != T * D) { fprintf(stderr, "kernel_launch: ws %zu < %zu or n_in %d or out %d\n", ws_size, (size_t)WS_END, n_in, out_size); grid = -1; return; }
        int dev = 0, cus = 0;
        if (hipGetDevice(&dev) != hipSuccess || hipDeviceGetAttribute(&cus, hipDeviceAttributeMultiprocessorCount, dev) != hipSuccess) { grid = -1; return; }
        if (hipFuncSetAttribute((const void*)mk_fwd, hipFuncAttributeMaxDynamicSharedMemorySize, LDS_BYTES) != hipSuccess) { fprintf(stderr, "hipFuncSetAttribute failed\n"); grid = -1; return; }
        grid = cus;
    }
    if (grid < 0) return;
    Args a{};
    for (int i = 0; i < 28; ++i) a.in[i] = (const float*)d_in[i];
    a.out = (float*)d_out; a.ws = (unsigned char*)d_ws;
    (void)hipMemsetAsync((char*)d_ws + wsm::ctl, 0, CTL_ZERO_BYTES, stream);
#if MK_ONE_LAUNCH
#ifdef MK_CUT
    a.ph_lo = 0; a.ph_hi = MK_CUT; hipLaunchKernelGGL(mk_fwd, dim3(grid), dim3(NTHR), LDS_BYTES, stream, a);
    a.ph_lo = MK_CUT; a.ph_hi = 11; a.mode = 256; hipLaunchKernelGGL(mk_fwd, dim3(grid), dim3(NTHR), LDS_BYTES, stream, a);
#else
    a.ph_lo = 0; a.ph_hi = 11; hipLaunchKernelGGL(mk_fwd, dim3(grid), dim3(NTHR), LDS_BYTES, stream, a);
#endif
#ifdef MK_STAMPS
    if (MK_STAMPS >= 0) k_delay<<<1, 64, 0, stream>>>((const unsigned long long*)((char*)d_ws + wsm::ctl + 14336 * 4), MK_STAMPS);
#endif
#ifdef MK_EXTRA
    a.out = (float*)((char*)d_ws + 16 * MB); a.ph_lo = MK_EXTRA; a.ph_hi = MK_EXTRA + 1;
#ifdef MK_MODE
    a.mode = MK_MODE;
#endif
    hipLaunchKernelGGL(mk_fwd, dim3(grid), dim3(NTHR), LDS_BYTES, stream, a);
#endif
#else
    for (int ph = 0; ph < 11; ++ph) { a.ph_lo = ph; a.ph_hi = ph + 1; hipLaunchKernelGGL(mk_fwd, dim3(grid), dim3(NTHR), LDS_BYTES, stream, a); }
#endif
}
```

```cpp
#define MK_TS_A 0
#define MK_TS_B 1
#define MK_DUP 6
#include <hip/hip_runtime.h>
#include <cstdio>
#include <cstdint>
#define GAS __attribute__((address_space(1)))
#define LAS __attribute__((address_space(3)))
typedef unsigned short bf16_t;
typedef short bf16x8 __attribute__((ext_vector_type(8)));
typedef float f32x4 __attribute__((ext_vector_type(4)));
typedef float f32x2 __attribute__((ext_vector_type(2)));
typedef unsigned u32x4 __attribute__((ext_vector_type(4)));
typedef unsigned u32x2 __attribute__((ext_vector_type(2)));
typedef GAS unsigned gu32;

namespace mk {
constexpr int T = 16384, SEQ = 4096, D = 1024, NPROJ = 1792, PLE = 256;
constexpr int OFF_K = 512, OFF_V = 640, OFF_LX = 768, OFF_LG = 1280;
constexpr int NE = 32, FF = 512;
constexpr float EPS = 1e-6f;
constexpr int NWAVES = 8, NTHR = 512;
constexpr int RING_BYTES = 131072, LDSCTL_OFF = RING_BYTES, MISC_OFF = LDSCTL_OFF + 320, XTRA_OFF = RING_BYTES + 1024, LDS_BYTES = 147456;

__device__ __forceinline__ unsigned f2bf(float f) { unsigned u = __builtin_bit_cast(unsigned, f); return (u + 0x7fffu + ((u >> 16) & 1u)) >> 16; }
typedef __bf16 bf16x2_t __attribute__((ext_vector_type(2)));
__device__ __forceinline__ unsigned pk2(float lo, float hi) { f32x2 f = {lo, hi}; return __builtin_bit_cast(unsigned, __builtin_convertvector(f, bf16x2_t)); }
__device__ __forceinline__ float bf2f(unsigned short b) { return __builtin_bit_cast(float, (unsigned)b << 16); }
__device__ __forceinline__ float bflo(unsigned w) { return __builtin_bit_cast(float, w << 16); }
__device__ __forceinline__ float bfhi(unsigned w) { return __builtin_bit_cast(float, w & 0xffff0000u); }
__device__ __forceinline__ float wsum(float v) {
#pragma unroll
    for (int o = 1; o < 64; o <<= 1) v += __shfl_xor(v, o);
    return v;
}

namespace pg8 {
constexpr int BM = 256, BK = 64, HALF = 128, HTB = HALF * BK * 2, STAGE_BYTES = 8 * HTB, NXCD = 8, WGM = 8;
__device__ __forceinline__ int lds_byte(int r, int c) { const int st = (r >> 4) * 2 + (c >> 5), rr = r & 15, cc = c & 31, ob = rr * 64 + cc * 2; return st * 1024 + (ob ^ (((ob >> 9) & 1) << 5)); }
__device__ __forceinline__ void stage_rc(int b, int& R, int& C) { const int st = b / 1024, sb = b % 1024, swz = sb ^ (((sb >> 9) & 1) << 5); R = (st >> 1) * 16 + swz / 64; C = (st & 1) * 32 + (swz % 64) / 2; }
__device__ __forceinline__ int perm32(int rho) { const int n = rho >> 4, i = rho & 15; return 8 * (i >> 2) + 4 * n + (i & 3); }

struct Unit { int pm, pn, e, nrow, li0, ord; };

struct DenseOrder {
    const bf16_t* A; const bf16_t* Bt; int K, PA, PB, nM, nN, nwg, G, c;
    __device__ void init(const bf16_t* A_, const bf16_t* Bt_, int M, int N, int K_, int G_, int c_) { A = A_; Bt = Bt_; K = K_; PA = K_; PB = K_; nM = M / BM; nN = N / BM; nwg = nM * nN; G = G_; c = c_; }
    __device__ bool next(int i, Unit& u) const {
        const long L = (long)i * G + c; if (L >= nwg || c < 0) return false;
        int wgid = (int)L; { const int q = nwg / NXCD, r = nwg % NXCD, xcd = wgid % NXCD, off = wgid / NXCD; wgid = (xcd < r ? xcd * (q + 1) : r * (q + 1) + (xcd - r) * q) + off; }
        const int nig = WGM * nN, gid = wgid / nig, fm = gid * WGM, gsz = (nM - fm) < WGM ? (nM - fm) : WGM;
        u.pm = fm + ((wgid % nig) % gsz); u.pn = (wgid % nig) / gsz; u.e = 0; u.nrow = BM; u.li0 = 0; u.ord = i; return true;
    }
    __device__ const char* a_ptr(const Unit& u) const { return (const char*)A + (size_t)u.pm * BM * PA * 2; }
    __device__ const char* b_ptr(const Unit& u) const { return (const char*)Bt + (size_t)u.pn * BM * PB * 2; }
    __device__ unsigned a_row(const Unit&, int r) const { return (unsigned)r; }
    __device__ __forceinline__ void a_ready(const Unit&) const {}
    __device__ __forceinline__ void done(const Unit&) const {}
};

#define PG8_WAIT_V(n) asm volatile("s_waitcnt vmcnt(" #n ")" ::: "memory")
#define PG8_WAIT_L(n) asm volatile("s_waitcnt lgkmcnt(" #n ")" ::: "memory")
#define PG8_BAR __builtin_amdgcn_s_barrier()
#define PG8_SCHED __builtin_amdgcn_sched_barrier(0)

template <class Epi, class Sched, bool ALIGN_EPI, bool GATHER>
__device__ __forceinline__ void gemm_phase(LAS unsigned char* lds, const int K, const Sched& S, const Epi& E) {
    const int tid = threadIdx.x, wid = __builtin_amdgcn_readfirstlane(tid >> 6), lane = tid & 63, wr = wid >> 2, wc = wid & 3, fr = lane & 15, fq = lane >> 4;
    const int nt = K / BK; const int PA = S.PA, PB = S.PB;
    int Rr[2], Cc[2]; unsigned voffA[2], voffB[2];
#pragma unroll
    for (int i = 0; i < 2; ++i) { stage_rc(tid * 16 + i * 8192, Rr[i], Cc[i]); const int Rb = Epi::PERM ? ((Rr[i] & ~31) + perm32(Rr[i] & 31)) : Rr[i];
        voffA[i] = (unsigned)(Rr[i] * PA + Cc[i]) * 2u; voffB[i] = (unsigned)(Rb * PB + Cc[i]) * 2u; }
    const size_t kstep = (size_t)(BK * 2);
    const size_t hstepB = (size_t)HALF * PB * 2;
    const size_t hstepA = GATHER ? 0 : (size_t)HALF * PA * 2;
    const unsigned ldsw = (unsigned)wid * 1024u;
    const int aoff = lds_byte(wr * 64 + fr, fq * 8), boff = lds_byte(wc * 32 + fr, fq * 8);
#define PG8_SA(b, h) (((b) * 2 + (h)) * HTB)
#define PG8_SB(b, h) ((4 + (b) * 2 + (h)) * HTB)
#define PG8_ST2(bufoff, gbase, v0, v1) do { \
        __builtin_amdgcn_global_load_lds((const unsigned*)((const char*)(gbase) + (v0)), (LAS unsigned*)(lds + (bufoff) + ldsw), 16, 0, 0); \
        __builtin_amdgcn_global_load_lds((const unsigned*)((const char*)(gbase) + (v1)), (LAS unsigned*)(lds + (bufoff) + ldsw + 8192), 16, 0, 0); } while (0)
#define PG8_STB(bufoff, gbase) PG8_ST2(bufoff, gbase, voffB[0], voffB[1])
#define PG8_LDA(dst, b, h) do { _Pragma("unroll") for (int m = 0; m < 4; ++m) _Pragma("unroll") for (int k = 0; k < 2; ++k) dst[m][k] = *(const LAS bf16x8*)(lds + PG8_SA(b, h) + aoff + m * 2048 + k * 1024); } while (0)
#define PG8_LDB(dst, b, h) do { _Pragma("unroll") for (int n = 0; n < 2; ++n) _Pragma("unroll") for (int k = 0; k < 2; ++k) dst[n][k] = *(const LAS bf16x8*)(lds + PG8_SB(b, h) + boff + n * 2048 + k * 1024); } while (0)
#define PG8_MMA(ai, bj, At, Bt) do { __builtin_amdgcn_s_setprio(1); _Pragma("unroll") for (int m = 0; m < 4; ++m) _Pragma("unroll") for (int n = 0; n < 2; ++n) _Pragma("unroll") for (int k = 0; k < 2; ++k) \
        acc[ai][bj][m][n] = __builtin_amdgcn_mfma_f32_16x16x32_bf16(Bt[n][k], At[m][k], acc[ai][bj][m][n], 0, 0, 0); __builtin_amdgcn_s_setprio(0); } while (0)
    Unit cur, nxt; int ui = 0;
    if (!S.next(0, cur)) return;
    f32x4 acc[2][2][4][2];
#pragma unroll
    for (int a = 0; a < 2; ++a)
#pragma unroll
        for (int b = 0; b < 2; ++b)
#pragma unroll
            for (int m = 0; m < 4; ++m)
#pragma unroll
                for (int n = 0; n < 2; ++n) acc[a][b][m][n] = (f32x4){0.f, 0.f, 0.f, 0.f};
    bf16x8 At[4][2], B0[2][2], B1[2][2];
    const char* cA = S.a_ptr(cur); const char* cB = S.b_ptr(cur);
    S.a_ready(cur);
    unsigned c00 = voffA[0], c01 = voffA[1], c10 = voffA[0], c11 = voffA[1];
    if constexpr (GATHER) {
        c00 = (S.a_row(cur, Rr[0]) * (unsigned)PA + (unsigned)Cc[0]) * 2u; c01 = (S.a_row(cur, Rr[1]) * (unsigned)PA + (unsigned)Cc[1]) * 2u;
        c10 = (S.a_row(cur, HALF + Rr[0]) * (unsigned)PA + (unsigned)Cc[0]) * 2u; c11 = (S.a_row(cur, HALF + Rr[1]) * (unsigned)PA + (unsigned)Cc[1]) * 2u;
    }
    PG8_STB(PG8_SB(0, 0), cB); PG8_STB(PG8_SB(0, 1), cB + hstepB); PG8_ST2(PG8_SA(0, 0), cA, c00, c01); PG8_ST2(PG8_SA(0, 1), cA + hstepA, c10, c11);
    if (wr == 1) PG8_BAR;
    PG8_WAIT_V(2); PG8_BAR;
    PG8_STB(PG8_SB(1, 0), cB + kstep); PG8_ST2(PG8_SA(1, 0), cA + kstep, c00, c01); PG8_STB(PG8_SB(1, 1), cB + hstepB + kstep);
    PG8_WAIT_V(6); PG8_BAR;
    for (;;) {
        const bool has_next = S.next(ui + 1, nxt);
        const char* nA = has_next ? S.a_ptr(nxt) : cA; const char* nB = has_next ? S.b_ptr(nxt) : cB;
        unsigned s00 = c00, s01 = c01, s10 = c10, s11 = c11;
        for (int t = 0; t < nt; t += 2) {
            const bool last = (t == nt - 2);
            const char* a1 = cA + (size_t)(t + 1) * kstep;
            const char* a2 = last ? nA : cA + (size_t)(t + 2) * kstep; const char* b2 = last ? nB : cB + (size_t)(t + 2) * kstep;
            const char* a3 = a2 + kstep; const char* b3 = b2 + kstep;
            if constexpr (GATHER) { if (last && has_next) {
                int R0, C0, R1, C1; stage_rc(tid * 16, R0, C0); stage_rc(tid * 16 + 8192, R1, C1);
                s00 = (S.a_row(nxt, R0) * (unsigned)PA + (unsigned)C0) * 2u; s01 = (S.a_row(nxt, R1) * (unsigned)PA + (unsigned)C1) * 2u;
                s10 = (S.a_row(nxt, HALF + R0) * (unsigned)PA + (unsigned)C0) * 2u; s11 = (S.a_row(nxt, HALF + R1) * (unsigned)PA + (unsigned)C1) * 2u; } }
            if constexpr (Epi::MIDSCALE) { if (t == nt / 2) E.midscale(acc, cur, wr, fr); }
            if (last && has_next) S.a_ready(nxt);
            PG8_LDB(B0, 0, 0); PG8_LDB(B1, 0, 1); PG8_SCHED; PG8_LDA(At, 0, 0); PG8_ST2(PG8_SA(1, 1), a1 + hstepA, c10, c11);
            PG8_WAIT_V(8); PG8_WAIT_L(0); PG8_BAR; PG8_MMA(0, 0, At, B0); PG8_MMA(0, 1, At, B1); PG8_BAR; PG8_SCHED;
            PG8_LDA(At, 0, 1); PG8_STB(PG8_SB(0, 0), b2); PG8_STB(PG8_SB(0, 1), b2 + hstepB); PG8_ST2(PG8_SA(0, 0), a2, s00, s01);
            PG8_WAIT_V(8); PG8_WAIT_L(0); PG8_BAR; PG8_MMA(1, 0, At, B0); PG8_MMA(1, 1, At, B1); PG8_BAR; PG8_SCHED;
            PG8_LDB(B0, 1, 0); PG8_LDB(B1, 1, 1); PG8_SCHED; PG8_LDA(At, 1, 0); PG8_ST2(PG8_SA(0, 1), a2 + hstepA, s10, s11);
            PG8_WAIT_V(8); PG8_WAIT_L(0); PG8_BAR; PG8_MMA(0, 0, At, B0); PG8_MMA(0, 1, At, B1); PG8_BAR; PG8_SCHED;
            PG8_LDA(At, 1, 1); PG8_STB(PG8_SB(1, 0), b3); PG8_STB(PG8_SB(1, 1), b3 + hstepB); PG8_ST2(PG8_SA(1, 0), a3, s00, s01);
            PG8_WAIT_V(8); PG8_WAIT_L(0); PG8_BAR; PG8_MMA(1, 0, At, B0); PG8_MMA(1, 1, At, B1); PG8_BAR; PG8_SCHED;
        }
        if constexpr (ALIGN_EPI) { if (wr == 0) PG8_BAR; }
        E(acc, cur, wr, wc, fr, fq);
        S.done(cur);
        if (!has_next) break;
#pragma unroll
        for (int a = 0; a < 2; ++a)
#pragma unroll
            for (int b = 0; b < 2; ++b)
#pragma unroll
                for (int m = 0; m < 4; ++m)
#pragma unroll
                    for (int n = 0; n < 2; ++n) acc[a][b][m][n] = (f32x4){0.f, 0.f, 0.f, 0.f};
        cur = nxt; cA = nA; cB = nB; ++ui;
        if constexpr (GATHER) { c00 = s00; c01 = s01; c10 = s10; c11 = s11; }
        if constexpr (ALIGN_EPI) { if (wr == 1) PG8_BAR; }
    }
    PG8_WAIT_V(0);
    if constexpr (!ALIGN_EPI) { if (wr == 0) PG8_BAR; }
    PG8_BAR;
#undef PG8_SA
#undef PG8_SB
#undef PG8_ST2
#undef PG8_STB
#undef PG8_LDA
#undef PG8_LDB
#undef PG8_MMA
}

struct EpiScaleBf16 {
    static constexpr bool PERM = true, MIDSCALE = false;
    bf16_t* O; const float* rs; int ldc; int pad;
    __device__ __forceinline__ void midscale(f32x4 (&)[2][2][4][2], const Unit&, int, int) const {}
    __device__ __forceinline__ void operator()(const f32x4 (&acc)[2][2][4][2], const Unit& u, int wr, int wc, int fr, int fq) const {
        const int row0 = u.pm * BM + wr * 64 + fr, col0 = u.pn * BM + wc * 32 + 8 * fq;
#pragma unroll
        for (int ai = 0; ai < 2; ++ai)
#pragma unroll
            for (int m = 0; m < 4; ++m) { const int row = row0 + ai * HALF + m * 16; const float s = rs ? rs[row] : 1.f; bf16_t* rowp = O + (size_t)row * ldc + col0;
#pragma unroll
                for (int bj = 0; bj < 2; ++bj) { const f32x4 v0 = acc[ai][bj][m][0] * s, v1 = acc[ai][bj][m][1] * s;
                    u32x4 w; w.x = pk2(v0[0], v0[1]); w.y = pk2(v0[2], v0[3]); w.z = pk2(v1[0], v1[1]); w.w = pk2(v1[2], v1[3]);
                    *(u32x4*)(rowp + bj * HALF) = w; } }
    }
};
}

#define XB_TMO      128
#define XB_XCNT(j)  (256  + 64 * (j))
#define XB_XSUB(j)  (1280 + 64 * (j))
#define XB_XGEN(j)  (2304 + 64 * (j))
#define XB_TOP      3328
#define XB_TOPGEN   3392
#define XCD_BAR_WORDS 3456
#define XB_SPIN_CAP (1u << 18)
__device__ __forceinline__ unsigned xb_ld(unsigned* p)              { return __hip_atomic_load(p, __ATOMIC_RELAXED, __HIP_MEMORY_SCOPE_AGENT); }
__device__ __forceinline__ unsigned xb_add(unsigned* p, unsigned v) { return __hip_atomic_fetch_add(p, v, __ATOMIC_RELAXED, __HIP_MEMORY_SCOPE_AGENT); }
__device__ __forceinline__ unsigned xb_xcc_id() { return (unsigned)__builtin_amdgcn_s_getreg((3 << 11) | 20) & 0xFu; }
#define XB_SPIN(cond, bar) do { unsigned _sp = 0; while (cond) { __builtin_amdgcn_s_sleep(1); \
    if ((++_sp & 255u) == 0u) { if (xb_ld(&(bar)[XB_TMO])) break; if (_sp > XB_SPIN_CAP) { atomicAdd(&(bar)[XB_TMO], 1u); break; } } } } while (0)
struct XcdBarrier { unsigned* bar; unsigned x; volatile LAS unsigned* st; };
__device__ __forceinline__ XcdBarrier xcd_barrier_post(unsigned* bar, volatile LAS unsigned* st) {
    XcdBarrier b; b.bar = bar; b.x = xb_xcc_id(); b.st = st;
    if (threadIdx.x == 0) (void)xb_add(&bar[XB_XCNT(b.x)], 1u);
    return b;
}
__device__ __forceinline__ void xcd_barrier_complete(unsigned* bar, unsigned x, unsigned& nloc, unsigned& nx) {
    const unsigned G = gridDim.x * gridDim.y * gridDim.z;
    unsigned sum, cnt, mine, sp = 0u;
    for (;;) {
        sum = 0u; cnt = 0u; mine = 0u;
#pragma unroll
        for (unsigned j = 0; j < 16; ++j) { const unsigned c = xb_ld(&bar[XB_XCNT(j)]); sum += c; cnt += (c > 0u) ? 1u : 0u; mine = (j == x) ? c : mine; }
        if (sum == G) break;
        __builtin_amdgcn_s_sleep(1);
        if ((++sp & 255u) == 0u) { if (xb_ld(&bar[XB_TMO])) break; if (sp > XB_SPIN_CAP) { atomicAdd(&bar[XB_TMO], 1u); break; } }
    }
    nloc = mine > 0u ? mine : 1u; nx = cnt > 0u ? cnt : 1u;
}
__device__ __forceinline__ void xcd_barrier(const XcdBarrier& b) {
    asm volatile("s_waitcnt vmcnt(0)" ::: "memory");
    __syncthreads();
    if (threadIdx.x == 0) {
        unsigned* bar = b.bar;
        __builtin_amdgcn_s_waitcnt(0);
        unsigned nloc = b.st[0], nx = b.st[1];
        if (nloc == 0u) { xcd_barrier_complete(bar, b.x, nloc, nx); b.st[0] = nloc; b.st[1] = nx; }
        const unsigned old = xb_add(&bar[XB_XSUB(b.x)], 1u);
        const unsigned gen = old / nloc;
        if (old + 1u == (gen + 1u) * nloc) {
            __builtin_amdgcn_fence(__ATOMIC_RELEASE, "agent");
            asm volatile("s_waitcnt vmcnt(0)" ::: "memory");
            const unsigned og = xb_add(&bar[XB_TOP], 1u);
            const unsigned tg = og / nx;
            if (og + 1u == (tg + 1u) * nx) xb_add(&bar[XB_TOPGEN], 1u);
            else XB_SPIN(xb_ld(&bar[XB_TOPGEN]) == tg, bar);
            __builtin_amdgcn_fence(__ATOMIC_ACQUIRE, "agent");
            xb_add(&bar[XB_XGEN(b.x)], 1u);
            asm volatile("s_waitcnt vmcnt(0)" ::: "memory");
        } else {
            XB_SPIN(xb_ld(&bar[XB_XGEN(b.x)]) == gen, bar);
            __builtin_amdgcn_fence(__ATOMIC_ACQUIRE, "agent");
            asm volatile("s_waitcnt vmcnt(0)" ::: "memory");
        }
    }
    __syncthreads();
}


constexpr size_t MiB = 1u << 20;
constexpr size_t WS_CTL = 0, CTL_ZERO_BYTES = 64 * 1024;
constexpr int CW_BAR = 1024;
constexpr int CW_CNT = 8192;
constexpr int CW_TILE = 5120;
constexpr int CW_PANA = 9216, CW_PANB = 11264;

__device__ __forceinline__ void p0_transpose_item(const float* W, int K, int N, const float* ks, bf16_t* WT, int rbase, int gshift, int gstride, LAS float* scr, int item, int lane) {
    const int nblk = N / 32, kb = item / nblk, nb = item % nblk, k0 = 64 * kb, n0 = 32 * nb;
#pragma unroll 8
    for (int i = 0; i < 32; ++i) { const int kk = 2 * i + (lane >> 5); const float s = ks ? ks[k0 + kk] : 1.f; scr[kk * 33 + (lane & 31)] = W[(size_t)(k0 + kk) * N + n0 + (lane & 31)] * s; }
    asm volatile("s_waitcnt lgkmcnt(0)" ::: "memory");
    const int c = lane & 7;
#pragma unroll
    for (int j = 0; j < 4; ++j) { const int nl = (lane >> 3) + 8 * j, n = n0 + nl; const LAS float* s = scr + (8 * c) * 33 + nl;
        const int row = rbase + (n >> gshift) * gstride + (n & ((1 << gshift) - 1));
        u32x4 o; o.x = pk2(s[0 * 33], s[1 * 33]); o.y = pk2(s[2 * 33], s[3 * 33]); o.z = pk2(s[4 * 33], s[5 * 33]); o.w = pk2(s[6 * 33], s[7 * 33]);
        *(u32x4*)(WT + (size_t)row * K + k0 + 8 * c) = o; }
    asm volatile("s_waitcnt lgkmcnt(0)" ::: "memory");
}

constexpr size_t MB_ = 1u << 20, KB_ = 1024;
namespace wsm {
constexpr size_t ctl = 0, r0 = 64 * KB_, rL = 128 * KB_, r2 = 192 * KB_, rP = 256 * KB_, tokE = 320 * KB_, tokPos = 448 * KB_,
    rope = 1 * MB_, wtot = 5 * MB_, ctot = 6 * MB_, ssq1p = 7 * MB_, ssq3p = 8 * MB_, lt = 9 * MB_, lw = 11 * MB_, lr = 13 * MB_, wr_t = 15 * MB_, wag_t = 15 * MB_ + 512 * KB_,
    w_in_t = 16 * MB_, w_out_t = 20 * MB_, wgu_t = 22 * MB_, projb = 86 * MB_, x1b = 110 * MB_,
    wd_t = 142 * MB_, w_pg_t = 174 * MB_, w_pp_t = 176 * MB_,
    xb = 177 * MB_, x2b = 177 * MB_, pb = 209 * MB_, mix = 209 * MB_, hid = 209 * MB_, x3b = 110 * MB_, pp = 249 * MB_, y2 = 86 * MB_, END = 281 * MB_;
}
struct Args {
    const float* in[28]; float* out; unsigned char* ws;
    int ph_lo, ph_hi, mode, pad;
};
typedef const __attribute__((address_space(4))) Args* KArgsP;
__device__ __forceinline__ KArgsP kargs() { KArgsP p = (KArgsP)__builtin_amdgcn_kernarg_segment_ptr(); asm volatile("" : "+s"(p)); return p; }
struct Frame {
    LAS unsigned char* lds; volatile LAS unsigned* MISC; gu32* ctl;
    int tid, lane, wave, vcu, G;
};
__device__ __forceinline__ float fexp2(float x) { return __builtin_amdgcn_exp2f(x); }
__device__ __forceinline__ float fexp(float x) { return __builtin_amdgcn_exp2f(x * 1.4426950408889634f); }
__device__ __forceinline__ float frcp(float x) { return __builtin_amdgcn_rcpf(x); }
__device__ __forceinline__ float fsigmoid(float x) { return frcp(1.f + fexp(-x)); }
__device__ __forceinline__ float fgelu_tanh(float x) {
    const float u = 0.7978845608028654f * (x + 0.044715f * x * x * x);
    return x * (1.f - frcp(1.f + fexp(2.f * u)));
}

__device__ __forceinline__ void p0_tr64(const float* W, int K, int N, const float* ks, bf16_t* WT, int rbase, int gshift, int gstride, LAS unsigned* t2, int item, int lane) {
    const int nblk = N / 64, kb = item / nblk, nb = item % nblk, k0 = 64 * kb, n0 = 64 * nb;
    const int n4 = lane & 15, kr = lane >> 4;
    f32x4 va[8], vb[8];
#pragma unroll
    for (int i = 0; i < 8; ++i) { const int k = k0 + 8 * i + 2 * kr; va[i] = *(const f32x4*)(W + (size_t)k * N + n0 + 4 * n4); vb[i] = *(const f32x4*)(W + (size_t)(k + 1) * N + n0 + 4 * n4); }
#pragma unroll
    for (int i = 0; i < 8; ++i) { const int k = k0 + 8 * i + 2 * kr, kp = 4 * i + kr; const float s0 = ks ? ks[k] : 1.f, s1 = ks ? ks[k + 1] : 1.f;
        LAS unsigned* d = t2 + (4 * n4) * 33 + kp;
        d[0] = pk2(va[i].x * s0, vb[i].x * s1); d[33] = pk2(va[i].y * s0, vb[i].y * s1); d[66] = pk2(va[i].z * s0, vb[i].z * s1); d[99] = pk2(va[i].w * s0, vb[i].w * s1); }
    asm volatile("s_waitcnt lgkmcnt(0)" ::: "memory");
    const int nl = lane >> 3, c = lane & 7;
#pragma unroll
    for (int j = 0; j < 8; ++j) { const int n = 8 * j + nl; const LAS unsigned* s = t2 + n * 33 + 4 * c; const int ng = n0 + n;
        const int row = rbase + (ng >> gshift) * gstride + (ng & ((1 << gshift) - 1));
        *(u32x4*)(WT + (size_t)row * K + k0 + 8 * c) = (u32x4){s[0], s[1], s[2], s[3]}; }
    asm volatile("s_waitcnt lgkmcnt(0)" ::: "memory");
}

__device__ __forceinline__ void p0_experts(const Frame& F, KArgsP a, int w, int nw, int part) {
    LAS unsigned* t2 = (LAS unsigned*)(F.lds + F.wave * 8704); unsigned char* ws = a->ws; const int lane = F.lane;
    const float* g_ffn = a->in[16]; const float* w_eg = a->in[21]; const float* w_eu = a->in[22]; const float* w_ed = a->in[23];
    constexpr int I_G = (D / 64) * (FF / 64), I_D = (FF / 64) * (D / 64);
    if (part & 1) for (int r = w; r < NE * 2 * I_G; r += nw) { const int e = r / (2 * I_G), q = r % (2 * I_G), up = q / I_G, item = q % I_G;
        p0_tr64((up ? w_eu : w_eg) + (size_t)e * D * FF, D, FF, g_ffn, (bf16_t*)(ws + wsm::wgu_t) + (size_t)e * 1024 * D, 128 * up, 7, 256, t2, item, lane); }
    if (part & 2) for (int r = w; r < NE * I_D; r += nw) { const int e = r / I_D, item = r % I_D;
        p0_tr64(w_ed + (size_t)e * FF * D, FF, D, nullptr, (bf16_t*)(ws + wsm::wd_t) + (size_t)e * D * FF, 0, 30, 0, t2, item, lane); }
}
__device__ __forceinline__ void p0_prologue(const Frame& F, KArgsP a) {
    LAS unsigned* t2 = (LAS unsigned*)(F.lds + F.wave * 8704);
    const int gw = F.vcu * NWAVES + F.wave, NGW = F.G * NWAVES, lane = F.lane;
    unsigned char* ws = a->ws;
    const float* w_in = a->in[4]; const float* g_mix = a->in[3]; const float* w_out = a->in[15]; const float* g_attn = a->in[13]; const float* g_lru = a->in[14];
    const float* g_ffn = a->in[16];
    const float* g_ple = a->in[24]; const float* w_pg = a->in[25]; const float* w_pp = a->in[26];
    constexpr int I_IN = (D / 64) * (NPROJ / 64), I_OUT = (D / 64) * (D / 64), I_PG = I_OUT, I_PP = (PLE / 64) * (D / 64);
    constexpr int NITEMS = I_IN + I_OUT + I_PG + I_PP;
    for (int it = gw; it < NITEMS; it += NGW) {
        int r = it;
        if (r < I_IN) { p0_tr64(w_in, D, NPROJ, g_mix, (bf16_t*)(ws + wsm::w_in_t), 0, 30, 0, t2, r, lane); continue; } r -= I_IN;
        if (r < I_PP) { p0_tr64(w_pp, PLE, D, nullptr, (bf16_t*)(ws + wsm::w_pp_t), 0, 30, 0, t2, r, lane); continue; } r -= I_PP;
        if (r < I_OUT) { const int kb = r / (D / 64); const float* ks = kb < 8 ? g_attn : g_lru - 512; p0_tr64(w_out, D, D, ks, (bf16_t*)(ws + wsm::w_out_t), 0, 30, 0, t2, r, lane); continue; } r -= I_OUT;
        p0_tr64(w_pg, D, D, g_ple, (bf16_t*)(ws + wsm::w_pg_t), 0, 30, 0, t2, r, lane);
    }
    if (F.G < 256) p0_experts(F, a, gw, NGW, 3);
    const float* x = a->in[0]; bf16_t* xb = (bf16_t*)(ws + wsm::xb); float* r0 = (float*)(ws + wsm::r0);
    for (int m = gw; m < T; m += 2 * NGW) {
        const int m2 = m + NGW;
        const f32x4* xr = (const f32x4*)(x + (size_t)m * D) + lane; const f32x4* xr2 = (const f32x4*)(x + (size_t)(m2 < T ? m2 : m) * D) + lane; f32x4 v[4], v2[4]; float s = 0.f, s2 = 0.f;
#pragma unroll
        for (int j = 0; j < 4; ++j) { v[j] = xr[64 * j]; v2[j] = xr2[64 * j]; }
#pragma unroll
        for (int j = 0; j < 4; ++j) { s += (v[j].x * v[j].x + v[j].y * v[j].y) + (v[j].z * v[j].z + v[j].w * v[j].w); s2 += (v2[j].x * v2[j].x + v2[j].y * v2[j].y) + (v2[j].z * v2[j].z + v2[j].w * v2[j].w); }
        s = wsum(s); s2 = wsum(s2);
        u32x2* o8 = (u32x2*)(xb + (size_t)m * D) + lane;
#pragma unroll
        for (int j = 0; j < 4; ++j) { u32x2 w; w.x = pk2(v[j].x, v[j].y); w.y = pk2(v[j].z, v[j].w); o8[64 * j] = w; }
        if (lane == 0) r0[m] = rsqrtf(s * (1.f / D) + EPS);
        if (m2 < T) { u32x2* o9 = (u32x2*)(xb + (size_t)m2 * D) + lane;
#pragma unroll
            for (int j = 0; j < 4; ++j) { u32x2 w; w.x = pk2(v2[j].x, v2[j].y); w.y = pk2(v2[j].z, v2[j].w); o9[64 * j] = w; }
            if (lane == 0) r0[m2] = rsqrtf(s2 * (1.f / D) + EPS); }
    }
    const float* p = a->in[1]; bf16_t* pb = (bf16_t*)(ws + wsm::pb);
    for (int m = gw; m < T; m += NGW) { const f32x4 v = ((const f32x4*)(p + (size_t)m * PLE))[lane]; u32x2 w; w.x = pk2(v.x, v.y); w.y = pk2(v.z, v.w); ((u32x2*)(pb + (size_t)m * PLE))[lane] = w; }
    const int* pos = (const int*)a->in[2]; f32x2* rope = (f32x2*)(ws + wsm::rope);
    for (int idx = (F.vcu * NTHR + F.tid); idx < T * 32; idx += F.G * NTHR) { const int t = idx >> 5, i = idx & 31;
        const float inv_freq = powf(10000.f, -(float)(2 * i) / 64.f); const float ang = (float)pos[t] * inv_freq; float sn, cs; sincosf(ang, &sn, &cs); rope[idx] = (f32x2){cs, sn}; }
    { const float* wa = a->in[8]; const float* wx = a->in[10]; bf16_t* wag_t = (bf16_t*)(ws + wsm::wag_t);
      for (int idx = (F.vcu * NTHR + F.tid); idx < 8 * 2 * 64 * 64; idx += F.G * NTHR) { const int i = idx & 63, j = (idx >> 6) & 63, gt = (idx >> 12) & 1, hb = idx >> 13;
          const float v = (gt ? wx : wa)[(size_t)(hb * 64 + i) * 64 + j]; wag_t[idx] = (bf16_t)(pk2(v, 0.f) & 0xffffu); } }
    const float* w_rg = a->in[17]; const float* w_re = a->in[19]; bf16_t* wr_t = (bf16_t*)(ws + wsm::wr_t);
    for (int idx = (F.vcu * NTHR + F.tid); idx < 48 * D; idx += F.G * NTHR) { const int j = idx >> 10, k = idx & 1023;
        float v = 0.f; if (j < 4) v = w_rg[k * 4 + j] * g_ffn[k]; else if (j < 36) v = w_re[k * 32 + (j - 4)] * g_ffn[k];
        wr_t[idx] = (bf16_t)(pk2(v, 0.f) & 0xffffu); }
}

constexpr int LB = 512;
constexpr int LRU_XS = 0, LRU_XS_PITCH = 144;
constexpr int LRU_WTL = LRU_XS + LB * LRU_XS_PITCH;
static_assert(LRU_WTL + 4096 <= RING_BYTES, "lru lds");

__device__ __forceinline__ void lruA_unit(const Frame& F, KArgsP a, int b, int hb, int chunk) {
    LAS unsigned char* lds = F.lds; const int tid = F.tid, lane = F.lane, wave = F.wave;
    unsigned char* ws = a->ws;
    const bf16_t* projb = (const bf16_t*)(ws + wsm::projb); bf16_t* hl = (bf16_t*)a->out; bf16_t* pl = hl + (size_t)T * 512;
    float* wtot = (float*)(ws + wsm::wtot); float* ctot = (float*)(ws + wsm::ctot); const bf16_t* wag_t = (const bf16_t*)(ws + wsm::wag_t);
    const float* cw = a->in[6]; const float* cb = a->in[7]; const float* ba = a->in[9]; const float* bx = a->in[11]; const float* lam = a->in[12];
    const int s0 = chunk * LB; const size_t t0 = (size_t)b * SEQ + s0;
    { const int q8 = tid & 7, cch = hb * 64 + q8 * 8;
      float cwr[4][8], cbr[8];
#pragma unroll
      for (int j = 0; j < 4; ++j)
#pragma unroll
          for (int e = 0; e < 8; ++e) cwr[j][e] = cw[j * 512 + cch + e];
#pragma unroll
      for (int e = 0; e < 8; ++e) cbr[e] = cb[cch + e];
#pragma unroll 1
      for (int i = 0; i < 2; ++i) {
          const int tq = (tid >> 3) + 64 * i;
          float xv[4][8];
#pragma unroll
          for (int tk = 0; tk < 4; ++tk)
#pragma unroll
              for (int e = 0; e < 8; ++e) xv[tk][e] = cbr[e];
          u32x4 w[7];
#pragma unroll
          for (int m = 0; m < 7; ++m) { const int sj = s0 + 4 * tq - 3 + m; const int sc = sj < 0 ? 0 : sj;
              w[m] = *(const u32x4*)(projb + ((size_t)b * SEQ + sc) * NPROJ + OFF_LX + cch); }
#pragma unroll
          for (int m = 0; m < 7; ++m) { const bool ok = (s0 + 4 * tq - 3 + m) >= 0; const u32x4 ww = w[m];
              const float r[8] = {ok ? bflo(ww.x) : 0.f, ok ? bfhi(ww.x) : 0.f, ok ? bflo(ww.y) : 0.f, ok ? bfhi(ww.y) : 0.f, ok ? bflo(ww.z) : 0.f, ok ? bfhi(ww.z) : 0.f, ok ? bflo(ww.w) : 0.f, ok ? bfhi(ww.w) : 0.f};
#pragma unroll
              for (int tk = 0; tk < 4; ++tk) { const int j = m - tk; if (j >= 0 && j < 4) {
#pragma unroll
                  for (int e = 0; e < 8; ++e) xv[tk][e] += cwr[j][e] * r[e]; } } }
#pragma unroll
          for (int tk = 0; tk < 4; ++tk)
              *(LAS u32x4*)(lds + LRU_XS + (4 * tq + tk) * LRU_XS_PITCH + q8 * 16) = (u32x4){pk2(xv[tk][0], xv[tk][1]), pk2(xv[tk][2], xv[tk][3]), pk2(xv[tk][4], xv[tk][5]), pk2(xv[tk][6], xv[tk][7])};
      } }
    __syncthreads();
#ifdef MK_STAMPS
    if (blockIdx.x == 0 && tid == 0) ((unsigned long long*)(F.ctl + 14336))[16] = __builtin_amdgcn_s_memrealtime();
#endif
    const int cl = lane & 15, kq = lane >> 4, tb0 = 64 * wave;
    bf16x8 af[4][2];
#pragma unroll
    for (int mt = 0; mt < 4; ++mt)
#pragma unroll
        for (int ks = 0; ks < 2; ++ks) af[mt][ks] = *(const LAS bf16x8*)(lds + LRU_XS + (tb0 + 16 * mt + cl) * LRU_XS_PITCH + (32 * ks + 8 * kq) * 2);
    LAS float* wtl = (LAS float*)(lds + LRU_WTL);
#pragma unroll 1
    for (int nt = 0; nt < 4; ++nt) {
        const int c = hb * 64 + nt * 16 + cl;
        bf16x8 wfa[2], wfx[2];
#pragma unroll
        for (int ks = 0; ks < 2; ++ks) { const bf16_t* s = wag_t + ((size_t)(hb * 2) * 64 + nt * 16 + cl) * 64 + 32 * ks + 8 * kq; wfa[ks] = *(const bf16x8*)s; wfx[ks] = *(const bf16x8*)(s + 64 * 64); }
        const float bac = ba[c], bxc = bx[c];
        const float spc = log1pf(expf(-lam[c])) * (-8.f * 1.4426950408889634f);
        float av[4][4], bv[4][4], Aex[4], Hex[4], At[4], Ht[4];
#pragma unroll
        for (int mt = 0; mt < 4; ++mt) {
            f32x4 ga = {0.f, 0.f, 0.f, 0.f}, gx = {0.f, 0.f, 0.f, 0.f};
#pragma unroll
            for (int ks = 0; ks < 2; ++ks) { ga = __builtin_amdgcn_mfma_f32_16x16x32_bf16(af[mt][ks], wfa[ks], ga, 0, 0, 0); gx = __builtin_amdgcn_mfma_f32_16x16x32_bf16(af[mt][ks], wfx[ks], gx, 0, 0, 0); }
            float A4 = 1.f, H4 = 0.f;
#pragma unroll
            for (int r = 0; r < 4; ++r) { const int tt = tb0 + 16 * mt + 4 * kq + r;
                const float xc = bf2f(*(const LAS unsigned short*)(lds + LRU_XS + tt * LRU_XS_PITCH + (16 * nt + cl) * 2));
                const float rg = fsigmoid(ga[r] + bac), ig = fsigmoid(gx[r] + bxc);
                const float aa = fexp2(rg * spc), mult = sqrtf(fmaxf(1.f - aa * aa, 0.f));
                const float bb = mult * ig * xc;
                av[mt][r] = aa; bv[mt][r] = bb; H4 = aa * H4 + bb; A4 *= aa; }
            { float Ap = __shfl_up(A4, 16), Hp = __shfl_up(H4, 16); if (kq >= 1) { H4 = A4 * Hp + H4; A4 = Ap * A4; }
              Ap = __shfl_up(A4, 32); Hp = __shfl_up(H4, 32); if (kq >= 2) { H4 = A4 * Hp + H4; A4 = Ap * A4; } }
            { const float Ae = __shfl_up(A4, 16), He = __shfl_up(H4, 16); Aex[mt] = kq >= 1 ? Ae : 1.f; Hex[mt] = kq >= 1 ? He : 0.f; }
            At[mt] = __shfl(A4, 48 + cl); Ht[mt] = __shfl(H4, 48 + cl);
        }
        float hin = 0.f, pin = 1.f;
#pragma unroll
        for (int mt = 0; mt < 4; ++mt) {
            float h = Aex[mt] * hin + Hex[mt], pr = Aex[mt] * pin; float hv[4], pv[4];
#pragma unroll
            for (int r = 0; r < 4; ++r) { h = av[mt][r] * h + bv[mt][r]; pr *= av[mt][r]; hv[r] = h; pv[r] = pr; }
            const size_t o = (((t0 + tb0 + 16 * mt) >> 2) + kq) * 2048 + (size_t)c * 4;
            *(u32x2*)(hl + o) = (u32x2){pk2(hv[0], hv[1]), pk2(hv[2], hv[3])}; *(u32x2*)(pl + o) = (u32x2){pk2(pv[0], pv[1]), pk2(pv[2], pv[3])};
            hin = At[mt] * hin + Ht[mt]; pin = At[mt] * pin;
        }
        if (kq == 0) { float* d = wtot + ((size_t)(b * 64 + chunk * 8 + wave) * 2) * 512 + c; d[0] = pin; d[512] = hin; wtl[(wave * 2) * 64 + nt * 16 + cl] = pin; wtl[(wave * 2 + 1) * 64 + nt * 16 + cl] = hin; }
    }
    __syncthreads();
    if (tid < 64) { float A = 1.f, H = 0.f;
#pragma unroll
        for (int w2 = 0; w2 < 8; ++w2) { const float a2 = wtl[(w2 * 2) * 64 + tid], h2 = wtl[(w2 * 2 + 1) * 64 + tid]; H = a2 * H + h2; A *= a2; }
        float* d = ctot + ((size_t)(b * 8 + chunk) * 2) * 512 + hb * 64 + tid; d[0] = A; d[512] = H; }
    __syncthreads();
}

__device__ __forceinline__ void lru_finish(const Frame& F, KArgsP a, int b, int wc) {
    LAS float* cl_ = (LAS float*)F.lds; const int tid = F.tid, lane = F.lane, wave = F.wave;
    unsigned char* ws = a->ws;
    const bf16_t* projb = (const bf16_t*)(ws + wsm::projb); const bf16_t* hl = (const bf16_t*)a->out; const bf16_t* pl = hl + (size_t)T * 512; bf16_t* mix = (bf16_t*)(ws + wsm::mix);
    const float* wtot = (const float*)(ws + wsm::wtot); const float* ctot = (const float*)(ws + wsm::ctot);
    { const int c = wc >> 3, sub = wc & 7; float h = 0.f;
      for (int c2 = 0; c2 < c; ++c2) { const float* s = ctot + ((size_t)(b * 8 + c2) * 2) * 512 + tid; h = s[0] * h + s[512]; }
      for (int w2 = 0; w2 < sub; ++w2) { const float* s = wtot + ((size_t)(b * 64 + c * 8 + w2) * 2) * 512 + tid; h = s[0] * h + s[512]; }
      cl_[tid] = h; }
    __syncthreads();
    float cr[8];
#pragma unroll
    for (int e = 0; e < 8; ++e) cr[e] = cl_[8 * lane + e];
#pragma unroll 1
    for (int i = 0; i < 2; ++i) {
        const size_t t = (size_t)b * SEQ + 64 * wc + 8 * wave + 4 * i;
        const u32x4* hp = (const u32x4*)(hl + ((t >> 2) * 512 + 8 * lane) * 4); const u32x4* pp4 = (const u32x4*)(pl + ((t >> 2) * 512 + 8 * lane) * 4);
        u32x4 hw[4], pw[4], gw4[4];
#pragma unroll
        for (int q = 0; q < 4; ++q) { hw[q] = hp[q]; pw[q] = pp4[q]; gw4[q] = *(const u32x4*)(projb + (t + q) * NPROJ + OFF_LG + 8 * lane); }
        float g[4][8], s[4] = {0.f, 0.f, 0.f, 0.f};
#pragma unroll
        for (int e = 0; e < 8; ++e) {
            const unsigned h01 = hw[e >> 1][(e & 1) * 2], h23 = hw[e >> 1][(e & 1) * 2 + 1], p01 = pw[e >> 1][(e & 1) * 2], p23 = pw[e >> 1][(e & 1) * 2 + 1];
            const float hv[4] = {bflo(h01), bfhi(h01), bflo(h23), bfhi(h23)}, pv[4] = {bflo(p01), bfhi(p01), bflo(p23), bfhi(p23)};
#pragma unroll
            for (int r = 0; r < 4; ++r) { const unsigned lw = gw4[r][e >> 1]; const float lg = (e & 1) ? bfhi(lw) : bflo(lw);
                g[r][e] = (hv[r] + pv[r] * cr[e]) * fgelu_tanh(lg); s[r] += g[r][e] * g[r][e]; }
        }
#pragma unroll
        for (int r = 0; r < 4; ++r) { const float rr = rsqrtf(wsum(s[r]) * (1.f / 512.f) + EPS);
            *(u32x4*)(mix + (t + r) * D + 512 + 8 * lane) = (u32x4){pk2(g[r][0] * rr, g[r][1] * rr), pk2(g[r][2] * rr, g[r][3] * rr), pk2(g[r][4] * rr, g[r][5] * rr), pk2(g[r][6] * rr, g[r][7] * rr)}; }
    }
    __syncthreads();
}

typedef float f32x16 __attribute__((ext_vector_type(16)));
typedef short s16x4 __attribute__((ext_vector_type(4)));
constexpr int AT_KP = 144;
constexpr int AT_NK = 160;
constexpr int AT_K = 0, AT_V = 2 * AT_NK * AT_KP;
constexpr int AT_LINV = XTRA_OFF + 256;
static_assert(2 * AT_V <= RING_BYTES && AT_LINV + 2048 <= LDS_BYTES, "attn lds");
__device__ __forceinline__ int crow(int reg, int h) { return (reg & 3) + 8 * (reg >> 2) + 4 * h; }
typedef LAS s16x4* lds_s16x4_p;
__device__ __forceinline__ s16x4 tr_rd(unsigned addr) { return __builtin_amdgcn_ds_read_tr16_b64_v4i16((lds_s16x4_p)(size_t)addr); }

template <int QB>
__device__ __forceinline__ void attn_qblock(const bf16_t* projb, const f32x2* rope, size_t tq0, int h, unsigned kbase, unsigned vbase, float sink2, int kmin, int r, int hh, LAS float* linv, f32x16& o0, f32x16& o1) {
    const size_t tq = tq0 + 32 * QB + r;
    bf16x8 qf[4];
    { const bf16_t* src = projb + tq * NPROJ + h * 64 + 8 * hh; const f32x2* cs = rope + tq * 32 + 8 * hh;
      const float qs = 0.125f * 1.4426950408889634f;
#pragma unroll
      for (int kp = 0; kp < 2; ++kp) {
          const u32x4 w1 = *(const u32x4*)(src + 16 * kp), w2 = *(const u32x4*)(src + 16 * (kp + 2));
          float x1[8] = {bflo(w1.x), bfhi(w1.x), bflo(w1.y), bfhi(w1.y), bflo(w1.z), bfhi(w1.z), bflo(w1.w), bfhi(w1.w)};
          float x2[8] = {bflo(w2.x), bfhi(w2.x), bflo(w2.y), bfhi(w2.y), bflo(w2.z), bfhi(w2.z), bflo(w2.w), bfhi(w2.w)};
          float y1[8], y2[8];
#pragma unroll
          for (int e = 0; e < 8; ++e) { const f32x2 c2 = cs[16 * kp + e]; y1[e] = (x1[e] * c2.x - x2[e] * c2.y) * qs; y2[e] = (x2[e] * c2.x + x1[e] * c2.y) * qs; }
          qf[kp] = __builtin_bit_cast(bf16x8, (u32x4){pk2(y1[0], y1[1]), pk2(y1[2], y1[3]), pk2(y1[4], y1[5]), pk2(y1[6], y1[7])});
          qf[kp + 2] = __builtin_bit_cast(bf16x8, (u32x4){pk2(y2[0], y2[1]), pk2(y2[2], y2[3]), pk2(y2[4], y2[5]), pk2(y2[6], y2[7])});
      } }
    f32x16 S[5];
#pragma unroll
    for (int ti = 0; ti < 5; ++ti) {
        const float pen = (32 * (QB + ti) < kmin) ? -1e30f : 0.f;
        f32x16 acc;
#pragma unroll
        for (int i = 0; i < 16; ++i) acc[i] = pen;
#pragma unroll
        for (int ks = 0; ks < 4; ++ks) { const bf16x8 kf = *(const LAS bf16x8*)(size_t)(kbase + (unsigned)(32 * (QB + ti) * AT_KP + 32 * ks));
            acc = __builtin_amdgcn_mfma_f32_32x32x16_bf16(kf, qf[ks], acc, 0, 0, 0); }
        S[ti] = acc;
    }
    const int c4 = 4 * hh;
#pragma unroll
    for (int i = 0; i < 16; ++i) { const bool up = ((i & 3) + 8 * (i >> 2) + c4) > r; S[0][i] = up ? S[0][i] : -1e30f; S[4][i] = up ? -1e30f : S[4][i]; }
    float mx = sink2;
#pragma unroll
    for (int ti = 0; ti < 5; ++ti)
#pragma unroll
        for (int i = 0; i < 16; ++i) mx = fmaxf(mx, S[ti][i]);
    mx = fmaxf(mx, __shfl_xor(mx, 32));
    float l = 0.f; unsigned P[5][8];
#pragma unroll
    for (int ti = 0; ti < 5; ++ti)
#pragma unroll
        for (int i = 0; i < 16; i += 2) { const float p0 = fexp2(S[ti][i] - mx), p1 = fexp2(S[ti][i + 1] - mx); l += p0 + p1; P[ti][i >> 1] = pk2(p0, p1); }
    l += __shfl_xor(l, 32);
    l += fexp2(sink2 - mx);
    if (hh == 0) linv[(32 * QB + r) * 8 + h] = frcp(l);
#pragma unroll
    for (int i = 0; i < 16; ++i) { o0[i] = 0.f; o1[i] = 0.f; }
#pragma unroll
    for (int ti = 0; ti < 5; ++ti) {
#pragma unroll
        for (int s = 0; s < 2; ++s) {
            const bf16x8 pa = __builtin_bit_cast(bf16x8, (u32x4){P[ti][4 * s], P[ti][4 * s + 1], P[ti][4 * s + 2], P[ti][4 * s + 3]});
            const unsigned va = vbase + (unsigned)((32 * (QB + ti) + 16 * s) * AT_KP);
            const s16x4 lo0 = tr_rd(va), hi0 = tr_rd(va + 8 * AT_KP), lo1 = tr_rd(va + 64), hi1 = tr_rd(va + 8 * AT_KP + 64);
            const bf16x8 vb0 = __builtin_shufflevector(lo0, hi0, 0, 1, 2, 3, 4, 5, 6, 7), vb1 = __builtin_shufflevector(lo1, hi1, 0, 1, 2, 3, 4, 5, 6, 7);
            o0 = __builtin_amdgcn_mfma_f32_32x32x16_bf16(pa, vb0, o0, 0, 0, 0);
            o1 = __builtin_amdgcn_mfma_f32_32x32x16_bf16(pa, vb1, o1, 0, 0, 0);
        }
    }
}

__device__ __forceinline__ void attn_unit(const Frame& F, KArgsP a, int b, int j) {
    LAS unsigned char* lds = F.lds; const int tid = F.tid, lane = F.lane, wave = F.wave;
    unsigned char* ws = a->ws;
    const bf16_t* projb = (const bf16_t*)(ws + wsm::projb); bf16_t* mix = (bf16_t*)(ws + wsm::mix); const f32x2* rope = (const f32x2*)(ws + wsm::rope);
    const float* sinks = a->in[5];
    const int key0 = 32 * j - 128;
#pragma unroll 1
    for (int task = tid; task < AT_NK * 2 * 4; task += NTHR) {
        const int c = task & 3, g = (task >> 2) & 1, kk = task >> 3; const int sp = key0 + kk;
        u32x4 o1 = {0u, 0u, 0u, 0u}, o2 = {0u, 0u, 0u, 0u};
        if (sp >= 0) { const size_t t = (size_t)b * SEQ + sp; const bf16_t* src = projb + t * NPROJ + OFF_K + g * 64 + 8 * c;
            const u32x4 w1 = *(const u32x4*)src, w2 = *(const u32x4*)(src + 32); const f32x2* cs = rope + t * 32 + 8 * c;
            float x1[8] = {bflo(w1.x), bfhi(w1.x), bflo(w1.y), bfhi(w1.y), bflo(w1.z), bfhi(w1.z), bflo(w1.w), bfhi(w1.w)};
            float x2[8] = {bflo(w2.x), bfhi(w2.x), bflo(w2.y), bfhi(w2.y), bflo(w2.z), bfhi(w2.z), bflo(w2.w), bfhi(w2.w)};
            float y1[8], y2[8];
#pragma unroll
            for (int e = 0; e < 8; ++e) { const f32x2 c2 = cs[e]; y1[e] = x1[e] * c2.x - x2[e] * c2.y; y2[e] = x2[e] * c2.x + x1[e] * c2.y; }
            o1 = (u32x4){pk2(y1[0], y1[1]), pk2(y1[2], y1[3]), pk2(y1[4], y1[5]), pk2(y1[6], y1[7])};
            o2 = (u32x4){pk2(y2[0], y2[1]), pk2(y2[2], y2[3]), pk2(y2[4], y2[5]), pk2(y2[6], y2[7])}; }
        LAS unsigned char* d = lds + AT_K + (g * AT_NK + kk) * AT_KP + 16 * c;
        *(LAS u32x4*)d = o1; *(LAS u32x4*)(d + 64) = o2;
    }
#pragma unroll 2
    for (int task = tid; task < AT_NK * 2 * 8; task += NTHR) {
        const int c = task & 7, g = (task >> 3) & 1, kk = task >> 4; const int sp = key0 + kk;
        u32x4 o = {0u, 0u, 0u, 0u};
        if (sp >= 0) o = *(const u32x4*)(projb + ((size_t)b * SEQ + sp) * NPROJ + OFF_V + g * 64 + 8 * c);
        *(LAS u32x4*)(lds + AT_V + (g * AT_NK + kk) * AT_KP + 16 * c) = o;
    }
    __syncthreads();
    const int h = wave, g = wave >> 2, r = lane & 31, hh = lane >> 5;
    const float sink2 = sinks[h] * 1.4426950408889634f;
    const int kmin = -key0;
    const unsigned kbase = (unsigned)(size_t)(lds + AT_K) + (unsigned)((g * AT_NK + r) * AT_KP + 16 * hh);
    const unsigned vbase = (unsigned)(size_t)(lds + AT_V) + (unsigned)((g * AT_NK + 4 * hh + ((lane & 15) >> 2)) * AT_KP + 32 * ((lane >> 4) & 1) + 8 * (lane & 3));
    const size_t tq0 = (size_t)b * SEQ + 32 * j;
    LAS float* linv = (LAS float*)(lds + AT_LINV);
    f32x16 oa0, oa1;
    attn_qblock<0>(projb, rope, tq0, h, kbase, vbase, sink2, kmin, r, hh, linv, oa0, oa1);
    __syncthreads();
    LAS float* ost = (LAS float*)lds;
#pragma unroll
    for (int i = 0; i < 16; ++i) { const int q = crow(i, hh); LAS float* d0 = ost + q * 512 + h * 64 + r; d0[0] = oa0[i]; d0[32] = oa1[i]; }
    __syncthreads();
    { const int tt = tid >> 4, pp = tid & 15; const LAS f32x4* row = (const LAS f32x4*)(ost + tt * 512);
      f32x4 v[8]; float s = 0.f;
#pragma unroll
      for (int i = 0; i < 8; ++i) { v[i] = row[pp + 16 * i] * linv[tt * 8 + i]; s += (v[i].x * v[i].x + v[i].y * v[i].y) + (v[i].z * v[i].z + v[i].w * v[i].w); }
      s += __shfl_xor(s, 1); s += __shfl_xor(s, 2); s += __shfl_xor(s, 4); s += __shfl_xor(s, 8);
      const float rr = rsqrtf(s * (1.f / 512.f) + EPS);
      bf16_t* dst = mix + (tq0 + tt) * D;
#pragma unroll
      for (int i = 0; i < 8; ++i) { u32x2 w; w.x = pk2(v[i].x * rr, v[i].y * rr); w.y = pk2(v[i].z * rr, v[i].w * rr); *(u32x2*)(dst + 4 * (pp + 16 * i)) = w; } }
    __syncthreads();
}

namespace pg8 {
struct EpiOutProj {
    static constexpr bool PERM = true, MIDSCALE = false;
    const bf16_t* xb; bf16_t* x1b; float* ssq1p;
    __device__ __forceinline__ void midscale(f32x4 (&)[2][2][4][2], const Unit&, int, int) const {}
    __device__ __forceinline__ void operator()(const f32x4 (&acc)[2][2][4][2], const Unit& u, int wr, int wc, int fr, int fq) const {
        const int col0 = u.pn * BM + wc * 32 + 8 * fq;
#pragma unroll
        for (int ai = 0; ai < 2; ++ai)
#pragma unroll
            for (int m = 0; m < 4; ++m) { const int row = u.pm * BM + ai * HALF + wr * 64 + m * 16 + fr; const size_t off = (size_t)row * D + col0; float q = 0.f;
#pragma unroll
                for (int bj = 0; bj < 2; ++bj) { const size_t o = off + bj * HALF; const u32x4 xw = *(const u32x4*)(xb + o);
                    const f32x4 v0 = (f32x4){bflo(xw.x), bfhi(xw.x), bflo(xw.y), bfhi(xw.y)} + acc[ai][bj][m][0], v1 = (f32x4){bflo(xw.z), bfhi(xw.z), bflo(xw.w), bfhi(xw.w)} + acc[ai][bj][m][1];
                    *(u32x4*)(x1b + o) = (u32x4){pk2(v0[0], v0[1]), pk2(v0[2], v0[3]), pk2(v1[0], v1[1]), pk2(v1[2], v1[3])};
                    q += (v0[0] * v0[0] + v0[1] * v0[1]) + (v0[2] * v0[2] + v0[3] * v0[3]) + (v1[0] * v1[0] + v1[1] * v1[1]) + (v1[2] * v1[2] + v1[3] * v1[3]); }
                q += __shfl_xor(q, 16); q += __shfl_xor(q, 32);
                if (fq == 0) ssq1p[(size_t)(u.pn * 4 + wc) * T + row] = q; }
    }
};
struct EpiMoe1 {
    static constexpr bool PERM = true, MIDSCALE = false;
    bf16_t* hid; const float* lw; const float* lr;
    __device__ __forceinline__ void midscale(f32x4 (&)[2][2][4][2], const Unit&, int, int) const {}
    __device__ __forceinline__ void operator()(const f32x4 (&acc)[2][2][4][2], const Unit& u, int wr, int wc, int fr, int fq) const {
        const __amdgpu_buffer_rsrc_t hrs = __builtin_amdgcn_make_buffer_rsrc(hid, 0, 40960 * FF * 2, 0x00020000);
        const int f0 = u.pn * HALF + wc * 32 + 8 * fq;
#pragma unroll
        for (int ai = 0; ai < 2; ++ai)
#pragma unroll
            for (int m = 0; m < 4; ++m) { const int rl = ai * HALF + wr * 64 + m * 16 + fr; const bool ok = rl < u.nrow; const size_t li = (size_t)u.e * T + u.li0 + rl;
                const float r2 = ok ? lr[li] : 0.f, w = ok ? lw[li] : 0.f; unsigned o[4];
#pragma unroll
                for (int n = 0; n < 2; ++n) { float hv[4];
#pragma unroll
                    for (int e = 0; e < 4; ++e) { const float gt = acc[ai][0][m][n][e] * r2, up = acc[ai][1][m][n][e] * r2; hv[e] = gt * frcp(1.f + fexp(-gt)) * up * w; }
                    o[2 * n] = pk2(hv[0], hv[1]); o[2 * n + 1] = pk2(hv[2], hv[3]); }
                __builtin_amdgcn_raw_buffer_store_b128((u32x4){o[0], o[1], o[2], o[3]}, hrs, (int)(((unsigned)(u.pm * BM + rl) * FF + f0) * 2u), 0, 16); }
    }
};
struct EpiPle {
    static constexpr bool PERM = true, MIDSCALE = false;
    const bf16_t* x2b; bf16_t* x3b; const bf16_t* pp; const float* rP; float* ssq3p;
    __device__ __forceinline__ void midscale(f32x4 (&)[2][2][4][2], const Unit&, int, int) const {}
    __device__ __forceinline__ void operator()(const f32x4 (&acc)[2][2][4][2], const Unit& u, int wr, int wc, int fr, int fq) const {
        const int col0 = u.pn * BM + wc * 32 + 8 * fq;
#pragma unroll
        for (int ai = 0; ai < 2; ++ai)
#pragma unroll
            for (int m = 0; m < 4; ++m) { const int row = u.pm * BM + ai * HALF + wr * 64 + m * 16 + fr; const float s = rP[row]; const size_t off = (size_t)row * D + col0; float q = 0.f;
#pragma unroll
                for (int bj = 0; bj < 2; ++bj) { const size_t o = off + bj * HALF; const u32x4 xw = *(const u32x4*)(x2b + o), pw = *(const u32x4*)(pp + o);
                    const f32x4 a0 = acc[ai][bj][m][0] * s, a1 = acc[ai][bj][m][1] * s;
                    float v[8] = {bflo(xw.x) + fsigmoid(a0[0]) * bflo(pw.x), bfhi(xw.x) + fsigmoid(a0[1]) * bfhi(pw.x), bflo(xw.y) + fsigmoid(a0[2]) * bflo(pw.y), bfhi(xw.y) + fsigmoid(a0[3]) * bfhi(pw.y),
                                  bflo(xw.z) + fsigmoid(a1[0]) * bflo(pw.z), bfhi(xw.z) + fsigmoid(a1[1]) * bfhi(pw.z), bflo(xw.w) + fsigmoid(a1[2]) * bflo(pw.w), bfhi(xw.w) + fsigmoid(a1[3]) * bfhi(pw.w)};
                    *(u32x4*)(x3b + o) = (u32x4){pk2(v[0], v[1]), pk2(v[2], v[3]), pk2(v[4], v[5]), pk2(v[6], v[7])};
                    q += (v[0] * v[0] + v[1] * v[1]) + (v[2] * v[2] + v[3] * v[3]) + (v[4] * v[4] + v[5] * v[5]) + (v[6] * v[6] + v[7] * v[7]); }
                q += __shfl_xor(q, 16); q += __shfl_xor(q, 32);
                if (fq == 0) ssq3p[(size_t)(u.pn * 4 + wc) * T + row] = q; }
    }
};
struct EpiY {
    static constexpr bool PERM = true, MIDSCALE = false;
    bf16_t* O0; bf16_t* O1;
    __device__ __forceinline__ void midscale(f32x4 (&)[2][2][4][2], const Unit&, int, int) const {}
    __device__ __forceinline__ void operator()(const f32x4 (&acc)[2][2][4][2], const Unit& u, int wr, int wc, int fr, int fq) const {
        bf16_t* base = u.pm < 128 ? O0 + (size_t)u.pm * BM * D : O1 + (size_t)(u.pm - 128) * BM * D;
        const int row0 = wr * 64 + fr, col0 = u.pn * BM + wc * 32 + 8 * fq;
#pragma unroll
        for (int ai = 0; ai < 2; ++ai)
#pragma unroll
            for (int m = 0; m < 4; ++m) { bf16_t* rowp = base + (size_t)(row0 + ai * HALF + m * 16) * D + col0;
#pragma unroll
                for (int bj = 0; bj < 2; ++bj) { const f32x4 v0 = acc[ai][bj][m][0], v1 = acc[ai][bj][m][1];
                    *(u32x4*)(rowp + bj * HALF) = (u32x4){pk2(v0[0], v0[1]), pk2(v0[2], v0[3]), pk2(v1[0], v1[1]), pk2(v1[2], v1[3])}; } }
    }
};
struct MoeOrder {
    const LAS int* tstart; const LAS int* cntl; const LAS int* rowtab; const int* lt; const char* A; const char* B; size_t strideB; int K, PA, PB, G, c, gather;
    __device__ bool next(int i, Unit& u) const {
        const int L = i * G + c, tile = L >> 2; if (tile >= __builtin_amdgcn_readfirstlane(tstart[NE])) return false;
        int e = 0;
#pragma unroll 1
        for (int k = 1; k < NE; ++k) e = (tstart[k] <= tile) ? k : e;
        e = __builtin_amdgcn_readfirstlane(e);
        u.e = e; u.pm = tile; u.pn = L & 3; u.li0 = __builtin_amdgcn_readfirstlane((tile - tstart[e]) * BM); const int left = __builtin_amdgcn_readfirstlane(cntl[e]) - u.li0; u.nrow = left < BM ? left : BM; u.ord = i; return true;
    }
    __device__ const char* a_ptr(const Unit& u) const { return gather ? A : A + (size_t)u.pm * BM * PA * 2; }
    __device__ const char* b_ptr(const Unit& u) const { return B + (size_t)u.e * strideB + (size_t)u.pn * BM * PB * 2; }
    __device__ unsigned a_row(const Unit& u, int r) const { return (unsigned)rowtab[(u.ord & 7) * BM + r]; }
    gu32* tilecnt;
    __device__ __forceinline__ void a_ready(const Unit&) const {}
    __device__ __forceinline__ void done(const Unit& u) const {
        if (tilecnt) { asm volatile("s_waitcnt vmcnt(0)" ::: "memory");
            if ((threadIdx.x & 63) == 0) (void)__hip_atomic_fetch_add(tilecnt + 16 * u.pm, 1u, __ATOMIC_RELAXED, __HIP_MEMORY_SCOPE_AGENT); }
    }
};
struct Moe2Order {
    const LAS int* tstart; const char* A; const char* B; size_t strideB; gu32* tilecnt; int K, PA, PB, G, c, E, S2, U;
    __device__ bool next(int i, Unit& u) const {
        int m;
        if (c >= E) m = (i < 2) ? (c - E) + i * S2 : 2 * S2 + c + (i - 2) * G; else m = 2 * S2 + c + i * G;
        if (m >= U) return false;
        const int tile = m >> 2; int e = 0;
#pragma unroll 1
        for (int k = 1; k < NE; ++k) e = (tstart[k] <= tile) ? k : e;
        u.e = __builtin_amdgcn_readfirstlane(e); u.pm = tile; u.pn = m & 3; u.li0 = 0; u.nrow = BM; u.ord = i; return true;
    }
    __device__ const char* a_ptr(const Unit& u) const { return A + (size_t)u.pm * BM * PA * 2; }
    __device__ const char* b_ptr(const Unit& u) const { return B + (size_t)u.e * strideB + (size_t)u.pn * BM * PB * 2; }
    __device__ unsigned a_row(const Unit&, int r) const { return (unsigned)r; }
    __device__ __forceinline__ void done(const Unit&) const {}
    __device__ __forceinline__ void a_ready(const Unit& u) const {
        if (threadIdx.x < 64) {
            unsigned sp = 0;
            while ((unsigned)__builtin_amdgcn_readfirstlane(__hip_atomic_load(tilecnt + 16 * u.pm, __ATOMIC_RELAXED, __HIP_MEMORY_SCOPE_AGENT)) < 32u) { __builtin_amdgcn_s_sleep(2); if (++sp > (1u << 22)) break; }
            __builtin_amdgcn_fence(__ATOMIC_ACQUIRE, "agent");
            asm volatile("s_waitcnt vmcnt(0)" ::: "memory");
        }
        asm volatile("" ::: "memory"); __builtin_amdgcn_s_barrier(); asm volatile("" ::: "memory");
    }
};
}

constexpr int MOE_TSTART = XTRA_OFF, MOE_CNTL = XTRA_OFF + 256, MOE_ROWTAB = XTRA_OFF + 512;
static_assert(MOE_ROWTAB + 8192 <= LDS_BYTES, "moe lds");
__device__ __forceinline__ void moe_tstart(const Frame& F, const int* cnt) {
    LAS int* tstart = (LAS int*)(F.lds + MOE_TSTART); LAS int* cntl = (LAS int*)(F.lds + MOE_CNTL);
    if (F.tid < 64) { const int l = F.tid; const int c = l < NE ? cnt[l * 32] : 0; const int nt = (c + 255) >> 8; int inc = nt;
#pragma unroll
        for (int o = 1; o < 32; o <<= 1) { const int v = __shfl_up(inc, o); if ((l & 31) >= o) inc += v; }
        if (l < NE) { tstart[l] = inc - nt; cntl[l] = c; } if (l == NE - 1) tstart[NE] = inc; }
    __syncthreads();
}
__device__ __forceinline__ void moe_rowtab(const Frame& F, const pg8::MoeOrder& S) {
    LAS int* rowtab = (LAS int*)(F.lds + MOE_ROWTAB);
    for (int i = 0; i < 8; ++i) { pg8::Unit u; if (!S.next(i, u)) break; if (F.tid < 256) rowtab[i * 256 + F.tid] = F.tid < u.nrow ? S.lt[(size_t)u.e * T + u.li0 + F.tid] : 0; }
    asm volatile("s_waitcnt vmcnt(0) lgkmcnt(0)" ::: "memory"); __syncthreads();
}

__device__ __forceinline__ void router_chunk(const Frame& F, KArgsP args, int* cnt, int ch) {
    unsigned char* ws = args->ws; const int lane = F.lane;
    const bf16_t* x1b = (const bf16_t*)(ws + wsm::x1b); const bf16_t* wr_t = (const bf16_t*)(ws + wsm::wr_t); const float* ssq1p = (const float*)(ws + wsm::ssq1p);
    float* r2v = (float*)(ws + wsm::r2); int* lt = (int*)(ws + wsm::lt); float* lw = (float*)(ws + wsm::lw); float* lr = (float*)(ws + wsm::lr);
    int* tokE = (int*)(ws + wsm::tokE); int* tokPos = (int*)(ws + wsm::tokPos);
    const float* b_rg = args->in[18]; const float* b_re = args->in[20];
    LAS float* lg = (LAS float*)F.lds;
    {
            const int tok0 = ch * 64, mt = F.wave & 3, kh = F.wave >> 2;
            f32x4 acc[3];
#pragma unroll
            for (int n = 0; n < 3; ++n) acc[n] = (f32x4){0.f, 0.f, 0.f, 0.f};
            const bf16_t* ap = x1b + (size_t)(tok0 + 16 * mt + (lane & 15)) * D + 512 * kh + 8 * (lane >> 4);
            const bf16_t* bp = wr_t + (size_t)(lane & 15) * D + 512 * kh + 8 * (lane >> 4);
#pragma unroll 4
            for (int ks = 0; ks < 16; ++ks) { const bf16x8 af = *(const bf16x8*)(ap + 32 * ks);
#pragma unroll
                for (int n = 0; n < 3; ++n) { const bf16x8 bf = *(const bf16x8*)(bp + (size_t)16 * n * D + 32 * ks); acc[n] = __builtin_amdgcn_mfma_f32_16x16x32_bf16(af, bf, acc[n], 0, 0, 0); } }
#pragma unroll
            for (int n = 0; n < 3; ++n)
#pragma unroll
                for (int r = 0; r < 4; ++r) lg[(kh * 64 + 16 * mt + (lane >> 4) * 4 + r) * 48 + 16 * n + (lane & 15)] = acc[n][r];
            __syncthreads();
            if (F.tid < 64) {
                const int t = tok0 + F.tid; float s = 0.f;
#pragma unroll
                for (int pq = 0; pq < 16; ++pq) s += ssq1p[(size_t)pq * T + t];
                const float r2 = rsqrtf(s * (1.f / D) + EPS); r2v[t] = r2;
                const LAS float* l0 = lg + F.tid * 48; const LAS float* l1 = lg + (64 + F.tid) * 48;
                float gm = -1e30f; int gt = 0; float gl[4];
#pragma unroll
                for (int jx = 0; jx < 4; ++jx) { gl[jx] = (l0[jx] + l1[jx]) * r2 + b_rg[jx]; if (gl[jx] > gm) { gm = gl[jx]; gt = jx; } }
                float gs = 0.f;
#pragma unroll
                for (int jx = 0; jx < 4; ++jx) gs += expf(gl[jx] - gm);
                const float gp = 1.f / gs;
                float m1 = -1e30f, m2 = -1e30f; int i1 = 0, i2 = 0;
#pragma unroll
                for (int jx = 0; jx < 8; ++jx) { const float v = (l0[4 + gt * 8 + jx] + l1[4 + gt * 8 + jx]) * r2 + b_re[gt * 8 + jx];
                    if (v > m1) { m2 = m1; i2 = i1; m1 = v; i1 = jx; } else if (v > m2) { m2 = v; i2 = jx; } }
                const float e2 = expf(m2 - m1), w1 = gp / (1.f + e2), w2 = gp * e2 / (1.f + e2);
                const int E1 = gt * 8 + i1, E2 = gt * 8 + i2;
                LAS int* hist = (LAS int*)(F.lds + 32768); LAS int* base = hist + 32;
                if (F.tid < 32) hist[F.tid] = 0;
                asm volatile("s_waitcnt lgkmcnt(0)" ::: "memory");
                const int q1 = __hip_atomic_fetch_add(hist + E1, 1, __ATOMIC_RELAXED, __HIP_MEMORY_SCOPE_WORKGROUP), q2 = __hip_atomic_fetch_add(hist + E2, 1, __ATOMIC_RELAXED, __HIP_MEMORY_SCOPE_WORKGROUP);
                asm volatile("s_waitcnt lgkmcnt(0)" ::: "memory");
                if (F.tid < 32) { const int hc = hist[F.tid]; base[F.tid] = hc > 0 ? atomicAdd(&cnt[F.tid * 32], hc) : 0; }
                asm volatile("s_waitcnt vmcnt(0) lgkmcnt(0)" ::: "memory");
                const int p1 = base[E1] + q1, p2 = base[E2] + q2;
                lt[(size_t)E1 * T + p1] = t; lw[(size_t)E1 * T + p1] = w1; lr[(size_t)E1 * T + p1] = r2;
                lt[(size_t)E2 * T + p2] = t; lw[(size_t)E2 * T + p2] = w2; lr[(size_t)E2 * T + p2] = r2;
                tokE[t * 2] = E1; tokPos[t * 2] = p1; tokE[t * 2 + 1] = E2; tokPos[t * 2 + 1] = p2;
            }
            __syncthreads();
    }
}

__device__ __forceinline__ void final_rows(const Frame& F, KArgsP args, int row0, int nrow) {
    unsigned char* ws = args->ws; const int lane = F.lane;
    const float* ssq3p = (const float*)(ws + wsm::ssq3p); const float* gfin = args->in[27]; float* X = args->out; const bf16_t* x3b = (const bf16_t*)(ws + wsm::x3b);
    f32x4 gv[4];
#pragma unroll
    for (int jx = 0; jx < 2; ++jx) { gv[2 * jx] = ((const f32x4*)gfin)[2 * (lane + 64 * jx)]; gv[2 * jx + 1] = ((const f32x4*)gfin)[2 * (lane + 64 * jx) + 1]; }
    for (int t = row0 + F.wave; t < row0 + nrow; t += NWAVES) {
        float s = 0.f;
        if (lane < 16) s = ssq3p[(size_t)lane * T + t];
        s = wsum(s);
        const float r3 = rsqrtf(s * (1.f / D) + EPS);
        const u32x4* xr = (const u32x4*)(x3b + (size_t)t * D) + lane; f32x4* orow = (f32x4*)(X + (size_t)t * D);
#pragma unroll
        for (int jx = 0; jx < 2; ++jx) { const u32x4 w = xr[64 * jx];
            orow[2 * (lane + 64 * jx)] = (f32x4){bflo(w.x), bfhi(w.x), bflo(w.y), bfhi(w.y)} * r3 * gv[2 * jx];
            orow[2 * (lane + 64 * jx) + 1] = (f32x4){bflo(w.z), bfhi(w.z), bflo(w.w), bfhi(w.w)} * r3 * gv[2 * jx + 1]; }
    }
}
__device__ __forceinline__ void panel_sync(const Frame& F, gu32* cw) {
    asm volatile("s_waitcnt vmcnt(0)" ::: "memory");
    __syncthreads();
    if (F.tid == 0) {
        __builtin_amdgcn_fence(__ATOMIC_RELEASE, "agent"); asm volatile("s_waitcnt vmcnt(0)" ::: "memory");
        (void)__hip_atomic_fetch_add(cw, 1u, __ATOMIC_RELAXED, __HIP_MEMORY_SCOPE_AGENT);
        unsigned sp = 0; while (__hip_atomic_load(cw, __ATOMIC_RELAXED, __HIP_MEMORY_SCOPE_AGENT) < 4u) { __builtin_amdgcn_s_sleep(2); if (++sp > (1u << 22)) break; }
        __builtin_amdgcn_fence(__ATOMIC_ACQUIRE, "agent"); asm volatile("s_waitcnt vmcnt(0)" ::: "memory");
    }
    __syncthreads();
}

__global__ void __launch_bounds__(NTHR, 2) mk_fwd(Args) {
    const KArgsP args0 = kargs();
    extern __shared__ __attribute__((aligned(16))) unsigned char lds_raw[];
    Frame F; F.lds = (LAS unsigned char*)lds_raw; F.MISC = (volatile LAS unsigned*)(F.lds + MISC_OFF);
    F.tid = threadIdx.x; F.lane = F.tid & 63; F.wave = __builtin_amdgcn_readfirstlane(F.tid >> 6);
    F.G = gridDim.x; { const int bx = blockIdx.x; F.vcu = (F.G % 8 == 0) ? (bx % 8) * (F.G / 8) + bx / 8 : bx; }
    unsigned char* ws = args0->ws; F.ctl = (gu32*)(ws + wsm::ctl);
    for (int u = F.tid; u < (LDS_BYTES - LDSCTL_OFF) / 4; u += NTHR) ((LAS unsigned*)(F.lds + LDSCTL_OFF))[u] = 0u;
    __syncthreads();
    const int lo = args0->ph_lo, hi = args0->ph_hi;
    XcdBarrier bar = xcd_barrier_post((unsigned*)(F.ctl + CW_BAR) + (args0->mode >> 8) * XCD_BAR_WORDS, F.MISC + 8);
    int* cnt = (int*)(F.ctl + CW_CNT);
    const LAS int* tstart = (const LAS int*)(F.lds + MOE_TSTART); const LAS int* cntl = (const LAS int*)(F.lds + MOE_CNTL); const LAS int* rowtab = (const LAS int*)(F.lds + MOE_ROWTAB);
    const int gw = F.vcu * NWAVES + F.wave, NGW = F.G * NWAVES, lane = F.lane;
#ifndef PHASE_MASK
#define PHASE_MASK 0x7ffu
#endif
#define IN(k) ((((PHASE_MASK) >> (k)) & 1u) && lo <= (k) && (k) < hi)
#ifdef MK_STAMPS
    unsigned long long* tsg = (unsigned long long*)(F.ctl + 14336);
#define STAMP(k) do { if (blockIdx.x == 0 && F.tid == 0) tsg[k] = __builtin_amdgcn_s_memrealtime(); } while (0)
#else
#define STAMP(k) do { } while (0)
#endif
#define GRID_BAR(k) do { if (IN(k) && IN((k) + 1)) xcd_barrier(bar); STAMP((k) + 1); } while (0)
    STAMP(0);
    const bool fused = false;
    const bool merged = lo <= 5 && hi >= 8;
    if (IN(0)) { const KArgsP args = kargs(); p0_prologue(F, args); __syncthreads(); }
    GRID_BAR(0);
    if (IN(1)) { const KArgsP args = kargs();
        { pg8::DenseOrder S; S.init((const bf16_t*)(ws + wsm::xb), (const bf16_t*)(ws + wsm::w_in_t), T, NPROJ, D, F.G, (int)blockIdx.x);
          pg8::EpiScaleBf16 E{(bf16_t*)(ws + wsm::projb), (const float*)(ws + wsm::r0), NPROJ, 0};
          pg8::gemm_phase<pg8::EpiScaleBf16, pg8::DenseOrder, true, false>(F.lds, D, S, E); }
        { pg8::DenseOrder S; S.init((const bf16_t*)(ws + wsm::pb), (const bf16_t*)(ws + wsm::w_pp_t), T, D, PLE, F.G, (int)blockIdx.x);
          pg8::EpiScaleBf16 E{(bf16_t*)(ws + wsm::pp), nullptr, D, 0};
          pg8::gemm_phase<pg8::EpiScaleBf16, pg8::DenseOrder, true, false>(F.lds, PLE, S, E); }
    }
    GRID_BAR(1);
    if (IN(2)) { const KArgsP args = kargs();
        const bool conv_first = (F.G >= 256) && (blockIdx.x & 1);
        if (conv_first) { p0_experts(F, args, gw, NGW, 1); __syncthreads(); }
        STAMP(12);
        for (int it = blockIdx.x; it < 256 + 512; it += F.G) {
            if (it < 256) { lruA_unit(F, args, it >> 6, (it >> 3) & 7, it & 7); STAMP(13); }
            else { const int u = it - 256; attn_unit(F, args, u >> 7, u & 127); }
        }
        STAMP(14);
        if (F.G >= 256 && !conv_first) p0_experts(F, args, gw, NGW, 1);
        STAMP(15);
    }
    GRID_BAR(2);
    if (IN(3)) { const KArgsP args = kargs();
        for (int it = blockIdx.x; it < T / 64; it += F.G) lru_finish(F, args, it >> 6, it & 63);
    }
    GRID_BAR(3);
    if (IN(4)) { const KArgsP args = kargs();
        pg8::DenseOrder S; S.init((const bf16_t*)(ws + wsm::mix), (const bf16_t*)(ws + wsm::w_out_t), T, D, D, F.G, (int)blockIdx.x);
        pg8::EpiOutProj E{(const bf16_t*)(ws + wsm::xb), (bf16_t*)(ws + wsm::x1b), (float*)(ws + wsm::ssq1p)};
        pg8::gemm_phase<pg8::EpiOutProj, pg8::DenseOrder, true, false>(F.lds, D, S, E);
        if (fused) { pg8::Unit u; S.next(0, u); panel_sync(F, F.ctl + CW_PANA + 32 * u.pm); router_chunk(F, args, cnt, 4 * u.pm + u.pn); }
    }
    if (!fused) GRID_BAR(4);
    if (IN(5) && !fused) { const KArgsP args = kargs();
        for (int ch = F.vcu; ch < T / 64; ch += F.G) router_chunk(F, args, cnt, ch);
        if (merged && F.G >= 256) p0_experts(F, args, gw, NGW, 2);
    }
    GRID_BAR(5);
    if (IN(6)) { const KArgsP args = kargs();
        moe_tstart(F, cnt);
        pg8::MoeOrder S{tstart, cntl, rowtab, (const int*)(ws + wsm::lt), (const char*)(ws + wsm::x1b), (const char*)(ws + wsm::wgu_t), (size_t)1024 * D * 2, D, D, D, F.G, F.vcu, 1, merged ? F.ctl + CW_TILE : nullptr};
        moe_rowtab(F, S);
        pg8::EpiMoe1 E{(bf16_t*)(ws + wsm::hid), (const float*)(ws + wsm::lw), (const float*)(ws + wsm::lr)};
        pg8::gemm_phase<pg8::EpiMoe1, pg8::MoeOrder, true, true>(F.lds, D, S, E);
        const int U = 4 * __builtin_amdgcn_readfirstlane(tstart[NE]), nfull = U / F.G, Ex = U - nfull * F.G;
        if (merged) {
            pg8::Moe2Order S2{tstart, (const char*)(ws + wsm::hid), (const char*)(ws + wsm::wd_t), (size_t)D * FF * 2, F.ctl + CW_TILE, FF, FF, FF, F.G, F.vcu, Ex, F.G - Ex, U};
            pg8::EpiY E2{(bf16_t*)args->out, (bf16_t*)(ws + wsm::y2)};
            pg8::gemm_phase<pg8::EpiY, pg8::Moe2Order, true, false>(F.lds, FF, S2, E2);
        } else if (F.G >= 256 && F.vcu >= Ex) p0_experts(F, args, (F.vcu - Ex) * NWAVES + F.wave, (F.G - Ex) * NWAVES, 2);
    }
    GRID_BAR(6);
    if (IN(7) && !merged) { const KArgsP args = kargs();
        moe_tstart(F, cnt);
        pg8::MoeOrder S{tstart, cntl, rowtab, nullptr, (const char*)(ws + wsm::hid), (const char*)(ws + wsm::wd_t), (size_t)D * FF * 2, FF, FF, FF, F.G, F.vcu, 0, nullptr};
        pg8::EpiY E{(bf16_t*)args->out, (bf16_t*)(ws + wsm::y2)};
        pg8::gemm_phase<pg8::EpiY, pg8::MoeOrder, true, false>(F.lds, FF, S, E);
    }
    if (!merged) GRID_BAR(7);
    if (IN(8)) { const KArgsP args = kargs();
        moe_tstart(F, cnt);
        const bf16_t* y0 = (const bf16_t*)args->out; const bf16_t* y1 = (const bf16_t*)(ws + wsm::y2); const bf16_t* x1b = (const bf16_t*)(ws + wsm::x1b); bf16_t* x2b = (bf16_t*)(ws + wsm::x2b); float* rP = (float*)(ws + wsm::rP);
        const int* tokE = (const int*)(ws + wsm::tokE); const int* tokPos = (const int*)(ws + wsm::tokPos);
        for (int t = gw; t < T; t += NGW) {
            const size_t s1 = (size_t)tstart[tokE[2 * t]] * 256 + tokPos[2 * t], s2 = (size_t)tstart[tokE[2 * t + 1]] * 256 + tokPos[2 * t + 1];
            const u32x4* xr = (const u32x4*)(x1b + (size_t)t * D) + lane; const u32x4* ya = (const u32x4*)(s1 < 32768 ? y0 + s1 * D : y1 + (s1 - 32768) * D) + lane; const u32x4* yb = (const u32x4*)(s2 < 32768 ? y0 + s2 * D : y1 + (s2 - 32768) * D) + lane;
            u32x4* ob = (u32x4*)(x2b + (size_t)t * D) + lane; float s = 0.f;
#pragma unroll
            for (int jx = 0; jx < 2; ++jx) { const u32x4 xw = xr[64 * jx], a2 = ya[64 * jx], b2 = yb[64 * jx];
                float v[8] = {bflo(xw.x) + bflo(a2.x) + bflo(b2.x), bfhi(xw.x) + bfhi(a2.x) + bfhi(b2.x), bflo(xw.y) + bflo(a2.y) + bflo(b2.y), bfhi(xw.y) + bfhi(a2.y) + bfhi(b2.y),
                              bflo(xw.z) + bflo(a2.z) + bflo(b2.z), bfhi(xw.z) + bfhi(a2.z) + bfhi(b2.z), bflo(xw.w) + bflo(a2.w) + bflo(b2.w), bfhi(xw.w) + bfhi(a2.w) + bfhi(b2.w)};
                ob[64 * jx] = (u32x4){pk2(v[0], v[1]), pk2(v[2], v[3]), pk2(v[4], v[5]), pk2(v[6], v[7])};
                s += (v[0] * v[0] + v[1] * v[1]) + (v[2] * v[2] + v[3] * v[3]) + (v[4] * v[4] + v[5] * v[5]) + (v[6] * v[6] + v[7] * v[7]); }
            s = wsum(s);
            if (lane == 0) rP[t] = rsqrtf(s * (1.f / D) + EPS);
        }
    }
    GRID_BAR(8);
    if (IN(9)) { const KArgsP args = kargs();
        pg8::DenseOrder S; S.init((const bf16_t*)(ws + wsm::x2b), (const bf16_t*)(ws + wsm::w_pg_t), T, D, D, F.G, (int)blockIdx.x);
        pg8::EpiPle E{(const bf16_t*)(ws + wsm::x2b), (bf16_t*)(ws + wsm::x3b), (const bf16_t*)(ws + wsm::pp), (const float*)(ws + wsm::rP), (float*)(ws + wsm::ssq3p)};
        pg8::gemm_phase<pg8::EpiPle, pg8::DenseOrder, true, false>(F.lds, D, S, E);
        if (fused) { pg8::Unit u; S.next(0, u); panel_sync(F, F.ctl + CW_PANB + 32 * u.pm); final_rows(F, args, 256 * u.pm + 64 * u.pn, 64); }
    }
    if (!fused) GRID_BAR(9);
    if (IN(10) && !fused) { const KArgsP args = kargs();
        for (int r0 = F.vcu * 64; r0 < T; r0 += F.G * 64) final_rows(F, args, r0, 64);
    }
#ifdef MK_XBAR
    for (int i = 0; i < MK_XBAR; ++i) xcd_barrier(bar);
#endif
    STAMP(11);
#undef IN
#undef GRID_BAR
}
}

#ifndef MK_ONE_LAUNCH
#define MK_ONE_LAUNCH 1
#endif
#ifdef MK_STAMPS
__global__ void k_delay(const unsigned long long* ts, int k) {
    if (threadIdx.x == 0) { const int ka = k < 100 ? k : k / 100, kb = k < 100 ? k + 1 : k % 100; const unsigned long long d = (ts[kb] - ts[ka]) * 8ull, t0 = __builtin_amdgcn_s_memrealtime(); while (__builtin_amdgcn_s_memrealtime() - t0 < d) __builtin_amdgcn_s_sleep(8); }
}
#endif
extern "C" void kernel_launch(void* const* d_in, const int* in_sizes, int n_in, void* d_out, int out_size, void* d_ws, size_t ws_size, hipStream_t stream) {
    using namespace mk;
    const size_t MB = 1u << 20, KB = 1024;
    const size_t WS_END = wsm::END;
    static int grid = 0;
    if (grid == 0) {
        if (ws_size < WS_END || n_in != 28 || out_size != T * D) { fprintf(stderr, "kernel_launch: ws %zu < %zu or n_in %d or out %d\n", ws_size, (size_t)WS_END, n_in, out_size); grid = -1; return; }
        int dev = 0, cus = 0;
        if (hipGetDevice(&dev) != hipSuccess || hipDeviceGetAttribute(&cus, hipDeviceAttributeMultiprocessorCount, dev) != hipSuccess) { grid = -1; return; }
        if (hipFuncSetAttribute((const void*)mk_fwd, hipFuncAttributeMaxDynamicSharedMemorySize, LDS_BYTES) != hipSuccess) { fprintf(stderr, "hipFuncSetAttribute failed\n"); grid = -1; return; }
        grid = cus;
    }
    if (grid < 0) return;
    Args a{};
    for (int i = 0; i < 28; ++i) a.in[i] = (const float*)d_in[i];
    a.out = (float*)d_out; a.ws = (unsigned char*)d_ws;
    (void)hipMemsetAsync((char*)d_ws + wsm::ctl, 0, CTL_ZERO_BYTES, stream);
#if MK_ONE_LAUNCH
#ifdef MK_CUT
    a.ph_lo = 0; a.ph_hi = MK_CUT; hipLaunchKernelGGL(mk_fwd, dim3(grid), dim3(NTHR), LDS_BYTES, stream, a);
    a.ph_lo = MK_CUT; a.ph_hi = 11; a.mode = 256; hipLaunchKernelGGL(mk_fwd, dim3(grid), dim3(NTHR), LDS_BYTES, stream, a);
#else
    a.ph_lo = 0; a.ph_hi = 11; hipLaunchKernelGGL(mk_fwd, dim3(grid), dim3(NTHR), LDS_BYTES, stream, a);
#endif
#ifdef MK_STAMPS
    if (MK_STAMPS >= 0) k_delay<<<1, 64, 0, stream>>>((const unsigned long long*)((char*)d_ws + wsm::ctl + 14336 * 4), MK_STAMPS);
#endif
#ifdef MK_EXTRA
    a.out = (float*)((char*)d_ws + 16 * MB); a.ph_lo = MK_EXTRA; a.ph_hi = MK_EXTRA + 1;
#ifdef MK_MODE
    a.mode = MK_MODE;
#endif
    hipLaunchKernelGGL(mk_fwd, dim3(grid), dim3(NTHR), LDS_BYTES, stream, a);
#endif
#else
    for (int ph = 0; ph < 11; ++ph) { a.ph_lo = ph; a.ph_hi = ph + 1; hipLaunchKernelGGL(mk_fwd, dim3(grid), dim3(NTHR), LDS_BYTES, stream, a); }
#endif
}
```

```cpp
#define MK_TS_A 0
#define MK_TS_B 1
#define MK_DUP 6
#include <hip/hip_runtime.h>
#include <cstdio>
#include <cstdint>
#define GAS __attribute__((address_space(1)))
#define LAS __attribute__((address_space(3)))
typedef unsigned short bf16_t;
typedef short bf16x8 __attribute__((ext_vector_type(8)));
typedef float f32x4 __attribute__((ext_vector_type(4)));
typedef float f32x2 __attribute__((ext_vector_type(2)));
typedef unsigned u32x4 __attribute__((ext_vector_type(4)));
typedef unsigned u32x2 __attribute__((ext_vector_type(2)));
typedef GAS unsigned gu32;
typedef long i64x2 __attribute__((ext_vector_type(2)));
typedef int i32x4 __attribute__((ext_vector_type(4)));
typedef int i32x8 __attribute__((ext_vector_type(8)));

namespace mk {
constexpr int T = 16384, SEQ = 4096, D = 1024, NPROJ = 1792, PLE = 256;
constexpr int OFF_K = 512, OFF_V = 640, OFF_LX = 768, OFF_LG = 1280;
constexpr int NE = 32, FF = 512;
constexpr float EPS = 1e-6f;
constexpr int NWAVES = 8, NTHR = 512;
constexpr int RING_BYTES = 131072, LDSCTL_OFF = RING_BYTES, MISC_OFF = LDSCTL_OFF + 320, XTRA_OFF = RING_BYTES + 1024, LDS_BYTES = 147456;

__device__ __forceinline__ unsigned f2bf(float f) { unsigned u = __builtin_bit_cast(unsigned, f); return (u + 0x7fffu + ((u >> 16) & 1u)) >> 16; }
typedef __bf16 bf16x2_t __attribute__((ext_vector_type(2)));
__device__ __forceinline__ unsigned pk2(float lo, float hi) { f32x2 f = {lo, hi}; return __builtin_bit_cast(unsigned, __builtin_convertvector(f, bf16x2_t)); }
__device__ __forceinline__ float bf2f(unsigned short b) { return __builtin_bit_cast(float, (unsigned)b << 16); }
__device__ __forceinline__ float bflo(unsigned w) { return __builtin_bit_cast(float, w << 16); }
__device__ __forceinline__ float bfhi(unsigned w) { return __builtin_bit_cast(float, w & 0xffff0000u); }
__device__ __forceinline__ float wsum(float v) {
#pragma unroll
    for (int o = 1; o < 64; o <<= 1) v += __shfl_xor(v, o);
    return v;
}

namespace pg8 {
constexpr int BM = 256, BK = 64, HALF = 128, HTB = HALF * BK * 2, STAGE_BYTES = 8 * HTB, NXCD = 8, WGM = 8;
__device__ __forceinline__ int lds_byte(int r, int c) { const int st = (r >> 4) * 2 + (c >> 5), rr = r & 15, cc = c & 31, ob = rr * 64 + cc * 2; return st * 1024 + (ob ^ (((ob >> 9) & 1) << 5)); }
__device__ __forceinline__ void stage_rc(int b, int& R, int& C) { const int st = b / 1024, sb = b % 1024, swz = sb ^ (((sb >> 9) & 1) << 5); R = (st >> 1) * 16 + swz / 64; C = (st & 1) * 32 + (swz % 64) / 2; }
__device__ __forceinline__ int perm32(int rho) { const int n = rho >> 4, i = rho & 15; return 8 * (i >> 2) + 4 * n + (i & 3); }

struct Unit { int pm, pn, e, nrow, li0, ord; };

struct DenseOrder {
    const bf16_t* A; const bf16_t* Bt; int K, PA, PB, nM, nN, nwg, G, c;
    __device__ void init(const bf16_t* A_, const bf16_t* Bt_, int M, int N, int K_, int G_, int c_) { A = A_; Bt = Bt_; K = K_; PA = K_; PB = K_; nM = M / BM; nN = N / BM; nwg = nM * nN; G = G_; c = c_; }
    __device__ bool next(int i, Unit& u) const {
        const long L = (long)i * G + c; if (L >= nwg || c < 0) return false;
        int wgid = (int)L; { const int q = nwg / NXCD, r = nwg % NXCD, xcd = wgid % NXCD, off = wgid / NXCD; wgid = (xcd < r ? xcd * (q + 1) : r * (q + 1) + (xcd - r) * q) + off; }
        const int nig = WGM * nN, gid = wgid / nig, fm = gid * WGM, gsz = (nM - fm) < WGM ? (nM - fm) : WGM;
        u.pm = fm + ((wgid % nig) % gsz); u.pn = (wgid % nig) / gsz; u.e = 0; u.nrow = BM; u.li0 = 0; u.ord = i; return true;
    }
    __device__ const char* a_ptr(const Unit& u) const { return (const char*)A + (size_t)u.pm * BM * PA * 2; }
    __device__ const char* b_ptr(const Unit& u) const { return (const char*)Bt + (size_t)u.pn * BM * PB * 2; }
    __device__ unsigned a_row(const Unit&, int r) const { return (unsigned)r; }
    __device__ __forceinline__ void a_ready(const Unit&) const {}
    __device__ __forceinline__ void done(const Unit&) const {}
};

#define PG8_WAIT_V(n) asm volatile("s_waitcnt vmcnt(" #n ")" ::: "memory")
#define PG8_WAIT_L(n) asm volatile("s_waitcnt lgkmcnt(" #n ")" ::: "memory")
#define PG8_BAR __builtin_amdgcn_s_barrier()
#define PG8_SCHED __builtin_amdgcn_sched_barrier(0)

template <class Epi, class Sched, bool ALIGN_EPI, bool GATHER, int MMA = 0>
__device__ __forceinline__ void gemm_phase(LAS unsigned char* lds, const int K, const Sched& S, const Epi& E) {
    const int tid = threadIdx.x, wid = __builtin_amdgcn_readfirstlane(tid >> 6), lane = tid & 63, wr = wid >> 2, wc = wid & 3, fr = lane & 15, fq = lane >> 4;
    const int nt = K / BK; const int PA = S.PA, PB = S.PB;
    int Rr[2], Cc[2]; unsigned voffA[2], voffB[2];
#pragma unroll
    for (int i = 0; i < 2; ++i) { stage_rc(tid * 16 + i * 8192, Rr[i], Cc[i]); const int Rb = Epi::PERM ? ((Rr[i] & ~31) + perm32(Rr[i] & 31)) : Rr[i];
        voffA[i] = (unsigned)(Rr[i] * PA + Cc[i]) * 2u; voffB[i] = (unsigned)(Rb * PB + Cc[i]) * 2u; }
    const size_t kstep = (size_t)(BK * 2);
    const size_t hstepB = (size_t)HALF * PB * 2;
    const size_t hstepA = GATHER ? 0 : (size_t)HALF * PA * 2;
    const unsigned ldsw = (unsigned)wid * 1024u;
    const int aoff = lds_byte(wr * 64 + fr, fq * 8), boff = lds_byte(wc * 32 + fr, fq * 8);
#define PG8_SA(b, h) (((b) * 2 + (h)) * HTB)
#define PG8_SB(b, h) ((4 + (b) * 2 + (h)) * HTB)
#define PG8_ST2(bufoff, gbase, v0, v1) do { \
        __builtin_amdgcn_global_load_lds((const unsigned*)((const char*)(gbase) + (v0)), (LAS unsigned*)(lds + (bufoff) + ldsw), 16, 0, 0); \
        __builtin_amdgcn_global_load_lds((const unsigned*)((const char*)(gbase) + (v1)), (LAS unsigned*)(lds + (bufoff) + ldsw + 8192), 16, 0, 0); } while (0)
#define PG8_STB(bufoff, gbase) PG8_ST2(bufoff, gbase, voffB[0], voffB[1])
#define PG8_LDA(dst, b, h) do { _Pragma("unroll") for (int m = 0; m < 4; ++m) _Pragma("unroll") for (int k = 0; k < 2; ++k) dst[m][k] = *(const LAS bf16x8*)(lds + PG8_SA(b, h) + aoff + m * 2048 + k * 1024); } while (0)
#define PG8_LDB(dst, b, h) do { _Pragma("unroll") for (int n = 0; n < 2; ++n) _Pragma("unroll") for (int k = 0; k < 2; ++k) dst[n][k] = *(const LAS bf16x8*)(lds + PG8_SB(b, h) + boff + n * 2048 + k * 1024); } while (0)
#define PG8_MMA(ai, bj, At, Bt) do { __builtin_amdgcn_s_setprio(1); _Pragma("unroll") for (int m = 0; m < 4; ++m) _Pragma("unroll") for (int n = 0; n < 2; ++n) { \
        if constexpr (MMA == 0) { _Pragma("unroll") for (int k = 0; k < 2; ++k) acc[ai][bj][m][n] = __builtin_amdgcn_mfma_f32_16x16x32_bf16(Bt[n][k], At[m][k], acc[ai][bj][m][n], 0, 0, 0); } \
        else if constexpr (MMA == 1) { _Pragma("unroll") for (int k = 0; k < 2; ++k) { const i64x2 b2_ = __builtin_bit_cast(i64x2, Bt[n][k]), a2_ = __builtin_bit_cast(i64x2, At[m][k]); \
            acc[ai][bj][m][n] = __builtin_amdgcn_mfma_f32_16x16x32_fp8_fp8(b2_[0], a2_[0], acc[ai][bj][m][n], 0, 0, 0); acc[ai][bj][m][n] = __builtin_amdgcn_mfma_f32_16x16x32_fp8_fp8(b2_[1], a2_[1], acc[ai][bj][m][n], 0, 0, 0); } } \
        else { const i32x4 b0_ = __builtin_bit_cast(i32x4, Bt[n][0]), b1_ = __builtin_bit_cast(i32x4, Bt[n][1]), a0_ = __builtin_bit_cast(i32x4, At[m][0]), a1_ = __builtin_bit_cast(i32x4, At[m][1]); \
            acc[ai][bj][m][n] = __builtin_amdgcn_mfma_scale_f32_16x16x128_f8f6f4(__builtin_shufflevector(b0_, b1_, 0, 1, 2, 3, 4, 5, 6, 7), __builtin_shufflevector(a0_, a1_, 0, 1, 2, 3, 4, 5, 6, 7), acc[ai][bj][m][n], 0, 0, 0, 0x7f7f7f7f, 0, 0x7f7f7f7f); } \
        } __builtin_amdgcn_s_setprio(0); } while (0)
    Unit cur, nxt; int ui = 0;
    if (!S.next(0, cur)) return;
    f32x4 acc[2][2][4][2];
#pragma unroll
    for (int a = 0; a < 2; ++a)
#pragma unroll
        for (int b = 0; b < 2; ++b)
#pragma unroll
            for (int m = 0; m < 4; ++m)
#pragma unroll
                for (int n = 0; n < 2; ++n) acc[a][b][m][n] = (f32x4){0.f, 0.f, 0.f, 0.f};
    bf16x8 At[4][2], B0[2][2], B1[2][2];
    const char* cA = S.a_ptr(cur); const char* cB = S.b_ptr(cur);
    S.a_ready(cur);
    unsigned c00 = voffA[0], c01 = voffA[1], c10 = voffA[0], c11 = voffA[1];
    if constexpr (GATHER) {
        c00 = (S.a_row(cur, Rr[0]) * (unsigned)PA + (unsigned)Cc[0]) * 2u; c01 = (S.a_row(cur, Rr[1]) * (unsigned)PA + (unsigned)Cc[1]) * 2u;
        c10 = (S.a_row(cur, HALF + Rr[0]) * (unsigned)PA + (unsigned)Cc[0]) * 2u; c11 = (S.a_row(cur, HALF + Rr[1]) * (unsigned)PA + (unsigned)Cc[1]) * 2u;
    }
    PG8_STB(PG8_SB(0, 0), cB); PG8_STB(PG8_SB(0, 1), cB + hstepB); PG8_ST2(PG8_SA(0, 0), cA, c00, c01); PG8_ST2(PG8_SA(0, 1), cA + hstepA, c10, c11);
    if (wr == 1) PG8_BAR;
    PG8_WAIT_V(2); PG8_BAR;
    PG8_STB(PG8_SB(1, 0), cB + kstep); PG8_ST2(PG8_SA(1, 0), cA + kstep, c00, c01); PG8_STB(PG8_SB(1, 1), cB + hstepB + kstep);
    PG8_WAIT_V(6); PG8_BAR;
    for (;;) {
        const bool has_next = S.next(ui + 1, nxt);
        const char* nA = has_next ? S.a_ptr(nxt) : cA; const char* nB = has_next ? S.b_ptr(nxt) : cB;
        unsigned s00 = c00, s01 = c01, s10 = c10, s11 = c11;
        for (int t = 0; t < nt; t += 2) {
            const bool last = (t == nt - 2);
            const char* a1 = cA + (size_t)(t + 1) * kstep;
            const char* a2 = last ? nA : cA + (size_t)(t + 2) * kstep; const char* b2 = last ? nB : cB + (size_t)(t + 2) * kstep;
            const char* a3 = a2 + kstep; const char* b3 = b2 + kstep;
            if constexpr (GATHER) { if (last && has_next) {
                int R0, C0, R1, C1; stage_rc(tid * 16, R0, C0); stage_rc(tid * 16 + 8192, R1, C1);
                s00 = (S.a_row(nxt, R0) * (unsigned)PA + (unsigned)C0) * 2u; s01 = (S.a_row(nxt, R1) * (unsigned)PA + (unsigned)C1) * 2u;
                s10 = (S.a_row(nxt, HALF + R0) * (unsigned)PA + (unsigned)C0) * 2u; s11 = (S.a_row(nxt, HALF + R1) * (unsigned)PA + (unsigned)C1) * 2u; } }
            if constexpr (Epi::MIDSCALE) { if (t == nt / 2) E.midscale(acc, cur, wr, fr); }
            if (last && has_next) S.a_ready(nxt);
            PG8_LDB(B0, 0, 0); PG8_LDB(B1, 0, 1); PG8_SCHED; PG8_LDA(At, 0, 0); PG8_ST2(PG8_SA(1, 1), a1 + hstepA, c10, c11);
            PG8_WAIT_V(8); PG8_WAIT_L(0); PG8_BAR; PG8_MMA(0, 0, At, B0); PG8_MMA(0, 1, At, B1); PG8_BAR; PG8_SCHED;
            PG8_LDA(At, 0, 1); PG8_STB(PG8_SB(0, 0), b2); PG8_STB(PG8_SB(0, 1), b2 + hstepB); PG8_ST2(PG8_SA(0, 0), a2, s00, s01);
            PG8_WAIT_V(8); PG8_WAIT_L(0); PG8_BAR; PG8_MMA(1, 0, At, B0); PG8_MMA(1, 1, At, B1); PG8_BAR; PG8_SCHED;
            PG8_LDB(B0, 1, 0); PG8_LDB(B1, 1, 1); PG8_SCHED; PG8_LDA(At, 1, 0); PG8_ST2(PG8_SA(0, 1), a2 + hstepA, s10, s11);
            PG8_WAIT_V(8); PG8_WAIT_L(0); PG8_BAR; PG8_MMA(0, 0, At, B0); PG8_MMA(0, 1, At, B1); PG8_BAR; PG8_SCHED;
            PG8_LDA(At, 1, 1); PG8_STB(PG8_SB(1, 0), b3); PG8_STB(PG8_SB(1, 1), b3 + hstepB); PG8_ST2(PG8_SA(1, 0), a3, s00, s01);
            PG8_WAIT_V(8); PG8_WAIT_L(0); PG8_BAR; PG8_MMA(1, 0, At, B0); PG8_MMA(1, 1, At, B1); PG8_BAR; PG8_SCHED;
        }
        if constexpr (ALIGN_EPI) { if (wr == 0) PG8_BAR; }
        E(acc, cur, wr, wc, fr, fq);
        S.done(cur);
        if (!has_next) break;
#pragma unroll
        for (int a = 0; a < 2; ++a)
#pragma unroll
            for (int b = 0; b < 2; ++b)
#pragma unroll
                for (int m = 0; m < 4; ++m)
#pragma unroll
                    for (int n = 0; n < 2; ++n) acc[a][b][m][n] = (f32x4){0.f, 0.f, 0.f, 0.f};
        cur = nxt; cA = nA; cB = nB; ++ui;
        if constexpr (GATHER) { c00 = s00; c01 = s01; c10 = s10; c11 = s11; }
        if constexpr (ALIGN_EPI) { if (wr == 1) PG8_BAR; }
    }
    PG8_WAIT_V(0);
    if constexpr (!ALIGN_EPI) { if (wr == 0) PG8_BAR; }
    PG8_BAR;
#undef PG8_SA
#undef PG8_SB
#undef PG8_ST2
#undef PG8_STB
#undef PG8_LDA
#undef PG8_LDB
#undef PG8_MMA
}

struct EpiScaleBf16 {
    static constexpr bool PERM = true, MIDSCALE = false;
    bf16_t* O; const float* rs; int ldc; int pad;
    __device__ __forceinline__ void midscale(f32x4 (&)[2][2][4][2], const Unit&, int, int) const {}
    __device__ __forceinline__ void operator()(const f32x4 (&acc)[2][2][4][2], const Unit& u, int wr, int wc, int fr, int fq) const {
        const int row0 = u.pm * BM + wr * 64 + fr, col0 = u.pn * BM + wc * 32 + 8 * fq;
#pragma unroll
        for (int ai = 0; ai < 2; ++ai)
#pragma unroll
            for (int m = 0; m < 4; ++m) { const int row = row0 + ai * HALF + m * 16; const float s = rs ? rs[row] : 1.f; bf16_t* rowp = O + (size_t)row * ldc + col0;
#pragma unroll
                for (int bj = 0; bj < 2; ++bj) { const f32x4 v0 = acc[ai][bj][m][0] * s, v1 = acc[ai][bj][m][1] * s;
                    u32x4 w; w.x = pk2(v0[0], v0[1]); w.y = pk2(v0[2], v0[3]); w.z = pk2(v1[0], v1[1]); w.w = pk2(v1[2], v1[3]);
                    *(u32x4*)(rowp + bj * HALF) = w; } }
    }
};
}

#define XB_TMO      128
#define XB_XCNT(j)  (256  + 64 * (j))
#define XB_XSUB(j)  (1280 + 64 * (j))
#define XB_XGEN(j)  (2304 + 64 * (j))
#define XB_TOP      3328
#define XB_TOPGEN   3392
#define XCD_BAR_WORDS 3456
#define XB_SPIN_CAP (1u << 18)
__device__ __forceinline__ unsigned xb_ld(unsigned* p)              { return __hip_atomic_load(p, __ATOMIC_RELAXED, __HIP_MEMORY_SCOPE_AGENT); }
__device__ __forceinline__ unsigned xb_add(unsigned* p, unsigned v) { return __hip_atomic_fetch_add(p, v, __ATOMIC_RELAXED, __HIP_MEMORY_SCOPE_AGENT); }
__device__ __forceinline__ unsigned xb_xcc_id() { return (unsigned)__builtin_amdgcn_s_getreg((3 << 11) | 20) & 0xFu; }
#define XB_SPIN(cond, bar) do { unsigned _sp = 0; while (cond) { __builtin_amdgcn_s_sleep(1); \
    if ((++_sp & 255u) == 0u) { if (xb_ld(&(bar)[XB_TMO])) break; if (_sp > XB_SPIN_CAP) { atomicAdd(&(bar)[XB_TMO], 1u); break; } } } } while (0)
struct XcdBarrier { unsigned* bar; unsigned x; volatile LAS unsigned* st; };
__device__ __forceinline__ XcdBarrier xcd_barrier_post(unsigned* bar, volatile LAS unsigned* st) {
    XcdBarrier b; b.bar = bar; b.x = xb_xcc_id(); b.st = st;
    if (threadIdx.x == 0) (void)xb_add(&bar[XB_XCNT(b.x)], 1u);
    return b;
}
__device__ __forceinline__ void xcd_barrier_complete(unsigned* bar, unsigned x, unsigned& nloc, unsigned& nx) {
    const unsigned G = gridDim.x * gridDim.y * gridDim.z;
    unsigned sum, cnt, mine, sp = 0u;
    for (;;) {
        sum = 0u; cnt = 0u; mine = 0u;
#pragma unroll
        for (unsigned j = 0; j < 16; ++j) { const unsigned c = xb_ld(&bar[XB_XCNT(j)]); sum += c; cnt += (c > 0u) ? 1u : 0u; mine = (j == x) ? c : mine; }
        if (sum == G) break;
        __builtin_amdgcn_s_sleep(1);
        if ((++sp & 255u) == 0u) { if (xb_ld(&bar[XB_TMO])) break; if (sp > XB_SPIN_CAP) { atomicAdd(&bar[XB_TMO], 1u); break; } }
    }
    nloc = mine > 0u ? mine : 1u; nx = cnt > 0u ? cnt : 1u;
}
__device__ __forceinline__ void xcd_barrier(const XcdBarrier& b) {
    asm volatile("s_waitcnt vmcnt(0)" ::: "memory");
    __syncthreads();
    if (threadIdx.x == 0) {
        unsigned* bar = b.bar;
        __builtin_amdgcn_s_waitcnt(0);
        unsigned nloc = b.st[0], nx = b.st[1];
        if (nloc == 0u) { xcd_barrier_complete(bar, b.x, nloc, nx); b.st[0] = nloc; b.st[1] = nx; }
        const unsigned old = xb_add(&bar[XB_XSUB(b.x)], 1u);
        const unsigned gen = old / nloc;
        if (old + 1u == (gen + 1u) * nloc) {
            __builtin_amdgcn_fence(__ATOMIC_RELEASE, "agent");
            asm volatile("s_waitcnt vmcnt(0)" ::: "memory");
            const unsigned og = xb_add(&bar[XB_TOP], 1u);
            const unsigned tg = og / nx;
            if (og + 1u == (tg + 1u) * nx) xb_add(&bar[XB_TOPGEN], 1u);
            else XB_SPIN(xb_ld(&bar[XB_TOPGEN]) == tg, bar);
            __builtin_amdgcn_fence(__ATOMIC_ACQUIRE, "agent");
            xb_add(&bar[XB_XGEN(b.x)], 1u);
            asm volatile("s_waitcnt vmcnt(0)" ::: "memory");
        } else {
            XB_SPIN(xb_ld(&bar[XB_XGEN(b.x)]) == gen, bar);
            __builtin_amdgcn_fence(__ATOMIC_ACQUIRE, "agent");
            asm volatile("s_waitcnt vmcnt(0)" ::: "memory");
        }
    }
    __syncthreads();
}


constexpr size_t MiB = 1u << 20;
constexpr size_t WS_CTL = 0, CTL_ZERO_BYTES = 64 * 1024;
constexpr int CW_BAR = 1024;
constexpr int CW_CNT = 8192;
constexpr int CW_TILE = 5120;
constexpr int CW_PANA = 9216, CW_PANB = 11264;

__device__ __forceinline__ void p0_transpose_item(const float* W, int K, int N, const float* ks, bf16_t* WT, int rbase, int gshift, int gstride, LAS float* scr, int item, int lane) {
    const int nblk = N / 32, kb = item / nblk, nb = item % nblk, k0 = 64 * kb, n0 = 32 * nb;
#pragma unroll 8
    for (int i = 0; i < 32; ++i) { const int kk = 2 * i + (lane >> 5); const float s = ks ? ks[k0 + kk] : 1.f; scr[kk * 33 + (lane & 31)] = W[(size_t)(k0 + kk) * N + n0 + (lane & 31)] * s; }
    asm volatile("s_waitcnt lgkmcnt(0)" ::: "memory");
    const int c = lane & 7;
#pragma unroll
    for (int j = 0; j < 4; ++j) { const int nl = (lane >> 3) + 8 * j, n = n0 + nl; const LAS float* s = scr + (8 * c) * 33 + nl;
        const int row = rbase + (n >> gshift) * gstride + (n & ((1 << gshift) - 1));
        u32x4 o; o.x = pk2(s[0 * 33], s[1 * 33]); o.y = pk2(s[2 * 33], s[3 * 33]); o.z = pk2(s[4 * 33], s[5 * 33]); o.w = pk2(s[6 * 33], s[7 * 33]);
        *(u32x4*)(WT + (size_t)row * K + k0 + 8 * c) = o; }
    asm volatile("s_waitcnt lgkmcnt(0)" ::: "memory");
}

constexpr size_t MB_ = 1u << 20, KB_ = 1024;
namespace wsm {
constexpr size_t ctl = 0, r0 = 64 * KB_, rL = 128 * KB_, r2 = 192 * KB_, rP = 256 * KB_, tokE = 320 * KB_, tokPos = 448 * KB_,
    rope = 1 * MB_, wtot = 5 * MB_, ctot = 6 * MB_, ssq1p = 7 * MB_, ssq3p = 8 * MB_, lt = 9 * MB_, lw = 11 * MB_, lr = 13 * MB_, wr_t = 15 * MB_, wag_t = 15 * MB_ + 512 * KB_,
    w_in_t = 16 * MB_, w_out_t = 20 * MB_, wgu_t = 22 * MB_  , projb = 86 * MB_, x1q = 86 * MB_  , x1b = 110 * MB_,
    wd_t = 142 * MB_, w_pg_t = 174 * MB_, w_pp_t = 176 * MB_,
    xb = 177 * MB_, x2b = 177 * MB_, pb = 209 * MB_, mix = 209 * MB_, hid = 209 * MB_, x3b = 110 * MB_, pp = 249 * MB_, y2 = 54 * MB_, END = 281 * MB_;
}
struct Args {
    const float* in[28]; float* out; unsigned char* ws;
    int ph_lo, ph_hi, mode, pad;
};
typedef const __attribute__((address_space(4))) Args* KArgsP;
__device__ __forceinline__ KArgsP kargs() { KArgsP p = (KArgsP)__builtin_amdgcn_kernarg_segment_ptr(); asm volatile("" : "+s"(p)); return p; }
struct Frame {
    LAS unsigned char* lds; volatile LAS unsigned* MISC; gu32* ctl;
    int tid, lane, wave, vcu, G;
};
__device__ __forceinline__ float fexp2(float x) { return __builtin_amdgcn_exp2f(x); }
__device__ __forceinline__ float fexp(float x) { return __builtin_amdgcn_exp2f(x * 1.4426950408889634f); }
__device__ __forceinline__ float frcp(float x) { return __builtin_amdgcn_rcpf(x); }
__device__ __forceinline__ float fsigmoid(float x) { return frcp(1.f + fexp(-x)); }
__device__ __forceinline__ float fgelu_tanh(float x) {
    const float u = 0.7978845608028654f * (x + 0.044715f * x * x * x);
    return x * (1.f - frcp(1.f + fexp(2.f * u)));
}

__device__ __forceinline__ void p0_tr64(const float* W, int K, int N, const float* ks, bf16_t* WT, int rbase, int gshift, int gstride, LAS unsigned* t2, int item, int lane) {
    const int nblk = N / 64, kb = item / nblk, nb = item % nblk, k0 = 64 * kb, n0 = 64 * nb;
    const int n4 = lane & 15, kr = lane >> 4;
    f32x4 va[8], vb[8];
#pragma unroll
    for (int i = 0; i < 8; ++i) { const int k = k0 + 8 * i + 2 * kr; va[i] = *(const f32x4*)(W + (size_t)k * N + n0 + 4 * n4); vb[i] = *(const f32x4*)(W + (size_t)(k + 1) * N + n0 + 4 * n4); }
#pragma unroll
    for (int i = 0; i < 8; ++i) { const int k = k0 + 8 * i + 2 * kr, kp = 4 * i + kr; const float s0 = ks ? ks[k] : 1.f, s1 = ks ? ks[k + 1] : 1.f;
        LAS unsigned* d = t2 + (4 * n4) * 33 + kp;
        d[0] = pk2(va[i].x * s0, vb[i].x * s1); d[33] = pk2(va[i].y * s0, vb[i].y * s1); d[66] = pk2(va[i].z * s0, vb[i].z * s1); d[99] = pk2(va[i].w * s0, vb[i].w * s1); }
    asm volatile("s_waitcnt lgkmcnt(0)" ::: "memory");
    const int nl = lane >> 3, c = lane & 7;
#pragma unroll
    for (int j = 0; j < 8; ++j) { const int n = 8 * j + nl; const LAS unsigned* s = t2 + n * 33 + 4 * c; const int ng = n0 + n;
        const int row = rbase + (ng >> gshift) * gstride + (ng & ((1 << gshift) - 1));
        *(u32x4*)(WT + (size_t)row * K + k0 + 8 * c) = (u32x4){s[0], s[1], s[2], s[3]}; }
    asm volatile("s_waitcnt lgkmcnt(0)" ::: "memory");
}

__device__ __forceinline__ unsigned pk4_fp8(float a, float b, float c, float d) {
    int w = 0; w = __builtin_amdgcn_cvt_pk_fp8_f32(a, b, w, false); w = __builtin_amdgcn_cvt_pk_fp8_f32(c, d, w, true); return (unsigned)w;
}
#ifndef MOE_MMA
#define MOE_MMA 1
#endif
constexpr float WQ_SCALE = 32.f, HQ_SCALE = 32.f, YQ_SCALE = 64.f;
__device__ __forceinline__ void p0_tr64_q(const float* W, int K, int N, const float* ks, unsigned char* WQ, int rbase, int gshift, int gstride, LAS unsigned* t4, int item, int lane) {
    const int nblk = N / 64, kb = item / nblk, nb = item % nblk, k0 = 64 * kb, n0 = 64 * nb;
    const int n4 = lane & 15, kr = lane >> 4;
    f32x4 v[4][4];
#pragma unroll
    for (int i = 0; i < 4; ++i)
#pragma unroll
        for (int r = 0; r < 4; ++r) v[i][r] = *(const f32x4*)(W + (size_t)(k0 + 16 * i + 4 * kr + r) * N + n0 + 4 * n4);
#pragma unroll
    for (int i = 0; i < 4; ++i) { const int k = k0 + 16 * i + 4 * kr; float s[4];
#pragma unroll
        for (int r = 0; r < 4; ++r) s[r] = (ks ? ks[k + r] : 1.f) * WQ_SCALE;
        LAS unsigned* d = t4 + (4 * n4) * 17 + 4 * i + kr;
        d[0] = pk4_fp8(v[i][0].x * s[0], v[i][1].x * s[1], v[i][2].x * s[2], v[i][3].x * s[3]); d[17] = pk4_fp8(v[i][0].y * s[0], v[i][1].y * s[1], v[i][2].y * s[2], v[i][3].y * s[3]);
        d[34] = pk4_fp8(v[i][0].z * s[0], v[i][1].z * s[1], v[i][2].z * s[2], v[i][3].z * s[3]); d[51] = pk4_fp8(v[i][0].w * s[0], v[i][1].w * s[1], v[i][2].w * s[2], v[i][3].w * s[3]); }
    asm volatile("s_waitcnt lgkmcnt(0)" ::: "memory");
    const int nl = lane >> 2, c = lane & 3;
#pragma unroll
    for (int j = 0; j < 4; ++j) { const int n = 16 * j + nl; const LAS unsigned* s = t4 + n * 17 + 4 * c; const int ng = n0 + n;
        const int row = rbase + (ng >> gshift) * gstride + (ng & ((1 << gshift) - 1));
        *(u32x4*)(WQ + (size_t)row * K + k0 + 16 * c) = (u32x4){s[0], s[1], s[2], s[3]}; }
    asm volatile("s_waitcnt lgkmcnt(0)" ::: "memory");
}

__device__ __forceinline__ void p0_experts(const Frame& F, KArgsP a, int w, int nw, int part) {
    LAS unsigned* t2 = (LAS unsigned*)(F.lds + F.wave * 8704); unsigned char* ws = a->ws; const int lane = F.lane;
    const float* g_ffn = a->in[16]; const float* w_eg = a->in[21]; const float* w_eu = a->in[22]; const float* w_ed = a->in[23];
    constexpr int I_G = (D / 64) * (FF / 64), I_D = (FF / 64) * (D / 64);
    if (part & 1) for (int r = w; r < NE * 2 * I_G; r += nw) { const int e = r / (2 * I_G), q = r % (2 * I_G), up = q / I_G, item = q % I_G;
        p0_tr64_q((up ? w_eu : w_eg) + (size_t)e * D * FF, D, FF, g_ffn, (unsigned char*)(ws + wsm::wgu_t) + (size_t)e * 1024 * D, 128 * up, 7, 256, t2, item, lane); }
    if (part & 2) for (int r = w; r < NE * I_D; r += nw) { const int e = r / I_D, item = r % I_D;
        p0_tr64_q(w_ed + (size_t)e * FF * D, FF, D, nullptr, (unsigned char*)(ws + wsm::wd_t) + (size_t)e * D * FF, 0, 30, 0, t2, item, lane); }
}
__device__ __forceinline__ void p0_prologue(const Frame& F, KArgsP a) {
    LAS unsigned* t2 = (LAS unsigned*)(F.lds + F.wave * 8704);
    const int gw = F.vcu * NWAVES + F.wave, NGW = F.G * NWAVES, lane = F.lane;
    unsigned char* ws = a->ws;
    const float* w_in = a->in[4]; const float* g_mix = a->in[3]; const float* w_out = a->in[15]; const float* g_attn = a->in[13]; const float* g_lru = a->in[14];
    const float* g_ffn = a->in[16];
    const float* g_ple = a->in[24]; const float* w_pg = a->in[25]; const float* w_pp = a->in[26];
    constexpr int I_IN = (D / 64) * (NPROJ / 64), I_OUT = (D / 64) * (D / 64), I_PG = I_OUT, I_PP = (PLE / 64) * (D / 64);
    constexpr int NITEMS = I_IN + I_OUT + I_PG + I_PP;
    for (int it = gw; it < NITEMS; it += NGW) {
        int r = it;
        if (r < I_IN) { p0_tr64(w_in, D, NPROJ, g_mix, (bf16_t*)(ws + wsm::w_in_t), 0, 30, 0, t2, r, lane); continue; } r -= I_IN;
        if (r < I_PP) { p0_tr64(w_pp, PLE, D, nullptr, (bf16_t*)(ws + wsm::w_pp_t), 0, 30, 0, t2, r, lane); continue; } r -= I_PP;
        if (r < I_OUT) { const int kb = r / (D / 64); const float* ks = kb < 8 ? g_attn : g_lru - 512; p0_tr64(w_out, D, D, ks, (bf16_t*)(ws + wsm::w_out_t), 0, 30, 0, t2, r, lane); continue; } r -= I_OUT;
        p0_tr64(w_pg, D, D, g_ple, (bf16_t*)(ws + wsm::w_pg_t), 0, 30, 0, t2, r, lane);
    }
    if (F.G < 256) p0_experts(F, a, gw, NGW, 3);
    const float* x = a->in[0]; bf16_t* xb = (bf16_t*)(ws + wsm::xb); float* r0 = (float*)(ws + wsm::r0);
    for (int m = gw; m < T; m += 2 * NGW) {
        const int m2 = m + NGW;
        const f32x4* xr = (const f32x4*)(x + (size_t)m * D) + lane; const f32x4* xr2 = (const f32x4*)(x + (size_t)(m2 < T ? m2 : m) * D) + lane; f32x4 v[4], v2[4]; float s = 0.f, s2 = 0.f;
#pragma unroll
        for (int j = 0; j < 4; ++j) { v[j] = xr[64 * j]; v2[j] = xr2[64 * j]; }
#pragma unroll
        for (int j = 0; j < 4; ++j) { s += (v[j].x * v[j].x + v[j].y * v[j].y) + (v[j].z * v[j].z + v[j].w * v[j].w); s2 += (v2[j].x * v2[j].x + v2[j].y * v2[j].y) + (v2[j].z * v2[j].z + v2[j].w * v2[j].w); }
        s = wsum(s); s2 = wsum(s2);
        u32x2* o8 = (u32x2*)(xb + (size_t)m * D) + lane;
#pragma unroll
        for (int j = 0; j < 4; ++j) { u32x2 w; w.x = pk2(v[j].x, v[j].y); w.y = pk2(v[j].z, v[j].w); o8[64 * j] = w; }
        if (lane == 0) r0[m] = rsqrtf(s * (1.f / D) + EPS);
        if (m2 < T) { u32x2* o9 = (u32x2*)(xb + (size_t)m2 * D) + lane;
#pragma unroll
            for (int j = 0; j < 4; ++j) { u32x2 w; w.x = pk2(v2[j].x, v2[j].y); w.y = pk2(v2[j].z, v2[j].w); o9[64 * j] = w; }
            if (lane == 0) r0[m2] = rsqrtf(s2 * (1.f / D) + EPS); }
    }
    const float* p = a->in[1]; bf16_t* pb = (bf16_t*)(ws + wsm::pb);
    for (int m = gw; m < T; m += NGW) { const f32x4 v = ((const f32x4*)(p + (size_t)m * PLE))[lane]; u32x2 w; w.x = pk2(v.x, v.y); w.y = pk2(v.z, v.w); ((u32x2*)(pb + (size_t)m * PLE))[lane] = w; }
    const int* pos = (const int*)a->in[2]; f32x2* rope = (f32x2*)(ws + wsm::rope);
    for (int idx = (F.vcu * NTHR + F.tid); idx < T * 32; idx += F.G * NTHR) { const int t = idx >> 5, i = idx & 31;
        const float inv_freq = powf(10000.f, -(float)(2 * i) / 64.f); const float ang = (float)pos[t] * inv_freq; float sn, cs; sincosf(ang, &sn, &cs); rope[idx] = (f32x2){cs, sn}; }
    { const float* wa = a->in[8]; const float* wx = a->in[10]; bf16_t* wag_t = (bf16_t*)(ws + wsm::wag_t);
      for (int idx = (F.vcu * NTHR + F.tid); idx < 8 * 2 * 64 * 64; idx += F.G * NTHR) { const int i = idx & 63, j = (idx >> 6) & 63, gt = (idx >> 12) & 1, hb = idx >> 13;
          const float v = (gt ? wx : wa)[(size_t)(hb * 64 + i) * 64 + j]; wag_t[idx] = (bf16_t)(pk2(v, 0.f) & 0xffffu); } }
    const float* w_rg = a->in[17]; const float* w_re = a->in[19]; bf16_t* wr_t = (bf16_t*)(ws + wsm::wr_t);
    for (int idx = (F.vcu * NTHR + F.tid); idx < 48 * D; idx += F.G * NTHR) { const int j = idx >> 10, k = idx & 1023;
        float v = 0.f; if (j < 4) v = w_rg[k * 4 + j] * g_ffn[k]; else if (j < 36) v = w_re[k * 32 + (j - 4)] * g_ffn[k];
        wr_t[idx] = (bf16_t)(pk2(v, 0.f) & 0xffffu); }
}

constexpr int LB = 512;
constexpr int LRU_XS = 0, LRU_XS_PITCH = 144;
constexpr int LRU_WTL = LRU_XS + LB * LRU_XS_PITCH;
static_assert(LRU_WTL + 4096 <= RING_BYTES, "lru lds");

__device__ __forceinline__ void lruA_unit(const Frame& F, KArgsP a, int b, int hb, int chunk) {
    LAS unsigned char* lds = F.lds; const int tid = F.tid, lane = F.lane, wave = F.wave;
    unsigned char* ws = a->ws;
    const bf16_t* projb = (const bf16_t*)(ws + wsm::projb); bf16_t* hl = (bf16_t*)a->out; bf16_t* pl = hl + (size_t)T * 512;
    float* wtot = (float*)(ws + wsm::wtot); float* ctot = (float*)(ws + wsm::ctot); const bf16_t* wag_t = (const bf16_t*)(ws + wsm::wag_t);
    const float* cw = a->in[6]; const float* cb = a->in[7]; const float* ba = a->in[9]; const float* bx = a->in[11]; const float* lam = a->in[12];
    const int s0 = chunk * LB; const size_t t0 = (size_t)b * SEQ + s0;
    { const int q8 = tid & 7, cch = hb * 64 + q8 * 8;
      float cwr[4][8], cbr[8];
#pragma unroll
      for (int j = 0; j < 4; ++j)
#pragma unroll
          for (int e = 0; e < 8; ++e) cwr[j][e] = cw[j * 512 + cch + e];
#pragma unroll
      for (int e = 0; e < 8; ++e) cbr[e] = cb[cch + e];
#pragma unroll 1
      for (int i = 0; i < 2; ++i) {
          const int tq = (tid >> 3) + 64 * i;
          float xv[4][8];
#pragma unroll
          for (int tk = 0; tk < 4; ++tk)
#pragma unroll
              for (int e = 0; e < 8; ++e) xv[tk][e] = cbr[e];
          u32x4 w[7];
#pragma unroll
          for (int m = 0; m < 7; ++m) { const int sj = s0 + 4 * tq - 3 + m; const int sc = sj < 0 ? 0 : sj;
              w[m] = *(const u32x4*)(projb + ((size_t)b * SEQ + sc) * NPROJ + OFF_LX + cch); }
#pragma unroll
          for (int m = 0; m < 7; ++m) { const bool ok = (s0 + 4 * tq - 3 + m) >= 0; const u32x4 ww = w[m];
              const float r[8] = {ok ? bflo(ww.x) : 0.f, ok ? bfhi(ww.x) : 0.f, ok ? bflo(ww.y) : 0.f, ok ? bfhi(ww.y) : 0.f, ok ? bflo(ww.z) : 0.f, ok ? bfhi(ww.z) : 0.f, ok ? bflo(ww.w) : 0.f, ok ? bfhi(ww.w) : 0.f};
#pragma unroll
              for (int tk = 0; tk < 4; ++tk) { const int j = m - tk; if (j >= 0 && j < 4) {
#pragma unroll
                  for (int e = 0; e < 8; ++e) xv[tk][e] += cwr[j][e] * r[e]; } } }
#pragma unroll
          for (int tk = 0; tk < 4; ++tk)
              *(LAS u32x4*)(lds + LRU_XS + (4 * tq + tk) * LRU_XS_PITCH + q8 * 16) = (u32x4){pk2(xv[tk][0], xv[tk][1]), pk2(xv[tk][2], xv[tk][3]), pk2(xv[tk][4], xv[tk][5]), pk2(xv[tk][6], xv[tk][7])};
      } }
    __syncthreads();
#ifdef MK_STAMPS
    if (blockIdx.x == 0 && tid == 0) ((unsigned long long*)(F.ctl + 14336))[16] = __builtin_amdgcn_s_memrealtime();
#endif
    const int cl = lane & 15, kq = lane >> 4, tb0 = 64 * wave;
    bf16x8 af[4][2];
#pragma unroll
    for (int mt = 0; mt < 4; ++mt)
#pragma unroll
        for (int ks = 0; ks < 2; ++ks) af[mt][ks] = *(const LAS bf16x8*)(lds + LRU_XS + (tb0 + 16 * mt + cl) * LRU_XS_PITCH + (32 * ks + 8 * kq) * 2);
    LAS float* wtl = (LAS float*)(lds + LRU_WTL);
#pragma unroll 1
    for (int nt = 0; nt < 4; ++nt) {
        const int c = hb * 64 + nt * 16 + cl;
        bf16x8 wfa[2], wfx[2];
#pragma unroll
        for (int ks = 0; ks < 2; ++ks) { const bf16_t* s = wag_t + ((size_t)(hb * 2) * 64 + nt * 16 + cl) * 64 + 32 * ks + 8 * kq; wfa[ks] = *(const bf16x8*)s; wfx[ks] = *(const bf16x8*)(s + 64 * 64); }
        const float bac = ba[c], bxc = bx[c];
        const float spc = log1pf(expf(-lam[c])) * (-8.f * 1.4426950408889634f);
        float av[4][4], bv[4][4], Aex[4], Hex[4], At[4], Ht[4];
#pragma unroll
        for (int mt = 0; mt < 4; ++mt) {
            f32x4 ga = {0.f, 0.f, 0.f, 0.f}, gx = {0.f, 0.f, 0.f, 0.f};
#pragma unroll
            for (int ks = 0; ks < 2; ++ks) { ga = __builtin_amdgcn_mfma_f32_16x16x32_bf16(af[mt][ks], wfa[ks], ga, 0, 0, 0); gx = __builtin_amdgcn_mfma_f32_16x16x32_bf16(af[mt][ks], wfx[ks], gx, 0, 0, 0); }
            float A4 = 1.f, H4 = 0.f;
#pragma unroll
            for (int r = 0; r < 4; ++r) { const int tt = tb0 + 16 * mt + 4 * kq + r;
                const float xc = bf2f(*(const LAS unsigned short*)(lds + LRU_XS + tt * LRU_XS_PITCH + (16 * nt + cl) * 2));
                const float rg = fsigmoid(ga[r] + bac), ig = fsigmoid(gx[r] + bxc);
                const float aa = fexp2(rg * spc), mult = sqrtf(fmaxf(1.f - aa * aa, 0.f));
                const float bb = mult * ig * xc;
                av[mt][r] = aa; bv[mt][r] = bb; H4 = aa * H4 + bb; A4 *= aa; }
            { float Ap = __shfl_up(A4, 16), Hp = __shfl_up(H4, 16); if (kq >= 1) { H4 = A4 * Hp + H4; A4 = Ap * A4; }
              Ap = __shfl_up(A4, 32); Hp = __shfl_up(H4, 32); if (kq >= 2) { H4 = A4 * Hp + H4; A4 = Ap * A4; } }
            { const float Ae = __shfl_up(A4, 16), He = __shfl_up(H4, 16); Aex[mt] = kq >= 1 ? Ae : 1.f; Hex[mt] = kq >= 1 ? He : 0.f; }
            At[mt] = __shfl(A4, 48 + cl); Ht[mt] = __shfl(H4, 48 + cl);
        }
        float hin = 0.f, pin = 1.f;
#pragma unroll
        for (int mt = 0; mt < 4; ++mt) {
            float h = Aex[mt] * hin + Hex[mt], pr = Aex[mt] * pin; float hv[4], pv[4];
#pragma unroll
            for (int r = 0; r < 4; ++r) { h = av[mt][r] * h + bv[mt][r]; pr *= av[mt][r]; hv[r] = h; pv[r] = pr; }
            const size_t o = (((t0 + tb0 + 16 * mt) >> 2) + kq) * 2048 + (size_t)c * 4;
            *(u32x2*)(hl + o) = (u32x2){pk2(hv[0], hv[1]), pk2(hv[2], hv[3])}; *(u32x2*)(pl + o) = (u32x2){pk2(pv[0], pv[1]), pk2(pv[2], pv[3])};
            hin = At[mt] * hin + Ht[mt]; pin = At[mt] * pin;
        }
        if (kq == 0) { float* d = wtot + ((size_t)(b * 64 + chunk * 8 + wave) * 2) * 512 + c; d[0] = pin; d[512] = hin; wtl[(wave * 2) * 64 + nt * 16 + cl] = pin; wtl[(wave * 2 + 1) * 64 + nt * 16 + cl] = hin; }
    }
    __syncthreads();
    if (tid < 64) { float A = 1.f, H = 0.f;
#pragma unroll
        for (int w2 = 0; w2 < 8; ++w2) { const float a2 = wtl[(w2 * 2) * 64 + tid], h2 = wtl[(w2 * 2 + 1) * 64 + tid]; H = a2 * H + h2; A *= a2; }
        float* d = ctot + ((size_t)(b * 8 + chunk) * 2) * 512 + hb * 64 + tid; d[0] = A; d[512] = H; }
    __syncthreads();
}

__device__ __forceinline__ void lru_finish(const Frame& F, KArgsP a, int b, int wc) {
    LAS float* cl_ = (LAS float*)F.lds; const int tid = F.tid, lane = F.lane, wave = F.wave;
    unsigned char* ws = a->ws;
    const bf16_t* projb = (const bf16_t*)(ws + wsm::projb); const bf16_t* hl = (const bf16_t*)a->out; const bf16_t* pl = hl + (size_t)T * 512; bf16_t* mix = (bf16_t*)(ws + wsm::mix);
    const float* wtot = (const float*)(ws + wsm::wtot); const float* ctot = (const float*)(ws + wsm::ctot);
    { const int c = wc >> 3, sub = wc & 7; float h = 0.f;
      for (int c2 = 0; c2 < c; ++c2) { const float* s = ctot + ((size_t)(b * 8 + c2) * 2) * 512 + tid; h = s[0] * h + s[512]; }
      for (int w2 = 0; w2 < sub; ++w2) { const float* s = wtot + ((size_t)(b * 64 + c * 8 + w2) * 2) * 512 + tid; h = s[0] * h + s[512]; }
      cl_[tid] = h; }
    __syncthreads();
    float cr[8];
#pragma unroll
    for (int e = 0; e < 8; ++e) cr[e] = cl_[8 * lane + e];
#pragma unroll 1
    for (int i = 0; i < 2; ++i) {
        const size_t t = (size_t)b * SEQ + 64 * wc + 8 * wave + 4 * i;
        const u32x4* hp = (const u32x4*)(hl + ((t >> 2) * 512 + 8 * lane) * 4); const u32x4* pp4 = (const u32x4*)(pl + ((t >> 2) * 512 + 8 * lane) * 4);
        u32x4 hw[4], pw[4], gw4[4];
#pragma unroll
        for (int q = 0; q < 4; ++q) { hw[q] = hp[q]; pw[q] = pp4[q]; gw4[q] = *(const u32x4*)(projb + (t + q) * NPROJ + OFF_LG + 8 * lane); }
        float g[4][8], s[4] = {0.f, 0.f, 0.f, 0.f};
#pragma unroll
        for (int e = 0; e < 8; ++e) {
            const unsigned h01 = hw[e >> 1][(e & 1) * 2], h23 = hw[e >> 1][(e & 1) * 2 + 1], p01 = pw[e >> 1][(e & 1) * 2], p23 = pw[e >> 1][(e & 1) * 2 + 1];
            const float hv[4] = {bflo(h01), bfhi(h01), bflo(h23), bfhi(h23)}, pv[4] = {bflo(p01), bfhi(p01), bflo(p23), bfhi(p23)};
#pragma unroll
            for (int r = 0; r < 4; ++r) { const unsigned lw = gw4[r][e >> 1]; const float lg = (e & 1) ? bfhi(lw) : bflo(lw);
                g[r][e] = (hv[r] + pv[r] * cr[e]) * fgelu_tanh(lg); s[r] += g[r][e] * g[r][e]; }
        }
#pragma unroll
        for (int r = 0; r < 4; ++r) { const float rr = rsqrtf(wsum(s[r]) * (1.f / 512.f) + EPS);
            *(u32x4*)(mix + (t + r) * D + 512 + 8 * lane) = (u32x4){pk2(g[r][0] * rr, g[r][1] * rr), pk2(g[r][2] * rr, g[r][3] * rr), pk2(g[r][4] * rr, g[r][5] * rr), pk2(g[r][6] * rr, g[r][7] * rr)}; }
    }
    __syncthreads();
}

typedef float f32x16 __attribute__((ext_vector_type(16)));
typedef short s16x4 __attribute__((ext_vector_type(4)));
constexpr int AT_KP = 144;
constexpr int AT_NK = 160;
constexpr int AT_K = 0, AT_V = 2 * AT_NK * AT_KP;
constexpr int AT_LINV = XTRA_OFF + 256;
static_assert(2 * AT_V <= RING_BYTES && AT_LINV + 2048 <= LDS_BYTES, "attn lds");
__device__ __forceinline__ int crow(int reg, int h) { return (reg & 3) + 8 * (reg >> 2) + 4 * h; }
typedef LAS s16x4* lds_s16x4_p;
__device__ __forceinline__ s16x4 tr_rd(unsigned addr) { return __builtin_amdgcn_ds_read_tr16_b64_v4i16((lds_s16x4_p)(size_t)addr); }

template <int QB>
__device__ __forceinline__ void attn_qblock(const bf16_t* projb, const f32x2* rope, size_t tq0, int h, unsigned kbase, unsigned vbase, float sink2, int kmin, int r, int hh, LAS float* linv, f32x16& o0, f32x16& o1) {
    const size_t tq = tq0 + 32 * QB + r;
    bf16x8 qf[4];
    { const bf16_t* src = projb + tq * NPROJ + h * 64 + 8 * hh; const f32x2* cs = rope + tq * 32 + 8 * hh;
      const float qs = 0.125f * 1.4426950408889634f;
#pragma unroll
      for (int kp = 0; kp < 2; ++kp) {
          const u32x4 w1 = *(const u32x4*)(src + 16 * kp), w2 = *(const u32x4*)(src + 16 * (kp + 2));
          float x1[8] = {bflo(w1.x), bfhi(w1.x), bflo(w1.y), bfhi(w1.y), bflo(w1.z), bfhi(w1.z), bflo(w1.w), bfhi(w1.w)};
          float x2[8] = {bflo(w2.x), bfhi(w2.x), bflo(w2.y), bfhi(w2.y), bflo(w2.z), bfhi(w2.z), bflo(w2.w), bfhi(w2.w)};
          float y1[8], y2[8];
#pragma unroll
          for (int e = 0; e < 8; ++e) { const f32x2 c2 = cs[16 * kp + e]; y1[e] = (x1[e] * c2.x - x2[e] * c2.y) * qs; y2[e] = (x2[e] * c2.x + x1[e] * c2.y) * qs; }
          qf[kp] = __builtin_bit_cast(bf16x8, (u32x4){pk2(y1[0], y1[1]), pk2(y1[2], y1[3]), pk2(y1[4], y1[5]), pk2(y1[6], y1[7])});
          qf[kp + 2] = __builtin_bit_cast(bf16x8, (u32x4){pk2(y2[0], y2[1]), pk2(y2[2], y2[3]), pk2(y2[4], y2[5]), pk2(y2[6], y2[7])});
      } }
    f32x16 S[5];
#pragma unroll
    for (int ti = 0; ti < 5; ++ti) {
        const float pen = (32 * (QB + ti) < kmin) ? -1e30f : 0.f;
        f32x16 acc;
#pragma unroll
        for (int i = 0; i < 16; ++i) acc[i] = pen;
#pragma unroll
        for (int ks = 0; ks < 4; ++ks) { const bf16x8 kf = *(const LAS bf16x8*)(size_t)(kbase + (unsigned)(32 * (QB + ti) * AT_KP + 32 * ks));
            acc = __builtin_amdgcn_mfma_f32_32x32x16_bf16(kf, qf[ks], acc, 0, 0, 0); }
        S[ti] = acc;
    }
    const int c4 = 4 * hh;
#pragma unroll
    for (int i = 0; i < 16; ++i) { const bool up = ((i & 3) + 8 * (i >> 2) + c4) > r; S[0][i] = up ? S[0][i] : -1e30f; S[4][i] = up ? -1e30f : S[4][i]; }
    float mx = sink2;
#pragma unroll
    for (int ti = 0; ti < 5; ++ti)
#pragma unroll
        for (int i = 0; i < 16; ++i) mx = fmaxf(mx, S[ti][i]);
    mx = fmaxf(mx, __shfl_xor(mx, 32));
    float l = 0.f; unsigned P[5][8];
#pragma unroll
    for (int ti = 0; ti < 5; ++ti)
#pragma unroll
        for (int i = 0; i < 16; i += 2) { const float p0 = fexp2(S[ti][i] - mx), p1 = fexp2(S[ti][i + 1] - mx); l += p0 + p1; P[ti][i >> 1] = pk2(p0, p1); }
    l += __shfl_xor(l, 32);
    l += fexp2(sink2 - mx);
    if (hh == 0) linv[(32 * QB + r) * 8 + h] = frcp(l);
#pragma unroll
    for (int i = 0; i < 16; ++i) { o0[i] = 0.f; o1[i] = 0.f; }
#pragma unroll
    for (int ti = 0; ti < 5; ++ti) {
#pragma unroll
        for (int s = 0; s < 2; ++s) {
            const bf16x8 pa = __builtin_bit_cast(bf16x8, (u32x4){P[ti][4 * s], P[ti][4 * s + 1], P[ti][4 * s + 2], P[ti][4 * s + 3]});
            const unsigned va = vbase + (unsigned)((32 * (QB + ti) + 16 * s) * AT_KP);
            const s16x4 lo0 = tr_rd(va), hi0 = tr_rd(va + 8 * AT_KP), lo1 = tr_rd(va + 64), hi1 = tr_rd(va + 8 * AT_KP + 64);
            const bf16x8 vb0 = __builtin_shufflevector(lo0, hi0, 0, 1, 2, 3, 4, 5, 6, 7), vb1 = __builtin_shufflevector(lo1, hi1, 0, 1, 2, 3, 4, 5, 6, 7);
            o0 = __builtin_amdgcn_mfma_f32_32x32x16_bf16(pa, vb0, o0, 0, 0, 0);
            o1 = __builtin_amdgcn_mfma_f32_32x32x16_bf16(pa, vb1, o1, 0, 0, 0);
        }
    }
}

__device__ __forceinline__ void attn_unit(const Frame& F, KArgsP a, int b, int j) {
    LAS unsigned char* lds = F.lds; const int tid = F.tid, lane = F.lane, wave = F.wave;
    unsigned char* ws = a->ws;
    const bf16_t* projb = (const bf16_t*)(ws + wsm::projb); bf16_t* mix = (bf16_t*)(ws + wsm::mix); const f32x2* rope = (const f32x2*)(ws + wsm::rope);
    const float* sinks = a->in[5];
    const int key0 = 32 * j - 128;
#pragma unroll 1
    for (int task = tid; task < AT_NK * 2 * 4; task += NTHR) {
        const int c = task & 3, g = (task >> 2) & 1, kk = task >> 3; const int sp = key0 + kk;
        u32x4 o1 = {0u, 0u, 0u, 0u}, o2 = {0u, 0u, 0u, 0u};
        if (sp >= 0) { const size_t t = (size_t)b * SEQ + sp; const bf16_t* src = projb + t * NPROJ + OFF_K + g * 64 + 8 * c;
            const u32x4 w1 = *(const u32x4*)src, w2 = *(const u32x4*)(src + 32); const f32x2* cs = rope + t * 32 + 8 * c;
            float x1[8] = {bflo(w1.x), bfhi(w1.x), bflo(w1.y), bfhi(w1.y), bflo(w1.z), bfhi(w1.z), bflo(w1.w), bfhi(w1.w)};
            float x2[8] = {bflo(w2.x), bfhi(w2.x), bflo(w2.y), bfhi(w2.y), bflo(w2.z), bfhi(w2.z), bflo(w2.w), bfhi(w2.w)};
            float y1[8], y2[8];
#pragma unroll
            for (int e = 0; e < 8; ++e) { const f32x2 c2 = cs[e]; y1[e] = x1[e] * c2.x - x2[e] * c2.y; y2[e] = x2[e] * c2.x + x1[e] * c2.y; }
            o1 = (u32x4){pk2(y1[0], y1[1]), pk2(y1[2], y1[3]), pk2(y1[4], y1[5]), pk2(y1[6], y1[7])};
            o2 = (u32x4){pk2(y2[0], y2[1]), pk2(y2[2], y2[3]), pk2(y2[4], y2[5]), pk2(y2[6], y2[7])}; }
        LAS unsigned char* d = lds + AT_K + (g * AT_NK + kk) * AT_KP + 16 * c;
        *(LAS u32x4*)d = o1; *(LAS u32x4*)(d + 64) = o2;
    }
#pragma unroll 2
    for (int task = tid; task < AT_NK * 2 * 8; task += NTHR) {
        const int c = task & 7, g = (task >> 3) & 1, kk = task >> 4; const int sp = key0 + kk;
        u32x4 o = {0u, 0u, 0u, 0u};
        if (sp >= 0) o = *(const u32x4*)(projb + ((size_t)b * SEQ + sp) * NPROJ + OFF_V + g * 64 + 8 * c);
        *(LAS u32x4*)(lds + AT_V + (g * AT_NK + kk) * AT_KP + 16 * c) = o;
    }
    __syncthreads();
    const int h = wave, g = wave >> 2, r = lane & 31, hh = lane >> 5;
    const float sink2 = sinks[h] * 1.4426950408889634f;
    const int kmin = -key0;
    const unsigned kbase = (unsigned)(size_t)(lds + AT_K) + (unsigned)((g * AT_NK + r) * AT_KP + 16 * hh);
    const unsigned vbase = (unsigned)(size_t)(lds + AT_V) + (unsigned)((g * AT_NK + 4 * hh + ((lane & 15) >> 2)) * AT_KP + 32 * ((lane >> 4) & 1) + 8 * (lane & 3));
    const size_t tq0 = (size_t)b * SEQ + 32 * j;
    LAS float* linv = (LAS float*)(lds + AT_LINV);
    f32x16 oa0, oa1;
    attn_qblock<0>(projb, rope, tq0, h, kbase, vbase, sink2, kmin, r, hh, linv, oa0, oa1);
    __syncthreads();
    LAS float* ost = (LAS float*)lds;
#pragma unroll
    for (int i = 0; i < 16; ++i) { const int q = crow(i, hh); LAS float* d0 = ost + q * 512 + h * 64 + r; d0[0] = oa0[i]; d0[32] = oa1[i]; }
    __syncthreads();
    { const int tt = tid >> 4, pp = tid & 15; const LAS f32x4* row = (const LAS f32x4*)(ost + tt * 512);
      f32x4 v[8]; float s = 0.f;
#pragma unroll
      for (int i = 0; i < 8; ++i) { v[i] = row[pp + 16 * i] * linv[tt * 8 + i]; s += (v[i].x * v[i].x + v[i].y * v[i].y) + (v[i].z * v[i].z + v[i].w * v[i].w); }
      s += __shfl_xor(s, 1); s += __shfl_xor(s, 2); s += __shfl_xor(s, 4); s += __shfl_xor(s, 8);
      const float rr = rsqrtf(s * (1.f / 512.f) + EPS);
      bf16_t* dst = mix + (tq0 + tt) * D;
#pragma unroll
      for (int i = 0; i < 8; ++i) { u32x2 w; w.x = pk2(v[i].x * rr, v[i].y * rr); w.y = pk2(v[i].z * rr, v[i].w * rr); *(u32x2*)(dst + 4 * (pp + 16 * i)) = w; } }
    __syncthreads();
}

namespace pg8 {
struct EpiOutProj {
    static constexpr bool PERM = true, MIDSCALE = false;
    const bf16_t* xb; bf16_t* x1b; float* ssq1p; unsigned char* x1q;
    __device__ __forceinline__ void midscale(f32x4 (&)[2][2][4][2], const Unit&, int, int) const {}
    __device__ __forceinline__ void operator()(const f32x4 (&acc)[2][2][4][2], const Unit& u, int wr, int wc, int fr, int fq) const {
        const int col0 = u.pn * BM + wc * 32 + 8 * fq;
#pragma unroll
        for (int ai = 0; ai < 2; ++ai)
#pragma unroll
            for (int m = 0; m < 4; ++m) { const int row = u.pm * BM + ai * HALF + wr * 64 + m * 16 + fr; const size_t off = (size_t)row * D + col0; float q = 0.f;
#pragma unroll
                for (int bj = 0; bj < 2; ++bj) { const size_t o = off + bj * HALF; const u32x4 xw = *(const u32x4*)(xb + o);
                    const f32x4 v0 = (f32x4){bflo(xw.x), bfhi(xw.x), bflo(xw.y), bfhi(xw.y)} + acc[ai][bj][m][0], v1 = (f32x4){bflo(xw.z), bfhi(xw.z), bflo(xw.w), bfhi(xw.w)} + acc[ai][bj][m][1];
                    *(u32x4*)(x1b + o) = (u32x4){pk2(v0[0], v0[1]), pk2(v0[2], v0[3]), pk2(v1[0], v1[1]), pk2(v1[2], v1[3])};
                    *(u32x2*)(x1q + o) = (u32x2){pk4_fp8(v0[0], v0[1], v0[2], v0[3]), pk4_fp8(v1[0], v1[1], v1[2], v1[3])};
                    q += (v0[0] * v0[0] + v0[1] * v0[1]) + (v0[2] * v0[2] + v0[3] * v0[3]) + (v1[0] * v1[0] + v1[1] * v1[1]) + (v1[2] * v1[2] + v1[3] * v1[3]); }
                q += __shfl_xor(q, 16); q += __shfl_xor(q, 32);
                if (fq == 0) ssq1p[(size_t)(u.pn * 4 + wc) * T + row] = q; }
    }
};
struct EpiMoe1 {
    static constexpr bool PERM = true, MIDSCALE = false;
    unsigned char* hid; const float* lw; const float* lr;
    __device__ __forceinline__ void midscale(f32x4 (&)[2][2][4][2], const Unit&, int, int) const {}
    __device__ __forceinline__ void operator()(const f32x4 (&acc)[2][2][4][2], const Unit& u, int wr, int wc, int fr, int fq) const {
        const __amdgpu_buffer_rsrc_t hrs = __builtin_amdgcn_make_buffer_rsrc(hid, 0, 40960 * FF, 0x00020000);
        const int f0 = u.pn * HALF + wc * 32 + 8 * fq;
#pragma unroll
        for (int ai = 0; ai < 2; ++ai)
#pragma unroll
            for (int m = 0; m < 4; ++m) { const int rl = ai * HALF + wr * 64 + m * 16 + fr; const bool ok = rl < u.nrow; const size_t li = (size_t)u.e * T + u.li0 + rl;
                const float r2 = ok ? lr[li] * (1.f / WQ_SCALE) : 0.f, w = ok ? lw[li] * HQ_SCALE : 0.f; float hv[8];
#pragma unroll
                for (int n = 0; n < 2; ++n)
#pragma unroll
                    for (int e = 0; e < 4; ++e) { const float gt = acc[ai][0][m][n][e] * r2, up = acc[ai][1][m][n][e] * r2; hv[4 * n + e] = gt * frcp(1.f + fexp(-gt)) * up * w; }
                __builtin_amdgcn_raw_buffer_store_b64((u32x2){pk4_fp8(hv[0], hv[1], hv[2], hv[3]), pk4_fp8(hv[4], hv[5], hv[6], hv[7])}, hrs, (int)((unsigned)(u.pm * BM + rl) * FF + f0), 0, 16); }
    }
};
struct EpiPle {
    static constexpr bool PERM = true, MIDSCALE = false;
    const bf16_t* x2b; bf16_t* x3b; const bf16_t* pp; const float* rP; float* ssq3p;
    __device__ __forceinline__ void midscale(f32x4 (&)[2][2][4][2], const Unit&, int, int) const {}
    __device__ __forceinline__ void operator()(const f32x4 (&acc)[2][2][4][2], const Unit& u, int wr, int wc, int fr, int fq) const {
        const int col0 = u.pn * BM + wc * 32 + 8 * fq;
#pragma unroll
        for (int ai = 0; ai < 2; ++ai)
#pragma unroll
            for (int m = 0; m < 4; ++m) { const int row = u.pm * BM + ai * HALF + wr * 64 + m * 16 + fr; const float s = rP[row]; const size_t off = (size_t)row * D + col0; float q = 0.f;
#pragma unroll
                for (int bj = 0; bj < 2; ++bj) { const size_t o = off + bj * HALF; const u32x4 xw = *(const u32x4*)(x2b + o), pw = *(const u32x4*)(pp + o);
                    const f32x4 a0 = acc[ai][bj][m][0] * s, a1 = acc[ai][bj][m][1] * s;
                    float v[8] = {bflo(xw.x) + fsigmoid(a0[0]) * bflo(pw.x), bfhi(xw.x) + fsigmoid(a0[1]) * bfhi(pw.x), bflo(xw.y) + fsigmoid(a0[2]) * bflo(pw.y), bfhi(xw.y) + fsigmoid(a0[3]) * bfhi(pw.y),
                                  bflo(xw.z) + fsigmoid(a1[0]) * bflo(pw.z), bfhi(xw.z) + fsigmoid(a1[1]) * bfhi(pw.z), bflo(xw.w) + fsigmoid(a1[2]) * bflo(pw.w), bfhi(xw.w) + fsigmoid(a1[3]) * bfhi(pw.w)};
                    *(u32x4*)(x3b + o) = (u32x4){pk2(v[0], v[1]), pk2(v[2], v[3]), pk2(v[4], v[5]), pk2(v[6], v[7])};
                    q += (v[0] * v[0] + v[1] * v[1]) + (v[2] * v[2] + v[3] * v[3]) + (v[4] * v[4] + v[5] * v[5]) + (v[6] * v[6] + v[7] * v[7]); }
                q += __shfl_xor(q, 16); q += __shfl_xor(q, 32);
                if (fq == 0) ssq3p[(size_t)(u.pn * 4 + wc) * T + row] = q; }
    }
};
struct EpiY {
    static constexpr bool PERM = true, MIDSCALE = false;
    unsigned char* O; float sc; int pad;
    __device__ __forceinline__ void midscale(f32x4 (&)[2][2][4][2], const Unit&, int, int) const {}
    __device__ __forceinline__ void operator()(const f32x4 (&acc)[2][2][4][2], const Unit& u, int wr, int wc, int fr, int fq) const {
        unsigned char* base = O + (size_t)u.pm * BM * D;
        int row0 = wr * 64 + fr; const int col0 = u.pn * BM + wc * 32 + 8 * fq;
        asm volatile("" : "+v"(row0));
#pragma unroll
        for (int ai = 0; ai < 2; ++ai)
#pragma unroll
            for (int m = 0; m < 4; ++m) { unsigned char* rowp = base + (size_t)(row0 + ai * HALF + m * 16) * D + col0;
#pragma unroll
                for (int bj = 0; bj < 2; ++bj) { const f32x4 v0 = acc[ai][bj][m][0] * sc, v1 = acc[ai][bj][m][1] * sc;
                    *(u32x2*)(rowp + bj * HALF) = (u32x2){pk4_fp8(v0[0], v0[1], v0[2], v0[3]), pk4_fp8(v1[0], v1[1], v1[2], v1[3])}; } }
    }
};
struct MoeOrder {
    const LAS int* tstart; const LAS int* cntl; const LAS int* rowtab; const int* lt; const char* A; const char* B; size_t strideB; int K, PA, PB, G, c, gather;
    __device__ bool next(int i, Unit& u) const {
        const int L = i * G + c, tile = L >> 2; if (tile >= __builtin_amdgcn_readfirstlane(tstart[NE])) return false;
        int e = 0;
#pragma unroll 1
        for (int k = 1; k < NE; ++k) e = (tstart[k] <= tile) ? k : e;
        e = __builtin_amdgcn_readfirstlane(e);
        u.e = e; u.pm = tile; u.pn = L & 3; u.li0 = __builtin_amdgcn_readfirstlane((tile - tstart[e]) * BM); const int left = __builtin_amdgcn_readfirstlane(cntl[e]) - u.li0; u.nrow = left < BM ? left : BM; u.ord = i; return true;
    }
    __device__ const char* a_ptr(const Unit& u) const { return gather ? A : A + (size_t)u.pm * BM * PA * 2; }
    __device__ const char* b_ptr(const Unit& u) const { return B + (size_t)u.e * strideB + (size_t)u.pn * BM * PB * 2; }
    __device__ unsigned a_row(const Unit& u, int r) const { return (unsigned)rowtab[(u.ord & 7) * BM + r]; }
    gu32* tilecnt;
    __device__ __forceinline__ void a_ready(const Unit&) const {}
    __device__ __forceinline__ void done(const Unit& u) const {
        if (tilecnt) { asm volatile("s_waitcnt vmcnt(0)" ::: "memory");
            if ((threadIdx.x & 63) == 0) (void)__hip_atomic_fetch_add(tilecnt + 16 * u.pm, 1u, __ATOMIC_RELAXED, __HIP_MEMORY_SCOPE_AGENT); }
    }
};
struct Moe2Order {
    const LAS int* tstart; const char* A; const char* B; size_t strideB; gu32* tilecnt; int K, PA, PB, G, c, E, S2, U;
    __device__ bool next(int i, Unit& u) const {
        int m;
        if (c >= E) m = (i < 2) ? (c - E) + i * S2 : 2 * S2 + c + (i - 2) * G; else m = 2 * S2 + c + i * G;
        if (m >= U) return false;
        const int tile = m >> 2; int e = 0;
#pragma unroll 1
        for (int k = 1; k < NE; ++k) e = (tstart[k] <= tile) ? k : e;
        u.e = __builtin_amdgcn_readfirstlane(e); u.pm = tile; u.pn = m & 3; u.li0 = 0; u.nrow = BM; u.ord = i; return true;
    }
    __device__ const char* a_ptr(const Unit& u) const { return A + (size_t)u.pm * BM * PA * 2; }
    __device__ const char* b_ptr(const Unit& u) const { return B + (size_t)u.e * strideB + (size_t)u.pn * BM * PB * 2; }
    __device__ unsigned a_row(const Unit&, int r) const { return (unsigned)r; }
    __device__ __forceinline__ void done(const Unit&) const {}
    __device__ __forceinline__ void a_ready(const Unit& u) const {
        if (threadIdx.x < 64) {
            unsigned sp = 0;
            while ((unsigned)__builtin_amdgcn_readfirstlane(__hip_atomic_load(tilecnt + 16 * u.pm, __ATOMIC_RELAXED, __HIP_MEMORY_SCOPE_AGENT)) < 32u) { __builtin_amdgcn_s_sleep(2); if (++sp > (1u << 22)) break; }
            __builtin_amdgcn_fence(__ATOMIC_ACQUIRE, "agent");
            asm volatile("s_waitcnt vmcnt(0)" ::: "memory");
        }
        asm volatile("" ::: "memory"); __builtin_amdgcn_s_barrier(); asm volatile("" ::: "memory");
    }
};
}

constexpr int MOE_TSTART = XTRA_OFF, MOE_CNTL = XTRA_OFF + 256, MOE_ROWTAB = XTRA_OFF + 512;
static_assert(MOE_ROWTAB + 8192 <= LDS_BYTES, "moe lds");
__device__ __forceinline__ void moe_tstart(const Frame& F, const int* cnt) {
    LAS int* tstart = (LAS int*)(F.lds + MOE_TSTART); LAS int* cntl = (LAS int*)(F.lds + MOE_CNTL);
    if (F.tid < 64) { const int l = F.tid; const int c = l < NE ? cnt[l * 32] : 0; const int nt = (c + 255) >> 8; int inc = nt;
#pragma unroll
        for (int o = 1; o < 32; o <<= 1) { const int v = __shfl_up(inc, o); if ((l & 31) >= o) inc += v; }
        if (l < NE) { tstart[l] = inc - nt; cntl[l] = c; } if (l == NE - 1) tstart[NE] = inc; }
    __syncthreads();
}
__device__ __forceinline__ void moe_rowtab(const Frame& F, const pg8::MoeOrder& S) {
    LAS int* rowtab = (LAS int*)(F.lds + MOE_ROWTAB);
    for (int i = 0; i < 8; ++i) { pg8::Unit u; if (!S.next(i, u)) break; if (F.tid < 256) rowtab[i * 256 + F.tid] = F.tid < u.nrow ? S.lt[(size_t)u.e * T + u.li0 + F.tid] : 0; }
    asm volatile("s_waitcnt vmcnt(0) lgkmcnt(0)" ::: "memory"); __syncthreads();
}

__device__ __forceinline__ void router_chunk(const Frame& F, KArgsP args, int* cnt, int ch) {
    unsigned char* ws = args->ws; const int lane = F.lane;
    const bf16_t* x1b = (const bf16_t*)(ws + wsm::x1b); const bf16_t* wr_t = (const bf16_t*)(ws + wsm::wr_t); const float* ssq1p = (const float*)(ws + wsm::ssq1p);
    float* r2v = (float*)(ws + wsm::r2); int* lt = (int*)(ws + wsm::lt); float* lw = (float*)(ws + wsm::lw); float* lr = (float*)(ws + wsm::lr);
    int* tokE = (int*)(ws + wsm::tokE); int* tokPos = (int*)(ws + wsm::tokPos);
    const float* b_rg = args->in[18]; const float* b_re = args->in[20];
    LAS float* lg = (LAS float*)F.lds;
    {
            const int tok0 = ch * 64, mt = F.wave & 3, kh = F.wave >> 2;
            f32x4 acc[3];
#pragma unroll
            for (int n = 0; n < 3; ++n) acc[n] = (f32x4){0.f, 0.f, 0.f, 0.f};
            const bf16_t* ap = x1b + (size_t)(tok0 + 16 * mt + (lane & 15)) * D + 512 * kh + 8 * (lane >> 4);
            const bf16_t* bp = wr_t + (size_t)(lane & 15) * D + 512 * kh + 8 * (lane >> 4);
#pragma unroll 4
            for (int ks = 0; ks < 16; ++ks) { const bf16x8 af = *(const bf16x8*)(ap + 32 * ks);
#pragma unroll
                for (int n = 0; n < 3; ++n) { const bf16x8 bf = *(const bf16x8*)(bp + (size_t)16 * n * D + 32 * ks); acc[n] = __builtin_amdgcn_mfma_f32_16x16x32_bf16(af, bf, acc[n], 0, 0, 0); } }
#pragma unroll
            for (int n = 0; n < 3; ++n)
#pragma unroll
                for (int r = 0; r < 4; ++r) lg[(kh * 64 + 16 * mt + (lane >> 4) * 4 + r) * 48 + 16 * n + (lane & 15)] = acc[n][r];
            __syncthreads();
            if (F.tid < 64) {
                const int t = tok0 + F.tid; float s = 0.f;
#pragma unroll
                for (int pq = 0; pq < 16; ++pq) s += ssq1p[(size_t)pq * T + t];
                const float r2 = rsqrtf(s * (1.f / D) + EPS); r2v[t] = r2;
                const LAS float* l0 = lg + F.tid * 48; const LAS float* l1 = lg + (64 + F.tid) * 48;
                float gm = -1e30f; int gt = 0; float gl[4];
#pragma unroll
                for (int jx = 0; jx < 4; ++jx) { gl[jx] = (l0[jx] + l1[jx]) * r2 + b_rg[jx]; if (gl[jx] > gm) { gm = gl[jx]; gt = jx; } }
                float gs = 0.f;
#pragma unroll
                for (int jx = 0; jx < 4; ++jx) gs += expf(gl[jx] - gm);
                const float gp = 1.f / gs;
                float m1 = -1e30f, m2 = -1e30f; int i1 = 0, i2 = 0;
#pragma unroll
                for (int jx = 0; jx < 8; ++jx) { const float v = (l0[4 + gt * 8 + jx] + l1[4 + gt * 8 + jx]) * r2 + b_re[gt * 8 + jx];
                    if (v > m1) { m2 = m1; i2 = i1; m1 = v; i1 = jx; } else if (v > m2) { m2 = v; i2 = jx; } }
                const float e2 = expf(m2 - m1), w1 = gp / (1.f + e2), w2 = gp * e2 / (1.f + e2);
                const int E1 = gt * 8 + i1, E2 = gt * 8 + i2;
                LAS int* hist = (LAS int*)(F.lds + 32768); LAS int* base = hist + 32;
                if (F.tid < 32) hist[F.tid] = 0;
                asm volatile("s_waitcnt lgkmcnt(0)" ::: "memory");
                const int q1 = __hip_atomic_fetch_add(hist + E1, 1, __ATOMIC_RELAXED, __HIP_MEMORY_SCOPE_WORKGROUP), q2 = __hip_atomic_fetch_add(hist + E2, 1, __ATOMIC_RELAXED, __HIP_MEMORY_SCOPE_WORKGROUP);
                asm volatile("s_waitcnt lgkmcnt(0)" ::: "memory");
                if (F.tid < 32) { const int hc = hist[F.tid]; base[F.tid] = hc > 0 ? atomicAdd(&cnt[F.tid * 32], hc) : 0; }
                asm volatile("s_waitcnt vmcnt(0) lgkmcnt(0)" ::: "memory");
                const int p1 = base[E1] + q1, p2 = base[E2] + q2;
                lt[(size_t)E1 * T + p1] = t; lw[(size_t)E1 * T + p1] = w1; lr[(size_t)E1 * T + p1] = r2;
                lt[(size_t)E2 * T + p2] = t; lw[(size_t)E2 * T + p2] = w2; lr[(size_t)E2 * T + p2] = r2;
                tokE[t * 2] = E1; tokPos[t * 2] = p1; tokE[t * 2 + 1] = E2; tokPos[t * 2 + 1] = p2;
            }
            __syncthreads();
    }
}

__device__ __forceinline__ void final_rows(const Frame& F, KArgsP args, int row0, int nrow) {
    unsigned char* ws = args->ws; const int lane = F.lane;
    const float* ssq3p = (const float*)(ws + wsm::ssq3p); const float* gfin = args->in[27]; float* X = args->out; const bf16_t* x3b = (const bf16_t*)(ws + wsm::x3b);
    f32x4 gv[4];
#pragma unroll
    for (int jx = 0; jx < 2; ++jx) { gv[2 * jx] = ((const f32x4*)gfin)[2 * (lane + 64 * jx)]; gv[2 * jx + 1] = ((const f32x4*)gfin)[2 * (lane + 64 * jx) + 1]; }
    for (int t = row0 + F.wave; t < row0 + nrow; t += NWAVES) {
        float s = 0.f;
        if (lane < 16) s = ssq3p[(size_t)lane * T + t];
        s = wsum(s);
        const float r3 = rsqrtf(s * (1.f / D) + EPS);
        const u32x4* xr = (const u32x4*)(x3b + (size_t)t * D) + lane; f32x4* orow = (f32x4*)(X + (size_t)t * D);
#pragma unroll
        for (int jx = 0; jx < 2; ++jx) { const u32x4 w = xr[64 * jx];
            orow[2 * (lane + 64 * jx)] = (f32x4){bflo(w.x), bfhi(w.x), bflo(w.y), bfhi(w.y)} * r3 * gv[2 * jx];
            orow[2 * (lane + 64 * jx) + 1] = (f32x4){bflo(w.z), bfhi(w.z), bflo(w.w), bfhi(w.w)} * r3 * gv[2 * jx + 1]; }
    }
}
__device__ __forceinline__ void panel_sync(const Frame& F, gu32* cw) {
    asm volatile("s_waitcnt vmcnt(0)" ::: "memory");
    __syncthreads();
    if (F.tid == 0) {
        __builtin_amdgcn_fence(__ATOMIC_RELEASE, "agent"); asm volatile("s_waitcnt vmcnt(0)" ::: "memory");
        (void)__hip_atomic_fetch_add(cw, 1u, __ATOMIC_RELAXED, __HIP_MEMORY_SCOPE_AGENT);
        unsigned sp = 0; while (__hip_atomic_load(cw, __ATOMIC_RELAXED, __HIP_MEMORY_SCOPE_AGENT) < 4u) { __builtin_amdgcn_s_sleep(2); if (++sp > (1u << 22)) break; }
        __builtin_amdgcn_fence(__ATOMIC_ACQUIRE, "agent"); asm volatile("s_waitcnt vmcnt(0)" ::: "memory");
    }
    __syncthreads();
}

__global__ void __launch_bounds__(NTHR, 2) mk_fwd(Args) {
    const KArgsP args0 = kargs();
    extern __shared__ __attribute__((aligned(16))) unsigned char lds_raw[];
    Frame F; F.lds = (LAS unsigned char*)lds_raw; F.MISC = (volatile LAS unsigned*)(F.lds + MISC_OFF);
    F.tid = threadIdx.x; F.lane = F.tid & 63; F.wave = __builtin_amdgcn_readfirstlane(F.tid >> 6);
    F.G = gridDim.x; { const int bx = blockIdx.x; F.vcu = (F.G % 8 == 0) ? (bx % 8) * (F.G / 8) + bx / 8 : bx; }
    unsigned char* ws = args0->ws; F.ctl = (gu32*)(ws + wsm::ctl);
    for (int u = F.tid; u < (LDS_BYTES - LDSCTL_OFF) / 4; u += NTHR) ((LAS unsigned*)(F.lds + LDSCTL_OFF))[u] = 0u;
    __syncthreads();
    const int lo = args0->ph_lo, hi = args0->ph_hi;
    XcdBarrier bar = xcd_barrier_post((unsigned*)(F.ctl + CW_BAR) + (args0->mode >> 8) * XCD_BAR_WORDS, F.MISC + 8);
    int* cnt = (int*)(F.ctl + CW_CNT);
    const LAS int* tstart = (const LAS int*)(F.lds + MOE_TSTART); const LAS int* cntl = (const LAS int*)(F.lds + MOE_CNTL); const LAS int* rowtab = (const LAS int*)(F.lds + MOE_ROWTAB);
    const int gw = F.vcu * NWAVES + F.wave, NGW = F.G * NWAVES, lane = F.lane;
#ifndef PHASE_MASK
#define PHASE_MASK 0x7ffu
#endif
#define IN(k) ((((PHASE_MASK) >> (k)) & 1u) && lo <= (k) && (k) < hi)
#ifdef MK_STAMPS
    unsigned long long* tsg = (unsigned long long*)(F.ctl + 14336);
#define STAMP(k) do { if (blockIdx.x == 0 && F.tid == 0) tsg[k] = __builtin_amdgcn_s_memrealtime(); } while (0)
#else
#define STAMP(k) do { } while (0)
#endif
#define GRID_BAR(k) do { if (IN(k) && IN((k) + 1)) xcd_barrier(bar); STAMP((k) + 1); } while (0)
    STAMP(0);
    const bool fused = false;
    const bool early_down = (F.G == 256) && lo <= 1 && hi >= 8;
    const bool merged = lo <= 5 && hi >= 8;
    if (IN(0)) { const KArgsP args = kargs(); p0_prologue(F, args); __syncthreads(); }
    GRID_BAR(0);
    if (IN(1)) { const KArgsP args = kargs();
        { pg8::DenseOrder S; S.init((const bf16_t*)(ws + wsm::xb), (const bf16_t*)(ws + wsm::w_in_t), T, NPROJ, D, F.G, (int)blockIdx.x);
          pg8::EpiScaleBf16 E{(bf16_t*)(ws + wsm::projb), (const float*)(ws + wsm::r0), NPROJ, 0};
          pg8::gemm_phase<pg8::EpiScaleBf16, pg8::DenseOrder, true, false>(F.lds, D, S, E);
          if (early_down) { pg8::Unit u; if (!S.next(1, u)) { const int nsp = 2 * F.G - (T / 256) * (NPROJ / 256);
              p0_experts(F, args, ((int)blockIdx.x - (F.G - nsp)) * NWAVES + F.wave, nsp * NWAVES, 2); __syncthreads(); } } }
        { pg8::DenseOrder S; S.init((const bf16_t*)(ws + wsm::pb), (const bf16_t*)(ws + wsm::w_pp_t), T, D, PLE, F.G, (int)blockIdx.x);
          pg8::EpiScaleBf16 E{(bf16_t*)(ws + wsm::pp), nullptr, D, 0};
          pg8::gemm_phase<pg8::EpiScaleBf16, pg8::DenseOrder, true, false>(F.lds, PLE, S, E); }
    }
    GRID_BAR(1);
    if (IN(2)) { const KArgsP args = kargs();
        const bool conv_first = (F.G >= 256) && (blockIdx.x & 1);
        if (conv_first) { p0_experts(F, args, gw, NGW, 1); __syncthreads(); }
        STAMP(12);
        for (int it = blockIdx.x; it < 256 + 512; it += F.G) {
            if (it < 256) { lruA_unit(F, args, it >> 6, (it >> 3) & 7, it & 7); STAMP(13); }
            else { const int u = it - 256; attn_unit(F, args, u >> 7, u & 127); }
        }
        STAMP(14);
        if (F.G >= 256 && !conv_first) p0_experts(F, args, gw, NGW, 1);
        STAMP(15);
    }
    GRID_BAR(2);
    if (IN(3)) { const KArgsP args = kargs();
        for (int it = blockIdx.x; it < T / 64; it += F.G) lru_finish(F, args, it >> 6, it & 63);
    }
    GRID_BAR(3);
    if (IN(4)) { const KArgsP args = kargs();
        pg8::DenseOrder S; S.init((const bf16_t*)(ws + wsm::mix), (const bf16_t*)(ws + wsm::w_out_t), T, D, D, F.G, (int)blockIdx.x);
        pg8::EpiOutProj E{(const bf16_t*)(ws + wsm::xb), (bf16_t*)(ws + wsm::x1b), (float*)(ws + wsm::ssq1p), (unsigned char*)(ws + wsm::x1q)};
        pg8::gemm_phase<pg8::EpiOutProj, pg8::DenseOrder, true, false>(F.lds, D, S, E);
        if (fused) { pg8::Unit u; S.next(0, u); panel_sync(F, F.ctl + CW_PANA + 32 * u.pm); router_chunk(F, args, cnt, 4 * u.pm + u.pn); }
    }
    if (!fused) GRID_BAR(4);
    if (IN(5) && !fused) { const KArgsP args = kargs();
        for (int ch = F.vcu; ch < T / 64; ch += F.G) router_chunk(F, args, cnt, ch);
        if (merged && F.G >= 256 && !early_down) p0_experts(F, args, gw, NGW, 2);
    }
    GRID_BAR(5);
    if (IN(6)) { const KArgsP args = kargs();
        moe_tstart(F, cnt);
        pg8::MoeOrder S{tstart, cntl, rowtab, (const int*)(ws + wsm::lt), (const char*)(ws + wsm::x1q), (const char*)(ws + wsm::wgu_t), (size_t)1024 * D, D / 2, D / 2, D / 2, F.G, F.vcu, 1, merged ? F.ctl + CW_TILE : nullptr};
        moe_rowtab(F, S);
        pg8::EpiMoe1 E{(unsigned char*)(ws + wsm::hid), (const float*)(ws + wsm::lw), (const float*)(ws + wsm::lr)};
        pg8::gemm_phase<pg8::EpiMoe1, pg8::MoeOrder, true, true, MOE_MMA>(F.lds, D / 2, S, E);
        const int U = 4 * __builtin_amdgcn_readfirstlane(tstart[NE]), nfull = U / F.G, Ex = U - nfull * F.G;
        if (merged) {
            pg8::Moe2Order S2{tstart, (const char*)(ws + wsm::hid), (const char*)(ws + wsm::wd_t), (size_t)D * FF, F.ctl + CW_TILE, FF / 2, FF / 2, FF / 2, F.G, F.vcu, Ex, F.G - Ex, U};
            pg8::EpiY E2{(unsigned char*)args->out, YQ_SCALE / (WQ_SCALE * HQ_SCALE), 0};
            pg8::gemm_phase<pg8::EpiY, pg8::Moe2Order, true, false, MOE_MMA>(F.lds, FF / 2, S2, E2);
        } else if (F.G >= 256 && F.vcu >= Ex) p0_experts(F, args, (F.vcu - Ex) * NWAVES + F.wave, (F.G - Ex) * NWAVES, 2);
    }
    GRID_BAR(6);
    if (IN(7) && !merged) { const KArgsP args = kargs();
        moe_tstart(F, cnt);
        pg8::MoeOrder S{tstart, cntl, rowtab, nullptr, (const char*)(ws + wsm::hid), (const char*)(ws + wsm::wd_t), (size_t)D * FF, FF / 2, FF / 2, FF / 2, F.G, F.vcu, 0, nullptr};
        pg8::EpiY E{(unsigned char*)args->out, YQ_SCALE / (WQ_SCALE * HQ_SCALE), 0};
        pg8::gemm_phase<pg8::EpiY, pg8::MoeOrder, true, false, MOE_MMA>(F.lds, FF / 2, S, E);
    }
    if (!merged) GRID_BAR(7);
    if (IN(8)) { const KArgsP args = kargs();
        moe_tstart(F, cnt);
        const unsigned char* y = (const unsigned char*)args->out; const bf16_t* x1b = (const bf16_t*)(ws + wsm::x1b); bf16_t* x2b = (bf16_t*)(ws + wsm::x2b); float* rP = (float*)(ws + wsm::rP);
        const int* tokE = (const int*)(ws + wsm::tokE); const int* tokPos = (const int*)(ws + wsm::tokPos);
        for (int t = gw; t < T; t += NGW) {
            const size_t s1 = (size_t)tstart[tokE[2 * t]] * 256 + tokPos[2 * t], s2 = (size_t)tstart[tokE[2 * t + 1]] * 256 + tokPos[2 * t + 1];
            const u32x4* xr = (const u32x4*)(x1b + (size_t)t * D) + lane; const u32x2* ya = (const u32x2*)(y + s1 * D) + lane; const u32x2* yb = (const u32x2*)(y + s2 * D) + lane;
            u32x4* ob = (u32x4*)(x2b + (size_t)t * D) + lane; float s = 0.f;
#pragma unroll
            for (int jx = 0; jx < 2; ++jx) { const u32x4 xw = xr[64 * jx]; const u32x2 a2 = ya[64 * jx], b2 = yb[64 * jx];
                const f32x2 a01 = __builtin_amdgcn_cvt_pk_f32_fp8((int)a2.x, false), a23 = __builtin_amdgcn_cvt_pk_f32_fp8((int)a2.x, true), a45 = __builtin_amdgcn_cvt_pk_f32_fp8((int)a2.y, false), a67 = __builtin_amdgcn_cvt_pk_f32_fp8((int)a2.y, true);
                const f32x2 b01 = __builtin_amdgcn_cvt_pk_f32_fp8((int)b2.x, false), b23 = __builtin_amdgcn_cvt_pk_f32_fp8((int)b2.x, true), b45 = __builtin_amdgcn_cvt_pk_f32_fp8((int)b2.y, false), b67 = __builtin_amdgcn_cvt_pk_f32_fp8((int)b2.y, true);
                constexpr float iy = 1.f / YQ_SCALE;
                float v[8] = {bflo(xw.x) + (a01.x + b01.x) * iy, bfhi(xw.x) + (a01.y + b01.y) * iy, bflo(xw.y) + (a23.x + b23.x) * iy, bfhi(xw.y) + (a23.y + b23.y) * iy,
                              bflo(xw.z) + (a45.x + b45.x) * iy, bfhi(xw.z) + (a45.y + b45.y) * iy, bflo(xw.w) + (a67.x + b67.x) * iy, bfhi(xw.w) + (a67.y + b67.y) * iy};
                ob[64 * jx] = (u32x4){pk2(v[0], v[1]), pk2(v[2], v[3]), pk2(v[4], v[5]), pk2(v[6], v[7])};
                s += (v[0] * v[0] + v[1] * v[1]) + (v[2] * v[2] + v[3] * v[3]) + (v[4] * v[4] + v[5] * v[5]) + (v[6] * v[6] + v[7] * v[7]); }
            s = wsum(s);
            if (lane == 0) rP[t] = rsqrtf(s * (1.f / D) + EPS);
        }
    }
    GRID_BAR(8);
    if (IN(9)) { const KArgsP args = kargs();
        pg8::DenseOrder S; S.init((const bf16_t*)(ws + wsm::x2b), (const bf16_t*)(ws + wsm::w_pg_t), T, D, D, F.G, (int)blockIdx.x);
        pg8::EpiPle E{(const bf16_t*)(ws + wsm::x2b), (bf16_t*)(ws + wsm::x3b), (const bf16_t*)(ws + wsm::pp), (const float*)(ws + wsm::rP), (float*)(ws + wsm::ssq3p)};
        pg8::gemm_phase<pg8::EpiPle, pg8::DenseOrder, true, false>(F.lds, D, S, E);
        if (fused) { pg8::Unit u; S.next(0, u); panel_sync(F, F.ctl + CW_PANB + 32 * u.pm); final_rows(F, args, 256 * u.pm + 64 * u.pn, 64); }
    }
    if (!fused) GRID_BAR(9);
    if (IN(10) && !fused) { const KArgsP args = kargs();
        for (int r0 = F.vcu * 64; r0 < T; r0 += F.G * 64) final_rows(F, args, r0, 64);
    }
#ifdef MK_XBAR
    for (int i = 0; i < MK_XBAR; ++i) xcd_barrier(bar);
#endif
    STAMP(11);
#undef IN
#undef GRID_BAR
}
}

#ifndef MK_ONE_LAUNCH
#define MK_ONE_LAUNCH 1
#endif
#ifdef MK_STAMPS
__global__ void k_delay(const unsigned long long* ts, int k) {
    if (threadIdx.x == 0) { const int ka = k < 100 ? k : k / 100, kb = k < 100 ? k + 1 : k % 100; const unsigned long long d = (ts[kb] - ts[ka]) * 8ull, t0 = __builtin_amdgcn_s_memrealtime(); while (__builtin_amdgcn_s_memrealtime() - t0 < d) __builtin_amdgcn_s_sleep(8); }
}
#endif
extern "C" void kernel_launch(void* const* d_in, const int* in_sizes, int n_in, void* d_out, int out_size, void* d_ws, size_t ws_size, hipStream_t stream) {
    using namespace mk;
    const size_t MB = 1u << 20, KB = 1024;
    const size_t WS_END = wsm::END;
    static int grid = 0;
    if (grid == 0) {
        if (ws_size < WS_END || n_in != 28 || out_size != T * D) { fprintf(stderr, "kernel_launch: ws %zu < %zu or n_in %d or out %d\n", ws_size, (size_t)WS_END, n_in, out_size); grid = -1; return; }
        int dev = 0, cus = 0;
        if (hipGetDevice(&dev) != hipSuccess || hipDeviceGetAttribute(&cus, hipDeviceAttributeMultiprocessorCount, dev) != hipSuccess) { grid = -1; return; }
        if (hipFuncSetAttribute((const void*)mk_fwd, hipFuncAttributeMaxDynamicSharedMemorySize, LDS_BYTES) != hipSuccess) { fprintf(stderr, "hipFuncSetAttribute failed\n"); grid = -1; return; }
        grid = cus;
    }
    if (grid < 0) return;
    Args a{};
    for (int i = 0; i < 28; ++i) a.in[i] = (const float*)d_in[i];
    a.out = (float*)d_out; a.ws = (unsigned char*)d_ws;
    (void)hipMemsetAsync((char*)d_ws + wsm::ctl, 0, CTL_ZERO_BYTES, stream);
#if MK_ONE_LAUNCH
#ifdef MK_CUT
    a.ph_lo = 0; a.ph_hi = MK_CUT; hipLaunchKernelGGL(mk_fwd, dim3(grid), dim3(NTHR), LDS_BYTES, stream, a);
    a.ph_lo = MK_CUT; a.ph_hi = 11; a.mode = 256; hipLaunchKernelGGL(mk_fwd, dim3(grid), dim3(NTHR), LDS_BYTES, stream, a);
#else
    a.ph_lo = 0; a.ph_hi = 11; hipLaunchKernelGGL(mk_fwd, dim3(grid), dim3(NTHR), LDS_BYTES, stream, a);
#endif
#ifdef MK_STAMPS
    if (MK_STAMPS >= 0) k_delay<<<1, 64, 0, stream>>>((const unsigned long long*)((char*)d_ws + wsm::ctl + 14336 * 4), MK_STAMPS);
#endif
#ifdef MK_EXTRA
    a.out = (float*)((char*)d_ws + 16 * MB); a.ph_lo = MK_EXTRA; a.ph_hi = MK_EXTRA + 1;
#ifdef MK_MODE
    a.mode = MK_MODE;
#endif
    hipLaunchKernelGGL(mk_fwd, dim3(grid), dim3(NTHR), LDS_BYTES, stream, a);
#endif
#else
    for (int ph = 0; ph < 11; ++ph) { a.ph_lo = ph; a.ph_hi = ph + 1; hipLaunchKernelGGL(mk_fwd, dim3(grid), dim3(NTHR), LDS_BYTES, stream, a); }
#endif
}
```

```cpp
#define MK_TS_A 0
#define MK_TS_B 1
#define MK_DUP 6
#include <hip/hip_runtime.h>
#include <cstdio>
#include <cstdint>
#define GAS __attribute__((address_space(1)))
#define LAS __attribute__((address_space(3)))
typedef unsigned short bf16_t;
typedef short bf16x8 __attribute__((ext_vector_type(8)));
typedef float f32x4 __attribute__((ext_vector_type(4)));
typedef float f32x2 __attribute__((ext_vector_type(2)));
typedef unsigned u32x4 __attribute__((ext_vector_type(4)));
typedef unsigned u32x2 __attribute__((ext_vector_type(2)));
typedef GAS unsigned gu32;
typedef long i64x2 __attribute__((ext_vector_type(2)));
typedef int i32x4 __attribute__((ext_vector_type(4)));
typedef int i32x8 __attribute__((ext_vector_type(8)));

namespace mk {
constexpr int T = 16384, SEQ = 4096, D = 1024, NPROJ = 1792, PLE = 256;
constexpr int OFF_K = 512, OFF_V = 640, OFF_LX = 768, OFF_LG = 1280;
constexpr int NE = 32, FF = 512;
constexpr float EPS = 1e-6f;
constexpr int NWAVES = 8, NTHR = 512;
constexpr int RING_BYTES = 131072, LDSCTL_OFF = RING_BYTES, MISC_OFF = LDSCTL_OFF + 320, XTRA_OFF = RING_BYTES + 1024, LDS_BYTES = 147456;

__device__ __forceinline__ unsigned f2bf(float f) { unsigned u = __builtin_bit_cast(unsigned, f); return (u + 0x7fffu + ((u >> 16) & 1u)) >> 16; }
typedef __bf16 bf16x2_t __attribute__((ext_vector_type(2)));
__device__ __forceinline__ unsigned pk2(float lo, float hi) { f32x2 f = {lo, hi}; return __builtin_bit_cast(unsigned, __builtin_convertvector(f, bf16x2_t)); }
__device__ __forceinline__ float bf2f(unsigned short b) { return __builtin_bit_cast(float, (unsigned)b << 16); }
__device__ __forceinline__ float bflo(unsigned w) { return __builtin_bit_cast(float, w << 16); }
__device__ __forceinline__ float bfhi(unsigned w) { return __builtin_bit_cast(float, w & 0xffff0000u); }
__device__ __forceinline__ void st_wt16(void* ptr, u32x4 v) { asm volatile("global_store_dwordx4 %0, %1, off sc1\n\ts_nop 1" :: "v"(ptr), "v"(v) : "memory"); }
__device__ __forceinline__ void st_wt8(void* ptr, u32x2 v) { asm volatile("global_store_dwordx2 %0, %1, off sc1\n\ts_nop 1" :: "v"(ptr), "v"(v) : "memory"); }
__device__ __forceinline__ void st_wt4(float* ptr, float v) { asm volatile("global_store_dword %0, %1, off sc1\n\ts_nop 0" :: "v"(ptr), "v"(v) : "memory"); }
__device__ __forceinline__ float wsum(float v) {
#pragma unroll
    for (int o = 1; o < 64; o <<= 1) v += __shfl_xor(v, o);
    return v;
}

#ifndef PG8_ASM_DMA
#define PG8_ASM_DMA 1
#endif
namespace pg8 {
constexpr int BM = 256, BK = 64, HALF = 128, HTB = HALF * BK * 2, STAGE_BYTES = 8 * HTB, NXCD = 8, WGM = 8;
__device__ __forceinline__ int lds_byte(int r, int c) { const int st = (r >> 4) * 2 + (c >> 5), rr = r & 15, cc = c & 31, ob = rr * 64 + cc * 2; return st * 1024 + (ob ^ (((ob >> 9) & 1) << 5)); }
__device__ __forceinline__ void stage_rc(int b, int& R, int& C) { const int st = b / 1024, sb = b % 1024, swz = sb ^ (((sb >> 9) & 1) << 5); R = (st >> 1) * 16 + swz / 64; C = (st & 1) * 32 + (swz % 64) / 2; }
__device__ __forceinline__ int perm32(int rho) { const int n = rho >> 4, i = rho & 15; return 8 * (i >> 2) + 4 * n + (i & 3); }

struct Unit { int pm, pn, e, nrow, li0, ord; };

struct DenseOrder {
    const bf16_t* A; const bf16_t* Bt; int K, PA, PB, nM, nN, nwg, G, c;
    __device__ __forceinline__ void init(const bf16_t* A_, const bf16_t* Bt_, int M, int N, int K_, int G_, int c_) { A = A_; Bt = Bt_; K = K_; PA = K_; PB = K_; nM = M / BM; nN = N / BM; nwg = nM * nN; G = G_; c = c_; }
    __device__ __forceinline__ bool next(int i, Unit& u) const {
        const long L = (long)i * G + c; if (L >= nwg || c < 0) return false;
        int wgid = (int)L; { const int q = nwg / NXCD, r = nwg % NXCD, xcd = wgid % NXCD, off = wgid / NXCD; wgid = (xcd < r ? xcd * (q + 1) : r * (q + 1) + (xcd - r) * q) + off; }
        const int nig = WGM * nN, gid = wgid / nig, fm = gid * WGM, gsz = (nM - fm) < WGM ? (nM - fm) : WGM;
        u.pm = fm + ((wgid % nig) % gsz); u.pn = (wgid % nig) / gsz; u.e = 0; u.nrow = BM; u.li0 = 0; u.ord = i; return true;
    }
    __device__ __forceinline__ const char* a_ptr(const Unit& u) const { return (const char*)A + (size_t)u.pm * BM * PA * 2; }
    __device__ __forceinline__ const char* b_ptr(const Unit& u) const { return (const char*)Bt + (size_t)u.pn * BM * PB * 2; }
    __device__ __forceinline__ unsigned a_row(const Unit&, int r) const { return (unsigned)r; }
    __device__ __forceinline__ void a_ready(const Unit&) const {}
    __device__ __forceinline__ void done(const Unit&) const {}
};

#define PG8_WAIT_V(n) asm volatile("s_waitcnt vmcnt(" #n ")" ::: "memory")
#define PG8_WAIT_L(n) asm volatile("s_waitcnt lgkmcnt(" #n ")" ::: "memory")
#define PG8_BAR __builtin_amdgcn_s_barrier()
#define PG8_SCHED __builtin_amdgcn_sched_barrier(0)

template <class Epi, class Sched, bool ALIGN_EPI, bool GATHER, int MMA = 0>
__device__ __forceinline__ void gemm_phase(LAS unsigned char* lds, const int K, const Sched& S, const Epi& E) {
    const int tid = threadIdx.x, wid = __builtin_amdgcn_readfirstlane(tid >> 6), lane = tid & 63, wr = wid >> 2, wc = wid & 3, fr = lane & 15, fq = lane >> 4;
    const int nt = K / BK; const int PA = S.PA, PB = S.PB;
    int Rr[2], Cc[2]; unsigned voffA[2], voffB[2];
#pragma unroll
    for (int i = 0; i < 2; ++i) { stage_rc(tid * 16 + i * 8192, Rr[i], Cc[i]); const int Rb = Epi::PERM ? ((Rr[i] & ~31) + perm32(Rr[i] & 31)) : Rr[i];
        voffA[i] = (unsigned)(Rr[i] * PA + Cc[i]) * 2u; voffB[i] = (unsigned)(Rb * PB + Cc[i]) * 2u; }
    const size_t kstep = (size_t)(BK * 2);
    const size_t hstepB = (size_t)HALF * PB * 2;
    const size_t hstepA = GATHER ? 0 : (size_t)HALF * PA * 2;
    const unsigned ldsw = (unsigned)wid * 1024u;
    const unsigned ldsb = (unsigned)__builtin_amdgcn_readfirstlane((int)((unsigned)(size_t)lds + ldsw));
    const int aoff = lds_byte(wr * 64 + fr, fq * 8), boff = lds_byte(wc * 32 + fr, fq * 8);
#define PG8_SA(b, h) (((b) * 2 + (h)) * HTB)
#define PG8_SB(b, h) ((4 + (b) * 2 + (h)) * HTB)
#if PG8_ASM_DMA
#define PG8_DMA1(ldsaddr, gbase, voff) do { unsigned keep_; asm volatile("s_mov_b32 %0, m0\n\ts_mov_b32 m0, %3\n\ts_nop 0\n\tglobal_load_lds_dwordx4 %1, %2\n\ts_mov_b32 m0, %0" \
        : "=&s"(keep_) : "v"(voff), "s"(gbase), "s"(ldsaddr) : "memory"); } while (0)
#define PG8_ST2(bufoff, gbase, v0, v1) do { PG8_DMA1(ldsb + (unsigned)(bufoff), (const char*)(gbase), (v0)); PG8_DMA1(ldsb + (unsigned)(bufoff) + 8192u, (const char*)(gbase), (v1)); } while (0)
#else
#define PG8_ST2(bufoff, gbase, v0, v1) do { \
        __builtin_amdgcn_global_load_lds((const unsigned*)((const char*)(gbase) + (v0)), (LAS unsigned*)(lds + (bufoff) + ldsw), 16, 0, 0); \
        __builtin_amdgcn_global_load_lds((const unsigned*)((const char*)(gbase) + (v1)), (LAS unsigned*)(lds + (bufoff) + ldsw + 8192), 16, 0, 0); } while (0)
#endif
#define PG8_STB(bufoff, gbase) PG8_ST2(bufoff, gbase, voffB[0], voffB[1])
#define PG8_LDA(dst, b, h) do { _Pragma("unroll") for (int m = 0; m < 4; ++m) { \
        if constexpr (MMA == 2) dst##8[m] = __builtin_shufflevector(*(const LAS i32x4*)(lds + PG8_SA(b, h) + aoff + m * 2048), *(const LAS i32x4*)(lds + PG8_SA(b, h) + aoff + m * 2048 + 1024), 0, 1, 2, 3, 4, 5, 6, 7); \
        else { _Pragma("unroll") for (int k = 0; k < 2; ++k) dst[m][k] = *(const LAS bf16x8*)(lds + PG8_SA(b, h) + aoff + m * 2048 + k * 1024); } } } while (0)
#define PG8_LDB(dst, b, h) do { _Pragma("unroll") for (int n = 0; n < 2; ++n) { \
        if constexpr (MMA == 2) dst##8[n] = __builtin_shufflevector(*(const LAS i32x4*)(lds + PG8_SB(b, h) + boff + n * 2048), *(const LAS i32x4*)(lds + PG8_SB(b, h) + boff + n * 2048 + 1024), 0, 1, 2, 3, 4, 5, 6, 7); \
        else { _Pragma("unroll") for (int k = 0; k < 2; ++k) dst[n][k] = *(const LAS bf16x8*)(lds + PG8_SB(b, h) + boff + n * 2048 + k * 1024); } } } while (0)
#define PG8_MMA(ai, bj, At, Bt) do { __builtin_amdgcn_s_setprio(1); _Pragma("unroll") for (int m = 0; m < 4; ++m) _Pragma("unroll") for (int n = 0; n < 2; ++n) { \
        if constexpr (MMA == 0) { _Pragma("unroll") for (int k = 0; k < 2; ++k) acc[ai][bj][m][n] = __builtin_amdgcn_mfma_f32_16x16x32_bf16(Bt[n][k], At[m][k], acc[ai][bj][m][n], 0, 0, 0); } \
        else if constexpr (MMA == 1) { _Pragma("unroll") for (int k = 0; k < 2; ++k) { const i64x2 b2_ = __builtin_bit_cast(i64x2, Bt[n][k]), a2_ = __builtin_bit_cast(i64x2, At[m][k]); \
            acc[ai][bj][m][n] = __builtin_amdgcn_mfma_f32_16x16x32_fp8_fp8(b2_[0], a2_[0], acc[ai][bj][m][n], 0, 0, 0); acc[ai][bj][m][n] = __builtin_amdgcn_mfma_f32_16x16x32_fp8_fp8(b2_[1], a2_[1], acc[ai][bj][m][n], 0, 0, 0); } } \
        else { acc[ai][bj][m][n] = __builtin_amdgcn_mfma_scale_f32_16x16x128_f8f6f4(Bt##8[n], At##8[m], acc[ai][bj][m][n], 0, 0, 0, 0x7f7f7f7f, 0, 0x7f7f7f7f); } \
        } __builtin_amdgcn_s_setprio(0); } while (0)
    Unit cur, nxt; int ui = 0;
    if (!S.next(0, cur)) return;
    f32x4 acc[2][2][4][2];
#pragma unroll
    for (int a = 0; a < 2; ++a)
#pragma unroll
        for (int b = 0; b < 2; ++b)
#pragma unroll
            for (int m = 0; m < 4; ++m)
#pragma unroll
                for (int n = 0; n < 2; ++n) acc[a][b][m][n] = (f32x4){0.f, 0.f, 0.f, 0.f};
    bf16x8 At[4][2], B0[2][2], B1[2][2]; i32x8 At8[4], B08[2], B18[2];
    const char* cA = S.a_ptr(cur); const char* cB = S.b_ptr(cur);
    S.a_ready(cur);
    unsigned c00 = voffA[0], c01 = voffA[1], c10 = voffA[0], c11 = voffA[1];
    if constexpr (GATHER) {
        c00 = (S.a_row(cur, Rr[0]) * (unsigned)PA + (unsigned)Cc[0]) * 2u; c01 = (S.a_row(cur, Rr[1]) * (unsigned)PA + (unsigned)Cc[1]) * 2u;
        c10 = (S.a_row(cur, HALF + Rr[0]) * (unsigned)PA + (unsigned)Cc[0]) * 2u; c11 = (S.a_row(cur, HALF + Rr[1]) * (unsigned)PA + (unsigned)Cc[1]) * 2u;
    }
    PG8_STB(PG8_SB(0, 0), cB); PG8_STB(PG8_SB(0, 1), cB + hstepB); PG8_ST2(PG8_SA(0, 0), cA, c00, c01); PG8_ST2(PG8_SA(0, 1), cA + hstepA, c10, c11);
    if (wr == 1) PG8_BAR;
    PG8_WAIT_V(2); PG8_BAR;
    PG8_STB(PG8_SB(1, 0), cB + kstep); PG8_ST2(PG8_SA(1, 0), cA + kstep, c00, c01); PG8_STB(PG8_SB(1, 1), cB + hstepB + kstep);
    PG8_WAIT_V(6); PG8_BAR;
    for (;;) {
        const bool has_next = S.next(ui + 1, nxt);
        const char* nA = has_next ? S.a_ptr(nxt) : cA; const char* nB = has_next ? S.b_ptr(nxt) : cB;
#pragma unroll 1
        for (int t = 0; t < nt; t += 2) {
            const bool last = (t == nt - 2);
            const char* a1 = cA + (size_t)(t + 1) * kstep;
            const char* a2 = last ? nA : cA + (size_t)(t + 2) * kstep; const char* b2 = last ? nB : cB + (size_t)(t + 2) * kstep;
            const char* a3 = a2 + kstep; const char* b3 = b2 + kstep;
            if constexpr (Epi::MIDSCALE) { if (t == nt / 2) E.midscale(acc, cur, wr, fr); }
            if (last && has_next) S.a_ready(nxt);
            PG8_LDB(B0, 0, 0); PG8_LDB(B1, 0, 1); PG8_SCHED; PG8_LDA(At, 0, 0); PG8_ST2(PG8_SA(1, 1), a1 + hstepA, c10, c11);
            if constexpr (GATHER) { if (last && has_next) {
                int R0, C0, R1, C1; stage_rc(tid * 16, R0, C0); stage_rc(tid * 16 + 8192, R1, C1);
                c00 = (S.a_row(nxt, R0) * (unsigned)PA + (unsigned)C0) * 2u; c01 = (S.a_row(nxt, R1) * (unsigned)PA + (unsigned)C1) * 2u;
                c10 = (S.a_row(nxt, HALF + R0) * (unsigned)PA + (unsigned)C0) * 2u; c11 = (S.a_row(nxt, HALF + R1) * (unsigned)PA + (unsigned)C1) * 2u; } }
            PG8_WAIT_V(8); PG8_WAIT_L(0); PG8_BAR; PG8_MMA(0, 0, At, B0); PG8_MMA(0, 1, At, B1); PG8_BAR; PG8_SCHED;
            PG8_LDA(At, 0, 1); PG8_STB(PG8_SB(0, 0), b2); PG8_STB(PG8_SB(0, 1), b2 + hstepB); PG8_ST2(PG8_SA(0, 0), a2, c00, c01);
            PG8_WAIT_V(8); PG8_WAIT_L(0); PG8_BAR; PG8_MMA(1, 0, At, B0); PG8_MMA(1, 1, At, B1); PG8_BAR; PG8_SCHED;
            PG8_LDB(B0, 1, 0); PG8_LDB(B1, 1, 1); PG8_SCHED; PG8_LDA(At, 1, 0); PG8_ST2(PG8_SA(0, 1), a2 + hstepA, c10, c11);
            PG8_WAIT_V(8); PG8_WAIT_L(0); PG8_BAR; PG8_MMA(0, 0, At, B0); PG8_MMA(0, 1, At, B1); PG8_BAR; PG8_SCHED;
            PG8_LDA(At, 1, 1); PG8_STB(PG8_SB(1, 0), b3); PG8_STB(PG8_SB(1, 1), b3 + hstepB); PG8_ST2(PG8_SA(1, 0), a3, c00, c01);
            PG8_WAIT_V(8); PG8_WAIT_L(0); PG8_BAR; PG8_MMA(1, 0, At, B0); PG8_MMA(1, 1, At, B1); PG8_BAR; PG8_SCHED;
        }
        if constexpr (ALIGN_EPI) { if (wr == 0) PG8_BAR; }
        E(acc, cur, wr, wc, fr, fq);
        S.done(cur);
        if (!has_next) break;
#pragma unroll
        for (int a = 0; a < 2; ++a)
#pragma unroll
            for (int b = 0; b < 2; ++b)
#pragma unroll
                for (int m = 0; m < 4; ++m)
#pragma unroll
                    for (int n = 0; n < 2; ++n) acc[a][b][m][n] = (f32x4){0.f, 0.f, 0.f, 0.f};
        cur = nxt; cA = nA; cB = nB; ++ui;
        if constexpr (ALIGN_EPI) { if (wr == 1) PG8_BAR; }
    }
    PG8_WAIT_V(0);
    if constexpr (!ALIGN_EPI) { if (wr == 0) PG8_BAR; }
    PG8_BAR;
#undef PG8_SA
#undef PG8_SB
#undef PG8_ST2
#undef PG8_STB
#undef PG8_LDA
#undef PG8_LDB
#undef PG8_MMA
}

struct EpiScaleBf16 {
    static constexpr bool PERM = true, MIDSCALE = false;
    bf16_t* O; const float* rs; int ldc; int pad;
    __device__ __forceinline__ void midscale(f32x4 (&)[2][2][4][2], const Unit&, int, int) const {}
    __device__ __forceinline__ void operator()(const f32x4 (&acc)[2][2][4][2], const Unit& u, int wr, int wc, int fr, int fq) const {
        const int row0 = u.pm * BM + wr * 64 + fr, col0 = u.pn * BM + wc * 32 + 8 * fq;
#pragma unroll
        for (int ai = 0; ai < 2; ++ai)
#pragma unroll
            for (int m = 0; m < 4; ++m) { const int row = row0 + ai * HALF + m * 16; const float s = rs ? rs[row] : 1.f; bf16_t* rowp = O + (size_t)row * ldc + col0;
#pragma unroll
                for (int bj = 0; bj < 2; ++bj) { const f32x4 v0 = acc[ai][bj][m][0] * s, v1 = acc[ai][bj][m][1] * s;
                    u32x4 w; w.x = pk2(v0[0], v0[1]); w.y = pk2(v0[2], v0[3]); w.z = pk2(v1[0], v1[1]); w.w = pk2(v1[2], v1[3]);
                    *(u32x4*)(rowp + bj * HALF) = w; } }
    }
};
}

#define XB_TMO      128
#define XB_XCNT(j)  (256  + 64 * (j))
#define XB_XSUB(j)  (1280 + 64 * (j))
#define XB_XGEN(j)  (2304 + 64 * (j))
#define XB_TOP      3328
#define XB_TOPGEN   3392
#define XCD_BAR_WORDS 3456
#define XB_SPIN_CAP (1u << 18)
__device__ __forceinline__ unsigned xb_ld(unsigned* p)              { return __hip_atomic_load(p, __ATOMIC_RELAXED, __HIP_MEMORY_SCOPE_AGENT); }
__device__ __forceinline__ unsigned xb_add(unsigned* p, unsigned v) { return __hip_atomic_fetch_add(p, v, __ATOMIC_RELAXED, __HIP_MEMORY_SCOPE_AGENT); }
__device__ __forceinline__ unsigned xb_xcc_id() { return (unsigned)__builtin_amdgcn_s_getreg((3 << 11) | 20) & 0xFu; }
#define XB_SPIN(cond, bar) do { unsigned _sp = 0; while (cond) { __builtin_amdgcn_s_sleep(1); \
    if ((++_sp & 255u) == 0u) { if (xb_ld(&(bar)[XB_TMO])) break; if (_sp > XB_SPIN_CAP) { atomicAdd(&(bar)[XB_TMO], 1u); break; } } } } while (0)
struct XcdBarrier { unsigned* bar; unsigned x; volatile LAS unsigned* st; };
__device__ __forceinline__ XcdBarrier xcd_barrier_post(unsigned* bar, volatile LAS unsigned* st) {
    XcdBarrier b; b.bar = bar; b.x = xb_xcc_id(); b.st = st;
    if (threadIdx.x == 0) (void)xb_add(&bar[XB_XCNT(b.x)], 1u);
    return b;
}
__device__ __forceinline__ void xcd_barrier_complete(unsigned* bar, unsigned x, unsigned& nloc, unsigned& nx) {
    const unsigned G = gridDim.x * gridDim.y * gridDim.z;
    unsigned sum, cnt, mine, sp = 0u;
    for (;;) {
        sum = 0u; cnt = 0u; mine = 0u;
#pragma unroll
        for (unsigned j = 0; j < 16; ++j) { const unsigned c = xb_ld(&bar[XB_XCNT(j)]); sum += c; cnt += (c > 0u) ? 1u : 0u; mine = (j == x) ? c : mine; }
        if (sum == G) break;
        __builtin_amdgcn_s_sleep(1);
        if ((++sp & 255u) == 0u) { if (xb_ld(&bar[XB_TMO])) break; if (sp > XB_SPIN_CAP) { atomicAdd(&bar[XB_TMO], 1u); break; } }
    }
    nloc = mine > 0u ? mine : 1u; nx = cnt > 0u ? cnt : 1u;
}
__device__ __forceinline__ void xcd_barrier(const XcdBarrier& b) {
    asm volatile("s_waitcnt vmcnt(0)" ::: "memory");
    __syncthreads();
    if (threadIdx.x == 0) {
        unsigned* bar = b.bar;
        __builtin_amdgcn_s_waitcnt(0);
        unsigned nloc = b.st[0], nx = b.st[1];
        if (nloc == 0u) { xcd_barrier_complete(bar, b.x, nloc, nx); b.st[0] = nloc; b.st[1] = nx; }
        const unsigned old = xb_add(&bar[XB_XSUB(b.x)], 1u);
        const unsigned gen = old / nloc;
        if (old + 1u == (gen + 1u) * nloc) {
            __builtin_amdgcn_fence(__ATOMIC_RELEASE, "agent");
            asm volatile("s_waitcnt vmcnt(0)" ::: "memory");
            const unsigned og = xb_add(&bar[XB_TOP], 1u);
            const unsigned tg = og / nx;
            if (og + 1u == (tg + 1u) * nx) xb_add(&bar[XB_TOPGEN], 1u);
            else XB_SPIN(xb_ld(&bar[XB_TOPGEN]) == tg, bar);
            __builtin_amdgcn_fence(__ATOMIC_ACQUIRE, "agent");
            xb_add(&bar[XB_XGEN(b.x)], 1u);
            asm volatile("s_waitcnt vmcnt(0)" ::: "memory");
        } else {
            XB_SPIN(xb_ld(&bar[XB_XGEN(b.x)]) == gen, bar);
            __builtin_amdgcn_fence(__ATOMIC_ACQUIRE, "agent");
            asm volatile("s_waitcnt vmcnt(0)" ::: "memory");
        }
    }
    __syncthreads();
}


constexpr size_t MiB = 1u << 20;
constexpr size_t WS_CTL = 0, CTL_ZERO_BYTES = 64 * 1024;
constexpr int CW_BAR = 1024;
constexpr int CW_CNT = 8192;
constexpr int CW_TILE = 5120;
constexpr int CW_PANA = 9216, CW_PANB = 11264;

__device__ __forceinline__ void p0_transpose_item(const float* W, int K, int N, const float* ks, bf16_t* WT, int rbase, int gshift, int gstride, LAS float* scr, int item, int lane) {
    const int nblk = N / 32, kb = item / nblk, nb = item % nblk, k0 = 64 * kb, n0 = 32 * nb;
#pragma unroll 8
    for (int i = 0; i < 32; ++i) { const int kk = 2 * i + (lane >> 5); const float s = ks ? ks[k0 + kk] : 1.f; scr[kk * 33 + (lane & 31)] = W[(size_t)(k0 + kk) * N + n0 + (lane & 31)] * s; }
    asm volatile("s_waitcnt lgkmcnt(0)" ::: "memory");
    const int c = lane & 7;
#pragma unroll
    for (int j = 0; j < 4; ++j) { const int nl = (lane >> 3) + 8 * j, n = n0 + nl; const LAS float* s = scr + (8 * c) * 33 + nl;
        const int row = rbase + (n >> gshift) * gstride + (n & ((1 << gshift) - 1));
        u32x4 o; o.x = pk2(s[0 * 33], s[1 * 33]); o.y = pk2(s[2 * 33], s[3 * 33]); o.z = pk2(s[4 * 33], s[5 * 33]); o.w = pk2(s[6 * 33], s[7 * 33]);
        *(u32x4*)(WT + (size_t)row * K + k0 + 8 * c) = o; }
    asm volatile("s_waitcnt lgkmcnt(0)" ::: "memory");
}

constexpr size_t MB_ = 1u << 20, KB_ = 1024;
namespace wsm {
constexpr size_t ctl = 0, r0 = 64 * KB_, rL = 128 * KB_, r2 = 192 * KB_, rP = 256 * KB_, tokE = 320 * KB_, tokPos = 448 * KB_,
    rope = 1 * MB_, wtot = 5 * MB_, ctot = 6 * MB_, ssq1p = 7 * MB_, ssq3p = 8 * MB_, lt = 9 * MB_, lw = 11 * MB_, lr = 13 * MB_, wr_t = 15 * MB_, wag_t = 15 * MB_ + 512 * KB_,
    w_in_t = 16 * MB_, w_out_t = 20 * MB_, wgu_t = 22 * MB_  , projb = 86 * MB_, x1q = 86 * MB_  , x2q = 86 * MB_  , x1b = 110 * MB_,
    wd_t = 142 * MB_, w_pg_t = 174 * MB_, w_pp_t = 176 * MB_,
    xb = 177 * MB_, x2b = 177 * MB_, pb = 209 * MB_, mix = 209 * MB_, hid = 209 * MB_, x3b = 110 * MB_, pp = 249 * MB_, y2 = 54 * MB_, END = 281 * MB_;
}
struct Args {
    const float* in[28]; float* out; unsigned char* ws;
    int ph_lo, ph_hi, mode, pad;
};
typedef const __attribute__((address_space(4))) Args* KArgsP;
__device__ __forceinline__ KArgsP kargs() { KArgsP p = (KArgsP)__builtin_amdgcn_kernarg_segment_ptr(); asm volatile("" : "+s"(p)); return p; }
struct Frame {
    LAS unsigned char* lds; volatile LAS unsigned* MISC; gu32* ctl;
    int tid, lane, wave, vcu, G;
};
__device__ __forceinline__ float fexp2(float x) { return __builtin_amdgcn_exp2f(x); }
__device__ __forceinline__ float fexp(float x) { return __builtin_amdgcn_exp2f(x * 1.4426950408889634f); }
__device__ __forceinline__ float frcp(float x) { return __builtin_amdgcn_rcpf(x); }
__device__ __forceinline__ float fsigmoid(float x) { return frcp(1.f + fexp(-x)); }
__device__ __forceinline__ float fgelu_tanh(float x) {
    const float u = 0.7978845608028654f * (x + 0.044715f * x * x * x);
    return x * (1.f - frcp(1.f + fexp(2.f * u)));
}

__device__ __forceinline__ void p0_tr64(const float* W, int K, int N, const float* ks, bf16_t* WT, int rbase, int gshift, int gstride, LAS unsigned* t2, int item, int lane) {
    const int nblk = N / 64, kb = item / nblk, nb = item % nblk, k0 = 64 * kb, n0 = 64 * nb;
    const int n4 = lane & 15, kr = lane >> 4;
    f32x4 va[8], vb[8];
#pragma unroll
    for (int i = 0; i < 8; ++i) { const int k = k0 + 8 * i + 2 * kr; va[i] = *(const f32x4*)(W + (size_t)k * N + n0 + 4 * n4); vb[i] = *(const f32x4*)(W + (size_t)(k + 1) * N + n0 + 4 * n4); }
#pragma unroll
    for (int i = 0; i < 8; ++i) { const int k = k0 + 8 * i + 2 * kr, kp = 4 * i + kr; const float s0 = ks ? ks[k] : 1.f, s1 = ks ? ks[k + 1] : 1.f;
        LAS unsigned* d = t2 + (4 * n4) * 33 + kp;
        d[0] = pk2(va[i].x * s0, vb[i].x * s1); d[33] = pk2(va[i].y * s0, vb[i].y * s1); d[66] = pk2(va[i].z * s0, vb[i].z * s1); d[99] = pk2(va[i].w * s0, vb[i].w * s1); }
    asm volatile("s_waitcnt lgkmcnt(0)" ::: "memory");
    const int nl = lane >> 3, c = lane & 7;
#pragma unroll
    for (int j = 0; j < 8; ++j) { const int n = 8 * j + nl; const LAS unsigned* s = t2 + n * 33 + 4 * c; const int ng = n0 + n;
        const int row = rbase + (ng >> gshift) * gstride + (ng & ((1 << gshift) - 1));
        *(u32x4*)(WT + (size_t)row * K + k0 + 8 * c) = (u32x4){s[0], s[1], s[2], s[3]}; }
    asm volatile("s_waitcnt lgkmcnt(0)" ::: "memory");
}

__device__ __forceinline__ unsigned pk4_fp8(float a, float b, float c, float d) {
    int w = 0; w = __builtin_amdgcn_cvt_pk_fp8_f32(a, b, w, false); w = __builtin_amdgcn_cvt_pk_fp8_f32(c, d, w, true); return (unsigned)w;
}
#ifndef MOE_MMA
#define MOE_MMA 1
#endif
#ifndef PLE_MMA
#define PLE_MMA 1
#endif
#ifndef MOE2_MMA
#define MOE2_MMA 2
#endif
constexpr float WQ_SCALE = 32.f, HQ_SCALE = 32.f, YQ_SCALE = 64.f;
__device__ __forceinline__ void p0_tr64_q(const float* W, int K, int N, const float* ks, unsigned char* WQ, int rbase, int gshift, int gstride, LAS unsigned* t4, int item, int lane) {
    const int nblk = N / 64, kb = item / nblk, nb = item % nblk, k0 = 64 * kb, n0 = 64 * nb;
    const int n4 = lane & 15, kr = lane >> 4;
    f32x4 v[4][4];
#pragma unroll
    for (int i = 0; i < 4; ++i)
#pragma unroll
        for (int r = 0; r < 4; ++r) v[i][r] = *(const f32x4*)(W + (size_t)(k0 + 16 * i + 4 * kr + r) * N + n0 + 4 * n4);
#pragma unroll
    for (int i = 0; i < 4; ++i) { const int k = k0 + 16 * i + 4 * kr; float s[4];
#pragma unroll
        for (int r = 0; r < 4; ++r) s[r] = (ks ? ks[k + r] : 1.f) * WQ_SCALE;
        LAS unsigned* d = t4 + (4 * n4) * 17 + 4 * i + kr;
        d[0] = pk4_fp8(v[i][0].x * s[0], v[i][1].x * s[1], v[i][2].x * s[2], v[i][3].x * s[3]); d[17] = pk4_fp8(v[i][0].y * s[0], v[i][1].y * s[1], v[i][2].y * s[2], v[i][3].y * s[3]);
        d[34] = pk4_fp8(v[i][0].z * s[0], v[i][1].z * s[1], v[i][2].z * s[2], v[i][3].z * s[3]); d[51] = pk4_fp8(v[i][0].w * s[0], v[i][1].w * s[1], v[i][2].w * s[2], v[i][3].w * s[3]); }
    asm volatile("s_waitcnt lgkmcnt(0)" ::: "memory");
    const int nl = lane >> 2, c = lane & 3;
#pragma unroll
    for (int j = 0; j < 4; ++j) { const int n = 16 * j + nl; const LAS unsigned* s = t4 + n * 17 + 4 * c; const int ng = n0 + n;
        const int row = rbase + (ng >> gshift) * gstride + (ng & ((1 << gshift) - 1));
        *(u32x4*)(WQ + (size_t)row * K + k0 + 16 * c) = (u32x4){s[0], s[1], s[2], s[3]}; }
    asm volatile("s_waitcnt lgkmcnt(0)" ::: "memory");
}

__device__ __forceinline__ void p0_experts(const Frame& F, KArgsP a, int w, int nw, int part) {
    LAS unsigned* t2 = (LAS unsigned*)(F.lds + F.wave * 8704); unsigned char* ws = a->ws; const int lane = F.lane;
    const float* g_ffn = a->in[16]; const float* w_eg = a->in[21]; const float* w_eu = a->in[22]; const float* w_ed = a->in[23];
    constexpr int I_G = (D / 64) * (FF / 64), I_D = (FF / 64) * (D / 64);
    if (part & 1) for (int r = w; r < NE * 2 * I_G; r += nw) { const int e = r / (2 * I_G), q = r % (2 * I_G), up = q / I_G, item = q % I_G;
        p0_tr64_q((up ? w_eu : w_eg) + (size_t)e * D * FF, D, FF, g_ffn, (unsigned char*)(ws + wsm::wgu_t) + (size_t)e * 1024 * D, 128 * up, 7, 256, t2, item, lane); }
    if (part & 2) for (int r = w; r < NE * I_D; r += nw) { const int e = r / I_D, item = r % I_D;
        p0_tr64_q(w_ed + (size_t)e * FF * D, FF, D, nullptr, (unsigned char*)(ws + wsm::wd_t) + (size_t)e * D * FF, 0, 30, 0, t2, item, lane); }
}
__device__ __forceinline__ void p0_prologue(const Frame& F, KArgsP a) {
    LAS unsigned* t2 = (LAS unsigned*)(F.lds + F.wave * 8704);
    const int gw = F.vcu * NWAVES + F.wave, NGW = F.G * NWAVES, lane = F.lane;
    unsigned char* ws = a->ws;
    const float* w_in = a->in[4]; const float* g_mix = a->in[3]; const float* w_out = a->in[15]; const float* g_attn = a->in[13]; const float* g_lru = a->in[14];
    const float* g_ffn = a->in[16];
    const float* g_ple = a->in[24]; const float* w_pg = a->in[25]; const float* w_pp = a->in[26];
    constexpr int I_IN = (D / 64) * (NPROJ / 64), I_OUT = (D / 64) * (D / 64), I_PG = I_OUT, I_PP = (PLE / 64) * (D / 64);
    constexpr int NITEMS = I_IN + I_OUT + I_PG + I_PP;
    for (int it = gw; it < NITEMS; it += NGW) {
        int r = it;
        if (r < I_IN) { p0_tr64(w_in, D, NPROJ, g_mix, (bf16_t*)(ws + wsm::w_in_t), 0, 30, 0, t2, r, lane); continue; } r -= I_IN;
        if (r < I_PP) { p0_tr64(w_pp, PLE, D, nullptr, (bf16_t*)(ws + wsm::w_pp_t), 0, 30, 0, t2, r, lane); continue; } r -= I_PP;
        if (r < I_OUT) { const int kb = r / (D / 64); const float* ks = kb < 8 ? g_attn : g_lru - 512; p0_tr64(w_out, D, D, ks, (bf16_t*)(ws + wsm::w_out_t), 0, 30, 0, t2, r, lane); continue; } r -= I_OUT;
        p0_tr64_q(w_pg, D, D, g_ple, (unsigned char*)(ws + wsm::w_pg_t), 0, 30, 0, t2, r, lane);
    }
    if (F.G < 256) p0_experts(F, a, gw, NGW, 3);
    const float* x = a->in[0]; bf16_t* xb = (bf16_t*)(ws + wsm::xb); float* r0 = (float*)(ws + wsm::r0);
    for (int m = gw; m < T; m += 2 * NGW) {
        const int m2 = m + NGW;
        const f32x4* xr = (const f32x4*)(x + (size_t)m * D) + lane; const f32x4* xr2 = (const f32x4*)(x + (size_t)(m2 < T ? m2 : m) * D) + lane; f32x4 v[4], v2[4]; float s = 0.f, s2 = 0.f;
#pragma unroll
        for (int j = 0; j < 4; ++j) { v[j] = xr[64 * j]; v2[j] = xr2[64 * j]; }
#pragma unroll
        for (int j = 0; j < 4; ++j) { s += (v[j].x * v[j].x + v[j].y * v[j].y) + (v[j].z * v[j].z + v[j].w * v[j].w); s2 += (v2[j].x * v2[j].x + v2[j].y * v2[j].y) + (v2[j].z * v2[j].z + v2[j].w * v2[j].w); }
        s = wsum(s); s2 = wsum(s2);
        u32x2* o8 = (u32x2*)(xb + (size_t)m * D) + lane;
#pragma unroll
        for (int j = 0; j < 4; ++j) { u32x2 w; w.x = pk2(v[j].x, v[j].y); w.y = pk2(v[j].z, v[j].w); o8[64 * j] = w; }
        if (lane == 0) r0[m] = rsqrtf(s * (1.f / D) + EPS);
        if (m2 < T) { u32x2* o9 = (u32x2*)(xb + (size_t)m2 * D) + lane;
#pragma unroll
            for (int j = 0; j < 4; ++j) { u32x2 w; w.x = pk2(v2[j].x, v2[j].y); w.y = pk2(v2[j].z, v2[j].w); o9[64 * j] = w; }
            if (lane == 0) r0[m2] = rsqrtf(s2 * (1.f / D) + EPS); }
    }
    const float* p = a->in[1]; bf16_t* pb = (bf16_t*)(ws + wsm::pb);
    for (int m0 = gw; m0 < T; m0 += 8 * NGW) { f32x4 v[8];
#pragma unroll
        for (int k = 0; k < 8; ++k) { const int m = m0 + k * NGW; v[k] = ((const f32x4*)(p + (size_t)(m < T ? m : m0) * PLE))[lane]; }
#pragma unroll
        for (int k = 0; k < 8; ++k) { const int m = m0 + k * NGW; if (m < T) { u32x2 w; w.x = pk2(v[k].x, v[k].y); w.y = pk2(v[k].z, v[k].w); ((u32x2*)(pb + (size_t)m * PLE))[lane] = w; } } }
    const int* pos = (const int*)a->in[2]; f32x2* rope = (f32x2*)(ws + wsm::rope);
    for (int idx = (F.vcu * NTHR + F.tid); idx < T * 32; idx += F.G * NTHR) { const int t = idx >> 5, i = idx & 31;
        const float inv_freq = powf(10000.f, -(float)(2 * i) / 64.f); const float ang = (float)pos[t] * inv_freq; float sn, cs; sincosf(ang, &sn, &cs); rope[idx] = (f32x2){cs, sn}; }
    { const float* wa = a->in[8]; const float* wx = a->in[10]; bf16_t* wag_t = (bf16_t*)(ws + wsm::wag_t);
      for (int idx = (F.vcu * NTHR + F.tid); idx < 8 * 2 * 64 * 64; idx += F.G * NTHR) { const int i = idx & 63, j = (idx >> 6) & 63, gt = (idx >> 12) & 1, hb = idx >> 13;
          const float v = (gt ? wx : wa)[(size_t)(hb * 64 + i) * 64 + j]; wag_t[idx] = (bf16_t)(pk2(v, 0.f) & 0xffffu); } }
    const float* w_rg = a->in[17]; const float* w_re = a->in[19]; bf16_t* wr_t = (bf16_t*)(ws + wsm::wr_t);
    for (int idx = (F.vcu * NTHR + F.tid); idx < 48 * D; idx += F.G * NTHR) { const int j = idx >> 10, k = idx & 1023;
        float v = 0.f; if (j < 4) v = w_rg[k * 4 + j] * g_ffn[k]; else if (j < 36) v = w_re[k * 32 + (j - 4)] * g_ffn[k];
        wr_t[idx] = (bf16_t)(pk2(v, 0.f) & 0xffffu); }
}

constexpr int LB = 512;
constexpr int LRU_XS = 0, LRU_XS_PITCH = 144;
constexpr int LRU_WTL = LRU_XS + LB * LRU_XS_PITCH;
static_assert(LRU_WTL + 4096 <= RING_BYTES, "lru lds");

__device__ __forceinline__ void lruA_unit(const Frame& F, KArgsP a, int b, int hb, int chunk) {
    LAS unsigned char* lds = F.lds; const int tid = F.tid, lane = F.lane, wave = F.wave;
    unsigned char* ws = a->ws;
    const bf16_t* projb = (const bf16_t*)(ws + wsm::projb); bf16_t* hl = (bf16_t*)a->out; bf16_t* pl = hl + (size_t)T * 512;
    float* wtot = (float*)(ws + wsm::wtot); float* ctot = (float*)(ws + wsm::ctot); const bf16_t* wag_t = (const bf16_t*)(ws + wsm::wag_t);
    const float* cw = a->in[6]; const float* cb = a->in[7]; const float* ba = a->in[9]; const float* bx = a->in[11]; const float* lam = a->in[12];
    const int s0 = chunk * LB; const size_t t0 = (size_t)b * SEQ + s0;
    { const int q8 = tid & 7, cch = hb * 64 + q8 * 8;
      float cwr[4][8], cbr[8];
#pragma unroll
      for (int j = 0; j < 4; ++j)
#pragma unroll
          for (int e = 0; e < 8; ++e) cwr[j][e] = cw[j * 512 + cch + e];
#pragma unroll
      for (int e = 0; e < 8; ++e) cbr[e] = cb[cch + e];
#pragma unroll 1
      for (int i = 0; i < 2; ++i) {
          const int tq = (tid >> 3) + 64 * i;
          float xv[4][8];
#pragma unroll
          for (int tk = 0; tk < 4; ++tk)
#pragma unroll
              for (int e = 0; e < 8; ++e) xv[tk][e] = cbr[e];
          u32x4 w[7];
#pragma unroll
          for (int m = 0; m < 7; ++m) { const int sj = s0 + 4 * tq - 3 + m; const int sc = sj < 0 ? 0 : sj;
              w[m] = *(const u32x4*)(projb + ((size_t)b * SEQ + sc) * NPROJ + OFF_LX + cch); }
#pragma unroll
          for (int m = 0; m < 7; ++m) { const bool ok = (s0 + 4 * tq - 3 + m) >= 0; const u32x4 ww = w[m];
              const float r[8] = {ok ? bflo(ww.x) : 0.f, ok ? bfhi(ww.x) : 0.f, ok ? bflo(ww.y) : 0.f, ok ? bfhi(ww.y) : 0.f, ok ? bflo(ww.z) : 0.f, ok ? bfhi(ww.z) : 0.f, ok ? bflo(ww.w) : 0.f, ok ? bfhi(ww.w) : 0.f};
#pragma unroll
              for (int tk = 0; tk < 4; ++tk) { const int j = m - tk; if (j >= 0 && j < 4) {
#pragma unroll
                  for (int e = 0; e < 8; ++e) xv[tk][e] += cwr[j][e] * r[e]; } } }
#pragma unroll
          for (int tk = 0; tk < 4; ++tk)
              *(LAS u32x4*)(lds + LRU_XS + (4 * tq + tk) * LRU_XS_PITCH + q8 * 16) = (u32x4){pk2(xv[tk][0], xv[tk][1]), pk2(xv[tk][2], xv[tk][3]), pk2(xv[tk][4], xv[tk][5]), pk2(xv[tk][6], xv[tk][7])};
      } }
    __syncthreads();
    const int cl = lane & 15, kq = lane >> 4, tb0 = 64 * wave;
    bf16x8 af[4][2];
#pragma unroll
    for (int mt = 0; mt < 4; ++mt)
#pragma unroll
        for (int ks = 0; ks < 2; ++ks) af[mt][ks] = *(const LAS bf16x8*)(lds + LRU_XS + (tb0 + 16 * mt + cl) * LRU_XS_PITCH + (32 * ks + 8 * kq) * 2);
    LAS float* wtl = (LAS float*)(lds + LRU_WTL);
#pragma unroll 1
    for (int nt = 0; nt < 4; ++nt) {
        const int c = hb * 64 + nt * 16 + cl;
        bf16x8 wfa[2], wfx[2];
#pragma unroll
        for (int ks = 0; ks < 2; ++ks) { const bf16_t* s = wag_t + ((size_t)(hb * 2) * 64 + nt * 16 + cl) * 64 + 32 * ks + 8 * kq; wfa[ks] = *(const bf16x8*)s; wfx[ks] = *(const bf16x8*)(s + 64 * 64); }
        const float bac = ba[c], bxc = bx[c];
        const float spc = log1pf(expf(-lam[c])) * (-8.f * 1.4426950408889634f);
        float av[4][4], bv[4][4], Aex[4], Hex[4], At[4], Ht[4];
#pragma unroll
        for (int mt = 0; mt < 4; ++mt) {
            f32x4 ga = {0.f, 0.f, 0.f, 0.f}, gx = {0.f, 0.f, 0.f, 0.f};
#pragma unroll
            for (int ks = 0; ks < 2; ++ks) { ga = __builtin_amdgcn_mfma_f32_16x16x32_bf16(af[mt][ks], wfa[ks], ga, 0, 0, 0); gx = __builtin_amdgcn_mfma_f32_16x16x32_bf16(af[mt][ks], wfx[ks], gx, 0, 0, 0); }
            float A4 = 1.f, H4 = 0.f;
#pragma unroll
            for (int r = 0; r < 4; ++r) { const int tt = tb0 + 16 * mt + 4 * kq + r;
                const float xc = bf2f(*(const LAS unsigned short*)(lds + LRU_XS + tt * LRU_XS_PITCH + (16 * nt + cl) * 2));
                const float rg = fsigmoid(ga[r] + bac), ig = fsigmoid(gx[r] + bxc);
                const float aa = fexp2(rg * spc), mult = sqrtf(fmaxf(1.f - aa * aa, 0.f));
                const float bb = mult * ig * xc;
                av[mt][r] = aa; bv[mt][r] = bb; H4 = aa * H4 + bb; A4 *= aa; }
            { float Ap = __shfl_up(A4, 16), Hp = __shfl_up(H4, 16); if (kq >= 1) { H4 = A4 * Hp + H4; A4 = Ap * A4; }
              Ap = __shfl_up(A4, 32); Hp = __shfl_up(H4, 32); if (kq >= 2) { H4 = A4 * Hp + H4; A4 = Ap * A4; } }
            { const float Ae = __shfl_up(A4, 16), He = __shfl_up(H4, 16); Aex[mt] = kq >= 1 ? Ae : 1.f; Hex[mt] = kq >= 1 ? He : 0.f; }
            At[mt] = __shfl(A4, 48 + cl); Ht[mt] = __shfl(H4, 48 + cl);
        }
        float hin = 0.f, pin = 1.f;
#pragma unroll
        for (int mt = 0; mt < 4; ++mt) {
            float h = Aex[mt] * hin + Hex[mt], pr = Aex[mt] * pin; float hv[4], pv[4];
#pragma unroll
            for (int r = 0; r < 4; ++r) { h = av[mt][r] * h + bv[mt][r]; pr *= av[mt][r]; hv[r] = h; pv[r] = pr; }
            const size_t o = (((t0 + tb0 + 16 * mt) >> 2) + kq) * 2048 + (size_t)c * 4;
            *(u32x2*)(hl + o) = (u32x2){pk2(hv[0], hv[1]), pk2(hv[2], hv[3])}; *(u32x2*)(pl + o) = (u32x2){pk2(pv[0], pv[1]), pk2(pv[2], pv[3])};
            hin = At[mt] * hin + Ht[mt]; pin = At[mt] * pin;
        }
        if (kq == 0) { float* d = wtot + ((size_t)(b * 64 + chunk * 8 + wave) * 2) * 512 + c; d[0] = pin; d[512] = hin; wtl[(wave * 2) * 64 + nt * 16 + cl] = pin; wtl[(wave * 2 + 1) * 64 + nt * 16 + cl] = hin; }
    }
    __syncthreads();
    if (tid < 64) { float A = 1.f, H = 0.f;
#pragma unroll
        for (int w2 = 0; w2 < 8; ++w2) { const float a2 = wtl[(w2 * 2) * 64 + tid], h2 = wtl[(w2 * 2 + 1) * 64 + tid]; H = a2 * H + h2; A *= a2; }
        float* d = ctot + ((size_t)(b * 8 + chunk) * 2) * 512 + hb * 64 + tid; d[0] = A; d[512] = H; }
    __syncthreads();
}

__device__ __forceinline__ void lru_finish(const Frame& F, KArgsP a, int b, int wc) {
    LAS float* cl_ = (LAS float*)F.lds; const int tid = F.tid, lane = F.lane, wave = F.wave;
    unsigned char* ws = a->ws;
    const bf16_t* projb = (const bf16_t*)(ws + wsm::projb); const bf16_t* hl = (const bf16_t*)a->out; const bf16_t* pl = hl + (size_t)T * 512; bf16_t* mix = (bf16_t*)(ws + wsm::mix);
    const float* wtot = (const float*)(ws + wsm::wtot); const float* ctot = (const float*)(ws + wsm::ctot);
    { const int c = wc >> 3, sub = wc & 7; float h = 0.f; float ta[16], th[16];
#pragma unroll
      for (int k = 0; k < 8; ++k) { const float* s = ctot + ((size_t)(b * 8 + (k < c ? k : 0)) * 2) * 512 + tid; ta[k] = s[0]; th[k] = s[512];
                                     const float* s2 = wtot + ((size_t)(b * 64 + c * 8 + (k < sub ? k : 0)) * 2) * 512 + tid; ta[8 + k] = s2[0]; th[8 + k] = s2[512]; }
#pragma unroll
      for (int k = 0; k < 8; ++k) if (k < c) h = ta[k] * h + th[k];
#pragma unroll
      for (int k = 0; k < 8; ++k) if (k < sub) h = ta[8 + k] * h + th[8 + k];
      cl_[tid] = h; }
    __syncthreads();
    float cr[8];
#pragma unroll
    for (int e = 0; e < 8; ++e) cr[e] = cl_[8 * lane + e];
#pragma unroll 1
    for (int i = 0; i < 2; ++i) {
        const size_t t = (size_t)b * SEQ + 64 * wc + 8 * wave + 4 * i;
        const u32x4* hp = (const u32x4*)(hl + ((t >> 2) * 512 + 8 * lane) * 4); const u32x4* pp4 = (const u32x4*)(pl + ((t >> 2) * 512 + 8 * lane) * 4);
        u32x4 hw[4], pw[4], gw4[4];
#pragma unroll
        for (int q = 0; q < 4; ++q) { hw[q] = hp[q]; pw[q] = pp4[q]; gw4[q] = *(const u32x4*)(projb + (t + q) * NPROJ + OFF_LG + 8 * lane); }
        float g[4][8], s[4] = {0.f, 0.f, 0.f, 0.f};
#pragma unroll
        for (int e = 0; e < 8; ++e) {
            const unsigned h01 = hw[e >> 1][(e & 1) * 2], h23 = hw[e >> 1][(e & 1) * 2 + 1], p01 = pw[e >> 1][(e & 1) * 2], p23 = pw[e >> 1][(e & 1) * 2 + 1];
            const float hv[4] = {bflo(h01), bfhi(h01), bflo(h23), bfhi(h23)}, pv[4] = {bflo(p01), bfhi(p01), bflo(p23), bfhi(p23)};
#pragma unroll
            for (int r = 0; r < 4; ++r) { const unsigned lw = gw4[r][e >> 1]; const float lg = (e & 1) ? bfhi(lw) : bflo(lw);
                g[r][e] = (hv[r] + pv[r] * cr[e]) * fgelu_tanh(lg); s[r] += g[r][e] * g[r][e]; }
        }
#pragma unroll
        for (int r = 0; r < 4; ++r) { const float rr = rsqrtf(wsum(s[r]) * (1.f / 512.f) + EPS);
            *(u32x4*)(mix + (t + r) * D + 512 + 8 * lane) = (u32x4){pk2(g[r][0] * rr, g[r][1] * rr), pk2(g[r][2] * rr, g[r][3] * rr), pk2(g[r][4] * rr, g[r][5] * rr), pk2(g[r][6] * rr, g[r][7] * rr)}; }
    }
    __syncthreads();
}

typedef float f32x16 __attribute__((ext_vector_type(16)));
typedef short s16x4 __attribute__((ext_vector_type(4)));
constexpr int AT_KP = 144;
constexpr int AT_NK = 160;
constexpr int AT_K = 0, AT_V = 2 * AT_NK * AT_KP;
constexpr int AT_LINV = XTRA_OFF + 256;
static_assert(2 * AT_V <= RING_BYTES && AT_LINV + 2048 <= LDS_BYTES, "attn lds");
__device__ __forceinline__ int crow(int reg, int h) { return (reg & 3) + 8 * (reg >> 2) + 4 * h; }
typedef LAS s16x4* lds_s16x4_p;
__device__ __forceinline__ s16x4 tr_rd(unsigned addr) { return __builtin_amdgcn_ds_read_tr16_b64_v4i16((lds_s16x4_p)(size_t)addr); }

template <int QB>
__device__ __forceinline__ void attn_qblock(const bf16_t* projb, const f32x2* rope, size_t tq0, int h, unsigned kbase, unsigned vbase, float sink2, int kmin, int r, int hh, LAS float* linv, f32x16& o0, f32x16& o1) {
    const size_t tq = tq0 + 32 * QB + r;
    bf16x8 qf[4];
    { const bf16_t* src = projb + tq * NPROJ + h * 64 + 8 * hh; const f32x2* cs = rope + tq * 32 + 8 * hh;
      const float qs = 0.125f * 1.4426950408889634f;
#pragma unroll
      for (int kp = 0; kp < 2; ++kp) {
          const u32x4 w1 = *(const u32x4*)(src + 16 * kp), w2 = *(const u32x4*)(src + 16 * (kp + 2));
          float x1[8] = {bflo(w1.x), bfhi(w1.x), bflo(w1.y), bfhi(w1.y), bflo(w1.z), bfhi(w1.z), bflo(w1.w), bfhi(w1.w)};
          float x2[8] = {bflo(w2.x), bfhi(w2.x), bflo(w2.y), bfhi(w2.y), bflo(w2.z), bfhi(w2.z), bflo(w2.w), bfhi(w2.w)};
          float y1[8], y2[8];
#pragma unroll
          for (int e = 0; e < 8; ++e) { const f32x2 c2 = cs[16 * kp + e]; y1[e] = (x1[e] * c2.x - x2[e] * c2.y) * qs; y2[e] = (x2[e] * c2.x + x1[e] * c2.y) * qs; }
          qf[kp] = __builtin_bit_cast(bf16x8, (u32x4){pk2(y1[0], y1[1]), pk2(y1[2], y1[3]), pk2(y1[4], y1[5]), pk2(y1[6], y1[7])});
          qf[kp + 2] = __builtin_bit_cast(bf16x8, (u32x4){pk2(y2[0], y2[1]), pk2(y2[2], y2[3]), pk2(y2[4], y2[5]), pk2(y2[6], y2[7])});
      } }
    f32x16 S[5];
#pragma unroll
    for (int ti = 0; ti < 5; ++ti) {
        const float pen = (32 * (QB + ti) < kmin) ? -1e30f : 0.f;
        f32x16 acc;
#pragma unroll
        for (int i = 0; i < 16; ++i) acc[i] = pen;
#pragma unroll
        for (int ks = 0; ks < 4; ++ks) { const bf16x8 kf = *(const LAS bf16x8*)(size_t)(kbase + (unsigned)(32 * (QB + ti) * AT_KP + 32 * ks));
            acc = __builtin_amdgcn_mfma_f32_32x32x16_bf16(kf, qf[ks], acc, 0, 0, 0); }
        S[ti] = acc;
    }
    const int c4 = 4 * hh;
#pragma unroll
    for (int i = 0; i < 16; ++i) { const bool up = ((i & 3) + 8 * (i >> 2) + c4) > r; S[0][i] = up ? S[0][i] : -1e30f; S[4][i] = up ? -1e30f : S[4][i]; }
    float mx = sink2;
#pragma unroll
    for (int ti = 0; ti < 5; ++ti)
#pragma unroll
        for (int i = 0; i < 16; ++i) mx = fmaxf(mx, S[ti][i]);
    mx = fmaxf(mx, __shfl_xor(mx, 32));
    float l = 0.f; unsigned P[5][8];
#pragma unroll
    for (int ti = 0; ti < 5; ++ti)
#pragma unroll
        for (int i = 0; i < 16; i += 2) { const float p0 = fexp2(S[ti][i] - mx), p1 = fexp2(S[ti][i + 1] - mx); l += p0 + p1; P[ti][i >> 1] = pk2(p0, p1); }
    l += __shfl_xor(l, 32);
    l += fexp2(sink2 - mx);
    if (hh == 0) linv[(32 * QB + r) * 8 + h] = frcp(l);
#pragma unroll
    for (int i = 0; i < 16; ++i) { o0[i] = 0.f; o1[i] = 0.f; }
#pragma unroll
    for (int ti = 0; ti < 5; ++ti) {
#pragma unroll
        for (int s = 0; s < 2; ++s) {
            const bf16x8 pa = __builtin_bit_cast(bf16x8, (u32x4){P[ti][4 * s], P[ti][4 * s + 1], P[ti][4 * s + 2], P[ti][4 * s + 3]});
            const unsigned va = vbase + (unsigned)((32 * (QB + ti) + 16 * s) * AT_KP);
            const s16x4 lo0 = tr_rd(va), hi0 = tr_rd(va + 8 * AT_KP), lo1 = tr_rd(va + 64), hi1 = tr_rd(va + 8 * AT_KP + 64);
            const bf16x8 vb0 = __builtin_shufflevector(lo0, hi0, 0, 1, 2, 3, 4, 5, 6, 7), vb1 = __builtin_shufflevector(lo1, hi1, 0, 1, 2, 3, 4, 5, 6, 7);
            o0 = __builtin_amdgcn_mfma_f32_32x32x16_bf16(pa, vb0, o0, 0, 0, 0);
            o1 = __builtin_amdgcn_mfma_f32_32x32x16_bf16(pa, vb1, o1, 0, 0, 0);
        }
    }
}

__device__ __forceinline__ void attn_unit(const Frame& F, KArgsP a, int b, int j) {
    LAS unsigned char* lds = F.lds; const int tid = F.tid, lane = F.lane, wave = F.wave;
    unsigned char* ws = a->ws;
    const bf16_t* projb = (const bf16_t*)(ws + wsm::projb); bf16_t* mix = (bf16_t*)(ws + wsm::mix); const f32x2* rope = (const f32x2*)(ws + wsm::rope);
    const float* sinks = a->in[5];
    const int key0 = 32 * j - 128;
#pragma unroll 1
    for (int task = tid; task < AT_NK * 2 * 4; task += NTHR) {
        const int c = task & 3, g = (task >> 2) & 1, kk = task >> 3; const int sp = key0 + kk;
        u32x4 o1 = {0u, 0u, 0u, 0u}, o2 = {0u, 0u, 0u, 0u};
        if (sp >= 0) { const size_t t = (size_t)b * SEQ + sp; const bf16_t* src = projb + t * NPROJ + OFF_K + g * 64 + 8 * c;
            const u32x4 w1 = *(const u32x4*)src, w2 = *(const u32x4*)(src + 32); const f32x2* cs = rope + t * 32 + 8 * c;
            float x1[8] = {bflo(w1.x), bfhi(w1.x), bflo(w1.y), bfhi(w1.y), bflo(w1.z), bfhi(w1.z), bflo(w1.w), bfhi(w1.w)};
            float x2[8] = {bflo(w2.x), bfhi(w2.x), bflo(w2.y), bfhi(w2.y), bflo(w2.z), bfhi(w2.z), bflo(w2.w), bfhi(w2.w)};
            float y1[8], y2[8];
#pragma unroll
            for (int e = 0; e < 8; ++e) { const f32x2 c2 = cs[e]; y1[e] = x1[e] * c2.x - x2[e] * c2.y; y2[e] = x2[e] * c2.x + x1[e] * c2.y; }
            o1 = (u32x4){pk2(y1[0], y1[1]), pk2(y1[2], y1[3]), pk2(y1[4], y1[5]), pk2(y1[6], y1[7])};
            o2 = (u32x4){pk2(y2[0], y2[1]), pk2(y2[2], y2[3]), pk2(y2[4], y2[5]), pk2(y2[6], y2[7])}; }
        LAS unsigned char* d = lds + AT_K + (g * AT_NK + kk) * AT_KP + 16 * c;
        *(LAS u32x4*)d = o1; *(LAS u32x4*)(d + 64) = o2;
    }
#pragma unroll 2
    for (int task = tid; task < AT_NK * 2 * 8; task += NTHR) {
        const int c = task & 7, g = (task >> 3) & 1, kk = task >> 4; const int sp = key0 + kk;
        u32x4 o = {0u, 0u, 0u, 0u};
        if (sp >= 0) o = *(const u32x4*)(projb + ((size_t)b * SEQ + sp) * NPROJ + OFF_V + g * 64 + 8 * c);
        *(LAS u32x4*)(lds + AT_V + (g * AT_NK + kk) * AT_KP + 16 * c) = o;
    }
    __syncthreads();
    const int h = wave, g = wave >> 2, r = lane & 31, hh = lane >> 5;
    const float sink2 = sinks[h] * 1.4426950408889634f;
    const int kmin = -key0;
    const unsigned kbase = (unsigned)(size_t)(lds + AT_K) + (unsigned)((g * AT_NK + r) * AT_KP + 16 * hh);
    const unsigned vbase = (unsigned)(size_t)(lds + AT_V) + (unsigned)((g * AT_NK + 4 * hh + ((lane & 15) >> 2)) * AT_KP + 32 * ((lane >> 4) & 1) + 8 * (lane & 3));
    const size_t tq0 = (size_t)b * SEQ + 32 * j;
    LAS float* linv = (LAS float*)(lds + AT_LINV);
    f32x16 oa0, oa1;
    attn_qblock<0>(projb, rope, tq0, h, kbase, vbase, sink2, kmin, r, hh, linv, oa0, oa1);
    __syncthreads();
    LAS float* ost = (LAS float*)lds;
#pragma unroll
    for (int i = 0; i < 16; ++i) { const int q = crow(i, hh); LAS float* d0 = ost + q * 512 + h * 64 + r; d0[0] = oa0[i]; d0[32] = oa1[i]; }
    __syncthreads();
    { const int tt = tid >> 4, pp = tid & 15; const LAS f32x4* row = (const LAS f32x4*)(ost + tt * 512);
      f32x4 v[8]; float s = 0.f;
#pragma unroll
      for (int i = 0; i < 8; ++i) { v[i] = row[pp + 16 * i] * linv[tt * 8 + i]; s += (v[i].x * v[i].x + v[i].y * v[i].y) + (v[i].z * v[i].z + v[i].w * v[i].w); }
      s += __shfl_xor(s, 1); s += __shfl_xor(s, 2); s += __shfl_xor(s, 4); s += __shfl_xor(s, 8);
      const float rr = rsqrtf(s * (1.f / 512.f) + EPS);
      bf16_t* dst = mix + (tq0 + tt) * D;
#pragma unroll
      for (int i = 0; i < 8; ++i) { u32x2 w; w.x = pk2(v[i].x * rr, v[i].y * rr); w.y = pk2(v[i].z * rr, v[i].w * rr); *(u32x2*)(dst + 4 * (pp + 16 * i)) = w; } }
    __syncthreads();
}

namespace pg8 {
struct EpiOutProj {
    static constexpr bool PERM = true, MIDSCALE = false;
    const bf16_t* xb; bf16_t* x1b; float* ssq1p; unsigned char* x1q;
    __device__ __forceinline__ void midscale(f32x4 (&)[2][2][4][2], const Unit&, int, int) const {}
    __device__ __forceinline__ void operator()(const f32x4 (&acc)[2][2][4][2], const Unit& u, int wr, int wc, int fr, int fq) const {
        const int col0 = u.pn * BM + wc * 32 + 8 * fq;
#pragma unroll
        for (int ai = 0; ai < 2; ++ai)
#pragma unroll
            for (int m = 0; m < 4; ++m) { const int row = u.pm * BM + ai * HALF + wr * 64 + m * 16 + fr; const size_t off = (size_t)row * D + col0; float q = 0.f;
#pragma unroll
                for (int bj = 0; bj < 2; ++bj) { const size_t o = off + bj * HALF; const u32x4 xw = *(const u32x4*)(xb + o);
                    const f32x4 v0 = (f32x4){bflo(xw.x), bfhi(xw.x), bflo(xw.y), bfhi(xw.y)} + acc[ai][bj][m][0], v1 = (f32x4){bflo(xw.z), bfhi(xw.z), bflo(xw.w), bfhi(xw.w)} + acc[ai][bj][m][1];
                    st_wt16(x1b + o, (u32x4){pk2(v0[0], v0[1]), pk2(v0[2], v0[3]), pk2(v1[0], v1[1]), pk2(v1[2], v1[3])});
                    st_wt8(x1q + o, (u32x2){pk4_fp8(v0[0], v0[1], v0[2], v0[3]), pk4_fp8(v1[0], v1[1], v1[2], v1[3])});
                    q += (v0[0] * v0[0] + v0[1] * v0[1]) + (v0[2] * v0[2] + v0[3] * v0[3]) + (v1[0] * v1[0] + v1[1] * v1[1]) + (v1[2] * v1[2] + v1[3] * v1[3]); }
                q += __shfl_xor(q, 16); q += __shfl_xor(q, 32);
                if (fq == 0) st_wt4(ssq1p + (size_t)(u.pn * 4 + wc) * T + row, q); }
    }
};
struct EpiMoe1 {
    static constexpr bool PERM = true, MIDSCALE = false;
    unsigned char* hid; const float* lw; const float* lr;
    __device__ __forceinline__ void midscale(f32x4 (&)[2][2][4][2], const Unit&, int, int) const {}
    __device__ __forceinline__ void operator()(const f32x4 (&acc)[2][2][4][2], const Unit& u, int wr, int wc, int fr, int fq) const {
        const __amdgpu_buffer_rsrc_t hrs = __builtin_amdgcn_make_buffer_rsrc(hid, 0, 40960 * FF, 0x00020000);
        asm volatile("" : "+v"(fr), "+v"(fq));
        const int f0 = u.pn * HALF + wc * 32 + 8 * fq;
#pragma unroll
        for (int ai = 0; ai < 2; ++ai)
#pragma unroll
            for (int m = 0; m < 4; ++m) { const int rl = ai * HALF + wr * 64 + m * 16 + fr; const bool ok = rl < u.nrow; const size_t li = (size_t)u.e * T + u.li0 + rl;
                const float r2 = ok ? lr[li] * (1.f / WQ_SCALE) : 0.f, w = ok ? lw[li] * HQ_SCALE : 0.f; float hv[8];
#pragma unroll
                for (int n = 0; n < 2; ++n)
#pragma unroll
                    for (int e = 0; e < 4; ++e) { const float gt = acc[ai][0][m][n][e] * r2, up = acc[ai][1][m][n][e] * r2; hv[4 * n + e] = gt * frcp(1.f + fexp(-gt)) * up * w; }
                __builtin_amdgcn_raw_buffer_store_b64((u32x2){pk4_fp8(hv[0], hv[1], hv[2], hv[3]), pk4_fp8(hv[4], hv[5], hv[6], hv[7])}, hrs, (int)((unsigned)(u.pm * BM + rl) * FF + f0), 0, 16); }
    }
};
struct EpiPle {
    static constexpr bool PERM = true, MIDSCALE = false;
    const bf16_t* x2b; bf16_t* x3b; const bf16_t* pp; const float* rP; float* ssq3p;
    __device__ __forceinline__ void midscale(f32x4 (&)[2][2][4][2], const Unit&, int, int) const {}
    __device__ __forceinline__ void operator()(const f32x4 (&acc)[2][2][4][2], const Unit& u, int wr, int wc, int fr, int fq) const {
        int pm_ = u.pm, pn_ = u.pn; asm volatile("" : "+v"(fr), "+v"(fq), "+s"(pm_), "+s"(pn_));
        const int col0 = pn_ * BM + wc * 32 + 8 * fq;
#pragma unroll
        for (int ai = 0; ai < 2; ++ai)
#pragma unroll
            for (int m = 0; m < 4; ++m) { const int row = pm_ * BM + ai * HALF + wr * 64 + m * 16 + fr; const float s = rP[row] * (1.f / WQ_SCALE); const size_t off = (size_t)row * D + col0; float q = 0.f;
#pragma unroll
                for (int bj = 0; bj < 2; ++bj) { const size_t o = off + bj * HALF; const u32x4 xw = *(const u32x4*)(x2b + o), pw = *(const u32x4*)(pp + o);
                    const f32x4 a0 = acc[ai][bj][m][0] * s, a1 = acc[ai][bj][m][1] * s;
                    float v[8] = {bflo(xw.x) + fsigmoid(a0[0]) * bflo(pw.x), bfhi(xw.x) + fsigmoid(a0[1]) * bfhi(pw.x), bflo(xw.y) + fsigmoid(a0[2]) * bflo(pw.y), bfhi(xw.y) + fsigmoid(a0[3]) * bfhi(pw.y),
                                  bflo(xw.z) + fsigmoid(a1[0]) * bflo(pw.z), bfhi(xw.z) + fsigmoid(a1[1]) * bfhi(pw.z), bflo(xw.w) + fsigmoid(a1[2]) * bflo(pw.w), bfhi(xw.w) + fsigmoid(a1[3]) * bfhi(pw.w)};
                    st_wt16(x3b + o, (u32x4){pk2(v[0], v[1]), pk2(v[2], v[3]), pk2(v[4], v[5]), pk2(v[6], v[7])});
                    q += (v[0] * v[0] + v[1] * v[1]) + (v[2] * v[2] + v[3] * v[3]) + (v[4] * v[4] + v[5] * v[5]) + (v[6] * v[6] + v[7] * v[7]);
                    asm volatile("" ::: "memory"); }
                q += __shfl_xor(q, 16); q += __shfl_xor(q, 32);
                if (fq == 0) st_wt4(ssq3p + (size_t)(pn_ * 4 + wc) * T + row, q); }
    }
};
struct EpiY {
    static constexpr bool PERM = true, MIDSCALE = false;
    unsigned char* O; float sc; int pad;
    __device__ __forceinline__ void midscale(f32x4 (&)[2][2][4][2], const Unit&, int, int) const {}
    __device__ __forceinline__ void operator()(const f32x4 (&acc)[2][2][4][2], const Unit& u, int wr, int wc, int fr, int fq) const {
        unsigned char* base = O + (size_t)u.pm * BM * D;
        int row0 = wr * 64 + fr; const int col0 = u.pn * BM + wc * 32 + 8 * fq;
        asm volatile("" : "+v"(row0));
#pragma unroll
        for (int ai = 0; ai < 2; ++ai)
#pragma unroll
            for (int m = 0; m < 4; ++m) { unsigned char* rowp = base + (size_t)(row0 + ai * HALF + m * 16) * D + col0;
#pragma unroll
                for (int bj = 0; bj < 2; ++bj) { const f32x4 v0 = acc[ai][bj][m][0] * sc, v1 = acc[ai][bj][m][1] * sc;
                    *(u32x2*)(rowp + bj * HALF) = (u32x2){pk4_fp8(v0[0], v0[1], v0[2], v0[3]), pk4_fp8(v1[0], v1[1], v1[2], v1[3])}; } }
    }
};
struct MoeOrder {
    const LAS int* tstart; const LAS int* cntl; const LAS int* rowtab; const int* lt; const char* A; const char* B; size_t strideB; int K, PA, PB, G, c, gather;
    __device__ __forceinline__ bool next(int i, Unit& u) const {
        const int L = i * G + c, tile = L >> 2; if (tile >= __builtin_amdgcn_readfirstlane(tstart[NE])) return false;
        int e = 0;
#pragma unroll 1
        for (int k = 1; k < NE; ++k) e = (tstart[k] <= tile) ? k : e;
        e = __builtin_amdgcn_readfirstlane(e);
        u.e = e; u.pm = tile; u.pn = L & 3; u.li0 = __builtin_amdgcn_readfirstlane((tile - tstart[e]) * BM); const int left = __builtin_amdgcn_readfirstlane(cntl[e]) - u.li0; u.nrow = left < BM ? left : BM; u.ord = i; return true;
    }
    __device__ __forceinline__ const char* a_ptr(const Unit& u) const { return gather ? A : A + (size_t)u.pm * BM * PA * 2; }
    __device__ __forceinline__ const char* b_ptr(const Unit& u) const { return B + (size_t)u.e * strideB + (size_t)u.pn * BM * PB * 2; }
    __device__ __forceinline__ unsigned a_row(const Unit& u, int r) const { return (unsigned)rowtab[(u.ord & 7) * BM + r]; }
    gu32* tilecnt;
    __device__ __forceinline__ void a_ready(const Unit&) const {}
    __device__ __forceinline__ void done(const Unit& u) const {
        if (tilecnt) { asm volatile("s_waitcnt vmcnt(0)" ::: "memory");
            if ((threadIdx.x & 63) == 0) (void)__hip_atomic_fetch_add(tilecnt + 16 * u.pm, 1u, __ATOMIC_RELAXED, __HIP_MEMORY_SCOPE_AGENT); }
    }
};
struct Moe2Order {
    const LAS int* tstart; const char* A; const char* B; size_t strideB; gu32* tilecnt; int K, PA, PB, G, c, E, S2, U;
    __device__ __forceinline__ bool next(int i, Unit& u) const {
        int m;
        if (c >= E) m = (i < 2) ? (c - E) + i * S2 : 2 * S2 + c + (i - 2) * G; else m = 2 * S2 + c + i * G;
        if (m >= U) return false;
        const int tile = m >> 2; int e = 0;
#pragma unroll 1
        for (int k = 1; k < NE; ++k) e = (tstart[k] <= tile) ? k : e;
        u.e = __builtin_amdgcn_readfirstlane(e); u.pm = tile; u.pn = m & 3; u.li0 = 0; u.nrow = BM; u.ord = i; return true;
    }
    __device__ __forceinline__ const char* a_ptr(const Unit& u) const { return A + (size_t)u.pm * BM * PA * 2; }
    __device__ __forceinline__ const char* b_ptr(const Unit& u) const { return B + (size_t)u.e * strideB + (size_t)u.pn * BM * PB * 2; }
    __device__ __forceinline__ unsigned a_row(const Unit&, int r) const { return (unsigned)r; }
    __device__ __forceinline__ void done(const Unit&) const {}
    __device__ __forceinline__ void a_ready(const Unit& u) const {
        if (threadIdx.x < 64) {
            unsigned sp = 0;
            while ((unsigned)__builtin_amdgcn_readfirstlane(__hip_atomic_load(tilecnt + 16 * u.pm, __ATOMIC_RELAXED, __HIP_MEMORY_SCOPE_AGENT)) < 32u) { __builtin_amdgcn_s_sleep(2); if (++sp > (1u << 22)) break; }
            __builtin_amdgcn_fence(__ATOMIC_ACQUIRE, "agent");
            asm volatile("s_waitcnt vmcnt(0)" ::: "memory");
        }
        asm volatile("" ::: "memory"); __builtin_amdgcn_s_barrier(); asm volatile("" ::: "memory");
    }
};
}

constexpr int MOE_TSTART = XTRA_OFF, MOE_CNTL = XTRA_OFF + 256, MOE_ROWTAB = XTRA_OFF + 512;
static_assert(MOE_ROWTAB + 8192 <= LDS_BYTES, "moe lds");
__device__ __forceinline__ void moe_tstart(const Frame& F, const int* cnt) {
    LAS int* tstart = (LAS int*)(F.lds + MOE_TSTART); LAS int* cntl = (LAS int*)(F.lds + MOE_CNTL);
    if (F.tid < 64) { const int l = F.tid; const int c = l < NE ? cnt[l * 32] : 0; const int nt = (c + 255) >> 8; int inc = nt;
#pragma unroll
        for (int o = 1; o < 32; o <<= 1) { const int v = __shfl_up(inc, o); if ((l & 31) >= o) inc += v; }
        if (l < NE) { tstart[l] = inc - nt; cntl[l] = c; } if (l == NE - 1) tstart[NE] = inc; }
    __syncthreads();
}
__device__ __forceinline__ void moe_rowtab(const Frame& F, const pg8::MoeOrder& S) {
    LAS int* rowtab = (LAS int*)(F.lds + MOE_ROWTAB);
    for (int i = 0; i < 8; ++i) { pg8::Unit u; if (!S.next(i, u)) break; if (F.tid < 256) rowtab[i * 256 + F.tid] = F.tid < u.nrow ? S.lt[(size_t)u.e * T + u.li0 + F.tid] : 0; }
    asm volatile("s_waitcnt vmcnt(0) lgkmcnt(0)" ::: "memory"); __syncthreads();
}

__device__ __forceinline__ void router_chunk(const Frame& F, KArgsP args, int* cnt, int ch) {
    unsigned char* ws = args->ws; const int lane = F.lane;
    const bf16_t* x1b = (const bf16_t*)(ws + wsm::x1b); const bf16_t* wr_t = (const bf16_t*)(ws + wsm::wr_t); const float* ssq1p = (const float*)(ws + wsm::ssq1p);
    float* r2v = (float*)(ws + wsm::r2); int* lt = (int*)(ws + wsm::lt); float* lw = (float*)(ws + wsm::lw); float* lr = (float*)(ws + wsm::lr);
    int* tokE = (int*)(ws + wsm::tokE); int* tokPos = (int*)(ws + wsm::tokPos);
    const float* b_rg = args->in[18]; const float* b_re = args->in[20];
    LAS float* lg = (LAS float*)F.lds;
    {
            const int tok0 = ch * 64, mt = F.wave & 3, kh = F.wave >> 2;
            f32x4 acc[3];
#pragma unroll
            for (int n = 0; n < 3; ++n) acc[n] = (f32x4){0.f, 0.f, 0.f, 0.f};
            const bf16_t* ap = x1b + (size_t)(tok0 + 16 * mt + (lane & 15)) * D + 512 * kh + 8 * (lane >> 4);
            const bf16_t* bp = wr_t + (size_t)(lane & 15) * D + 512 * kh + 8 * (lane >> 4);
#pragma unroll 4
            for (int ks = 0; ks < 16; ++ks) { const bf16x8 af = *(const bf16x8*)(ap + 32 * ks);
#pragma unroll
                for (int n = 0; n < 3; ++n) { const bf16x8 bf = *(const bf16x8*)(bp + (size_t)16 * n * D + 32 * ks); acc[n] = __builtin_amdgcn_mfma_f32_16x16x32_bf16(af, bf, acc[n], 0, 0, 0); } }
#pragma unroll
            for (int n = 0; n < 3; ++n)
#pragma unroll
                for (int r = 0; r < 4; ++r) lg[(kh * 64 + 16 * mt + (lane >> 4) * 4 + r) * 48 + 16 * n + (lane & 15)] = acc[n][r];
            __syncthreads();
            if (F.tid < 64) {
                const int t = tok0 + F.tid; float s = 0.f;
#pragma unroll
                for (int pq = 0; pq < 16; ++pq) s += ssq1p[(size_t)pq * T + t];
                const float r2 = rsqrtf(s * (1.f / D) + EPS); r2v[t] = r2;
                const LAS float* l0 = lg + F.tid * 48; const LAS float* l1 = lg + (64 + F.tid) * 48;
                float gm = -1e30f; int gt = 0; float gl[4];
#pragma unroll
                for (int jx = 0; jx < 4; ++jx) { gl[jx] = (l0[jx] + l1[jx]) * r2 + b_rg[jx]; if (gl[jx] > gm) { gm = gl[jx]; gt = jx; } }
                float gs = 0.f;
#pragma unroll
                for (int jx = 0; jx < 4; ++jx) gs += expf(gl[jx] - gm);
                const float gp = 1.f / gs;
                float m1 = -1e30f, m2 = -1e30f; int i1 = 0, i2 = 0;
#pragma unroll
                for (int jx = 0; jx < 8; ++jx) { const float v = (l0[4 + gt * 8 + jx] + l1[4 + gt * 8 + jx]) * r2 + b_re[gt * 8 + jx];
                    if (v > m1) { m2 = m1; i2 = i1; m1 = v; i1 = jx; } else if (v > m2) { m2 = v; i2 = jx; } }
                const float e2 = expf(m2 - m1), w1 = gp / (1.f + e2), w2 = gp * e2 / (1.f + e2);
                const int E1 = gt * 8 + i1, E2 = gt * 8 + i2;
                LAS int* hist = (LAS int*)(F.lds + 32768); LAS int* base = hist + 32;
                if (F.tid < 32) hist[F.tid] = 0;
                asm volatile("s_waitcnt lgkmcnt(0)" ::: "memory");
                const int q1 = __hip_atomic_fetch_add(hist + E1, 1, __ATOMIC_RELAXED, __HIP_MEMORY_SCOPE_WORKGROUP), q2 = __hip_atomic_fetch_add(hist + E2, 1, __ATOMIC_RELAXED, __HIP_MEMORY_SCOPE_WORKGROUP);
                asm volatile("s_waitcnt lgkmcnt(0)" ::: "memory");
                if (F.tid < 32) { const int hc = hist[F.tid]; base[F.tid] = hc > 0 ? atomicAdd(&cnt[F.tid * 32], hc) : 0; }
                asm volatile("s_waitcnt vmcnt(0) lgkmcnt(0)" ::: "memory");
                const int p1 = base[E1] + q1, p2 = base[E2] + q2;
                lt[(size_t)E1 * T + p1] = t; lw[(size_t)E1 * T + p1] = w1; lr[(size_t)E1 * T + p1] = r2;
                lt[(size_t)E2 * T + p2] = t; lw[(size_t)E2 * T + p2] = w2; lr[(size_t)E2 * T + p2] = r2;
                tokE[t * 2] = E1; tokPos[t * 2] = p1; tokE[t * 2 + 1] = E2; tokPos[t * 2 + 1] = p2;
            }
            __syncthreads();
    }
}

__device__ __forceinline__ void final_rows(const Frame& F, KArgsP args, int row0, int nrow) {
    unsigned char* ws = args->ws; const int lane = F.lane;
    const float* ssq3p = (const float*)(ws + wsm::ssq3p); const float* gfin = args->in[27]; float* X = args->out; const bf16_t* x3b = (const bf16_t*)(ws + wsm::x3b);
    f32x4 gv[4];
#pragma unroll
    for (int jx = 0; jx < 2; ++jx) { gv[2 * jx] = ((const f32x4*)gfin)[2 * (lane + 64 * jx)]; gv[2 * jx + 1] = ((const f32x4*)gfin)[2 * (lane + 64 * jx) + 1]; }
    for (int tb = row0 + F.wave; tb < row0 + nrow; tb += 4 * NWAVES) {
        float sv[4]; u32x4 w[4][2];
#pragma unroll
        for (int k = 0; k < 4; ++k) { const int t = (tb + k * NWAVES) < row0 + nrow ? tb + k * NWAVES : tb; sv[k] = lane < 16 ? ssq3p[(size_t)lane * T + t] : 0.f;
            const u32x4* xr = (const u32x4*)(x3b + (size_t)t * D) + lane; w[k][0] = xr[0]; w[k][1] = xr[64]; }
#pragma unroll
        for (int k = 0; k < 4; ++k) { const int t = tb + k * NWAVES; if (t < row0 + nrow) {
            const float r3 = rsqrtf(wsum(sv[k]) * (1.f / D) + EPS); f32x4* orow = (f32x4*)(X + (size_t)t * D);
#pragma unroll
            for (int jx = 0; jx < 2; ++jx) { const u32x4 ww = w[k][jx];
                orow[2 * (lane + 64 * jx)] = (f32x4){bflo(ww.x), bfhi(ww.x), bflo(ww.y), bfhi(ww.y)} * r3 * gv[2 * jx];
                orow[2 * (lane + 64 * jx) + 1] = (f32x4){bflo(ww.z), bfhi(ww.z), bflo(ww.w), bfhi(ww.w)} * r3 * gv[2 * jx + 1]; } } }
    }
}
__device__ __forceinline__ void panel_sync(const Frame& F, gu32* cw) {
    asm volatile("s_waitcnt vmcnt(0)" ::: "memory");
    __syncthreads();
    if (F.tid == 0) {
        (void)__hip_atomic_fetch_add(cw, 1u, __ATOMIC_RELAXED, __HIP_MEMORY_SCOPE_AGENT);
        unsigned sp = 0; while (__hip_atomic_load(cw, __ATOMIC_RELAXED, __HIP_MEMORY_SCOPE_AGENT) < 4u) { __builtin_amdgcn_s_sleep(2); if (++sp > (1u << 22)) break; }
        __builtin_amdgcn_fence(__ATOMIC_ACQUIRE, "agent"); asm volatile("s_waitcnt vmcnt(0)" ::: "memory");
    }
    __syncthreads();
}

__global__ void __launch_bounds__(NTHR, 2) mk_fwd(Args) {
    const KArgsP args0 = kargs();
    extern __shared__ __attribute__((aligned(16))) unsigned char lds_raw[];
    Frame F; F.lds = (LAS unsigned char*)lds_raw; F.MISC = (volatile LAS unsigned*)(F.lds + MISC_OFF);
    F.tid = threadIdx.x; F.lane = F.tid & 63; F.wave = __builtin_amdgcn_readfirstlane(F.tid >> 6);
    F.G = gridDim.x; { const int bx = blockIdx.x; F.vcu = (F.G % 8 == 0) ? (bx % 8) * (F.G / 8) + bx / 8 : bx; }
    unsigned char* ws = args0->ws; F.ctl = (gu32*)(ws + wsm::ctl);
    for (int u = F.tid; u < (LDS_BYTES - LDSCTL_OFF) / 4; u += NTHR) ((LAS unsigned*)(F.lds + LDSCTL_OFF))[u] = 0u;
    __syncthreads();
    const int lo = args0->ph_lo, hi = args0->ph_hi;
    XcdBarrier bar = xcd_barrier_post((unsigned*)(F.ctl + CW_BAR) + (args0->mode >> 8) * XCD_BAR_WORDS, F.MISC + 8);
    int* cnt = (int*)(F.ctl + CW_CNT);
    const LAS int* tstart = (const LAS int*)(F.lds + MOE_TSTART); const LAS int* cntl = (const LAS int*)(F.lds + MOE_CNTL); const LAS int* rowtab = (const LAS int*)(F.lds + MOE_ROWTAB);
    const int gw = F.vcu * NWAVES + F.wave, NGW = F.G * NWAVES, lane = F.lane;
#ifndef PHASE_MASK
#define PHASE_MASK 0x7ffu
#endif
#define IN(k) ((((PHASE_MASK) >> (k)) & 1u) && lo <= (k) && (k) < hi)
#ifdef MK_STAMPS
    unsigned long long* tsg = (unsigned long long*)(F.ctl + 14336);
#define STAMP(k) do { if (blockIdx.x == 0 && F.tid == 0) tsg[k] = __builtin_amdgcn_s_memrealtime(); } while (0)
#else
#define STAMP(k) do { } while (0)
#endif
#define GRID_BAR(k) do { if (IN(k) && IN((k) + 1)) xcd_barrier(bar); STAMP((k) + 1); } while (0)
    STAMP(0);
    const bool fused = (F.G == 256) && lo == 0 && hi == 11;
    const bool early_down = (F.G == 256) && lo <= 1 && hi >= 8;
    const bool merged = lo <= 5 && hi >= 8;
    if (IN(0)) { const KArgsP args = kargs(); p0_prologue(F, args); __syncthreads(); }
    GRID_BAR(0);
    if (IN(1)) { const KArgsP args = kargs();
        { pg8::DenseOrder S; S.init((const bf16_t*)(ws + wsm::xb), (const bf16_t*)(ws + wsm::w_in_t), T, NPROJ, D, F.G, (int)blockIdx.x);
          pg8::EpiScaleBf16 E{(bf16_t*)(ws + wsm::projb), (const float*)(ws + wsm::r0), NPROJ, 0};
          pg8::gemm_phase<pg8::EpiScaleBf16, pg8::DenseOrder, true, false>(F.lds, D, S, E);
          if (early_down) { pg8::Unit u; if (!S.next(1, u)) { const int nsp = 2 * F.G - (T / 256) * (NPROJ / 256);
              p0_experts(F, args, ((int)blockIdx.x - (F.G - nsp)) * NWAVES + F.wave, nsp * NWAVES, 2); __syncthreads(); } } }
        { pg8::DenseOrder S; S.init((const bf16_t*)(ws + wsm::pb), (const bf16_t*)(ws + wsm::w_pp_t), T, D, PLE, F.G, (int)blockIdx.x);
          pg8::EpiScaleBf16 E{(bf16_t*)(ws + wsm::pp), nullptr, D, 0};
          pg8::gemm_phase<pg8::EpiScaleBf16, pg8::DenseOrder, true, false>(F.lds, PLE, S, E); }
    }
    GRID_BAR(1);
    if (IN(2)) { const KArgsP args = kargs();
        const bool conv_first = (F.G >= 256) && (blockIdx.x & 1);
        if (conv_first) { p0_experts(F, args, gw, NGW, 1); __syncthreads(); }
        STAMP(12);
        for (int it = blockIdx.x; it < 256 + 512; it += F.G) {
            if (it < 256) { lruA_unit(F, args, it >> 6, (it >> 3) & 7, it & 7); STAMP(13); }
            else { const int u = it - 256; attn_unit(F, args, u >> 7, u & 127); }
        }
        STAMP(14);
        if (F.G >= 256 && !conv_first) p0_experts(F, args, gw, NGW, 1);
        STAMP(15);
    }
    GRID_BAR(2);
    if (IN(3)) { const KArgsP args = kargs();
        for (int it = blockIdx.x; it < T / 64; it += F.G) lru_finish(F, args, it >> 6, it & 63);
    }
    GRID_BAR(3);
    if (IN(4)) { const KArgsP args = kargs();
        pg8::DenseOrder S; S.init((const bf16_t*)(ws + wsm::mix), (const bf16_t*)(ws + wsm::w_out_t), T, D, D, F.G, (int)blockIdx.x);
        pg8::EpiOutProj E{(const bf16_t*)(ws + wsm::xb), (bf16_t*)(ws + wsm::x1b), (float*)(ws + wsm::ssq1p), (unsigned char*)(ws + wsm::x1q)};
        pg8::gemm_phase<pg8::EpiOutProj, pg8::DenseOrder, true, false>(F.lds, D, S, E);
        if (fused) { pg8::Unit u; S.next(0, u); panel_sync(F, F.ctl + CW_PANA + 32 * u.pm); router_chunk(F, args, cnt, 4 * u.pm + u.pn); }
    }
    if (!fused) GRID_BAR(4);
    if (IN(5) && !fused) { const KArgsP args = kargs();
        for (int ch = F.vcu; ch < T / 64; ch += F.G) router_chunk(F, args, cnt, ch);
        if (merged && F.G >= 256 && !early_down) p0_experts(F, args, gw, NGW, 2);
    }
    GRID_BAR(5);
    if (IN(6)) { const KArgsP args = kargs();
        moe_tstart(F, cnt);
        pg8::MoeOrder S{tstart, cntl, rowtab, (const int*)(ws + wsm::lt), (const char*)(ws + wsm::x1q), (const char*)(ws + wsm::wgu_t), (size_t)1024 * D, D / 2, D / 2, D / 2, F.G, F.vcu, 1, merged ? F.ctl + CW_TILE : nullptr};
        moe_rowtab(F, S);
        pg8::EpiMoe1 E{(unsigned char*)(ws + wsm::hid), (const float*)(ws + wsm::lw), (const float*)(ws + wsm::lr)};
        pg8::gemm_phase<pg8::EpiMoe1, pg8::MoeOrder, true, true, 2>(F.lds, D / 2, S, E);
        const int U = 4 * __builtin_amdgcn_readfirstlane(tstart[NE]), nfull = U / F.G, Ex = U - nfull * F.G;
        if (merged) {
            pg8::Moe2Order S2{tstart, (const char*)(ws + wsm::hid), (const char*)(ws + wsm::wd_t), (size_t)D * FF, F.ctl + CW_TILE, FF / 2, FF / 2, FF / 2, F.G, F.vcu, Ex, F.G - Ex, U};
            pg8::EpiY E2{(unsigned char*)args->out, YQ_SCALE / (WQ_SCALE * HQ_SCALE), 0};
            pg8::gemm_phase<pg8::EpiY, pg8::Moe2Order, true, false, MOE2_MMA>(F.lds, FF / 2, S2, E2);
        } else if (F.G >= 256 && F.vcu >= Ex) p0_experts(F, args, (F.vcu - Ex) * NWAVES + F.wave, (F.G - Ex) * NWAVES, 2);
    }
    GRID_BAR(6);
    if (IN(7) && !merged) { const KArgsP args = kargs();
        moe_tstart(F, cnt);
        pg8::MoeOrder S{tstart, cntl, rowtab, nullptr, (const char*)(ws + wsm::hid), (const char*)(ws + wsm::wd_t), (size_t)D * FF, FF / 2, FF / 2, FF / 2, F.G, F.vcu, 0, nullptr};
        pg8::EpiY E{(unsigned char*)args->out, YQ_SCALE / (WQ_SCALE * HQ_SCALE), 0};
        pg8::gemm_phase<pg8::EpiY, pg8::MoeOrder, true, false, MOE_MMA>(F.lds, FF / 2, S, E);
    }
    if (!merged) GRID_BAR(7);
    if (IN(8)) { const KArgsP args = kargs();
        moe_tstart(F, cnt);
        const unsigned char* y = (const unsigned char*)args->out; const bf16_t* x1b = (const bf16_t*)(ws + wsm::x1b); bf16_t* x2b = (bf16_t*)(ws + wsm::x2b); float* rP = (float*)(ws + wsm::rP); unsigned char* x2q = (unsigned char*)(ws + wsm::x2q);
        const int* tokE = (const int*)(ws + wsm::tokE); const int* tokPos = (const int*)(ws + wsm::tokPos);
        constexpr float iy = 1.f / YQ_SCALE;
        for (int t0 = gw; t0 < T; t0 += 4 * NGW) {
            u32x4 xw[4][2]; u32x2 a2[4][2], b2[4][2];
#pragma unroll
            for (int k = 0; k < 4; ++k) { const int t = (t0 + k * NGW) < T ? t0 + k * NGW : t0;
                const size_t s1 = (size_t)tstart[tokE[2 * t]] * 256 + tokPos[2 * t], s2 = (size_t)tstart[tokE[2 * t + 1]] * 256 + tokPos[2 * t + 1];
                const u32x4* xr = (const u32x4*)(x1b + (size_t)t * D) + lane; const u32x2* ya = (const u32x2*)(y + s1 * D) + lane; const u32x2* yb = (const u32x2*)(y + s2 * D) + lane;
#pragma unroll
                for (int jx = 0; jx < 2; ++jx) { xw[k][jx] = xr[64 * jx]; a2[k][jx] = ya[64 * jx]; b2[k][jx] = yb[64 * jx]; } }
#pragma unroll
            for (int k = 0; k < 4; ++k) { const int t = t0 + k * NGW; if (t < T) {
                u32x4* ob = (u32x4*)(x2b + (size_t)t * D) + lane; float s = 0.f;
#pragma unroll
                for (int jx = 0; jx < 2; ++jx) { const u32x4 x4 = xw[k][jx]; const u32x2 ay = a2[k][jx], by = b2[k][jx];
                    const f32x2 a01 = __builtin_amdgcn_cvt_pk_f32_fp8((int)ay.x, false), a23 = __builtin_amdgcn_cvt_pk_f32_fp8((int)ay.x, true), a45 = __builtin_amdgcn_cvt_pk_f32_fp8((int)ay.y, false), a67 = __builtin_amdgcn_cvt_pk_f32_fp8((int)ay.y, true);
                    const f32x2 b01 = __builtin_amdgcn_cvt_pk_f32_fp8((int)by.x, false), b23 = __builtin_amdgcn_cvt_pk_f32_fp8((int)by.x, true), b45 = __builtin_amdgcn_cvt_pk_f32_fp8((int)by.y, false), b67 = __builtin_amdgcn_cvt_pk_f32_fp8((int)by.y, true);
                    float v[8] = {bflo(x4.x) + (a01.x + b01.x) * iy, bfhi(x4.x) + (a01.y + b01.y) * iy, bflo(x4.y) + (a23.x + b23.x) * iy, bfhi(x4.y) + (a23.y + b23.y) * iy,
                                  bflo(x4.z) + (a45.x + b45.x) * iy, bfhi(x4.z) + (a45.y + b45.y) * iy, bflo(x4.w) + (a67.x + b67.x) * iy, bfhi(x4.w) + (a67.y + b67.y) * iy};
                    ob[64 * jx] = (u32x4){pk2(v[0], v[1]), pk2(v[2], v[3]), pk2(v[4], v[5]), pk2(v[6], v[7])};
                    ((u32x2*)(x2q + (size_t)t * D))[lane + 64 * jx] = (u32x2){pk4_fp8(v[0], v[1], v[2], v[3]), pk4_fp8(v[4], v[5], v[6], v[7])};
                    s += (v[0] * v[0] + v[1] * v[1]) + (v[2] * v[2] + v[3] * v[3]) + (v[4] * v[4] + v[5] * v[5]) + (v[6] * v[6] + v[7] * v[7]); }
                s = wsum(s);
                if (lane == 0) rP[t] = rsqrtf(s * (1.f / D) + EPS); } }
        }
    }
    GRID_BAR(8);
    if (IN(9)) { const KArgsP args = kargs();
        pg8::DenseOrder S; S.init((const bf16_t*)(ws + wsm::x2q), (const bf16_t*)(ws + wsm::w_pg_t), T, D, D / 2, F.G, (int)blockIdx.x);
        pg8::EpiPle E{(const bf16_t*)(ws + wsm::x2b), (bf16_t*)(ws + wsm::x3b), (const bf16_t*)(ws + wsm::pp), (const float*)(ws + wsm::rP), (float*)(ws + wsm::ssq3p)};
        pg8::gemm_phase<pg8::EpiPle, pg8::DenseOrder, true, false, PLE_MMA>(F.lds, D / 2, S, E);
        if (fused) { pg8::Unit u; S.next(0, u); panel_sync(F, F.ctl + CW_PANB + 32 * u.pm); final_rows(F, args, 256 * u.pm + 64 * u.pn, 64); }
    }
    if (!fused) GRID_BAR(9);
    if (IN(10) && !fused) { const KArgsP args = kargs();
        for (int r0 = F.vcu * 64; r0 < T; r0 += F.G * 64) final_rows(F, args, r0, 64);
    }
#ifdef MK_XBAR
    for (int i = 0; i < MK_XBAR; ++i) xcd_barrier(bar);
#endif
    STAMP(11);
#undef IN
#undef GRID_BAR
}
}

#ifndef MK_ONE_LAUNCH
#define MK_ONE_LAUNCH 1
#endif
#ifdef MK_STAMPS
__global__ void k_delay(const unsigned long long* ts, int k) {
    if (threadIdx.x == 0) { const int ka = k < 100 ? k : k / 100, kb = k < 100 ? k + 1 : k % 100; const unsigned long long d = (ts[kb] - ts[ka]) * 8ull, t0 = __builtin_amdgcn_s_memrealtime(); while (__builtin_amdgcn_s_memrealtime() - t0 < d) __builtin_amdgcn_s_sleep(8); }
}
#endif
extern "C" void kernel_launch(void* const* d_in, const int* in_sizes, int n_in, void* d_out, int out_size, void* d_ws, size_t ws_size, hipStream_t stream) {
    using namespace mk;
    const size_t MB = 1u << 20, KB = 1024;
    const size_t WS_END = wsm::END;
    static int grid = 0;
    if (grid == 0) {
        if (ws_size < WS_END || n_in != 28 || out_size != T * D) { fprintf(stderr, "kernel_launch: ws %zu < %zu or n_in %d or out %d\n", ws_size, (size_t)WS_END, n_in, out_size); grid = -1; return; }
        int dev = 0, cus = 0;
        if (hipGetDevice(&dev) != hipSuccess || hipDeviceGetAttribute(&cus, hipDeviceAttributeMultiprocessorCount, dev) != hipSuccess) { grid = -1; return; }
        if (hipFuncSetAttribute((const void*)mk_fwd, hipFuncAttributeMaxDynamicSharedMemorySize, LDS_BYTES) != hipSuccess) { fprintf(stderr, "hipFuncSetAttribute failed\n"); grid = -1; return; }
        grid = cus;
    }
    if (grid < 0) return;
    Args a{};
    for (int i = 0; i < 28; ++i) a.in[i] = (const float*)d_in[i];
    a.out = (float*)d_out; a.ws = (unsigned char*)d_ws;
    (void)hipMemsetAsync((char*)d_ws + wsm::ctl, 0, CTL_ZERO_BYTES, stream);
#if MK_ONE_LAUNCH
#ifdef MK_CUT
    a.ph_lo = 0; a.ph_hi = MK_CUT; hipLaunchKernelGGL(mk_fwd, dim3(grid), dim3(NTHR), LDS_BYTES, stream, a);
    a.ph_lo = MK_CUT; a.ph_hi = 11; a.mode = 256; hipLaunchKernelGGL(mk_fwd, dim3(grid), dim3(NTHR), LDS_BYTES, stream, a);
#else
    a.ph_lo = 0; a.ph_hi = 11; hipLaunchKernelGGL(mk_fwd, dim3(grid), dim3(NTHR), LDS_BYTES, stream, a);
#endif
#ifdef MK_STAMPS
    if (MK_STAMPS >= 0) k_delay<<<1, 64, 0, stream>>>((const unsigned long long*)((char*)d_ws + wsm::ctl + 14336 * 4), MK_STAMPS);
#endif
#ifdef MK_EXTRA
    a.out = (float*)((char*)d_ws + 16 * MB); a.ph_lo = MK_EXTRA; a.ph_hi = MK_EXTRA + 1;
#ifdef MK_MODE
    a.mode = MK_MODE;
#endif
    hipLaunchKernelGGL(mk_fwd, dim3(grid), dim3(NTHR), LDS_BYTES, stream, a);
#endif
#else
    for (int ph = 0; ph < 11; ++ph) { a.ph_lo = ph; a.ph_hi = ph + 1; hipLaunchKernelGGL(mk_fwd, dim3(grid), dim3(NTHR), LDS_BYTES, stream, a); }
#endif
}
```

```cpp
#define MK_TS_A 0
#define MK_TS_B 1
#define MK_DUP 6
#include <hip/hip_runtime.h>
#include <cstdio>
#include <cstdint>
#define GAS __attribute__((address_space(1)))
#define LAS __attribute__((address_space(3)))
typedef unsigned short bf16_t;
typedef short bf16x8 __attribute__((ext_vector_type(8)));
typedef float f32x4 __attribute__((ext_vector_type(4)));
typedef float f32x2 __attribute__((ext_vector_type(2)));
typedef unsigned u32x4 __attribute__((ext_vector_type(4)));
typedef unsigned u32x2 __attribute__((ext_vector_type(2)));
typedef GAS unsigned gu32;
typedef long i64x2 __attribute__((ext_vector_type(2)));
typedef int i32x4 __attribute__((ext_vector_type(4)));
typedef int i32x8 __attribute__((ext_vector_type(8)));

namespace mk {
constexpr int T = 16384, SEQ = 4096, D = 1024, NPROJ = 1792, PLE = 256;
constexpr int OFF_K = 512, OFF_V = 640, OFF_LX = 768, OFF_LG = 1280;
constexpr int NE = 32, FF = 512;
constexpr float EPS = 1e-6f;
constexpr int NWAVES = 8, NTHR = 512;
constexpr int RING_BYTES = 131072, LDSCTL_OFF = RING_BYTES, MISC_OFF = LDSCTL_OFF + 320, XTRA_OFF = RING_BYTES + 1024, LDS_BYTES = 147456;

__device__ __forceinline__ unsigned f2bf(float f) { unsigned u = __builtin_bit_cast(unsigned, f); return (u + 0x7fffu + ((u >> 16) & 1u)) >> 16; }
typedef __bf16 bf16x2_t __attribute__((ext_vector_type(2)));
__device__ __forceinline__ unsigned pk2(float lo, float hi) { f32x2 f = {lo, hi}; return __builtin_bit_cast(unsigned, __builtin_convertvector(f, bf16x2_t)); }
__device__ __forceinline__ float bf2f(unsigned short b) { return __builtin_bit_cast(float, (unsigned)b << 16); }
__device__ __forceinline__ float bflo(unsigned w) { return __builtin_bit_cast(float, w << 16); }
__device__ __forceinline__ float bfhi(unsigned w) { return __builtin_bit_cast(float, w & 0xffff0000u); }
__device__ __forceinline__ void st_wt16(void* ptr, u32x4 v) { asm volatile("global_store_dwordx4 %0, %1, off sc1\n\ts_nop 1" :: "v"(ptr), "v"(v) : "memory"); }
__device__ __forceinline__ void st_wt8(void* ptr, u32x2 v) { asm volatile("global_store_dwordx2 %0, %1, off sc1\n\ts_nop 1" :: "v"(ptr), "v"(v) : "memory"); }
__device__ __forceinline__ void st_wt4(float* ptr, float v) { asm volatile("global_store_dword %0, %1, off sc1\n\ts_nop 0" :: "v"(ptr), "v"(v) : "memory"); }
__device__ __forceinline__ float wsum(float v) {
#pragma unroll
    for (int o = 1; o < 64; o <<= 1) v += __shfl_xor(v, o);
    return v;
}

#ifndef PG8_ASM_DMA
#define PG8_ASM_DMA 1
#endif
__device__ __forceinline__ int plane() { int t; asm volatile("v_mov_b32 %0, %1" : "=v"(t) : "v"((int)threadIdx.x)); return t & 63; }
#ifndef MK_STAMP_WHO
#define MK_STAMP_WHO 1
#endif
#ifndef MK_STAMP_BLK
#define MK_STAMP_BLK 0
#endif
namespace pg8 {
constexpr int BM = 256, BK = 64, HALF = 128, HTB = HALF * BK * 2, STAGE_BYTES = 8 * HTB, NXCD = 8, WGM = 8;
__device__ __forceinline__ int lds_byte(int r, int c) { const int st = (r >> 4) * 2 + (c >> 5), rr = r & 15, cc = c & 31, ob = rr * 64 + cc * 2; return st * 1024 + (ob ^ (((ob >> 9) & 1) << 5)); }
__device__ __forceinline__ void stage_rc(int b, int& R, int& C) { const int st = b / 1024, sb = b % 1024, swz = sb ^ (((sb >> 9) & 1) << 5); R = (st >> 1) * 16 + swz / 64; C = (st & 1) * 32 + (swz % 64) / 2; }
__device__ __forceinline__ int perm32(int rho) { const int n = rho >> 4, i = rho & 15; return 8 * (i >> 2) + 4 * n + (i & 3); }

struct Unit { int pm, pn, e, nrow, li0, ord; };

struct DenseOrder {
    static constexpr bool STAMPED = (MK_STAMP_WHO >= 10);
    const bf16_t* A; const bf16_t* Bt; unsigned long long* tsg = nullptr; int K, PA, PB, nM, nN, nwg, G, c;
    __device__ __forceinline__ void init(const bf16_t* A_, const bf16_t* Bt_, int M, int N, int K_, int G_, int c_) { A = A_; Bt = Bt_; K = K_; PA = K_; PB = K_; nM = M / BM; nN = N / BM; nwg = nM * nN; G = G_; c = c_; }
    __device__ __forceinline__ bool next(int i, Unit& u) const {
        const long L = (long)i * G + c; if (L >= nwg || c < 0) return false;
        int wgid = (int)L; { const int q = nwg / NXCD, r = nwg % NXCD, xcd = wgid % NXCD, off = wgid / NXCD; wgid = (xcd < r ? xcd * (q + 1) : r * (q + 1) + (xcd - r) * q) + off; }
        const int nig = WGM * nN, gid = wgid / nig, fm = gid * WGM, gsz = (nM - fm) < WGM ? (nM - fm) : WGM;
        u.pm = fm + ((wgid % nig) % gsz); u.pn = (wgid % nig) / gsz; u.e = 0; u.nrow = BM; u.li0 = 0; u.ord = i; return true;
    }
    __device__ __forceinline__ const char* a_ptr(const Unit& u) const { return (const char*)A + (size_t)u.pm * BM * PA * 2; }
    __device__ __forceinline__ const char* b_ptr(const Unit& u) const { return (const char*)Bt + (size_t)u.pn * BM * PB * 2; }
    __device__ __forceinline__ unsigned a_row(const Unit&, int r) const { return (unsigned)r; }
    __device__ __forceinline__ void a_ready(const Unit&) const {}
    __device__ __forceinline__ void done(const Unit&) const {}
};

#define PG8_WAIT_V(n) asm volatile("s_waitcnt vmcnt(" #n ")" ::: "memory")
#define PG8_WAIT_L(n) asm volatile("s_waitcnt lgkmcnt(" #n ")" ::: "memory")
#define PG8_BAR __builtin_amdgcn_s_barrier()
#define PG8_SCHED __builtin_amdgcn_sched_barrier(0)

template <class Epi, class Sched, bool ALIGN_EPI, bool GATHER, int MMA = 0>
__device__ __forceinline__ void gemm_phase(LAS unsigned char* lds, const int K, const Sched& S, const Epi& E) {
    const int tid = threadIdx.x, wid = __builtin_amdgcn_readfirstlane(tid >> 6), lane = plane(), wr = wid >> 2, wc = wid & 3, fr = lane & 15, fq = lane >> 4;
    const int nt = K / BK; const int PA = S.PA, PB = S.PB;
    int Rr[2], Cc[2]; unsigned voffA[2], voffB[2];
#pragma unroll
    for (int i = 0; i < 2; ++i) { stage_rc(tid * 16 + i * 8192, Rr[i], Cc[i]); const int Rb = Epi::PERM ? ((Rr[i] & ~31) + perm32(Rr[i] & 31)) : Rr[i];
        voffA[i] = (unsigned)(Rr[i] * PA + Cc[i]) * 2u; voffB[i] = (unsigned)(Rb * PB + Cc[i]) * 2u; }
    const size_t kstep = (size_t)(BK * 2);
    const size_t hstepB = (size_t)HALF * PB * 2;
    const size_t hstepA = GATHER ? 0 : (size_t)HALF * PA * 2;
    const unsigned ldsw = (unsigned)wid * 1024u;
    const unsigned ldsb = (unsigned)__builtin_amdgcn_readfirstlane((int)((unsigned)(size_t)lds + ldsw));
    const int aoff = lds_byte(wr * 64 + fr, fq * 8), boff = lds_byte(wc * 32 + fr, fq * 8);
#define PG8_SA(b, h) (((b) * 2 + (h)) * HTB)
#define PG8_SB(b, h) ((4 + (b) * 2 + (h)) * HTB)
#if PG8_ASM_DMA
#define PG8_DMA1(ldsaddr, gbase, voff) do { unsigned keep_; asm volatile("s_mov_b32 %0, m0\n\ts_mov_b32 m0, %3\n\ts_nop 0\n\tglobal_load_lds_dwordx4 %1, %2\n\ts_mov_b32 m0, %0" \
        : "=&s"(keep_) : "v"(voff), "s"(gbase), "s"(ldsaddr) : "memory"); } while (0)
#define PG8_ST2(bufoff, gbase, v0, v1) do { PG8_DMA1(ldsb + (unsigned)(bufoff), (const char*)(gbase), (v0)); PG8_DMA1(ldsb + (unsigned)(bufoff) + 8192u, (const char*)(gbase), (v1)); } while (0)
#else
#define PG8_ST2(bufoff, gbase, v0, v1) do { \
        __builtin_amdgcn_global_load_lds((const unsigned*)((const char*)(gbase) + (v0)), (LAS unsigned*)(lds + (bufoff) + ldsw), 16, 0, 0); \
        __builtin_amdgcn_global_load_lds((const unsigned*)((const char*)(gbase) + (v1)), (LAS unsigned*)(lds + (bufoff) + ldsw + 8192), 16, 0, 0); } while (0)
#endif
#define PG8_STB(bufoff, gbase) PG8_ST2(bufoff, gbase, voffB[0], voffB[1])
#define PG8_LDA(dst, b, h) do { _Pragma("unroll") for (int m = 0; m < 4; ++m) { \
        if constexpr (MMA == 2) dst##8[m] = __builtin_shufflevector(*(const LAS i32x4*)(lds + PG8_SA(b, h) + aoff + m * 2048), *(const LAS i32x4*)(lds + PG8_SA(b, h) + aoff + m * 2048 + 1024), 0, 1, 2, 3, 4, 5, 6, 7); \
        else { _Pragma("unroll") for (int k = 0; k < 2; ++k) dst[m][k] = *(const LAS bf16x8*)(lds + PG8_SA(b, h) + aoff + m * 2048 + k * 1024); } } } while (0)
#define PG8_LDB(dst, b, h) do { _Pragma("unroll") for (int n = 0; n < 2; ++n) { \
        if constexpr (MMA == 2) dst##8[n] = __builtin_shufflevector(*(const LAS i32x4*)(lds + PG8_SB(b, h) + boff + n * 2048), *(const LAS i32x4*)(lds + PG8_SB(b, h) + boff + n * 2048 + 1024), 0, 1, 2, 3, 4, 5, 6, 7); \
        else { _Pragma("unroll") for (int k = 0; k < 2; ++k) dst[n][k] = *(const LAS bf16x8*)(lds + PG8_SB(b, h) + boff + n * 2048 + k * 1024); } } } while (0)
#define PG8_MMA(ai, bj, At, Bt) do { __builtin_amdgcn_s_setprio(1); _Pragma("unroll") for (int m = 0; m < 4; ++m) _Pragma("unroll") for (int n = 0; n < 2; ++n) { \
        if constexpr (MMA == 0) { _Pragma("unroll") for (int k = 0; k < 2; ++k) acc[ai][bj][m][n] = __builtin_amdgcn_mfma_f32_16x16x32_bf16(Bt[n][k], At[m][k], acc[ai][bj][m][n], 0, 0, 0); } \
        else if constexpr (MMA == 1) { _Pragma("unroll") for (int k = 0; k < 2; ++k) { const i64x2 b2_ = __builtin_bit_cast(i64x2, Bt[n][k]), a2_ = __builtin_bit_cast(i64x2, At[m][k]); \
            acc[ai][bj][m][n] = __builtin_amdgcn_mfma_f32_16x16x32_fp8_fp8(b2_[0], a2_[0], acc[ai][bj][m][n], 0, 0, 0); acc[ai][bj][m][n] = __builtin_amdgcn_mfma_f32_16x16x32_fp8_fp8(b2_[1], a2_[1], acc[ai][bj][m][n], 0, 0, 0); } } \
        else { acc[ai][bj][m][n] = __builtin_amdgcn_mfma_scale_f32_16x16x128_f8f6f4(Bt##8[n], At##8[m], acc[ai][bj][m][n], 0, 0, 0, 0x7f7f7f7f, 0, 0x7f7f7f7f); } \
        } __builtin_amdgcn_s_setprio(0); } while (0)
#ifdef MK_STAMPS
#define PG8_STAMP(k) do { if constexpr (Sched::STAMPED) { if (blockIdx.x == MK_STAMP_BLK && tid == 0 && S.tsg) S.tsg[k] = __builtin_amdgcn_s_memrealtime(); } } while (0)
#else
#define PG8_STAMP(k) do { } while (0)
#endif
    Unit cur, nxt; int ui = 0;
    if (!S.next(0, cur)) return;
    f32x4 acc[2][2][4][2];
#pragma unroll
    for (int a = 0; a < 2; ++a)
#pragma unroll
        for (int b = 0; b < 2; ++b)
#pragma unroll
            for (int m = 0; m < 4; ++m)
#pragma unroll
                for (int n = 0; n < 2; ++n) acc[a][b][m][n] = (f32x4){0.f, 0.f, 0.f, 0.f};
    bf16x8 At[4][2], B0[2][2], B1[2][2]; i32x8 At8[4], B08[2], B18[2];
    const char* cA = S.a_ptr(cur); const char* cB = S.b_ptr(cur);
    S.a_ready(cur);
    unsigned c00 = voffA[0], c01 = voffA[1], c10 = voffA[0], c11 = voffA[1];
    if constexpr (GATHER) {
        c00 = (S.a_row(cur, Rr[0]) * (unsigned)PA + (unsigned)Cc[0]) * 2u; c01 = (S.a_row(cur, Rr[1]) * (unsigned)PA + (unsigned)Cc[1]) * 2u;
        c10 = (S.a_row(cur, HALF + Rr[0]) * (unsigned)PA + (unsigned)Cc[0]) * 2u; c11 = (S.a_row(cur, HALF + Rr[1]) * (unsigned)PA + (unsigned)Cc[1]) * 2u;
    }
    unsigned pfd[Epi::NPF > 0 ? Epi::NPF : 1];
    if constexpr (Epi::NPF > 0) {
#pragma unroll
        for (int j = 0; j < Epi::NPF; ++j) asm volatile("global_load_dword %0, %1, off" : "=v"(pfd[j]) : "v"(E.pf_addr(cur, tid, j)) : "memory");
    }
    PG8_STB(PG8_SB(0, 0), cB); PG8_STB(PG8_SB(0, 1), cB + hstepB); PG8_ST2(PG8_SA(0, 0), cA, c00, c01); PG8_ST2(PG8_SA(0, 1), cA + hstepA, c10, c11);
    if (wr == 1) PG8_BAR;
    PG8_WAIT_V(2); PG8_BAR;
    if constexpr (Epi::NPF > 0) {
#pragma unroll
        for (int j = 0; j < Epi::NPF; ++j) asm volatile("" :: "v"(pfd[j]));
    }
    PG8_STB(PG8_SB(1, 0), cB + kstep); PG8_ST2(PG8_SA(1, 0), cA + kstep, c00, c01); PG8_STB(PG8_SB(1, 1), cB + hstepB + kstep);
    PG8_WAIT_V(6); PG8_BAR; PG8_STAMP(30);
    for (;;) {
        const bool has_next = S.next(ui + 1, nxt);
        const char* nA = has_next ? S.a_ptr(nxt) : cA; const char* nB = has_next ? S.b_ptr(nxt) : cB;
#pragma unroll 1
        for (int t = 0; t < nt; t += 2) {
            const bool last = (t == nt - 2);
            const char* a1 = cA + (size_t)(t + 1) * kstep;
            const char* a2 = last ? nA : cA + (size_t)(t + 2) * kstep; const char* b2 = last ? nB : cB + (size_t)(t + 2) * kstep;
            const char* a3 = a2 + kstep; const char* b3 = b2 + kstep;
            if constexpr (Epi::MIDSCALE) { if (t == nt / 2) E.midscale(acc, cur, wr, fr); }
            if (last && has_next) S.a_ready(nxt);
            PG8_LDB(B0, 0, 0); PG8_LDB(B1, 0, 1); PG8_SCHED; PG8_LDA(At, 0, 0); PG8_ST2(PG8_SA(1, 1), a1 + hstepA, c10, c11);
            if constexpr (GATHER) { if (last && has_next) {
                int R0, C0, R1, C1; stage_rc(tid * 16, R0, C0); stage_rc(tid * 16 + 8192, R1, C1);
                c00 = (S.a_row(nxt, R0) * (unsigned)PA + (unsigned)C0) * 2u; c01 = (S.a_row(nxt, R1) * (unsigned)PA + (unsigned)C1) * 2u;
                c10 = (S.a_row(nxt, HALF + R0) * (unsigned)PA + (unsigned)C0) * 2u; c11 = (S.a_row(nxt, HALF + R1) * (unsigned)PA + (unsigned)C1) * 2u; } }
            PG8_WAIT_V(8); PG8_WAIT_L(0); PG8_BAR; PG8_MMA(0, 0, At, B0); PG8_MMA(0, 1, At, B1); PG8_BAR; PG8_SCHED;
            PG8_LDA(At, 0, 1); PG8_STB(PG8_SB(0, 0), b2); PG8_STB(PG8_SB(0, 1), b2 + hstepB); PG8_ST2(PG8_SA(0, 0), a2, c00, c01);
            PG8_WAIT_V(8); PG8_WAIT_L(0); PG8_BAR; PG8_MMA(1, 0, At, B0); PG8_MMA(1, 1, At, B1); PG8_BAR; PG8_SCHED;
            PG8_LDB(B0, 1, 0); PG8_LDB(B1, 1, 1); PG8_SCHED; PG8_LDA(At, 1, 0); PG8_ST2(PG8_SA(0, 1), a2 + hstepA, c10, c11);
            PG8_WAIT_V(8); PG8_WAIT_L(0); PG8_BAR; PG8_MMA(0, 0, At, B0); PG8_MMA(0, 1, At, B1); PG8_BAR; PG8_SCHED;
            PG8_LDA(At, 1, 1); PG8_STB(PG8_SB(1, 0), b3); PG8_STB(PG8_SB(1, 1), b3 + hstepB); PG8_ST2(PG8_SA(1, 0), a3, c00, c01);
            PG8_WAIT_V(8); PG8_WAIT_L(0); PG8_BAR; PG8_MMA(1, 0, At, B0); PG8_MMA(1, 1, At, B1); PG8_BAR; PG8_SCHED;
        }
        if constexpr (ALIGN_EPI) { if (wr == 0) PG8_BAR; }
        PG8_STAMP(31 + 2 * ui);
        { const int le = plane(); E(acc, cur, wr, wc, le & 15, le >> 4); }
        PG8_STAMP(40 + ui);
        S.done(cur);
        PG8_STAMP(32 + 2 * ui);
        if (!has_next) break;
#pragma unroll
        for (int a = 0; a < 2; ++a)
#pragma unroll
            for (int b = 0; b < 2; ++b)
#pragma unroll
                for (int m = 0; m < 4; ++m)
#pragma unroll
                    for (int n = 0; n < 2; ++n) acc[a][b][m][n] = (f32x4){0.f, 0.f, 0.f, 0.f};
        cur = nxt; cA = nA; cB = nB; ++ui;
        if constexpr (ALIGN_EPI) { if (wr == 1) PG8_BAR; }
    }
    PG8_WAIT_V(0);
    if constexpr (!ALIGN_EPI) { if (wr == 0) PG8_BAR; }
    PG8_BAR;
#undef PG8_SA
#undef PG8_SB
#undef PG8_ST2
#undef PG8_STB
#undef PG8_LDA
#undef PG8_LDB
#undef PG8_MMA
}

struct EpiScaleBf16 {
    static constexpr bool PERM = true, MIDSCALE = false; static constexpr int NPF = 0;
    bf16_t* O; const float* rs; int ldc; int pad;
    __device__ __forceinline__ void midscale(f32x4 (&)[2][2][4][2], const Unit&, int, int) const {}
    __device__ __forceinline__ void operator()(const f32x4 (&acc)[2][2][4][2], const Unit& u, int wr, int wc, int fr, int fq) const {
        const int row0 = u.pm * BM + wr * 64 + fr, col0 = u.pn * BM + wc * 32 + 8 * fq;
        float sv[2][4];
#pragma unroll
        for (int ai = 0; ai < 2; ++ai)
#pragma unroll
            for (int m = 0; m < 4; ++m) sv[ai][m] = rs ? rs[row0 + ai * HALF + m * 16] : 1.f;
#pragma unroll
        for (int ai = 0; ai < 2; ++ai)
#pragma unroll
            for (int m = 0; m < 4; ++m) { const int row = row0 + ai * HALF + m * 16; const float s = sv[ai][m]; bf16_t* rowp = O + (size_t)row * ldc + col0;
#pragma unroll
                for (int bj = 0; bj < 2; ++bj) { const f32x4 v0 = acc[ai][bj][m][0] * s, v1 = acc[ai][bj][m][1] * s;
                    u32x4 w; w.x = pk2(v0[0], v0[1]); w.y = pk2(v0[2], v0[3]); w.z = pk2(v1[0], v1[1]); w.w = pk2(v1[2], v1[3]);
                    *(u32x4*)(rowp + bj * HALF) = w; } }
    }
};
}

#define XB_TMO      128
#define XB_XCNT(j)  (256  + 64 * (j))
#define XB_XSUB(j)  (1280 + 64 * (j))
#define XB_XGEN(j)  (2304 + 64 * (j))
#define XB_TOP      3328
#define XB_TOPGEN   3392
#define XCD_BAR_WORDS 3456
#define XB_SPIN_CAP (1u << 18)
__device__ __forceinline__ unsigned xb_ld(unsigned* p)              { return __hip_atomic_load(p, __ATOMIC_RELAXED, __HIP_MEMORY_SCOPE_AGENT); }
__device__ __forceinline__ unsigned xb_add(unsigned* p, unsigned v) { return __hip_atomic_fetch_add(p, v, __ATOMIC_RELAXED, __HIP_MEMORY_SCOPE_AGENT); }
__device__ __forceinline__ unsigned xb_xcc_id() { return (unsigned)__builtin_amdgcn_s_getreg((3 << 11) | 20) & 0xFu; }
#define XB_SPIN(cond, bar) do { unsigned _sp = 0; while (cond) { __builtin_amdgcn_s_sleep(1); \
    if ((++_sp & 255u) == 0u) { if (xb_ld(&(bar)[XB_TMO])) break; if (_sp > XB_SPIN_CAP) { atomicAdd(&(bar)[XB_TMO], 1u); break; } } } } while (0)
struct XcdBarrier { unsigned* bar; unsigned x; volatile LAS unsigned* st; };
__device__ __forceinline__ XcdBarrier xcd_barrier_post(unsigned* bar, volatile LAS unsigned* st) {
    XcdBarrier b; b.bar = bar; b.x = xb_xcc_id(); b.st = st;
    if (threadIdx.x == 0) (void)xb_add(&bar[XB_XCNT(b.x)], 1u);
    return b;
}
__device__ __forceinline__ void xcd_barrier_complete(unsigned* bar, unsigned x, unsigned& nloc, unsigned& nx) {
    const unsigned G = gridDim.x * gridDim.y * gridDim.z;
    unsigned sum, cnt, mine, sp = 0u;
    for (;;) {
        sum = 0u; cnt = 0u; mine = 0u;
#pragma unroll
        for (unsigned j = 0; j < 16; ++j) { const unsigned c = xb_ld(&bar[XB_XCNT(j)]); sum += c; cnt += (c > 0u) ? 1u : 0u; mine = (j == x) ? c : mine; }
        if (sum == G) break;
        __builtin_amdgcn_s_sleep(1);
        if ((++sp & 255u) == 0u) { if (xb_ld(&bar[XB_TMO])) break; if (sp > XB_SPIN_CAP) { atomicAdd(&bar[XB_TMO], 1u); break; } }
    }
    nloc = mine > 0u ? mine : 1u; nx = cnt > 0u ? cnt : 1u;
}
__device__ __forceinline__ void xcd_barrier(const XcdBarrier& b, const char* pf = nullptr, int pfpitch = 0) {
    asm volatile("s_waitcnt vmcnt(0)" ::: "memory");
    __syncthreads();
    if (pf && threadIdx.x >= 64) { const int q = (int)threadIdx.x - 64; unsigned d[5];
#pragma unroll
        for (int j = 0; j < 5; ++j) { int c = q + 448 * j; c = c < 2048 ? c : 2047; const char* p = pf + (size_t)(c >> 3) * pfpitch + (c & 7) * 64; asm volatile("global_load_dword %0, %1, off" : "=v"(d[j]) : "v"(p) : "memory"); }
        asm volatile("s_waitcnt vmcnt(0)" ::: "memory");
#pragma unroll
        for (int j = 0; j < 5; ++j) asm volatile("" :: "v"(d[j])); }
    if (threadIdx.x == 0) {
        unsigned* bar = b.bar;
        __builtin_amdgcn_s_waitcnt(0);
        unsigned nloc = b.st[0], nx = b.st[1];
        if (nloc == 0u) { xcd_barrier_complete(bar, b.x, nloc, nx); b.st[0] = nloc; b.st[1] = nx; }
        const unsigned old = xb_add(&bar[XB_XSUB(b.x)], 1u);
        const unsigned gen = old / nloc;
        if (old + 1u == (gen + 1u) * nloc) {
            __builtin_amdgcn_fence(__ATOMIC_RELEASE, "agent");
            asm volatile("s_waitcnt vmcnt(0)" ::: "memory");
            const unsigned og = xb_add(&bar[XB_TOP], 1u);
            const unsigned tg = og / nx;
            if (og + 1u == (tg + 1u) * nx) xb_add(&bar[XB_TOPGEN], 1u);
            else XB_SPIN(xb_ld(&bar[XB_TOPGEN]) == tg, bar);
            __builtin_amdgcn_fence(__ATOMIC_ACQUIRE, "agent");
            xb_add(&bar[XB_XGEN(b.x)], 1u);
            asm volatile("s_waitcnt vmcnt(0)" ::: "memory");
        } else {
            XB_SPIN(xb_ld(&bar[XB_XGEN(b.x)]) == gen, bar);
            __builtin_amdgcn_fence(__ATOMIC_ACQUIRE, "agent");
            asm volatile("s_waitcnt vmcnt(0)" ::: "memory");
        }
    }
    __syncthreads();
}


constexpr size_t MiB = 1u << 20;
constexpr size_t WS_CTL = 0, CTL_ZERO_BYTES = 64 * 1024;
constexpr int CW_BAR = 1024;
constexpr int CW_CNT = 8192;
constexpr int CW_TILE = 5120;
constexpr int CW_Q2 = 13312;
constexpr int CW_PANA = 9216, CW_PANB = 11264;

__device__ __forceinline__ void p0_transpose_item(const float* W, int K, int N, const float* ks, bf16_t* WT, int rbase, int gshift, int gstride, LAS float* scr, int item, int lane) {
    const int nblk = N / 32, kb = item / nblk, nb = item % nblk, k0 = 64 * kb, n0 = 32 * nb;
#pragma unroll 8
    for (int i = 0; i < 32; ++i) { const int kk = 2 * i + (lane >> 5); const float s = ks ? ks[k0 + kk] : 1.f; scr[kk * 33 + (lane & 31)] = W[(size_t)(k0 + kk) * N + n0 + (lane & 31)] * s; }
    asm volatile("s_waitcnt lgkmcnt(0)" ::: "memory");
    const int c = lane & 7;
#pragma unroll
    for (int j = 0; j < 4; ++j) { const int nl = (lane >> 3) + 8 * j, n = n0 + nl; const LAS float* s = scr + (8 * c) * 33 + nl;
        const int row = rbase + (n >> gshift) * gstride + (n & ((1 << gshift) - 1));
        u32x4 o; o.x = pk2(s[0 * 33], s[1 * 33]); o.y = pk2(s[2 * 33], s[3 * 33]); o.z = pk2(s[4 * 33], s[5 * 33]); o.w = pk2(s[6 * 33], s[7 * 33]);
        *(u32x4*)(WT + (size_t)row * K + k0 + 8 * c) = o; }
    asm volatile("s_waitcnt lgkmcnt(0)" ::: "memory");
}

constexpr size_t MB_ = 1u << 20, KB_ = 1024;
namespace wsm {
constexpr size_t ctl = 0, r0 = 64 * KB_, rL = 128 * KB_, r2 = 192 * KB_, rP = 256 * KB_, tokE = 320 * KB_, tokPos = 448 * KB_,
    rope = 1 * MB_, wtot = 5 * MB_, ctot = 6 * MB_, ssq1p = 7 * MB_, ssq3p = 8 * MB_, lt = 9 * MB_, lw = 11 * MB_, lr = 13 * MB_, wr_t = 15 * MB_, wag_t = 15 * MB_ + 512 * KB_,
    w_in_t = 16 * MB_, w_out_t = 20 * MB_, wgu_t = 22 * MB_  , projb = 86 * MB_, x1q = 86 * MB_  , x2q = 86 * MB_  , x1b = 110 * MB_,
    wd_t = 142 * MB_, w_pg_t = 174 * MB_, w_pp_t = 176 * MB_,
    xb = 177 * MB_, x2b = 177 * MB_, pb = 209 * MB_, mix = 209 * MB_, hid = 209 * MB_, x3b = 110 * MB_, pp = 249 * MB_, y2 = 54 * MB_, END = 281 * MB_;
}
struct Args {
    const float* in[28]; float* out; unsigned char* ws;
    int ph_lo, ph_hi, mode, pad;
};
typedef const __attribute__((address_space(4))) Args* KArgsP;
__device__ __forceinline__ KArgsP kargs() { KArgsP p = (KArgsP)__builtin_amdgcn_kernarg_segment_ptr(); asm volatile("" : "+s"(p)); return p; }
struct Frame {
    LAS unsigned char* lds; volatile LAS unsigned* MISC; gu32* ctl;
    int tid, lane, wave, vcu, G;
};
__device__ __forceinline__ float fexp2(float x) { return __builtin_amdgcn_exp2f(x); }
__device__ __forceinline__ float fexp(float x) { return __builtin_amdgcn_exp2f(x * 1.4426950408889634f); }
__device__ __forceinline__ float frcp(float x) { return __builtin_amdgcn_rcpf(x); }
__device__ __forceinline__ float fsigmoid(float x) { return frcp(1.f + fexp(-x)); }
__device__ __forceinline__ float fgelu_tanh(float x) {
    const float u = 0.7978845608028654f * (x + 0.044715f * x * x * x);
    return x * (1.f - frcp(1.f + fexp(2.f * u)));
}

__device__ __forceinline__ void p0_tr64(const float* W, int K, int N, const float* ks, bf16_t* WT, int rbase, int gshift, int gstride, LAS unsigned* t2, int item, int lane) {
    const int nblk = N / 64, kb = item / nblk, nb = item % nblk, k0 = 64 * kb, n0 = 64 * nb;
    const int n4 = lane & 15, kr = lane >> 4;
    f32x4 va[8], vb[8]; f32x2 sk[8];
#pragma unroll
    for (int i = 0; i < 8; ++i) sk[i] = (f32x2){1.f, 1.f};
    if (ks) {
#pragma unroll
        for (int i = 0; i < 8; ++i) sk[i] = *(const f32x2*)(ks + k0 + 8 * i + 2 * kr); }
#pragma unroll
    for (int i = 0; i < 8; ++i) { const int k = k0 + 8 * i + 2 * kr; va[i] = *(const f32x4*)(W + (size_t)k * N + n0 + 4 * n4); vb[i] = *(const f32x4*)(W + (size_t)(k + 1) * N + n0 + 4 * n4); }
#pragma unroll
    for (int i = 0; i < 8; ++i) { const int kp = 4 * i + kr; const float s0 = sk[i].x, s1 = sk[i].y;
        LAS unsigned* d = t2 + (4 * n4) * 33 + kp;
        d[0] = pk2(va[i].x * s0, vb[i].x * s1); d[33] = pk2(va[i].y * s0, vb[i].y * s1); d[66] = pk2(va[i].z * s0, vb[i].z * s1); d[99] = pk2(va[i].w * s0, vb[i].w * s1); }
    asm volatile("s_waitcnt lgkmcnt(0)" ::: "memory");
    const int nl = lane >> 3, c = lane & 7;
#pragma unroll
    for (int j = 0; j < 8; ++j) { const int n = 8 * j + nl; const LAS unsigned* s = t2 + n * 33 + 4 * c; const int ng = n0 + n;
        const int row = rbase + (ng >> gshift) * gstride + (ng & ((1 << gshift) - 1));
        *(u32x4*)(WT + (size_t)row * K + k0 + 8 * c) = (u32x4){s[0], s[1], s[2], s[3]}; }
    asm volatile("s_waitcnt lgkmcnt(0)" ::: "memory");
}

__device__ __forceinline__ unsigned pk4_fp8(float a, float b, float c, float d) {
    int w = 0; w = __builtin_amdgcn_cvt_pk_fp8_f32(a, b, w, false); w = __builtin_amdgcn_cvt_pk_fp8_f32(c, d, w, true); return (unsigned)w;
}
#ifndef MOE_MMA
#define MOE_MMA 1
#endif
#ifndef PLE_MMA
#define PLE_MMA 2
#endif
#ifndef DOWN_SPLIT
#define DOWN_SPLIT 2560
#endif
#ifndef P2_QUEUE
#define P2_QUEUE 0
#endif
#ifndef PLE_NPF
#define PLE_NPF 0
#endif
#ifndef OUT_NPF
#define OUT_NPF 0
#endif
#ifndef MOE2_MMA
#define MOE2_MMA 2
#endif
constexpr float PQ_SCALE = 16.f;
constexpr float WQ_SCALE = 32.f, HQ_SCALE = 32.f, YQ_SCALE = 64.f;
#ifdef MK_STAMPS
#define TRQ_STAMP(k) do { if (blockIdx.x == MK_STAMP_BLK && threadIdx.x == 0) ((unsigned long long*)(kargs()->ws + wsm::ctl + 14336 * 4))[k] = __builtin_amdgcn_s_memrealtime(); } while (0)
#else
#define TRQ_STAMP(k) do { } while (0)
#endif
__device__ __forceinline__ void p0_tr64_q(const float* W, int K, int N, const float* ks, unsigned char* WQ, int rbase, int gshift, int gstride, LAS unsigned* t4, int item, int lane) {
    const int nblk = N / 64, kb = item / nblk, nb = item % nblk, k0 = 64 * kb, n0 = 64 * nb;
    const int n4 = lane & 15, kr = lane >> 4;
    f32x4 v[4][4], sk[4];
#pragma unroll
    for (int i = 0; i < 4; ++i) sk[i] = (f32x4){1.f, 1.f, 1.f, 1.f};
    if (ks) {
#pragma unroll
        for (int i = 0; i < 4; ++i) sk[i] = *(const f32x4*)(ks + k0 + 16 * i + 4 * kr); }
#pragma unroll
    for (int i = 0; i < 4; ++i)
#pragma unroll
        for (int r = 0; r < 4; ++r) v[i][r] = *(const f32x4*)(W + (size_t)(k0 + 16 * i + 4 * kr + r) * N + n0 + 4 * n4);
#pragma unroll
    for (int i = 0; i < 4; ++i) { float s[4];
#pragma unroll
        for (int r = 0; r < 4; ++r) s[r] = sk[i][r] * WQ_SCALE;
        LAS unsigned* d = t4 + (4 * n4) * 17 + 4 * i + kr;
        d[0] = pk4_fp8(v[i][0].x * s[0], v[i][1].x * s[1], v[i][2].x * s[2], v[i][3].x * s[3]); d[17] = pk4_fp8(v[i][0].y * s[0], v[i][1].y * s[1], v[i][2].y * s[2], v[i][3].y * s[3]);
        d[34] = pk4_fp8(v[i][0].z * s[0], v[i][1].z * s[1], v[i][2].z * s[2], v[i][3].z * s[3]); d[51] = pk4_fp8(v[i][0].w * s[0], v[i][1].w * s[1], v[i][2].w * s[2], v[i][3].w * s[3]); }
    asm volatile("s_waitcnt lgkmcnt(0)" ::: "memory");
    const int nl = lane >> 2, c = lane & 3;
#pragma unroll
    for (int j = 0; j < 4; ++j) { const int n = 16 * j + nl; const LAS unsigned* s = t4 + n * 17 + 4 * c; const int ng = n0 + n;
        const int row = rbase + (ng >> gshift) * gstride + (ng & ((1 << gshift) - 1));
        *(u32x4*)(WQ + (size_t)row * K + k0 + 16 * c) = (u32x4){s[0], s[1], s[2], s[3]}; }
    asm volatile("s_waitcnt lgkmcnt(0)" ::: "memory");
}

__device__ __forceinline__ void p0_experts(const Frame& F, KArgsP a, int w, int nw, int part, int lo2 = 0, int hi2 = 1 << 30) {
    LAS unsigned* t2 = (LAS unsigned*)(F.lds + F.wave * 8704); unsigned char* ws = a->ws; const int lane = plane();
    const float* g_ffn = a->in[16]; const float* w_eg = a->in[21]; const float* w_eu = a->in[22]; const float* w_ed = a->in[23];
    constexpr int I_G = (D / 64) * (FF / 64), I_D = (FF / 64) * (D / 64);
    if (part & 1) for (int r = w; r < NE * 2 * I_G; r += nw) { const int e = r / (2 * I_G), q = r % (2 * I_G), up = q / I_G, item = q % I_G;
        p0_tr64_q((up ? w_eu : w_eg) + (size_t)e * D * FF, D, FF, g_ffn, (unsigned char*)(ws + wsm::wgu_t) + (size_t)e * 1024 * D, 128 * up, 7, 256, t2, item, lane); }
    const int h2 = hi2 < NE * I_D ? hi2 : NE * I_D;
    if (part & 2) for (int r = lo2 + w; r < h2; r += nw) { const int e = r / I_D, item = r % I_D;
        p0_tr64_q(w_ed + (size_t)e * FF * D, FF, D, nullptr, (unsigned char*)(ws + wsm::wd_t) + (size_t)e * D * FF, 0, 30, 0, t2, item, lane); }
}
__device__ __forceinline__ void p0_experts_chunk(const Frame& F, KArgsP a, int c) {
    LAS unsigned* t2 = (LAS unsigned*)(F.lds + F.wave * 8704); unsigned char* ws = a->ws; const int lane = plane();
    const float* g_ffn = a->in[16]; const float* w_eg = a->in[21]; const float* w_eu = a->in[22];
    constexpr int I_G = (D / 64) * (FF / 64);
#pragma unroll 1
    for (int j = 0; j < 2; ++j) { const int r = c * 16 + F.wave * 2 + j, e = r / (2 * I_G), q = r % (2 * I_G), up = q / I_G, item = q % I_G;
        p0_tr64_q((up ? w_eu : w_eg) + (size_t)e * D * FF, D, FF, g_ffn, (unsigned char*)(ws + wsm::wgu_t) + (size_t)e * 1024 * D, 128 * up, 7, 256, t2, item, lane); }
}
#ifdef MK_CONVPROBE
__device__ __forceinline__ void conv_probe(const Frame& F, KArgsP a, int w, int nw, int mode) {
    const int lane = plane(); const float* w_eg = a->in[21]; const float* w_eu = a->in[22];
    constexpr int I_G = (D / 64) * (FF / 64); const int NT = NE * 2 * I_G; float acc = 0.f;
    for (int r = w; r < NT; r += 2 * nw) {
        f32x4 v[2][16];
#pragma unroll
        for (int h = 0; h < 2; ++h) { const int rr = (r + h * nw) < NT ? r + h * nw : r; const int e = rr / (2 * I_G), q = rr % (2 * I_G), up = q / I_G, item = q % I_G;
            const float* W = (up ? w_eu : w_eg) + (size_t)e * D * FF; const int kb = item / 8, nb = item % 8, k0 = 64 * kb, n0 = 64 * nb, n4 = lane & 15, kr = lane >> 4;
#pragma unroll
            for (int i = 0; i < 16; ++i) {
                if (mode == 4) v[h][i] = *(const f32x4*)((const float*)(a->ws + wsm::projb) + (size_t)rr * 4096 + (i * 64 + lane) * 4);
                else if (mode == 5) v[h][i] = *(const f32x4*)(a->in[0] + (size_t)rr * 4096 + (i * 64 + lane) * 4);
                else if (mode == 2) v[h][i] = *(const f32x4*)(W + (size_t)item * 4096 + (i * 64 + lane) * 4);
                else v[h][i] = *(const f32x4*)(W + (size_t)(k0 + 16 * (i >> 2) + 4 * kr + (i & 3)) * FF + n0 + 4 * n4); }
            if (mode == 3) {
#pragma unroll
                for (int i = 0; i < 16; ++i) acc += v[h][i].x + v[h][i].w; } }
        if (mode != 3) {
#pragma unroll
            for (int h = 0; h < 2; ++h)
#pragma unroll
                for (int i = 0; i < 16; ++i) acc += v[h][i].x + v[h][i].w; }
    }
    if (acc == 12345.678f) ((float*)(a->ws + wsm::y2))[lane] = acc;
}
#endif
__device__ __forceinline__ void p0_prologue(const Frame& F, KArgsP a) {
    LAS unsigned* t2 = (LAS unsigned*)(F.lds + F.wave * 8704);
    const int gw = F.vcu * NWAVES + F.wave, NGW = F.G * NWAVES, lane = plane();
    unsigned char* ws = a->ws;
    const float* w_in = a->in[4]; const float* g_mix = a->in[3]; const float* w_out = a->in[15]; const float* g_attn = a->in[13]; const float* g_lru = a->in[14];
    const float* g_ffn = a->in[16];
    const float* g_ple = a->in[24]; const float* w_pg = a->in[25]; const float* w_pp = a->in[26];
    constexpr int I_IN = (D / 64) * (NPROJ / 64), I_OUT = (D / 64) * (D / 64), I_PG = I_OUT, I_PP = (PLE / 64) * (D / 64);
    constexpr int NITEMS = I_IN + I_OUT + I_PG + I_PP;
    for (int it = gw; it < NITEMS; it += NGW) {
        int r = it;
        if (r < I_IN) { p0_tr64(w_in, D, NPROJ, g_mix, (bf16_t*)(ws + wsm::w_in_t), 0, 30, 0, t2, r, lane); continue; } r -= I_IN;
        if (r < I_PP) { p0_tr64(w_pp, PLE, D, nullptr, (bf16_t*)(ws + wsm::w_pp_t), 0, 30, 0, t2, r, lane); continue; } r -= I_PP;
        if (r < I_OUT) { const int kb = r / (D / 64); const float* ks = kb < 8 ? g_attn : g_lru - 512; p0_tr64(w_out, D, D, ks, (bf16_t*)(ws + wsm::w_out_t), 0, 30, 0, t2, r, lane); continue; } r -= I_OUT;
        p0_tr64_q(w_pg, D, D, g_ple, (unsigned char*)(ws + wsm::w_pg_t), 0, 30, 0, t2, r, lane);
    }
    if (F.G < 256) p0_experts(F, a, gw, NGW, 3);
    const float* x = a->in[0]; bf16_t* xb = (bf16_t*)(ws + wsm::xb); float* r0 = (float*)(ws + wsm::r0);
    for (int m0 = 8 * gw; m0 < T; m0 += 8 * NGW) {
        f32x4 v[8][4];
#pragma unroll
        for (int k = 0; k < 8; ++k) { const int m = m0 + k; const f32x4* xr = (const f32x4*)(x + (size_t)(m < T ? m : m0) * D) + lane;
#pragma unroll
            for (int j = 0; j < 4; ++j) v[k][j] = xr[64 * j]; }
#pragma unroll
        for (int k = 0; k < 8; ++k) { const int m = m0 + k; float s = 0.f;
#pragma unroll
            for (int j = 0; j < 4; ++j) s += (v[k][j].x * v[k][j].x + v[k][j].y * v[k][j].y) + (v[k][j].z * v[k][j].z + v[k][j].w * v[k][j].w);
            s = wsum(s);
            if (m < T) { u32x2* o8 = (u32x2*)(xb + (size_t)m * D) + lane;
#pragma unroll
                for (int j = 0; j < 4; ++j) { u32x2 w; w.x = pk2(v[k][j].x, v[k][j].y); w.y = pk2(v[k][j].z, v[k][j].w); o8[64 * j] = w; }
                if (lane == 0) r0[m] = rsqrtf(s * (1.f / D) + EPS); } }
    }
    const float* p = a->in[1]; bf16_t* pb = (bf16_t*)(ws + wsm::pb);
    for (int m0 = 8 * gw; m0 < T; m0 += 8 * NGW) { f32x4 v[8];
#pragma unroll
        for (int k = 0; k < 8; ++k) { const int m = m0 + k; v[k] = ((const f32x4*)(p + (size_t)(m < T ? m : m0) * PLE))[lane]; }
#pragma unroll
        for (int k = 0; k < 8; ++k) { const int m = m0 + k; if (m < T) { u32x2 w; w.x = pk2(v[k].x, v[k].y); w.y = pk2(v[k].z, v[k].w); ((u32x2*)(pb + (size_t)m * PLE))[lane] = w; } } }
    const int* pos = (const int*)a->in[2]; f32x2* rope = (f32x2*)(ws + wsm::rope);
    for (int idx = (F.vcu * NTHR + F.tid); idx < T * 32; idx += F.G * NTHR) { const int t = idx >> 5, i = idx & 31;
        const float inv_freq = exp2f(-(float)(2 * i) * (13.287712379549449f / 64.f)); const float ang = (float)pos[t] * inv_freq; float sn, cs; sincosf(ang, &sn, &cs); rope[idx] = (f32x2){cs, sn}; }
    { const float* wa = a->in[8]; const float* wx = a->in[10]; bf16_t* wag_t = (bf16_t*)(ws + wsm::wag_t);
      for (int idx = (F.vcu * NTHR + F.tid); idx < 8 * 2 * 64 * 64; idx += F.G * NTHR) { const int i = idx & 63, j = (idx >> 6) & 63, gt = (idx >> 12) & 1, hb = idx >> 13;
          const float v = (gt ? wx : wa)[(size_t)(hb * 64 + i) * 64 + j]; wag_t[idx] = (bf16_t)(pk2(v, 0.f) & 0xffffu); } }
    const float* w_rg = a->in[17]; const float* w_re = a->in[19]; bf16_t* wr_t = (bf16_t*)(ws + wsm::wr_t);
    for (int idx = (F.vcu * NTHR + F.tid); idx < 48 * D; idx += F.G * NTHR) { const int j = idx >> 10, k = idx & 1023;
        float v = 0.f; if (j < 4) v = w_rg[k * 4 + j] * g_ffn[k]; else if (j < 36) v = w_re[k * 32 + (j - 4)] * g_ffn[k];
        wr_t[idx] = (bf16_t)(pk2(v, 0.f) & 0xffffu); }
}

constexpr int LB = 512;
constexpr int LRU_XS = 0, LRU_XS_PITCH = 144;
constexpr int LRU_WTL = LRU_XS + LB * LRU_XS_PITCH;
static_assert(LRU_WTL + 4096 <= RING_BYTES, "lru lds");

__device__ __forceinline__ void lruA_unit(const Frame& F, KArgsP a, int b, int hb, int chunk) {
    LAS unsigned char* lds = F.lds; const int tid = F.tid, lane = plane(), wave = F.wave;
    unsigned char* ws = a->ws;
    const bf16_t* projb = (const bf16_t*)(ws + wsm::projb); bf16_t* hl = (bf16_t*)a->out; bf16_t* pl = hl + (size_t)T * 512;
    float* wtot = (float*)(ws + wsm::wtot); float* ctot = (float*)(ws + wsm::ctot); const bf16_t* wag_t = (const bf16_t*)(ws + wsm::wag_t);
    const float* cw = a->in[6]; const float* cb = a->in[7]; const float* ba = a->in[9]; const float* bx = a->in[11]; const float* lam = a->in[12];
    const int s0 = chunk * LB; const size_t t0 = (size_t)b * SEQ + s0;
    { const int q8 = tid & 7, cch = hb * 64 + q8 * 8;
      float cwr[4][8], cbr[8];
#pragma unroll
      for (int j = 0; j < 4; ++j)
#pragma unroll
          for (int e = 0; e < 8; ++e) cwr[j][e] = cw[j * 512 + cch + e];
#pragma unroll
      for (int e = 0; e < 8; ++e) cbr[e] = cb[cch + e];
#pragma unroll
      for (int i = 0; i < 2; ++i) {
          const int tq = (tid >> 3) + 64 * i;
          float xv[4][8];
#pragma unroll
          for (int tk = 0; tk < 4; ++tk)
#pragma unroll
              for (int e = 0; e < 8; ++e) xv[tk][e] = cbr[e];
          u32x4 w[7];
#pragma unroll
          for (int m = 0; m < 7; ++m) { const int sj = s0 + 4 * tq - 3 + m; const int sc = sj < 0 ? 0 : sj;
              w[m] = *(const u32x4*)(projb + ((size_t)b * SEQ + sc) * NPROJ + OFF_LX + cch); }
#pragma unroll
          for (int m = 0; m < 7; ++m) { const bool ok = (s0 + 4 * tq - 3 + m) >= 0; const u32x4 ww = w[m];
              const float r[8] = {ok ? bflo(ww.x) : 0.f, ok ? bfhi(ww.x) : 0.f, ok ? bflo(ww.y) : 0.f, ok ? bfhi(ww.y) : 0.f, ok ? bflo(ww.z) : 0.f, ok ? bfhi(ww.z) : 0.f, ok ? bflo(ww.w) : 0.f, ok ? bfhi(ww.w) : 0.f};
#pragma unroll
              for (int tk = 0; tk < 4; ++tk) { const int j = m - tk; if (j >= 0 && j < 4) {
#pragma unroll
                  for (int e = 0; e < 8; ++e) xv[tk][e] += cwr[j][e] * r[e]; } } }
#pragma unroll
          for (int tk = 0; tk < 4; ++tk)
              *(LAS u32x4*)(lds + LRU_XS + (4 * tq + tk) * LRU_XS_PITCH + q8 * 16) = (u32x4){pk2(xv[tk][0], xv[tk][1]), pk2(xv[tk][2], xv[tk][3]), pk2(xv[tk][4], xv[tk][5]), pk2(xv[tk][6], xv[tk][7])};
      } }
    __syncthreads();
    const int cl = lane & 15, kq = lane >> 4, tb0 = 64 * wave;
    bf16x8 af[4][2];
#pragma unroll
    for (int mt = 0; mt < 4; ++mt)
#pragma unroll
        for (int ks = 0; ks < 2; ++ks) af[mt][ks] = *(const LAS bf16x8*)(lds + LRU_XS + (tb0 + 16 * mt + cl) * LRU_XS_PITCH + (32 * ks + 8 * kq) * 2);
    LAS float* wtl = (LAS float*)(lds + LRU_WTL);
    bf16x8 nfa[2], nfx[2]; float nba, nbx, nlam;
#define LRU_LOADNT(nt_) do { const int c_ = hb * 64 + (nt_) * 16 + cl; _Pragma("unroll") for (int ks = 0; ks < 2; ++ks) { const bf16_t* s = wag_t + ((size_t)(hb * 2) * 64 + (nt_) * 16 + cl) * 64 + 32 * ks + 8 * kq; \
        nfa[ks] = *(const bf16x8*)s; nfx[ks] = *(const bf16x8*)(s + 64 * 64); } nba = ba[c_]; nbx = bx[c_]; nlam = lam[c_]; } while (0)
    LRU_LOADNT(0);
#pragma unroll 1
    for (int nt = 0; nt < 4; ++nt) {
        const int c = hb * 64 + nt * 16 + cl;
        bf16x8 wfa[2], wfx[2];
#pragma unroll
        for (int ks = 0; ks < 2; ++ks) { wfa[ks] = nfa[ks]; wfx[ks] = nfx[ks]; }
        const float bac = nba, bxc = nbx, lamc = nlam;
        { const int nn = nt < 3 ? nt + 1 : 3; LRU_LOADNT(nn); }
        const float spc = log1pf(expf(-lamc)) * (-8.f * 1.4426950408889634f);
        float av[4][4], bv[4][4], Aex[4], Hex[4], At[4], Ht[4];
#pragma unroll
        for (int mt = 0; mt < 4; ++mt) {
            f32x4 ga = {0.f, 0.f, 0.f, 0.f}, gx = {0.f, 0.f, 0.f, 0.f};
#pragma unroll
            for (int ks = 0; ks < 2; ++ks) { ga = __builtin_amdgcn_mfma_f32_16x16x32_bf16(af[mt][ks], wfa[ks], ga, 0, 0, 0); gx = __builtin_amdgcn_mfma_f32_16x16x32_bf16(af[mt][ks], wfx[ks], gx, 0, 0, 0); }
            float A4 = 1.f, H4 = 0.f;
#pragma unroll
            for (int r = 0; r < 4; ++r) { const int tt = tb0 + 16 * mt + 4 * kq + r;
                const float xc = bf2f(*(const LAS unsigned short*)(lds + LRU_XS + tt * LRU_XS_PITCH + (16 * nt + cl) * 2));
                const float rg = fsigmoid(ga[r] + bac), ig = fsigmoid(gx[r] + bxc);
                const float aa = fexp2(rg * spc), mult = __builtin_amdgcn_sqrtf(fmaxf(1.f - aa * aa, 0.f));
                const float bb = mult * ig * xc;
                av[mt][r] = aa; bv[mt][r] = bb; H4 = aa * H4 + bb; A4 *= aa; }
            { float Ap = __shfl_up(A4, 16), Hp = __shfl_up(H4, 16); if (kq >= 1) { H4 = A4 * Hp + H4; A4 = Ap * A4; }
              Ap = __shfl_up(A4, 32); Hp = __shfl_up(H4, 32); if (kq >= 2) { H4 = A4 * Hp + H4; A4 = Ap * A4; } }
            { const float Ae = __shfl_up(A4, 16), He = __shfl_up(H4, 16); Aex[mt] = kq >= 1 ? Ae : 1.f; Hex[mt] = kq >= 1 ? He : 0.f; }
            At[mt] = __shfl(A4, 48 + cl); Ht[mt] = __shfl(H4, 48 + cl);
        }
        float hin = 0.f, pin = 1.f;
#pragma unroll
        for (int mt = 0; mt < 4; ++mt) {
            float h = Aex[mt] * hin + Hex[mt], pr = Aex[mt] * pin; float hv[4], pv[4];
#pragma unroll
            for (int r = 0; r < 4; ++r) { h = av[mt][r] * h + bv[mt][r]; pr *= av[mt][r]; hv[r] = h; pv[r] = pr; }
            const size_t o = (((t0 + tb0 + 16 * mt) >> 2) + kq) * 2048 + (size_t)c * 4;
            *(u32x2*)(hl + o) = (u32x2){pk2(hv[0], hv[1]), pk2(hv[2], hv[3])}; *(u32x2*)(pl + o) = (u32x2){pk2(pv[0], pv[1]), pk2(pv[2], pv[3])};
            hin = At[mt] * hin + Ht[mt]; pin = At[mt] * pin;
        }
        if (kq == 0) { float* d = wtot + ((size_t)(b * 64 + chunk * 8 + wave) * 2) * 512 + c; d[0] = pin; d[512] = hin; wtl[(wave * 2) * 64 + nt * 16 + cl] = pin; wtl[(wave * 2 + 1) * 64 + nt * 16 + cl] = hin; }
    }
    __syncthreads();
    if (tid < 64) { float A = 1.f, H = 0.f;
#pragma unroll
        for (int w2 = 0; w2 < 8; ++w2) { const float a2 = wtl[(w2 * 2) * 64 + tid], h2 = wtl[(w2 * 2 + 1) * 64 + tid]; H = a2 * H + h2; A *= a2; }
        float* d = ctot + ((size_t)(b * 8 + chunk) * 2) * 512 + hb * 64 + tid; d[0] = A; d[512] = H; }
    __syncthreads();
}

__device__ __forceinline__ void lru_finish(const Frame& F, KArgsP a, int b, int wc) {
    LAS float* cl_ = (LAS float*)F.lds; const int tid = F.tid, lane = plane(), wave = F.wave;
    unsigned char* ws = a->ws;
    const bf16_t* projb = (const bf16_t*)(ws + wsm::projb); const bf16_t* hl = (const bf16_t*)a->out; const bf16_t* pl = hl + (size_t)T * 512; bf16_t* mix = (bf16_t*)(ws + wsm::mix);
    const float* wtot = (const float*)(ws + wsm::wtot); const float* ctot = (const float*)(ws + wsm::ctot);
    { const int c = wc >> 3, sub = wc & 7; float h = 0.f; float ta[16], th[16];
#pragma unroll
      for (int k = 0; k < 8; ++k) { const float* s = ctot + ((size_t)(b * 8 + (k < c ? k : 0)) * 2) * 512 + tid; ta[k] = s[0]; th[k] = s[512];
                                     const float* s2 = wtot + ((size_t)(b * 64 + c * 8 + (k < sub ? k : 0)) * 2) * 512 + tid; ta[8 + k] = s2[0]; th[8 + k] = s2[512]; }
#pragma unroll
      for (int k = 0; k < 8; ++k) if (k < c) h = ta[k] * h + th[k];
#pragma unroll
      for (int k = 0; k < 8; ++k) if (k < sub) h = ta[8 + k] * h + th[8 + k];
      cl_[tid] = h; }
    __syncthreads();
    float cr[8];
#pragma unroll
    for (int e = 0; e < 8; ++e) cr[e] = cl_[8 * lane + e];
#pragma unroll 1
    for (int i = 0; i < 2; ++i) {
        const size_t t = (size_t)b * SEQ + 64 * wc + 8 * wave + 4 * i;
        const u32x4* hp = (const u32x4*)(hl + ((t >> 2) * 512 + 8 * lane) * 4); const u32x4* pp4 = (const u32x4*)(pl + ((t >> 2) * 512 + 8 * lane) * 4);
        u32x4 hw[4], pw[4], gw4[4];
#pragma unroll
        for (int q = 0; q < 4; ++q) { hw[q] = hp[q]; pw[q] = pp4[q]; gw4[q] = *(const u32x4*)(projb + (t + q) * NPROJ + OFF_LG + 8 * lane); }
        float g[4][8], s[4] = {0.f, 0.f, 0.f, 0.f};
#pragma unroll
        for (int e = 0; e < 8; ++e) {
            const unsigned h01 = hw[e >> 1][(e & 1) * 2], h23 = hw[e >> 1][(e & 1) * 2 + 1], p01 = pw[e >> 1][(e & 1) * 2], p23 = pw[e >> 1][(e & 1) * 2 + 1];
            const float hv[4] = {bflo(h01), bfhi(h01), bflo(h23), bfhi(h23)}, pv[4] = {bflo(p01), bfhi(p01), bflo(p23), bfhi(p23)};
#pragma unroll
            for (int r = 0; r < 4; ++r) { const unsigned lw = gw4[r][e >> 1]; const float lg = (e & 1) ? bfhi(lw) : bflo(lw);
                g[r][e] = (hv[r] + pv[r] * cr[e]) * fgelu_tanh(lg); s[r] += g[r][e] * g[r][e]; }
        }
#pragma unroll
        for (int r = 0; r < 4; ++r) { const float rr = rsqrtf(wsum(s[r]) * (1.f / 512.f) + EPS);
            *(u32x4*)(mix + (t + r) * D + 512 + 8 * lane) = (u32x4){pk2(g[r][0] * rr, g[r][1] * rr), pk2(g[r][2] * rr, g[r][3] * rr), pk2(g[r][4] * rr, g[r][5] * rr), pk2(g[r][6] * rr, g[r][7] * rr)}; }
    }
    __syncthreads();
}

typedef float f32x16 __attribute__((ext_vector_type(16)));
typedef short s16x4 __attribute__((ext_vector_type(4)));
constexpr int AT_KP = 144;
constexpr int AT_NK = 160;
constexpr int AT_K = 0, AT_V = 2 * AT_NK * AT_KP;
constexpr int AT_LINV = XTRA_OFF + 256;
static_assert(2 * AT_V <= RING_BYTES && AT_LINV + 2048 <= LDS_BYTES, "attn lds");
__device__ __forceinline__ int crow(int reg, int h) { return (reg & 3) + 8 * (reg >> 2) + 4 * h; }
typedef LAS s16x4* lds_s16x4_p;
__device__ __forceinline__ s16x4 tr_rd(unsigned addr) { return __builtin_amdgcn_ds_read_tr16_b64_v4i16((lds_s16x4_p)(size_t)addr); }

template <int QB>
__device__ __forceinline__ void attn_qblock(const bf16_t* projb, const f32x2* rope, size_t tq0, int h, unsigned kbase, unsigned vbase, float sink2, int kmin, int r, int hh, LAS float* linv, f32x16& o0, f32x16& o1) {
    const size_t tq = tq0 + 32 * QB + r;
    bf16x8 qf[4];
    { const bf16_t* src = projb + tq * NPROJ + h * 64 + 8 * hh; const f32x2* cs = rope + tq * 32 + 8 * hh;
      const float qs = 0.125f * 1.4426950408889634f;
#pragma unroll
      for (int kp = 0; kp < 2; ++kp) {
          const u32x4 w1 = *(const u32x4*)(src + 16 * kp), w2 = *(const u32x4*)(src + 16 * (kp + 2));
          float x1[8] = {bflo(w1.x), bfhi(w1.x), bflo(w1.y), bfhi(w1.y), bflo(w1.z), bfhi(w1.z), bflo(w1.w), bfhi(w1.w)};
          float x2[8] = {bflo(w2.x), bfhi(w2.x), bflo(w2.y), bfhi(w2.y), bflo(w2.z), bfhi(w2.z), bflo(w2.w), bfhi(w2.w)};
          float y1[8], y2[8];
#pragma unroll
          for (int e = 0; e < 8; ++e) { const f32x2 c2 = cs[16 * kp + e]; y1[e] = (x1[e] * c2.x - x2[e] * c2.y) * qs; y2[e] = (x2[e] * c2.x + x1[e] * c2.y) * qs; }
          qf[kp] = __builtin_bit_cast(bf16x8, (u32x4){pk2(y1[0], y1[1]), pk2(y1[2], y1[3]), pk2(y1[4], y1[5]), pk2(y1[6], y1[7])});
          qf[kp + 2] = __builtin_bit_cast(bf16x8, (u32x4){pk2(y2[0], y2[1]), pk2(y2[2], y2[3]), pk2(y2[4], y2[5]), pk2(y2[6], y2[7])});
      } }
    f32x16 S[5];
#pragma unroll
    for (int ti = 0; ti < 5; ++ti) {
        const float pen = (32 * (QB + ti) < kmin) ? -1e30f : 0.f;
        f32x16 acc;
#pragma unroll
        for (int i = 0; i < 16; ++i) acc[i] = pen;
#pragma unroll
        for (int ks = 0; ks < 4; ++ks) { const bf16x8 kf = *(const LAS bf16x8*)(size_t)(kbase + (unsigned)(32 * (QB + ti) * AT_KP + 32 * ks));
            acc = __builtin_amdgcn_mfma_f32_32x32x16_bf16(kf, qf[ks], acc, 0, 0, 0); }
        S[ti] = acc;
    }
    const int c4 = 4 * hh;
#pragma unroll
    for (int i = 0; i < 16; ++i) { const bool up = ((i & 3) + 8 * (i >> 2) + c4) > r; S[0][i] = up ? S[0][i] : -1e30f; S[4][i] = up ? -1e30f : S[4][i]; }
    float mx = sink2;
#pragma unroll
    for (int ti = 0; ti < 5; ++ti)
#pragma unroll
        for (int i = 0; i < 16; ++i) mx = fmaxf(mx, S[ti][i]);
    mx = fmaxf(mx, __shfl_xor(mx, 32));
    float l = 0.f; unsigned P[5][8];
#pragma unroll
    for (int ti = 0; ti < 5; ++ti)
#pragma unroll
        for (int i = 0; i < 16; i += 2) { const float p0 = fexp2(S[ti][i] - mx), p1 = fexp2(S[ti][i + 1] - mx); l += p0 + p1; P[ti][i >> 1] = pk2(p0, p1); }
    l += __shfl_xor(l, 32);
    l += fexp2(sink2 - mx);
    if (hh == 0) linv[(32 * QB + r) * 8 + h] = frcp(l);
#pragma unroll
    for (int i = 0; i < 16; ++i) { o0[i] = 0.f; o1[i] = 0.f; }
#pragma unroll
    for (int ti = 0; ti < 5; ++ti) {
#pragma unroll
        for (int s = 0; s < 2; ++s) {
            const bf16x8 pa = __builtin_bit_cast(bf16x8, (u32x4){P[ti][4 * s], P[ti][4 * s + 1], P[ti][4 * s + 2], P[ti][4 * s + 3]});
            const unsigned va = vbase + (unsigned)((32 * (QB + ti) + 16 * s) * AT_KP);
            const s16x4 lo0 = tr_rd(va), hi0 = tr_rd(va + 8 * AT_KP), lo1 = tr_rd(va + 64), hi1 = tr_rd(va + 8 * AT_KP + 64);
            const bf16x8 vb0 = __builtin_shufflevector(lo0, hi0, 0, 1, 2, 3, 4, 5, 6, 7), vb1 = __builtin_shufflevector(lo1, hi1, 0, 1, 2, 3, 4, 5, 6, 7);
            o0 = __builtin_amdgcn_mfma_f32_32x32x16_bf16(pa, vb0, o0, 0, 0, 0);
            o1 = __builtin_amdgcn_mfma_f32_32x32x16_bf16(pa, vb1, o1, 0, 0, 0);
        }
    }
}

__device__ __forceinline__ void attn_unit(const Frame& F, KArgsP a, int b, int j) {
    LAS unsigned char* lds = F.lds; const int tid = F.tid, lane = plane(), wave = F.wave;
    unsigned char* ws = a->ws;
    const bf16_t* projb = (const bf16_t*)(ws + wsm::projb); bf16_t* mix = (bf16_t*)(ws + wsm::mix); const f32x2* rope = (const f32x2*)(ws + wsm::rope);
    const float* sinks = a->in[5];
    const int key0 = 32 * j - 128;
#pragma unroll 1
    for (int task = tid; task < AT_NK * 2 * 4; task += NTHR) {
        const int c = task & 3, g = (task >> 2) & 1, kk = task >> 3; const int sp = key0 + kk;
        u32x4 o1 = {0u, 0u, 0u, 0u}, o2 = {0u, 0u, 0u, 0u};
        if (sp >= 0) { const size_t t = (size_t)b * SEQ + sp; const bf16_t* src = projb + t * NPROJ + OFF_K + g * 64 + 8 * c;
            const u32x4 w1 = *(const u32x4*)src, w2 = *(const u32x4*)(src + 32); const f32x2* cs = rope + t * 32 + 8 * c;
            float x1[8] = {bflo(w1.x), bfhi(w1.x), bflo(w1.y), bfhi(w1.y), bflo(w1.z), bfhi(w1.z), bflo(w1.w), bfhi(w1.w)};
            float x2[8] = {bflo(w2.x), bfhi(w2.x), bflo(w2.y), bfhi(w2.y), bflo(w2.z), bfhi(w2.z), bflo(w2.w), bfhi(w2.w)};
            float y1[8], y2[8];
#pragma unroll
            for (int e = 0; e < 8; ++e) { const f32x2 c2 = cs[e]; y1[e] = x1[e] * c2.x - x2[e] * c2.y; y2[e] = x2[e] * c2.x + x1[e] * c2.y; }
            o1 = (u32x4){pk2(y1[0], y1[1]), pk2(y1[2], y1[3]), pk2(y1[4], y1[5]), pk2(y1[6], y1[7])};
            o2 = (u32x4){pk2(y2[0], y2[1]), pk2(y2[2], y2[3]), pk2(y2[4], y2[5]), pk2(y2[6], y2[7])}; }
        LAS unsigned char* d = lds + AT_K + (g * AT_NK + kk) * AT_KP + 16 * c;
        *(LAS u32x4*)d = o1; *(LAS u32x4*)(d + 64) = o2;
    }
#pragma unroll 2
    for (int task = tid; task < AT_NK * 2 * 8; task += NTHR) {
        const int c = task & 7, g = (task >> 3) & 1, kk = task >> 4; const int sp = key0 + kk;
        u32x4 o = {0u, 0u, 0u, 0u};
        if (sp >= 0) o = *(const u32x4*)(projb + ((size_t)b * SEQ + sp) * NPROJ + OFF_V + g * 64 + 8 * c);
        *(LAS u32x4*)(lds + AT_V + (g * AT_NK + kk) * AT_KP + 16 * c) = o;
    }
    __syncthreads();
    const int h = wave, g = wave >> 2, r = lane & 31, hh = lane >> 5;
    const float sink2 = sinks[h] * 1.4426950408889634f;
    const int kmin = -key0;
    const unsigned kbase = (unsigned)(size_t)(lds + AT_K) + (unsigned)((g * AT_NK + r) * AT_KP + 16 * hh);
    const unsigned vbase = (unsigned)(size_t)(lds + AT_V) + (unsigned)((g * AT_NK + 4 * hh + ((lane & 15) >> 2)) * AT_KP + 32 * ((lane >> 4) & 1) + 8 * (lane & 3));
    const size_t tq0 = (size_t)b * SEQ + 32 * j;
    LAS float* linv = (LAS float*)(lds + AT_LINV);
    f32x16 oa0, oa1;
    attn_qblock<0>(projb, rope, tq0, h, kbase, vbase, sink2, kmin, r, hh, linv, oa0, oa1);
    __syncthreads();
    LAS float* ost = (LAS float*)lds;
#pragma unroll
    for (int i = 0; i < 16; ++i) { const int q = crow(i, hh); LAS float* d0 = ost + q * 512 + h * 64 + r; d0[0] = oa0[i]; d0[32] = oa1[i]; }
    __syncthreads();
    { const int tt = tid >> 4, pp = tid & 15; const LAS f32x4* row = (const LAS f32x4*)(ost + tt * 512);
      f32x4 v[8]; float s = 0.f;
#pragma unroll
      for (int i = 0; i < 8; ++i) { v[i] = row[pp + 16 * i] * linv[tt * 8 + i]; s += (v[i].x * v[i].x + v[i].y * v[i].y) + (v[i].z * v[i].z + v[i].w * v[i].w); }
      s += __shfl_xor(s, 1); s += __shfl_xor(s, 2); s += __shfl_xor(s, 4); s += __shfl_xor(s, 8);
      const float rr = rsqrtf(s * (1.f / 512.f) + EPS);
      bf16_t* dst = mix + (tq0 + tt) * D;
#pragma unroll
      for (int i = 0; i < 8; ++i) { u32x2 w; w.x = pk2(v[i].x * rr, v[i].y * rr); w.y = pk2(v[i].z * rr, v[i].w * rr); *(u32x2*)(dst + 4 * (pp + 16 * i)) = w; } }
    __syncthreads();
}

namespace pg8 {
__device__ __forceinline__ u32x4 pair16(u32x2 a, u32x2 b, bool odd) {
    const u32x2 snd = odd ? a : b; const u32x2 rcv = {(unsigned)__shfl_xor((int)snd.x, 16), (unsigned)__shfl_xor((int)snd.y, 16)};
    return odd ? (u32x4){rcv.x, rcv.y, b.x, b.y} : (u32x4){a.x, a.y, rcv.x, rcv.y};
}
__device__ __forceinline__ f32x4 quad_rows(float q0, float q1, float q2, float q3, int fq) {
    const int qi = __float_as_int(fq == 0 ? q0 : fq == 1 ? q1 : fq == 2 ? q2 : q3);
    return (f32x4){__int_as_float(__builtin_amdgcn_update_dpp(0, qi, 0x00, 0xf, 0xf, false)), __int_as_float(__builtin_amdgcn_update_dpp(0, qi, 0x55, 0xf, 0xf, false)),
                   __int_as_float(__builtin_amdgcn_update_dpp(0, qi, 0xaa, 0xf, 0xf, false)), __int_as_float(__builtin_amdgcn_update_dpp(0, qi, 0xff, 0xf, 0xf, false))};
}
struct EpiPpQ {
    static constexpr bool PERM = true, MIDSCALE = false; static constexpr int NPF = 0;
    unsigned char* O;
    __device__ __forceinline__ void midscale(f32x4 (&)[2][2][4][2], const Unit&, int, int) const {}
    __device__ __forceinline__ void operator()(const f32x4 (&acc)[2][2][4][2], const Unit& u, int wr, int wc, int fr, int fq) const {
        const int row0 = u.pm * BM + wr * 64 + fr, col0 = u.pn * BM + wc * 32 + 8 * fq; const bool odd = fq & 1;
#pragma unroll
        for (int ai = 0; ai < 2; ++ai)
#pragma unroll
            for (int m = 0; m < 4; ++m) { const int row = row0 + ai * HALF + m * 16; u32x2 p8[2];
#pragma unroll
                for (int bj = 0; bj < 2; ++bj) { const f32x4 v0 = acc[ai][bj][m][0] * PQ_SCALE, v1 = acc[ai][bj][m][1] * PQ_SCALE; p8[bj] = (u32x2){pk4_fp8(v0[0], v0[1], v0[2], v0[3]), pk4_fp8(v1[0], v1[1], v1[2], v1[3])}; }
                *(u32x4*)(O + (size_t)row * D + col0 + (odd ? HALF - 8 : 0)) = pair16(p8[0], p8[1], odd); }
    }
};
__device__ __forceinline__ void panel_meet(gu32* cw) {
    asm volatile("s_waitcnt vmcnt(0)" ::: "memory");
    __syncthreads();
    if (threadIdx.x == 0) {
        (void)__hip_atomic_fetch_add(cw, 1u, __ATOMIC_RELAXED, __HIP_MEMORY_SCOPE_AGENT);
        unsigned sp = 0; while (__hip_atomic_load(cw, __ATOMIC_RELAXED, __HIP_MEMORY_SCOPE_AGENT) < 4u) { __builtin_amdgcn_s_sleep(2); if (++sp > (1u << 22)) break; }
        __builtin_amdgcn_fence(__ATOMIC_ACQUIRE, "agent"); asm volatile("s_waitcnt vmcnt(0)" ::: "memory");
    }
    __syncthreads();
}
struct EpiOutProj {
    static constexpr bool PERM = true, MIDSCALE = false; static constexpr int NPF = OUT_NPF;
    const bf16_t* xb; bf16_t* x1b; float* ssq1p; unsigned char* x1q;
    __device__ __forceinline__ const void* pf_addr(const Unit& u, int tid, int j) const { const int c = tid + 512 * j; return xb + (size_t)(u.pm * BM + (c >> 3)) * D + u.pn * BM + (c & 7) * 32; }
    __device__ __forceinline__ void midscale(f32x4 (&)[2][2][4][2], const Unit&, int, int) const {}
    __device__ __forceinline__ void operator()(const f32x4 (&acc)[2][2][4][2], const Unit& u, int wr, int wc, int fr, int fq) const {
        const int col0 = u.pn * BM + wc * 32 + 8 * fq;
        u32x4 xv[2][4][2];
#pragma unroll
        for (int ai = 0; ai < 2; ++ai)
#pragma unroll
            for (int m = 0; m < 4; ++m)
#pragma unroll
                for (int bj = 0; bj < 2; ++bj) xv[ai][m][bj] = *(const u32x4*)(xb + (size_t)(u.pm * BM + ai * HALF + wr * 64 + m * 16 + fr) * D + col0 + bj * HALF);
        const bool odd = fq & 1;
#pragma unroll
        for (int ai = 0; ai < 2; ++ai) { float qv[4];
#pragma unroll
            for (int m = 0; m < 4; ++m) { const int row = u.pm * BM + ai * HALF + wr * 64 + m * 16 + fr; const size_t off = (size_t)row * D + col0; float q = 0.f; u32x2 p8[2];
#pragma unroll
                for (int bj = 0; bj < 2; ++bj) { const size_t o = off + bj * HALF; const u32x4 xw = xv[ai][m][bj];
                    const f32x4 v0 = (f32x4){bflo(xw.x), bfhi(xw.x), bflo(xw.y), bfhi(xw.y)} + acc[ai][bj][m][0], v1 = (f32x4){bflo(xw.z), bfhi(xw.z), bflo(xw.w), bfhi(xw.w)} + acc[ai][bj][m][1];
                    st_wt16(x1b + o, (u32x4){pk2(v0[0], v0[1]), pk2(v0[2], v0[3]), pk2(v1[0], v1[1]), pk2(v1[2], v1[3])});
                    p8[bj] = (u32x2){pk4_fp8(v0[0], v0[1], v0[2], v0[3]), pk4_fp8(v1[0], v1[1], v1[2], v1[3])};
                    q += (v0[0] * v0[0] + v0[1] * v0[1]) + (v0[2] * v0[2] + v0[3] * v0[3]) + (v1[0] * v1[0] + v1[1] * v1[1]) + (v1[2] * v1[2] + v1[3] * v1[3]); }
                *(u32x4*)(x1q + off + (odd ? HALF - 8 : 0)) = pair16(p8[0], p8[1], odd);
                q += __shfl_xor(q, 16); q += __shfl_xor(q, 32); qv[m] = q; }
            const f32x4 q4 = quad_rows(qv[0], qv[1], qv[2], qv[3], fq);
            if ((fr & 3) == 0) st_wt16(ssq1p + (size_t)(u.pn * 4 + wc) * T + u.pm * BM + ai * HALF + wr * 64 + fq * 16 + fr, __builtin_bit_cast(u32x4, q4)); }
    }
};
struct EpiMoe1 {
    static constexpr bool PERM = true, MIDSCALE = false; static constexpr int NPF = 0;
    unsigned char* hid; const float* lw; const float* lr;
    __device__ __forceinline__ void midscale(f32x4 (&)[2][2][4][2], const Unit&, int, int) const {}
    __device__ __forceinline__ void operator()(const f32x4 (&acc)[2][2][4][2], const Unit& u, int wr, int wc, int fr, int fq) const {
        const __amdgpu_buffer_rsrc_t hrs = __builtin_amdgcn_make_buffer_rsrc(hid, 0, 40960 * FF, 0x00020000);
        asm volatile("" : "+v"(fr), "+v"(fq));
        const int f0 = u.pn * HALF + wc * 32 + 8 * fq;
        float rv[2][4], wv[2][4];
#pragma unroll
        for (int ai = 0; ai < 2; ++ai)
#pragma unroll
            for (int m = 0; m < 4; ++m) { const int rl = ai * HALF + wr * 64 + m * 16 + fr; const size_t li = (size_t)u.e * T + u.li0 + (rl < u.nrow ? rl : 0); rv[ai][m] = lr[li]; wv[ai][m] = lw[li]; }
#pragma unroll
        for (int ai = 0; ai < 2; ++ai)
#pragma unroll
            for (int m = 0; m < 4; ++m) { const int rl = ai * HALF + wr * 64 + m * 16 + fr; const bool ok = rl < u.nrow;
                const float r2 = ok ? rv[ai][m] * (1.f / WQ_SCALE) : 0.f, w = ok ? wv[ai][m] * HQ_SCALE : 0.f; float hv[8];
#pragma unroll
                for (int n = 0; n < 2; ++n)
#pragma unroll
                    for (int e = 0; e < 4; ++e) { const float gt = acc[ai][0][m][n][e] * r2, up = acc[ai][1][m][n][e] * r2; hv[4 * n + e] = gt * frcp(1.f + fexp(-gt)) * up * w; }
                __builtin_amdgcn_raw_buffer_store_b64((u32x2){pk4_fp8(hv[0], hv[1], hv[2], hv[3]), pk4_fp8(hv[4], hv[5], hv[6], hv[7])}, hrs, (int)((unsigned)(u.pm * BM + rl) * FF + f0), 0, 16); }
    }
};
struct EpiPle {
    static constexpr bool PERM = true, MIDSCALE = false; static constexpr int NPF = 0;
    unsigned char* ws;
    __device__ __forceinline__ void midscale(f32x4 (&)[2][2][4][2], const Unit&, int, int) const {}
    __device__ __forceinline__ void operator()(const f32x4 (&acc)[2][2][4][2], const Unit& u, int wr, int wc, int fr, int fq) const {
        const bf16_t* x2b = (const bf16_t*)(ws + wsm::x2b); bf16_t* x3b = (bf16_t*)(ws + wsm::x3b); const unsigned char* pp = (const unsigned char*)(ws + wsm::pp); const float* rP = (const float*)(ws + wsm::rP); float* ssq3p = (float*)(ws + wsm::ssq3p);
        int pm_ = u.pm, pn_ = u.pn; asm volatile("" : "+v"(fr), "+v"(fq), "+s"(pm_), "+s"(pn_));
        const int col0 = pn_ * BM + wc * 32 + 8 * fq, rowb = pm_ * BM + wr * 64 + fr;
        constexpr int PD = 2;
        float sr[8]; u32x4 xq[8][2]; u32x2 pq[8][2];
#pragma unroll
        for (int i = 0; i < 8; ++i) sr[i] = rP[rowb + (i >> 2) * HALF + (i & 3) * 16];
#define PLE_LOADROW(i) do { const size_t o_ = (size_t)(rowb + ((i) >> 2) * HALF + ((i) & 3) * 16) * D + col0; \
        xq[i][0] = *(const u32x4*)(x2b + o_); pq[i][0] = *(const u32x2*)(pp + o_); xq[i][1] = *(const u32x4*)(x2b + o_ + HALF); pq[i][1] = *(const u32x2*)(pp + o_ + HALF); } while (0)
#pragma unroll
        for (int i = 0; i < PD; ++i) PLE_LOADROW(i);
#pragma unroll
        for (int i = 0; i < 8; ++i) { const int ai = i >> 2, m = i & 3;
            if (i + PD < 8) PLE_LOADROW(i + PD);
            const int row = rowb + ai * HALF + m * 16; const float s = sr[i] * (1.f / WQ_SCALE); const size_t off = (size_t)row * D + col0; float q = 0.f;
#pragma unroll
            for (int bj = 0; bj < 2; ++bj) { const size_t o = off + bj * HALF; const u32x4 xw = xq[i][bj]; const u32x2 pw8 = pq[i][bj]; constexpr float ipq = 1.f / PQ_SCALE;
                const f32x2 p01 = __builtin_amdgcn_cvt_pk_f32_fp8((int)pw8.x, false), p23 = __builtin_amdgcn_cvt_pk_f32_fp8((int)pw8.x, true), p45 = __builtin_amdgcn_cvt_pk_f32_fp8((int)pw8.y, false), p67 = __builtin_amdgcn_cvt_pk_f32_fp8((int)pw8.y, true);
                const float pf[8] = {p01.x * ipq, p01.y * ipq, p23.x * ipq, p23.y * ipq, p45.x * ipq, p45.y * ipq, p67.x * ipq, p67.y * ipq};
                const f32x4 a0 = acc[ai][bj][m][0] * s, a1 = acc[ai][bj][m][1] * s;
                float v[8] = {bflo(xw.x) + fsigmoid(a0[0]) * pf[0], bfhi(xw.x) + fsigmoid(a0[1]) * pf[1], bflo(xw.y) + fsigmoid(a0[2]) * pf[2], bfhi(xw.y) + fsigmoid(a0[3]) * pf[3],
                              bflo(xw.z) + fsigmoid(a1[0]) * pf[4], bfhi(xw.z) + fsigmoid(a1[1]) * pf[5], bflo(xw.w) + fsigmoid(a1[2]) * pf[6], bfhi(xw.w) + fsigmoid(a1[3]) * pf[7]};
                st_wt16(x3b + o, (u32x4){pk2(v[0], v[1]), pk2(v[2], v[3]), pk2(v[4], v[5]), pk2(v[6], v[7])});
                q += (v[0] * v[0] + v[1] * v[1]) + (v[2] * v[2] + v[3] * v[3]) + (v[4] * v[4] + v[5] * v[5]) + (v[6] * v[6] + v[7] * v[7]); }
            q += __shfl_xor(q, 16); q += __shfl_xor(q, 32);
            if (fq == 0) st_wt4(ssq3p + (size_t)(pn_ * 4 + wc) * T + row, q); }
#undef PLE_LOADROW
    }
};
struct EpiPleFin {
    static constexpr bool PERM = true, MIDSCALE = false; static constexpr int NPF = PLE_NPF;
    unsigned char* ws; const float* gfin; float* out; gu32* pan;
    __device__ __forceinline__ const void* pf_addr(const Unit& u, int tid, int j) const { const int c = tid + 512 * (j & 3); const bf16_t* base = (const bf16_t*)(ws + (j < 4 ? wsm::x2b : wsm::pp));
        return base + (size_t)(u.pm * BM + (c >> 3)) * D + u.pn * BM + (c & 7) * 32; }
    __device__ __forceinline__ void midscale(f32x4 (&)[2][2][4][2], const Unit&, int, int) const {}
    __device__ __forceinline__ void operator()(f32x4 (&acc)[2][2][4][2], const Unit& u, int wr, int wc, int fr, int fq) const {
        const bf16_t* x2b = (const bf16_t*)(ws + wsm::x2b); const unsigned char* pp = (const unsigned char*)(ws + wsm::pp); const float* rP = (const float*)(ws + wsm::rP); float* ssq3p = (float*)(ws + wsm::ssq3p);
        int pm_ = u.pm, pn_ = u.pn; asm volatile("" : "+v"(fr), "+v"(fq), "+s"(pm_), "+s"(pn_));
        const int col0 = pn_ * BM + wc * 32 + 8 * fq, rowb = pm_ * BM + wr * 64 + fr;
        constexpr int PD = 2;
        { float sr[8]; u32x4 xq[8][2]; u32x2 pq[8][2];
#pragma unroll
        for (int i = 0; i < 8; ++i) sr[i] = rP[rowb + (i >> 2) * HALF + (i & 3) * 16];
#define PLE_LOADROW(i) do { const size_t o_ = (size_t)(rowb + ((i) >> 2) * HALF + ((i) & 3) * 16) * D + col0; \
        xq[i][0] = *(const u32x4*)(x2b + o_); pq[i][0] = *(const u32x2*)(pp + o_); xq[i][1] = *(const u32x4*)(x2b + o_ + HALF); pq[i][1] = *(const u32x2*)(pp + o_ + HALF); } while (0)
#pragma unroll
        for (int i = 0; i < PD; ++i) PLE_LOADROW(i);
#pragma unroll
        for (int i = 0; i < 8; ++i) { const int ai = i >> 2, m = i & 3;
            if (i + PD < 8) PLE_LOADROW(i + PD);
            const int row = rowb + ai * HALF + m * 16; const float s = sr[i] * (1.f / WQ_SCALE); float q = 0.f;
#pragma unroll
            for (int bj = 0; bj < 2; ++bj) { const u32x4 xw = xq[i][bj]; const u32x2 pw8 = pq[i][bj]; constexpr float ipq = 1.f / PQ_SCALE;
                const f32x2 p01 = __builtin_amdgcn_cvt_pk_f32_fp8((int)pw8.x, false), p23 = __builtin_amdgcn_cvt_pk_f32_fp8((int)pw8.x, true), p45 = __builtin_amdgcn_cvt_pk_f32_fp8((int)pw8.y, false), p67 = __builtin_amdgcn_cvt_pk_f32_fp8((int)pw8.y, true);
                const float pf[8] = {p01.x * ipq, p01.y * ipq, p23.x * ipq, p23.y * ipq, p45.x * ipq, p45.y * ipq, p67.x * ipq, p67.y * ipq};
                const f32x4 a0 = acc[ai][bj][m][0] * s, a1 = acc[ai][bj][m][1] * s;
                const f32x4 v0 = {bflo(xw.x) + fsigmoid(a0[0]) * pf[0], bfhi(xw.x) + fsigmoid(a0[1]) * pf[1], bflo(xw.y) + fsigmoid(a0[2]) * pf[2], bfhi(xw.y) + fsigmoid(a0[3]) * pf[3]};
                const f32x4 v1 = {bflo(xw.z) + fsigmoid(a1[0]) * pf[4], bfhi(xw.z) + fsigmoid(a1[1]) * pf[5], bflo(xw.w) + fsigmoid(a1[2]) * pf[6], bfhi(xw.w) + fsigmoid(a1[3]) * pf[7]};
                acc[ai][bj][m][0] = v0; acc[ai][bj][m][1] = v1;
                q += (v0[0] * v0[0] + v0[1] * v0[1]) + (v0[2] * v0[2] + v0[3] * v0[3]) + (v1[0] * v1[0] + v1[1] * v1[1]) + (v1[2] * v1[2] + v1[3] * v1[3]); }
            q += __shfl_xor(q, 16); q += __shfl_xor(q, 32);
            if (fq == 0) st_wt4(ssq3p + (size_t)(pn_ * 4 + wc) * T + row, q); }
#undef PLE_LOADROW
        }
        panel_meet(pan + 32 * pm_);
        float r3[8];
#pragma unroll
        for (int i = 0; i < 8; ++i) { const int row = rowb + (i >> 2) * HALF + (i & 3) * 16; const float* sp = ssq3p + (size_t)(4 * fq) * T + row;
            r3[i] = (sp[0] + sp[T]) + (sp[2 * (size_t)T] + sp[3 * (size_t)T]); }
        f32x4 g[2][2];
#pragma unroll
        for (int bj = 0; bj < 2; ++bj) { g[bj][0] = *(const f32x4*)(gfin + col0 + bj * HALF); g[bj][1] = *(const f32x4*)(gfin + col0 + bj * HALF + 4); }
#pragma unroll
        for (int i = 0; i < 8; ++i) { const int ai = i >> 2, m = i & 3; float s = r3[i]; s += __shfl_xor(s, 16); s += __shfl_xor(s, 32);
            const float r = rsqrtf(s * (1.f / D) + EPS); float* orow = out + (size_t)(rowb + ai * HALF + m * 16) * D + col0;
#pragma unroll
            for (int bj = 0; bj < 2; ++bj) { *(f32x4*)(orow + bj * HALF) = acc[ai][bj][m][0] * r * g[bj][0]; *(f32x4*)(orow + bj * HALF + 4) = acc[ai][bj][m][1] * r * g[bj][1]; } }
    }
};
struct EpiY {
    static constexpr bool PERM = true, MIDSCALE = false; static constexpr int NPF = 0;
    unsigned char* O; float sc; int pad;
    __device__ __forceinline__ void midscale(f32x4 (&)[2][2][4][2], const Unit&, int, int) const {}
    __device__ __forceinline__ void operator()(const f32x4 (&acc)[2][2][4][2], const Unit& u, int wr, int wc, int fr, int fq) const {
        unsigned char* base = O + (size_t)u.pm * BM * D;
        int row0 = wr * 64 + fr; const int col0 = u.pn * BM + wc * 32 + 8 * fq;
        asm volatile("" : "+v"(row0));
#pragma unroll
        for (int ai = 0; ai < 2; ++ai)
#pragma unroll
            for (int m = 0; m < 4; ++m) { unsigned char* rowp = base + (size_t)(row0 + ai * HALF + m * 16) * D + col0;
#pragma unroll
                for (int bj = 0; bj < 2; ++bj) { const f32x4 v0 = acc[ai][bj][m][0] * sc, v1 = acc[ai][bj][m][1] * sc;
                    *(u32x2*)(rowp + bj * HALF) = (u32x2){pk4_fp8(v0[0], v0[1], v0[2], v0[3]), pk4_fp8(v1[0], v1[1], v1[2], v1[3])}; } }
    }
};
struct MoeOrder {
    static constexpr bool STAMPED = (MK_STAMP_WHO == 1);
    const LAS int* tstart; const LAS int* cntl; const LAS int* rowtab; const int* lt; const char* A; const char* B; size_t strideB; int K, PA, PB, G, c, gather;
    __device__ __forceinline__ bool next(int i, Unit& u) const {
        const int L = i * G + c, tile = L >> 2; if (tile >= __builtin_amdgcn_readfirstlane(tstart[NE])) return false;
        int e = 0;
#pragma unroll
        for (int st = NE / 2; st; st >>= 1) e += (tstart[e + st] <= tile) ? st : 0;
        e = __builtin_amdgcn_readfirstlane(e);
        u.e = e; u.pm = tile; u.pn = L & 3; u.li0 = __builtin_amdgcn_readfirstlane((tile - tstart[e]) * BM); const int left = __builtin_amdgcn_readfirstlane(cntl[e]) - u.li0; u.nrow = left < BM ? left : BM; u.ord = i; return true;
    }
    __device__ __forceinline__ const char* a_ptr(const Unit& u) const { return gather ? A : A + (size_t)u.pm * BM * PA * 2; }
    __device__ __forceinline__ const char* b_ptr(const Unit& u) const { return B + (size_t)u.e * strideB + (size_t)u.pn * BM * PB * 2; }
    __device__ __forceinline__ unsigned a_row(const Unit& u, int r) const { return (unsigned)rowtab[(u.ord & 7) * BM + r]; }
    gu32* tilecnt; unsigned long long* tsg;
    __device__ __forceinline__ void a_ready(const Unit&) const {}
    __device__ __forceinline__ void done(const Unit& u) const {
        if (tilecnt) { asm volatile("s_waitcnt vmcnt(0)" ::: "memory");
            if ((threadIdx.x & 63) == 0) (void)__hip_atomic_fetch_add(tilecnt + 16 * u.pm, 1u, __ATOMIC_RELAXED, __HIP_MEMORY_SCOPE_AGENT); }
    }
};
struct Moe2Order {
    static constexpr bool STAMPED = (MK_STAMP_WHO == 2);
    const LAS int* tstart; const char* A; const char* B; size_t strideB; gu32* tilecnt; int K, PA, PB, G, c, E, S2, U; unsigned long long* tsg;
    __device__ __forceinline__ bool next(int i, Unit& u) const {
        int m;
        if (c >= E) m = (i < 2) ? (c - E) + i * S2 : 2 * S2 + c + (i - 2) * G; else m = 2 * S2 + c + i * G;
        if (m >= U) return false;
        const int tile = m >> 2; int e = 0;
#pragma unroll
        for (int st = NE / 2; st; st >>= 1) e += (tstart[e + st] <= tile) ? st : 0;
        u.e = __builtin_amdgcn_readfirstlane(e); u.pm = tile; u.pn = m & 3; u.li0 = 0; u.nrow = BM; u.ord = i; return true;
    }
    __device__ __forceinline__ const char* a_ptr(const Unit& u) const { return A + (size_t)u.pm * BM * PA * 2; }
    __device__ __forceinline__ const char* b_ptr(const Unit& u) const { return B + (size_t)u.e * strideB + (size_t)u.pn * BM * PB * 2; }
    __device__ __forceinline__ unsigned a_row(const Unit&, int r) const { return (unsigned)r; }
    __device__ __forceinline__ void done(const Unit&) const {}
    __device__ __forceinline__ void a_ready(const Unit& u) const {
        if (threadIdx.x < 64) {
            unsigned sp = 0;
            while ((unsigned)__builtin_amdgcn_readfirstlane(__hip_atomic_load(tilecnt + 16 * u.pm, __ATOMIC_RELAXED, __HIP_MEMORY_SCOPE_AGENT)) < 32u) { __builtin_amdgcn_s_sleep(2); if (++sp > (1u << 22)) break; }
            __builtin_amdgcn_fence(__ATOMIC_ACQUIRE, "agent");
            asm volatile("s_waitcnt vmcnt(0)" ::: "memory");
        }
        asm volatile("" ::: "memory"); __builtin_amdgcn_s_barrier(); asm volatile("" ::: "memory");
    }
};
}

constexpr int MOE_TSTART = XTRA_OFF, MOE_CNTL = XTRA_OFF + 256, MOE_ROWTAB = XTRA_OFF + 512;
static_assert(MOE_ROWTAB + 8192 <= LDS_BYTES, "moe lds");
constexpr int Q_SLOT = MOE_ROWTAB + 8192;
static_assert(Q_SLOT + 16 <= LDS_BYTES, "queue slot");
__device__ __forceinline__ void moe_tstart(const Frame& F, const int* cnt) {
    LAS int* tstart = (LAS int*)(F.lds + MOE_TSTART); LAS int* cntl = (LAS int*)(F.lds + MOE_CNTL);
    if (F.tid < 64) { const int l = F.tid; const int c = l < NE ? cnt[l * 32] : 0; const int nt = (c + 255) >> 8; int inc = nt;
#pragma unroll
        for (int o = 1; o < 32; o <<= 1) { const int v = __shfl_up(inc, o); if ((l & 31) >= o) inc += v; }
        if (l < NE) { tstart[l] = inc - nt; cntl[l] = c; } if (l == NE - 1) tstart[NE] = inc; }
    __syncthreads();
}
__device__ __forceinline__ void moe_rowtab(const Frame& F, const pg8::MoeOrder& S) {
    LAS int* rowtab = (LAS int*)(F.lds + MOE_ROWTAB);
    for (int i = 0; i < 8; ++i) { pg8::Unit u; if (!S.next(i, u)) break; if (F.tid < 256) rowtab[i * 256 + F.tid] = F.tid < u.nrow ? S.lt[(size_t)u.e * T + u.li0 + F.tid] : 0; }
    asm volatile("s_waitcnt vmcnt(0) lgkmcnt(0)" ::: "memory"); __syncthreads();
}

__device__ __forceinline__ void router_chunk(const Frame& F, KArgsP args, int* cnt, int ch) {
    unsigned char* ws = args->ws; const int lane = plane();
    const bf16_t* x1b = (const bf16_t*)(ws + wsm::x1b); const bf16_t* wr_t = (const bf16_t*)(ws + wsm::wr_t); const float* ssq1p = (const float*)(ws + wsm::ssq1p);
    float* r2v = (float*)(ws + wsm::r2); int* lt = (int*)(ws + wsm::lt); float* lw = (float*)(ws + wsm::lw); float* lr = (float*)(ws + wsm::lr);
    int* tokE = (int*)(ws + wsm::tokE); int* tokPos = (int*)(ws + wsm::tokPos);
    const float* b_rg = args->in[18]; const float* b_re = args->in[20];
    LAS float* lg = (LAS float*)F.lds;
    {
            const int tok0 = ch * 64, mt = F.wave & 3, kh = F.wave >> 2;
            f32x4 acc[3];
#pragma unroll
            for (int n = 0; n < 3; ++n) acc[n] = (f32x4){0.f, 0.f, 0.f, 0.f};
            const bf16_t* ap = x1b + (size_t)(tok0 + 16 * mt + (lane & 15)) * D + 512 * kh + 8 * (lane >> 4);
            const bf16_t* bp = wr_t + (size_t)(lane & 15) * D + 512 * kh + 8 * (lane >> 4);
            bf16x8 afv[16];
#pragma unroll
            for (int ks = 0; ks < 16; ++ks) afv[ks] = *(const bf16x8*)(ap + 32 * ks);
#pragma unroll
            for (int ks = 0; ks < 16; ++ks) { const bf16x8 af = afv[ks];
#pragma unroll
                for (int n = 0; n < 3; ++n) { const bf16x8 bf = *(const bf16x8*)(bp + (size_t)16 * n * D + 32 * ks); acc[n] = __builtin_amdgcn_mfma_f32_16x16x32_bf16(af, bf, acc[n], 0, 0, 0); } }
#pragma unroll
            for (int n = 0; n < 3; ++n)
#pragma unroll
                for (int r = 0; r < 4; ++r) lg[(kh * 64 + 16 * mt + (lane >> 4) * 4 + r) * 48 + 16 * n + (lane & 15)] = acc[n][r];
            __syncthreads();
            if (F.tid < 64) {
                const int t = tok0 + F.tid; float s = 0.f;
#pragma unroll
                for (int pq = 0; pq < 16; ++pq) s += ssq1p[(size_t)pq * T + t];
                const float r2 = rsqrtf(s * (1.f / D) + EPS); r2v[t] = r2;
                const LAS float* l0 = lg + F.tid * 48; const LAS float* l1 = lg + (64 + F.tid) * 48;
                float gm = -1e30f; int gt = 0; float gl[4];
#pragma unroll
                for (int jx = 0; jx < 4; ++jx) { gl[jx] = (l0[jx] + l1[jx]) * r2 + b_rg[jx]; if (gl[jx] > gm) { gm = gl[jx]; gt = jx; } }
                float gs = 0.f;
#pragma unroll
                for (int jx = 0; jx < 4; ++jx) gs += expf(gl[jx] - gm);
                const float gp = 1.f / gs;
                float m1 = -1e30f, m2 = -1e30f; int i1 = 0, i2 = 0;
#pragma unroll
                for (int jx = 0; jx < 8; ++jx) { const float v = (l0[4 + gt * 8 + jx] + l1[4 + gt * 8 + jx]) * r2 + b_re[gt * 8 + jx];
                    if (v > m1) { m2 = m1; i2 = i1; m1 = v; i1 = jx; } else if (v > m2) { m2 = v; i2 = jx; } }
                const float e2 = expf(m2 - m1), w1 = gp / (1.f + e2), w2 = gp * e2 / (1.f + e2);
                const int E1 = gt * 8 + i1, E2 = gt * 8 + i2;
                LAS int* hist = (LAS int*)(F.lds + 32768); LAS int* base = hist + 32;
                if (F.tid < 32) hist[F.tid] = 0;
                asm volatile("s_waitcnt lgkmcnt(0)" ::: "memory");
                const int q1 = __hip_atomic_fetch_add(hist + E1, 1, __ATOMIC_RELAXED, __HIP_MEMORY_SCOPE_WORKGROUP), q2 = __hip_atomic_fetch_add(hist + E2, 1, __ATOMIC_RELAXED, __HIP_MEMORY_SCOPE_WORKGROUP);
                asm volatile("s_waitcnt lgkmcnt(0)" ::: "memory");
                if (F.tid < 32) { const int hc = hist[F.tid]; base[F.tid] = hc > 0 ? atomicAdd(&cnt[F.tid * 32], hc) : 0; }
                asm volatile("s_waitcnt vmcnt(0) lgkmcnt(0)" ::: "memory");
                const int p1 = base[E1] + q1, p2 = base[E2] + q2;
                lt[(size_t)E1 * T + p1] = t; lw[(size_t)E1 * T + p1] = w1; lr[(size_t)E1 * T + p1] = r2;
                lt[(size_t)E2 * T + p2] = t; lw[(size_t)E2 * T + p2] = w2; lr[(size_t)E2 * T + p2] = r2;
                tokE[t * 2] = E1; tokPos[t * 2] = p1; tokE[t * 2 + 1] = E2; tokPos[t * 2 + 1] = p2;
            }
            __syncthreads();
    }
}

__device__ __forceinline__ void final_rows(const Frame& F, KArgsP args, int row0, int nrow) {
    unsigned char* ws = args->ws; const int lane = plane();
    const float* ssq3p = (const float*)(ws + wsm::ssq3p); const float* gfin = args->in[27]; float* X = args->out; const bf16_t* x3b = (const bf16_t*)(ws + wsm::x3b);
    f32x4 gv[4];
#pragma unroll
    for (int jx = 0; jx < 2; ++jx) { gv[2 * jx] = ((const f32x4*)gfin)[2 * (lane + 64 * jx)]; gv[2 * jx + 1] = ((const f32x4*)gfin)[2 * (lane + 64 * jx) + 1]; }
    for (int tb = row0 + F.wave; tb < row0 + nrow; tb += 4 * NWAVES) {
        float sv[4]; u32x4 w[4][2];
#pragma unroll
        for (int k = 0; k < 4; ++k) { const int t = (tb + k * NWAVES) < row0 + nrow ? tb + k * NWAVES : tb; sv[k] = lane < 16 ? ssq3p[(size_t)lane * T + t] : 0.f;
            const u32x4* xr = (const u32x4*)(x3b + (size_t)t * D) + lane; w[k][0] = xr[0]; w[k][1] = xr[64]; }
#pragma unroll
        for (int k = 0; k < 4; ++k) { const int t = tb + k * NWAVES; if (t < row0 + nrow) {
            const float r3 = rsqrtf(wsum(sv[k]) * (1.f / D) + EPS); f32x4* orow = (f32x4*)(X + (size_t)t * D);
#pragma unroll
            for (int jx = 0; jx < 2; ++jx) { const u32x4 ww = w[k][jx];
                orow[2 * (lane + 64 * jx)] = (f32x4){bflo(ww.x), bfhi(ww.x), bflo(ww.y), bfhi(ww.y)} * r3 * gv[2 * jx];
                orow[2 * (lane + 64 * jx) + 1] = (f32x4){bflo(ww.z), bfhi(ww.z), bflo(ww.w), bfhi(ww.w)} * r3 * gv[2 * jx + 1]; } } }
    }
}
__device__ __forceinline__ void panel_sync(const Frame& F, gu32* cw) {
    asm volatile("s_waitcnt vmcnt(0)" ::: "memory");
    __syncthreads();
    if (F.tid == 0) {
        (void)__hip_atomic_fetch_add(cw, 1u, __ATOMIC_RELAXED, __HIP_MEMORY_SCOPE_AGENT);
        unsigned sp = 0; while (__hip_atomic_load(cw, __ATOMIC_RELAXED, __HIP_MEMORY_SCOPE_AGENT) < 4u) { __builtin_amdgcn_s_sleep(2); if (++sp > (1u << 22)) break; }
        __builtin_amdgcn_fence(__ATOMIC_ACQUIRE, "agent"); asm volatile("s_waitcnt vmcnt(0)" ::: "memory");
    }
    __syncthreads();
}

__global__ void __launch_bounds__(NTHR, 2) mk_fwd(Args) {
    const KArgsP args0 = kargs();
    extern __shared__ __attribute__((aligned(16))) unsigned char lds_raw[];
    Frame F; F.lds = (LAS unsigned char*)lds_raw; F.MISC = (volatile LAS unsigned*)(F.lds + MISC_OFF);
    F.tid = threadIdx.x; F.lane = F.tid & 63; F.wave = __builtin_amdgcn_readfirstlane(F.tid >> 6);
    F.G = gridDim.x; { const int bx = blockIdx.x; F.vcu = (F.G % 8 == 0) ? (bx % 8) * (F.G / 8) + bx / 8 : bx; }
    unsigned char* ws = args0->ws; F.ctl = (gu32*)(ws + wsm::ctl);
    for (int u = F.tid; u < (LDS_BYTES - LDSCTL_OFF) / 4; u += NTHR) ((LAS unsigned*)(F.lds + LDSCTL_OFF))[u] = 0u;
    __syncthreads();
    const int lo = args0->ph_lo, hi = args0->ph_hi;
    XcdBarrier bar = xcd_barrier_post((unsigned*)(F.ctl + CW_BAR) + (args0->mode >> 8) * XCD_BAR_WORDS, F.MISC + 8);
    int* cnt = (int*)(F.ctl + CW_CNT);
    const LAS int* tstart = (const LAS int*)(F.lds + MOE_TSTART); const LAS int* cntl = (const LAS int*)(F.lds + MOE_CNTL); const LAS int* rowtab = (const LAS int*)(F.lds + MOE_ROWTAB);
    const int gw = F.vcu * NWAVES + F.wave, NGW = F.G * NWAVES;
#ifndef PHASE_MASK
#define PHASE_MASK 0x7ffu
#endif
#define IN(k) ((((PHASE_MASK) >> (k)) & 1u) && lo <= (k) && (k) < hi)
#ifdef MK_STAMPS
    unsigned long long* tsg = (unsigned long long*)(F.ctl + 14336);
#define STAMP(k) do { if (blockIdx.x == MK_STAMP_BLK && F.tid == 0) tsg[k] = __builtin_amdgcn_s_memrealtime(); } while (0)
#else
#define STAMP(k) do { } while (0)
#endif
#define GRID_BAR(k) do { if (IN(k) && IN((k) + 1)) xcd_barrier(bar); STAMP((k) + 1); } while (0)
#define GRID_BAR_PF(k, p, pitch) do { if (IN(k) && IN((k) + 1)) xcd_barrier(bar, (const char*)(p), (pitch)); STAMP((k) + 1); } while (0)
    STAMP(0);
    size_t slice_off = 0;
    if (F.G == 256) { pg8::DenseOrder So; So.init(nullptr, nullptr, T, D, D, F.G, (int)blockIdx.x); pg8::Unit uo; So.next(0, uo); slice_off = ((size_t)uo.pm * 256 + 64 * uo.pn) * D * 2; }
    const bool fused = (F.G == 256) && lo == 0 && hi == 11;
    const bool early_down = (F.G == 256) && lo <= 1 && hi >= 8;
    const bool merged = lo <= 5 && hi >= 8;
    if (IN(0)) { const KArgsP args = kargs(); p0_prologue(F, args); __syncthreads(); }
    GRID_BAR(0);
    if (IN(1)) { const KArgsP args = kargs();
        { pg8::DenseOrder S; S.init((const bf16_t*)(ws + wsm::xb), (const bf16_t*)(ws + wsm::w_in_t), T, NPROJ, D, F.G, (int)blockIdx.x);
#ifdef MK_STAMPS
          if (MK_STAMP_WHO == 11) S.tsg = tsg;
#endif
          pg8::EpiScaleBf16 E{(bf16_t*)(ws + wsm::projb), (const float*)(ws + wsm::r0), NPROJ, 0};
          STAMP(24); pg8::gemm_phase<pg8::EpiScaleBf16, pg8::DenseOrder, true, false>(F.lds, D, S, E); STAMP(25);
          if (early_down) { pg8::Unit u; const int nsp = 2 * F.G - (T / 256) * (NPROJ / 256);
              if (!S.next(1, u)) p0_experts(F, args, ((int)blockIdx.x - (F.G - nsp)) * NWAVES + F.wave, nsp * NWAVES, 2, 0, DOWN_SPLIT);
              else p0_experts(F, args, (int)blockIdx.x * NWAVES + F.wave, (F.G - nsp) * NWAVES, 2, DOWN_SPLIT, 1 << 30);
              __syncthreads(); } }
        { pg8::DenseOrder S; S.init((const bf16_t*)(ws + wsm::pb), (const bf16_t*)(ws + wsm::w_pp_t), T, D, PLE, F.G, (int)blockIdx.x);
          pg8::EpiPpQ E{(unsigned char*)(ws + wsm::pp)};
          pg8::gemm_phase<pg8::EpiPpQ, pg8::DenseOrder, true, false>(F.lds, PLE, S, E); STAMP(26); }
    }
    GRID_BAR(1);
    if (IN(2)) { const KArgsP args = kargs();
        if (F.G >= 256 && P2_QUEUE) {
            gu32* qc = F.ctl + CW_Q2; volatile LAS int* slot = (volatile LAS int*)(F.lds + Q_SLOT);
            constexpr int NQ = 256 + 1024;
            if (F.tid == 0) slot[0] = (int)__hip_atomic_fetch_add(qc, 1u, __ATOMIC_RELAXED, __HIP_MEMORY_SCOPE_AGENT);
            __syncthreads();
            int cur = __builtin_amdgcn_readfirstlane(slot[0]);
            while (cur < NQ) {
                unsigned nx = 0; if (F.tid == 0) nx = __hip_atomic_fetch_add(qc, 1u, __ATOMIC_RELAXED, __HIP_MEMORY_SCOPE_AGENT);
                if (cur < 256) lruA_unit(F, args, cur >> 6, (cur >> 3) & 7, cur & 7);
                else { const int k = cur - 256, h = k >> 1;
                    if ((k & 1) == 0) attn_unit(F, args, h >> 7, h & 127);
                    else p0_experts_chunk(F, args, h); }
                __syncthreads();
                if (F.tid == 0) slot[0] = (int)nx;
                __syncthreads();
                cur = __builtin_amdgcn_readfirstlane(slot[0]);
            }
        } else {
        const bool conv_first = (F.G >= 256) && (blockIdx.x & 1);
        if (conv_first) { p0_experts(F, args, gw, NGW, 1); __syncthreads(); }
        for (int it = blockIdx.x; it < 256 + 512; it += F.G) {
            if (it < 256) lruA_unit(F, args, it >> 6, (it >> 3) & 7, it & 7);
            else { const int u = it - 256; attn_unit(F, args, u >> 7, u & 127); }
        }
        if (F.G >= 256 && !conv_first) p0_experts(F, args, gw, NGW, 1);
        }
    }
    if (fused) GRID_BAR_PF(2, ws + wsm::xb + slice_off, 512); else GRID_BAR(2);
    if (IN(3)) { const KArgsP args = kargs();
        for (int it = blockIdx.x; it < T / 64; it += F.G) lru_finish(F, args, it >> 6, it & 63);
    }
    GRID_BAR(3);
    if (IN(4)) { const KArgsP args = kargs();
        pg8::DenseOrder S; S.init((const bf16_t*)(ws + wsm::mix), (const bf16_t*)(ws + wsm::w_out_t), T, D, D, F.G, (int)blockIdx.x);
#ifdef MK_STAMPS
          if (MK_STAMP_WHO == 14) S.tsg = tsg;
#endif
        pg8::EpiOutProj E{(const bf16_t*)(ws + wsm::xb), (bf16_t*)(ws + wsm::x1b), (float*)(ws + wsm::ssq1p), (unsigned char*)(ws + wsm::x1q)};
        pg8::gemm_phase<pg8::EpiOutProj, pg8::DenseOrder, true, false>(F.lds, D, S, E);
        STAMP(27); if (fused) { pg8::Unit u; S.next(0, u); panel_sync(F, F.ctl + CW_PANA + 32 * u.pm); STAMP(28); router_chunk(F, args, cnt, 4 * u.pm + u.pn); STAMP(29); }
    }
    if (!fused) GRID_BAR(4);
    if (IN(5) && !fused) { const KArgsP args = kargs();
        for (int ch = F.vcu; ch < T / 64; ch += F.G) router_chunk(F, args, cnt, ch);
        if (merged && F.G >= 256 && !early_down) p0_experts(F, args, gw, NGW, 2);
    }
    GRID_BAR(5);
    if (IN(6)) { const KArgsP args = kargs();
        STAMP(20); moe_tstart(F, cnt);
        pg8::MoeOrder S{tstart, cntl, rowtab, (const int*)(ws + wsm::lt), (const char*)(ws + wsm::x1q), (const char*)(ws + wsm::wgu_t), (size_t)1024 * D, D / 2, D / 2, D / 2, F.G, F.vcu, 1, merged ? F.ctl + CW_TILE : nullptr, nullptr};
        moe_rowtab(F, S); STAMP(21);
#ifdef MK_STAMPS
        S.tsg = tsg;
#endif
        pg8::EpiMoe1 E{(unsigned char*)(ws + wsm::hid), (const float*)(ws + wsm::lw), (const float*)(ws + wsm::lr)};
        pg8::gemm_phase<pg8::EpiMoe1, pg8::MoeOrder, true, true, 2>(F.lds, D / 2, S, E); STAMP(22);
        const int U = 4 * __builtin_amdgcn_readfirstlane(tstart[NE]), nfull = U / F.G, Ex = U - nfull * F.G;
        if (merged) {
            pg8::Moe2Order S2{tstart, (const char*)(ws + wsm::hid), (const char*)(ws + wsm::wd_t), (size_t)D * FF, F.ctl + CW_TILE, FF / 2, FF / 2, FF / 2, F.G, F.vcu, Ex, F.G - Ex, U, nullptr};
            pg8::EpiY E2{(unsigned char*)args->out, YQ_SCALE / (WQ_SCALE * HQ_SCALE), 0};
#ifdef MK_STAMPS
            if (MK_STAMP_WHO == 2) S2.tsg = tsg;
#endif
            pg8::gemm_phase<pg8::EpiY, pg8::Moe2Order, true, false, MOE2_MMA>(F.lds, FF / 2, S2, E2); STAMP(23);
        } else if (F.G >= 256 && F.vcu >= Ex) p0_experts(F, args, (F.vcu - Ex) * NWAVES + F.wave, (F.G - Ex) * NWAVES, 2);
    }
    GRID_BAR(6);
    if (IN(7) && !merged) { const KArgsP args = kargs();
        moe_tstart(F, cnt);
        pg8::MoeOrder S{tstart, cntl, rowtab, nullptr, (const char*)(ws + wsm::hid), (const char*)(ws + wsm::wd_t), (size_t)D * FF, FF / 2, FF / 2, FF / 2, F.G, F.vcu, 0, nullptr, nullptr};
        pg8::EpiY E{(unsigned char*)args->out, YQ_SCALE / (WQ_SCALE * HQ_SCALE), 0};
        pg8::gemm_phase<pg8::EpiY, pg8::MoeOrder, true, false, MOE_MMA>(F.lds, FF / 2, S, E);
    }
    if (!merged) GRID_BAR(7);
    if (IN(8)) { const KArgsP args = kargs();
        moe_tstart(F, cnt);
        const unsigned char* y = (const unsigned char*)args->out; const bf16_t* x1b = (const bf16_t*)(ws + wsm::x1b); bf16_t* x2b = (bf16_t*)(ws + wsm::x2b); float* rP = (float*)(ws + wsm::rP); unsigned char* x2q = (unsigned char*)(ws + wsm::x2q);
        const int* tokE = (const int*)(ws + wsm::tokE); const int* tokPos = (const int*)(ws + wsm::tokPos);
        constexpr float iy = 1.f / YQ_SCALE; const int lane = plane();
        for (int t0 = gw; t0 < T; t0 += 4 * NGW) {
            u32x4 xw[4][2]; u32x2 a2[4][2], b2[4][2];
#pragma unroll
            for (int k = 0; k < 4; ++k) { const int t = (t0 + k * NGW) < T ? t0 + k * NGW : t0;
                const size_t s1 = (size_t)tstart[tokE[2 * t]] * 256 + tokPos[2 * t], s2 = (size_t)tstart[tokE[2 * t + 1]] * 256 + tokPos[2 * t + 1];
                const u32x4* xr = (const u32x4*)(x1b + (size_t)t * D) + lane; const u32x2* ya = (const u32x2*)(y + s1 * D) + lane; const u32x2* yb = (const u32x2*)(y + s2 * D) + lane;
#pragma unroll
                for (int jx = 0; jx < 2; ++jx) { xw[k][jx] = xr[64 * jx]; a2[k][jx] = ya[64 * jx]; b2[k][jx] = yb[64 * jx]; } }
#pragma unroll
            for (int k = 0; k < 4; ++k) { const int t = t0 + k * NGW; if (t < T) {
                u32x4* ob = (u32x4*)(x2b + (size_t)t * D) + lane; float s = 0.f;
#pragma unroll
                for (int jx = 0; jx < 2; ++jx) { const u32x4 x4 = xw[k][jx]; const u32x2 ay = a2[k][jx], by = b2[k][jx];
                    const f32x2 a01 = __builtin_amdgcn_cvt_pk_f32_fp8((int)ay.x, false), a23 = __builtin_amdgcn_cvt_pk_f32_fp8((int)ay.x, true), a45 = __builtin_amdgcn_cvt_pk_f32_fp8((int)ay.y, false), a67 = __builtin_amdgcn_cvt_pk_f32_fp8((int)ay.y, true);
                    const f32x2 b01 = __builtin_amdgcn_cvt_pk_f32_fp8((int)by.x, false), b23 = __builtin_amdgcn_cvt_pk_f32_fp8((int)by.x, true), b45 = __builtin_amdgcn_cvt_pk_f32_fp8((int)by.y, false), b67 = __builtin_amdgcn_cvt_pk_f32_fp8((int)by.y, true);
                    float v[8] = {bflo(x4.x) + (a01.x + b01.x) * iy, bfhi(x4.x) + (a01.y + b01.y) * iy, bflo(x4.y) + (a23.x + b23.x) * iy, bfhi(x4.y) + (a23.y + b23.y) * iy,
                                  bflo(x4.z) + (a45.x + b45.x) * iy, bfhi(x4.z) + (a45.y + b45.y) * iy, bflo(x4.w) + (a67.x + b67.x) * iy, bfhi(x4.w) + (a67.y + b67.y) * iy};
                    ob[64 * jx] = (u32x4){pk2(v[0], v[1]), pk2(v[2], v[3]), pk2(v[4], v[5]), pk2(v[6], v[7])};
                    ((u32x2*)(x2q + (size_t)t * D))[lane + 64 * jx] = (u32x2){pk4_fp8(v[0], v[1], v[2], v[3]), pk4_fp8(v[4], v[5], v[6], v[7])};
                    s += (v[0] * v[0] + v[1] * v[1]) + (v[2] * v[2] + v[3] * v[3]) + (v[4] * v[4] + v[5] * v[5]) + (v[6] * v[6] + v[7] * v[7]); }
                s = wsum(s);
                if (lane == 0) rP[t] = rsqrtf(s * (1.f / D) + EPS); } }
        }
    }
    GRID_BAR(8);
    if (IN(9)) { const KArgsP args = kargs();
        pg8::DenseOrder S; S.init((const bf16_t*)(ws + wsm::x2q), (const bf16_t*)(ws + wsm::w_pg_t), T, D, D / 2, F.G, (int)blockIdx.x);
#ifdef MK_STAMPS
          if (MK_STAMP_WHO == 19) S.tsg = tsg;
#endif
        if (fused) { pg8::EpiPleFin E{ws, args->in[27], args->out, F.ctl + CW_PANB}; pg8::gemm_phase<pg8::EpiPleFin, pg8::DenseOrder, true, false, PLE_MMA>(F.lds, D / 2, S, E); }
        else { pg8::EpiPle E{ws}; pg8::gemm_phase<pg8::EpiPle, pg8::DenseOrder, true, false, PLE_MMA>(F.lds, D / 2, S, E); }
    }
    if (!fused) GRID_BAR(9);
    if (IN(10) && !fused) { const KArgsP args = kargs();
        for (int r0 = F.vcu * 64; r0 < T; r0 += F.G * 64) final_rows(F, args, r0, 64);
    }
#ifdef MK_XBAR
    for (int i = 0; i < MK_XBAR; ++i) xcd_barrier(bar);
#endif
    STAMP(11);
#undef IN
#undef GRID_BAR
}
}

#ifndef MK_ONE_LAUNCH
#define MK_ONE_LAUNCH 1
#endif
#ifdef MK_STAMPS
__global__ void k_delay(const unsigned long long* ts, int k) {
    if (threadIdx.x == 0) { const int ka = k < 100 ? k : k / 100, kb = k < 100 ? k + 1 : k % 100; const unsigned long long d = (ts[kb] - ts[ka]) * 8ull, t0 = __builtin_amdgcn_s_memrealtime(); while (__builtin_amdgcn_s_memrealtime() - t0 < d) __builtin_amdgcn_s_sleep(8); }
}
#endif
extern "C" void kernel_launch(void* const* d_in, const int* in_sizes, int n_in, void* d_out, int out_size, void* d_ws, size_t ws_size, hipStream_t stream) {
    using namespace mk;
    const size_t MB = 1u << 20, KB = 1024;
    const size_t WS_END = wsm::END;
    static int grid = 0;
    if (grid == 0) {
        if (ws_size < WS_END || n_in != 28 || out_size != T * D) { fprintf(stderr, "kernel_launch: ws %zu < %zu or n_in %d or out %d\n", ws_size, (size_t)WS_END, n_in, out_size); grid = -1; return; }
        int dev = 0, cus = 0;
        if (hipGetDevice(&dev) != hipSuccess || hipDeviceGetAttribute(&cus, hipDeviceAttributeMultiprocessorCount, dev) != hipSuccess) { grid = -1; return; }
        if (hipFuncSetAttribute((const void*)mk_fwd, hipFuncAttributeMaxDynamicSharedMemorySize, LDS_BYTES) != hipSuccess) { fprintf(stderr, "hipFuncSetAttribute failed\n"); grid = -1; return; }
        grid = cus;
    }
    if (grid < 0) return;
    Args a{};
    for (int i = 0; i < 28; ++i) a.in[i] = (const float*)d_in[i];
    a.out = (float*)d_out; a.ws = (unsigned char*)d_ws;
    (void)hipMemsetAsync((char*)d_ws + wsm::ctl, 0, CTL_ZERO_BYTES, stream);
#if MK_ONE_LAUNCH
#ifdef MK_CUT
    a.ph_lo = 0; a.ph_hi = MK_CUT; hipLaunchKernelGGL(mk_fwd, dim3(grid), dim3(NTHR), LDS_BYTES, stream, a);
    a.ph_lo = MK_CUT; a.ph_hi = 11; a.mode = 256; hipLaunchKernelGGL(mk_fwd, dim3(grid), dim3(NTHR), LDS_BYTES, stream, a);
#else
    a.ph_lo = 0; a.ph_hi = 11; hipLaunchKernelGGL(mk_fwd, dim3(grid), dim3(NTHR), LDS_BYTES, stream, a);
#endif
#ifdef MK_STAMPS
    if (MK_STAMPS >= 0) k_delay<<<1, 64, 0, stream>>>((const unsigned long long*)((char*)d_ws + wsm::ctl + 14336 * 4), MK_STAMPS);
#endif
#ifdef MK_EXTRA
    a.out = (float*)((char*)d_ws + 16 * MB); a.ph_lo = MK_EXTRA; a.ph_hi = MK_EXTRA + 1;
#ifdef MK_MODE
    a.mode = MK_MODE;
#endif
    hipLaunchKernelGGL(mk_fwd, dim3(grid), dim3(NTHR), LDS_BYTES, stream, a);
#endif
#else
    for (int ph = 0; ph < 11; ++ph) { a.ph_lo = ph; a.ph_hi = ph + 1; hipLaunchKernelGGL(mk_fwd, dim3(grid), dim3(NTHR), LDS_BYTES, stream, a); }
#endif
}
```
